# Optimizing an MI355X kernel written in HIP

```python
import math
import jax, jax.numpy as jnp
from jax import lax
import numpy as np


D_MODEL = 1024
BATCH = 32
SEQ = 2048
DEPTH = 2

HEAD_DIM = D_MODEL // 16
MIX_WIDTH = D_MODEL // 2
FOX_HEADS = MIX_WIDTH // HEAD_DIM
SWA_Q_HEADS = MIX_WIDTH // HEAD_DIM
SWA_KV_HEADS = 2
SWA_WINDOW = 128
MLSTM_HEADS = 4
MLSTM_HEAD_DIM = MIX_WIDTH // MLSTM_HEADS
CONV_WIDTH = 4
D_FF = 4 * D_MODEL
N_BRANCHES = 3
BLOCK = 128
ROPE_THETA = 10000.0
EPS = 1e-6

IN_SPLITS = (
    MIX_WIDTH, MIX_WIDTH, MIX_WIDTH, FOX_HEADS,
    SWA_Q_HEADS * HEAD_DIM, SWA_KV_HEADS * HEAD_DIM, SWA_KV_HEADS * HEAD_DIM,
    MIX_WIDTH, MIX_WIDTH, MIX_WIDTH, MLSTM_HEADS, MLSTM_HEADS, MIX_WIDTH,
    N_BRANCHES * D_MODEL,
)
IN_WIDTH = sum(IN_SPLITS)

kernel_name = 'hybrid_fox_swa_mlstm_block'


def _rmsnorm(x, g):
    xf = x.astype(jnp.float32)
    y = xf * lax.rsqrt(jnp.mean(xf * xf, axis=-1, keepdims=True) + EPS)
    return (y * g.astype(jnp.float32)).astype(x.dtype)


def _rope_tables(seq, dim):
    inv = ROPE_THETA ** (-jnp.arange(0, dim, 2, dtype=jnp.float32) / dim)
    ang = jnp.arange(seq, dtype=jnp.float32)[:, None] * inv[None, :]
    return jnp.cos(ang), jnp.sin(ang)


def _rope(x, cos, sin):
    xf = x.astype(jnp.float32)
    x1, x2 = jnp.split(xf, 2, axis=-1)
    c = cos[None, :, None, :]
    s = sin[None, :, None, :]
    return jnp.concatenate([x1 * c - x2 * s, x1 * s + x2 * c], axis=-1).astype(x.dtype)


def _fox_attention(q, k, v, f_logit):
    B, S, H, Dh = q.shape
    nb = S // BLOCK
    scale = Dh ** -0.5
    c = jnp.cumsum(jax.nn.log_sigmoid(f_logit.astype(jnp.float32)), axis=1).transpose(0, 2, 1)
    qb = q.reshape(B, nb, BLOCK, H, Dh).transpose(1, 0, 2, 3, 4)
    cb = c.reshape(B, H, nb, BLOCK).transpose(2, 0, 1, 3)
    k_pos = jnp.arange(S)

    def one_block(args):
        i, qi, ci = args
        logits = jnp.einsum('bqhd,bshd->bhqs', qi, k, preferred_element_type=jnp.float32) * scale
        logits = logits + ci[..., :, None] - c[:, :, None, :]
        q_pos = i * BLOCK + jnp.arange(BLOCK)
        mask = k_pos[None, :] <= q_pos[:, None]
        p = jax.nn.softmax(jnp.where(mask, logits, -jnp.inf), axis=-1)
        return jnp.einsum('bhqs,bshd->bqhd', p.astype(v.dtype), v)

    out = lax.map(one_block, (jnp.arange(nb), qb, cb))
    return out.transpose(1, 0, 2, 3, 4).reshape(B, S, H * Dh)


def _swa_sink_attention(q, k, v, sinks):
    B, S, Hq, Dh = q.shape
    Hkv = k.shape[2]
    G = Hq // Hkv
    nb = S // BLOCK
    scale = Dh ** -0.5
    qb = q.reshape(B, nb, BLOCK, Hkv, G, Dh)

    def frame(t):
        tb = t.reshape(B, nb, BLOCK, Hkv, Dh)
        prev = jnp.pad(tb, ((0, 0), (1, 0), (0, 0), (0, 0), (0, 0)))[:, :-1]
        return jnp.concatenate([prev, tb], axis=2)

    kf, vf = frame(k), frame(v)
    logits = jnp.einsum('bnqhgd,bnkhd->bnhgqk', qb, kf, preferred_element_type=jnp.float32) * scale
    q_pos = jnp.arange(nb)[:, None, None] * BLOCK + jnp.arange(BLOCK)[None, :, None]
    k_pos = jnp.arange(nb)[:, None, None] * BLOCK - BLOCK + jnp.arange(2 * BLOCK)[None, None, :]
    mask = (k_pos <= q_pos) & (k_pos > q_pos - SWA_WINDOW) & (k_pos >= 0)
    logits = jnp.where(mask[None, :, None, None], logits, -jnp.inf)
    sink = jnp.broadcast_to(sinks.astype(jnp.float32).reshape(1, 1, Hkv, G, 1, 1), logits.shape[:-1] + (1,))
    p = jax.nn.softmax(jnp.concatenate([logits, sink], axis=-1), axis=-1)[..., :-1]
    out = jnp.einsum('bnhgqk,bnkhd->bnqhgd', p.astype(v.dtype), vf)
    return out.reshape(B, S, Hq * Dh)


def _causal_conv_silu(x, w, b):
    S = x.shape[1]
    W = w.shape[0]
    xp = jnp.pad(x, ((0, 0), (W - 1, 0), (0, 0)))
    y = b
    for j in range(W):
        y = y + xp[:, j:j + S] * w[j]
    return jax.nn.silu(y)


def _mlstm_chunkwise(q, k, v, i_logit, f_logit):
    B, S, H, Dh = q.shape
    L = BLOCK
    nc = S // L
    f32 = jnp.float32

    def chunks(t):
        return t.astype(f32).reshape(B, nc, L, H, -1).transpose(1, 0, 3, 2, 4)

    qc = chunks(q)
    kc = chunks(k) * (Dh ** -0.5)
    vc = chunks(v)
    ic = i_logit.astype(f32).reshape(B, nc, L, H).transpose(1, 0, 3, 2)
    bc = jnp.cumsum(jax.nn.log_sigmoid(f_logit.astype(f32)).reshape(B, nc, L, H).transpose(1, 0, 3, 2), axis=-1)
    causal = jnp.tril(jnp.ones((L, L), dtype=bool))

    def step(carry, xs):
        C, n, m = carry
        qi, ki, vi, ii, bi = xs
        a = bi + m[..., None]
        D = jnp.where(causal, bi[..., :, None] - bi[..., None, :] + ii[..., None, :], -jnp.inf)
        mt = jnp.maximum(a, jnp.max(D, axis=-1))
        w_inter = jnp.exp(a - mt)
        s = jnp.exp(D - mt[..., None]) * jnp.einsum('bhtd,bhsd->bhts', qi, ki)
        num = w_inter[..., None] * jnp.einsum('bhtd,bhde->bhte', qi, C) + jnp.einsum('bhts,bhse->bhte', s, vi)
        den = w_inter * jnp.einsum('bhtd,bhd->bht', qi, n) + jnp.sum(s, axis=-1)
        h = num / jnp.maximum(jnp.abs(den), jnp.exp(-mt))[..., None]
        bL = bi[..., -1]
        g = bL[..., None] - bi + ii
        m_new = jnp.maximum(bL + m, jnp.max(g, axis=-1))
        decay = jnp.exp(bL + m - m_new)
        wk = jnp.exp(g - m_new[..., None])
        C_new = decay[..., None, None] * C + jnp.einsum('bhs,bhsd,bhse->bhde', wk, ki, vi)
        n_new = decay[..., None] * n + jnp.einsum('bhs,bhsd->bhd', wk, ki)
        return (C_new, n_new, m_new), h

    init = (jnp.zeros((B, H, Dh, Dh), f32), jnp.zeros((B, H, Dh), f32), jnp.zeros((B, H), f32))
    _, hs = lax.scan(step, init, (qc, kc, vc, ic, bc))
    return hs.transpose(1, 0, 3, 2, 4).reshape(B, S, H, Dh)


def _hybrid_layer(x, cos, sin, norm_mix, w_in, fox_f_bias, fox_q_norm, fox_k_norm,
                  swa_q_norm, swa_k_norm, swa_sinks, conv_w, conv_b, mlstm_i_bias,
                  mlstm_f_bias, mlstm_out_norm, w_branch, w_out, norm_mlp, w_up, w_down):
    B, S, _ = x.shape
    h = _rmsnorm(x, norm_mix)
    u = jnp.einsum('bsd,de->bse', h, w_in)
    offsets = np.cumsum(IN_SPLITS)[:-1].tolist()
    fq, fk, fv, ff, sq, sk, sv, mq, mk, mv, mi, mf, mo, gl = jnp.split(u, offsets, axis=-1)

    def heads(t, n_heads):
        return t.reshape(B, S, n_heads, -1)

    y_fox = _fox_attention(_rmsnorm(heads(fq, FOX_HEADS), fox_q_norm),
                           _rmsnorm(heads(fk, FOX_HEADS), fox_k_norm),
                           heads(fv, FOX_HEADS), ff + fox_f_bias)
    sq = _rope(_rmsnorm(heads(sq, SWA_Q_HEADS), swa_q_norm), cos, sin)
    sk = _rope(_rmsnorm(heads(sk, SWA_KV_HEADS), swa_k_norm), cos, sin)
    y_swa = _swa_sink_attention(sq, sk, heads(sv, SWA_KV_HEADS), swa_sinks)
    qk = _causal_conv_silu(jnp.concatenate([mq, mk], axis=-1), conv_w, conv_b)
    mq, mk = jnp.split(qk, 2, axis=-1)
    hm = _mlstm_chunkwise(heads(mq, MLSTM_HEADS), heads(mk, MLSTM_HEADS), heads(mv, MLSTM_HEADS),
                          mi + mlstm_i_bias, mf + mlstm_f_bias)
    hm = _rmsnorm(hm, mlstm_out_norm.reshape(MLSTM_HEADS, MLSTM_HEAD_DIM)).reshape(B, S, MIX_WIDTH)
    y_mlstm = (hm * jax.nn.sigmoid(mo.astype(jnp.float32))).astype(x.dtype)

    gates = jax.nn.sigmoid(gl.reshape(B, S, N_BRANCHES, D_MODEL))
    merged = (gates[:, :, 0] * jnp.einsum('bsc,cd->bsd', y_fox, w_branch[0])
              + gates[:, :, 1] * jnp.einsum('bsc,cd->bsd', y_swa, w_branch[1])
              + gates[:, :, 2] * jnp.einsum('bsc,cd->bsd', y_mlstm, w_branch[2]))
    x = x + jnp.einsum('bsd,de->bse', merged, w_out)

    h2 = _rmsnorm(x, norm_mlp)
    act = jnp.square(jax.nn.relu(jnp.einsum('bsd,df->bsf', h2, w_up)))
    return x + jnp.einsum('bsf,fd->bsd', act, w_down)


def setup_inputs(seed: int = 0) -> dict:
    key = jax.random.key(seed)
    ks = jax.random.split(key, 20)
    f32 = jnp.float32
    nrm = lambda k, shape, s: jax.random.normal(k, shape, f32) * s
    gain = lambda k, shape: 1.0 + 0.05 * jax.random.normal(k, shape, f32)
    return {
        'x': nrm(ks[0], (BATCH, SEQ, D_MODEL), 1.0),
        'norm_mix': gain(ks[1], (DEPTH, D_MODEL)),
        'w_in': nrm(ks[2], (DEPTH, D_MODEL, IN_WIDTH), D_MODEL ** -0.5),
        'fox_f_bias': 3.0 + 0.5 * jax.random.normal(ks[3], (DEPTH, FOX_HEADS), f32),
        'fox_q_norm': gain(ks[4], (DEPTH, HEAD_DIM)),
        'fox_k_norm': gain(ks[5], (DEPTH, HEAD_DIM)),
        'swa_q_norm': gain(ks[6], (DEPTH, HEAD_DIM)),
        'swa_k_norm': gain(ks[7], (DEPTH, HEAD_DIM)),
        'swa_sinks': nrm(ks[8], (DEPTH, SWA_Q_HEADS), 0.5),
        'conv_w': nrm(ks[9], (DEPTH, CONV_WIDTH, 2 * MIX_WIDTH), CONV_WIDTH ** -0.5),
        'conv_b': nrm(ks[10], (DEPTH, 2 * MIX_WIDTH), 0.02),
        'mlstm_i_bias': nrm(ks[11], (DEPTH, MLSTM_HEADS), 0.1),
        'mlstm_f_bias': 3.0 + 0.5 * jax.random.normal(ks[12], (DEPTH, MLSTM_HEADS), f32),
        'mlstm_out_norm': gain(ks[13], (DEPTH, MIX_WIDTH)),
        'w_branch': nrm(ks[14], (DEPTH, N_BRANCHES, MIX_WIDTH, D_MODEL), MIX_WIDTH ** -0.5),
        'w_out': nrm(ks[15], (DEPTH, D_MODEL, D_MODEL), D_MODEL ** -0.5),
        'norm_mlp': gain(ks[16], (DEPTH, D_MODEL)),
        'w_up': nrm(ks[17], (DEPTH, D_MODEL, D_FF), D_MODEL ** -0.5),
        'w_down': nrm(ks[18], (DEPTH, D_FF, D_MODEL), D_FF ** -0.5),
    }


def reference(x, norm_mix, w_in, fox_f_bias, fox_q_norm, fox_k_norm, swa_q_norm, swa_k_norm,
              swa_sinks, conv_w, conv_b, mlstm_i_bias, mlstm_f_bias, mlstm_out_norm, w_branch,
              w_out, norm_mlp, w_up, w_down):
    S = x.shape[1]
    cos, sin = _rope_tables(S, HEAD_DIM)
    for l in range(DEPTH):
        x = _hybrid_layer(x, cos, sin, norm_mix[l], w_in[l], fox_f_bias[l], fox_q_norm[l],
                          fox_k_norm[l], swa_q_norm[l], swa_k_norm[l], swa_sinks[l], conv_w[l],
                          conv_b[l], mlstm_i_bias[l], mlstm_f_bias[l], mlstm_out_norm[l],
                          w_branch[l], w_out[l], norm_mlp[l], w_up[l], w_down[l])
    return x
```

```cpp
#include <hip/hip_runtime.h>
#include <hip/hip_cooperative_groups.h>
#include <cstdio>
#include <cstdint>
#include <cmath>
namespace cg = cooperative_groups;
namespace pg8 {
#define PG8_LAS __attribute__((address_space(3)))
typedef unsigned short bf16_t;
typedef short bf16x8 __attribute__((ext_vector_type(8)));
typedef float f32x4 __attribute__((ext_vector_type(4)));
typedef unsigned u32x4 __attribute__((ext_vector_type(4)));
constexpr int BM = 256, BK = 64, HALF = 128, HTB = HALF * BK * 2  , STAGE_BYTES = 8 * HTB, NXCD = 8, WGM = 8;

__host__ __device__ __forceinline__ int lds_byte(int r, int c) { const int st = (r >> 4) * 2 + (c >> 5), rr = r & 15, cc = c & 31, ob = rr * 64 + cc * 2; return st * 1024 + (ob ^ (((ob >> 9) & 1) << 5)); }
__host__ __device__ __forceinline__ void stage_rc(int b, int& R, int& C) { const int st = b / 1024, sb = b % 1024, swz = sb ^ (((sb >> 9) & 1) << 5); R = (st >> 1) * 16 + swz / 64; C = (st & 1) * 32 + (swz % 64) / 2; }
__host__ __device__ __forceinline__ int perm32(int rho) { const int n = rho >> 4, i = rho & 15; return 8 * (i >> 2) + 4 * n + (i & 3); }

struct Unit { int pm, pn; };
struct Gemm { const bf16_t* A; const bf16_t* Bt; int M, N, K; };

struct StaticOrder {
    int nM, nN, nwg, G, c;
    __host__ __device__ void init(int M, int N, int G_, int c_) { nM = M / BM; nN = N / BM; nwg = nM * nN; G = G_; c = c_; }
    __host__ __device__ bool next(int i, Unit& u) const {
        const long L = (long)i * G + c; if (L >= nwg) return false;
        int wgid = (int)L; { const int q = nwg / NXCD, r = nwg % NXCD, xcd = wgid % NXCD, off = wgid / NXCD; wgid = (xcd < r ? xcd * (q + 1) : r * (q + 1) + (xcd - r) * q) + off; }
        const int nig = WGM * nN, gid = wgid / nig, fm = gid * WGM, gsz = (nM - fm) < WGM ? (nM - fm) : WGM;
        u.pm = fm + ((wgid % nig) % gsz); u.pn = (wgid % nig) / gsz; return true;
    }
    __device__ __forceinline__ void a_ready(const Unit&) const {}
    __device__ __forceinline__ void done(const Unit&) const {}
};


typedef unsigned u32x2 __attribute__((ext_vector_type(2)));
typedef float f32x2_t __attribute__((ext_vector_type(2)));
typedef __bf16 bf16x2_t __attribute__((ext_vector_type(2)));
__device__ __forceinline__ unsigned pk2(float lo, float hi) { f32x2_t v = {lo, hi}; bf16x2_t b = __builtin_convertvector(v, bf16x2_t); return __builtin_bit_cast(unsigned, b); }
__device__ __forceinline__ float bflo(unsigned w) { return __uint_as_float(w << 16); }
__device__ __forceinline__ float bfhi(unsigned w) { return __uint_as_float(w & 0xffff0000u); }
__device__ __forceinline__ float sigm(float x) { return __builtin_amdgcn_rcpf(1.f + __expf(-x)); }
__device__ __forceinline__ float rowscale(const float* rs, int row) {
    const f32x4* p = (const f32x4*)(rs + (size_t)row * 16);
    const f32x4 a = p[0], b = p[1], c = p[2], d = p[3];
    const float s = ((a[0] + a[1]) + (a[2] + a[3])) + ((b[0] + b[1]) + (b[2] + b[3])) + ((c[0] + c[1]) + (c[2] + c[3])) + ((d[0] + d[1]) + (d[2] + d[3]));
    return rsqrtf(s * (1.f / 1024.f) + 1e-6f);
}
struct EpiA {
    static constexpr bool PERM = true, AFTER_DRAIN = false;
    int mode, sub; const float* rs; bf16_t* out; int ldo; float* sg; const bf16_t* gate; int ldg; float* tmp;
    __device__ __forceinline__ void operator()(const f32x4 (&acc)[2][2][4][2], const Unit& u, int wr, int wc, int fr, int fq) const {
        const int row0 = u.pm * BM + wr * 64 + fr, colb = u.pn * BM + wc * 32 + 8 * fq;
#pragma unroll
        for (int ai = 0; ai < 2; ++ai)
#pragma unroll
            for (int m = 0; m < 4; ++m) {
                const int row = row0 + ai * HALF + m * 16;
                float rsv = 1.f; if (mode != 1) rsv = rowscale(rs, row);
#pragma unroll
                for (int bj = 0; bj < 2; ++bj) {
                    const int col = colb + bj * HALF;
                    f32x4 v0 = acc[ai][bj][m][0] * rsv, v1 = acc[ai][bj][m][1] * rsv;
                    if (mode == 0) {
                        if (u.pn == 29) {
                            if (bj == 0 && wc == 0 && fq < 2) { float* q = sg + (size_t)row * 16 + 8 * fq; *(f32x4*)q = v0; *(f32x4*)(q + 4) = v1; }
                        } else {
                            if (u.pn >= 17) {
#pragma unroll
                                for (int e = 0; e < 4; ++e) { v0[e] = sigm(v0[e]); v1[e] = sigm(v1[e]); }
                            }
                            u32x4 w; w.x = pk2(v0[0], v0[1]); w.y = pk2(v0[2], v0[3]); w.z = pk2(v1[0], v1[1]); w.w = pk2(v1[2], v1[3]);
                            *(u32x4*)(out + (size_t)row * ldo + col) = w;
                        }
                    } else if (mode == 1) {
                        const u32x4 g = *(const u32x4*)(gate + (size_t)row * ldg + col);
                        f32x4 p0 = {v0[0] * bflo(g.x), v0[1] * bfhi(g.x), v0[2] * bflo(g.y), v0[3] * bfhi(g.y)};
                        f32x4 p1 = {v1[0] * bflo(g.z), v1[1] * bfhi(g.z), v1[2] * bflo(g.w), v1[3] * bfhi(g.w)};
                        float* tp = tmp + (size_t)row * 1024 + col;
                        if (sub == 0) { *(f32x4*)tp = p0; *(f32x4*)(tp + 4) = p1; }
                        else if (sub == 1) { *(f32x4*)tp = *(const f32x4*)tp + p0; *(f32x4*)(tp + 4) = *(const f32x4*)(tp + 4) + p1; }
                        else { p0 = p0 + *(const f32x4*)tp; p1 = p1 + *(const f32x4*)(tp + 4);
                            u32x4 w; w.x = pk2(p0[0], p0[1]); w.y = pk2(p0[2], p0[3]); w.z = pk2(p1[0], p1[1]); w.w = pk2(p1[2], p1[3]);
                            *(u32x4*)(out + (size_t)row * ldo + col) = w; }
                    } else {
#pragma unroll
                        for (int e = 0; e < 4; ++e) { const float a = fmaxf(v0[e], 0.f), b = fmaxf(v1[e], 0.f); v0[e] = a * a; v1[e] = b * b; }
                        u32x4 w; w.x = pk2(v0[0], v0[1]); w.y = pk2(v0[2], v0[3]); w.z = pk2(v1[0], v1[1]); w.w = pk2(v1[2], v1[3]);
                        *(u32x4*)(out + (size_t)row * ldo + col) = w;
                    }
                }
            }
    }
};
struct EpiB {
    static constexpr bool PERM = false, AFTER_DRAIN = false;
    const float* resid; float* out; bf16_t* xb; float* rs;
    __device__ __forceinline__ void operator()(const f32x4 (&acc)[2][2][4][2], const Unit& u, int wr, int wc, int fr, int fq) const {
        const int row0 = u.pm * BM + wr * 64 + fr, colb = u.pn * BM + wc * 32 + 4 * fq;
#pragma unroll
        for (int ai = 0; ai < 2; ++ai)
#pragma unroll
            for (int m = 0; m < 4; ++m) {
                const int row = row0 + ai * HALF + m * 16; float ss = 0.f;
#pragma unroll
                for (int bj = 0; bj < 2; ++bj)
#pragma unroll
                    for (int n = 0; n < 2; ++n) {
                        const size_t off = (size_t)row * 1024 + colb + bj * HALF + n * 16;
                        const f32x4 x = *(const f32x4*)(resid + off) + acc[ai][bj][m][n];
                        *(f32x4*)(out + off) = x;
                        u32x2 w; w.x = pk2(x[0], x[1]); w.y = pk2(x[2], x[3]); *(u32x2*)(xb + off) = w;
                        ss += (x[0] * x[0] + x[1] * x[1]) + (x[2] * x[2] + x[3] * x[3]);
                    }
                ss += __shfl_xor(ss, 16); ss += __shfl_xor(ss, 32);
                if (fq == 0) rs[(size_t)row * 16 + u.pn * 4 + wc] = ss;
            }
    }
};

template <class Epi, class Sched, bool ALIGN_EPI = false, bool SP2 = false>
__device__ __forceinline__ void gemm_phase(PG8_LAS unsigned char* lds, const Gemm g, const Sched& S, const Epi& E) {
    int tid_ = threadIdx.x; asm volatile("" : "+v"(tid_));
    const int tid = tid_, wid = __builtin_amdgcn_readfirstlane(tid >> 6), lane = tid & 63, wr = wid >> 2, wc = wid & 3, fr = lane & 15, fq = lane >> 4;
    const int K = g.K, nt = K / BK;
    unsigned voffA[2], voffB[2];
#pragma unroll
    for (int i = 0; i < 2; ++i) { int R, C; stage_rc(tid * 16 + i * 8192, R, C); const int Rb = Epi::PERM ? ((R & ~31) + perm32(R & 31)) : R;
        voffA[i] = (unsigned)(R * K + C) * 2u; voffB[i] = (unsigned)(Rb * K + C) * 2u; }
    const size_t kstep = (size_t)(BK * 2);
    const size_t hstep = (size_t)HALF * K * 2;
    const size_t tstep = 2 * hstep;
    const unsigned ldsw = (unsigned)wid * 1024u;
    const int aoff = lds_byte(wr * 64 + fr, fq * 8), boff = lds_byte(wc * 32 + fr, fq * 8);
#define PG8_SA(b, h) (((b) * 2 + (h)) * HTB)
#define PG8_SB(b, h) ((4 + (b) * 2 + (h)) * HTB)
#define PG8_STAGE(bufoff, gbase, voff) do { _Pragma("unroll") for (int _i = 0; _i < 2; ++_i) \
        __builtin_amdgcn_global_load_lds((const unsigned*)((const char*)(gbase) + (voff)[_i]), (PG8_LAS unsigned*)(lds + (bufoff) + ldsw + _i * 8192), 16, 0, 0); } while (0)
#define PG8_LDA(dst, b, h) do { _Pragma("unroll") for (int m = 0; m < 4; ++m) _Pragma("unroll") for (int k = 0; k < 2; ++k) dst[m][k] = *(const PG8_LAS bf16x8*)(lds + PG8_SA(b, h) + aoff + m * 2048 + k * 1024); } while (0)
#define PG8_LDB(dst, b, h) do { _Pragma("unroll") for (int n = 0; n < 2; ++n) _Pragma("unroll") for (int k = 0; k < 2; ++k) dst[n][k] = *(const PG8_LAS bf16x8*)(lds + PG8_SB(b, h) + boff + n * 2048 + k * 1024); } while (0)
#define PG8_MMA(ai, bj, At, Bt) do { __builtin_amdgcn_s_setprio(1); _Pragma("unroll") for (int m = 0; m < 4; ++m) _Pragma("unroll") for (int n = 0; n < 2; ++n) _Pragma("unroll") for (int k = 0; k < 2; ++k) \
        acc[ai][bj][m][n] = __builtin_amdgcn_mfma_f32_16x16x32_bf16(Bt[n][k], At[m][k], acc[ai][bj][m][n], 0, 0, 0); __builtin_amdgcn_s_setprio(0); } while (0)
#define PG8_WAIT_V(n) asm volatile("s_waitcnt vmcnt(" #n ")" ::: "memory")
#define PG8_WAIT_L(n) asm volatile("s_waitcnt lgkmcnt(" #n ")" ::: "memory")
#define PG8_BAR __builtin_amdgcn_s_barrier()
#define PG8_SCHED __builtin_amdgcn_sched_barrier(0)
    Unit cur, nxt; int ui = 0;
    if (!S.next(0, cur)) return;
    f32x4 acc[2][2][4][2];
#pragma unroll
    for (int a = 0; a < 2; ++a)
#pragma unroll
        for (int b = 0; b < 2; ++b)
#pragma unroll
            for (int m = 0; m < 4; ++m)
#pragma unroll
                for (int n = 0; n < 2; ++n) acc[a][b][m][n] = (f32x4){0.f, 0.f, 0.f, 0.f};
    bf16x8 At[4][2], B0[2][2], B1[2][2];
    const char* cA = (const char*)g.A + (size_t)cur.pm * tstep; const char* cB = (const char*)g.Bt + (size_t)cur.pn * tstep;
    S.a_ready(cur);
    if constexpr (SP2) {
        PG8_STAGE(PG8_SB(0, 0), cB, voffB); PG8_STAGE(PG8_SB(0, 1), cB + hstep, voffB); PG8_STAGE(PG8_SA(0, 0), cA, voffA); PG8_STAGE(PG8_SA(0, 1), cA + hstep, voffA);
        if (wr == 1) PG8_BAR;
        PG8_WAIT_V(2); PG8_BAR;
        PG8_STAGE(PG8_SB(1, 0), cB + kstep, voffB); PG8_STAGE(PG8_SA(1, 0), cA + kstep, voffA); PG8_STAGE(PG8_SB(1, 1), cB + hstep + kstep, voffB);
        PG8_WAIT_V(6); PG8_BAR;
    } else {
        PG8_STAGE(PG8_SB(0, 0), cB, voffB); PG8_STAGE(PG8_SA(0, 0), cA, voffA); PG8_STAGE(PG8_SB(0, 1), cB + hstep, voffB); PG8_STAGE(PG8_SA(0, 1), cA + hstep, voffA);
        if (wr == 1) PG8_BAR;
        PG8_WAIT_V(4); PG8_BAR;
        PG8_STAGE(PG8_SB(1, 0), cB + kstep, voffB); PG8_STAGE(PG8_SA(1, 0), cA + kstep, voffA); PG8_STAGE(PG8_SB(1, 1), cB + hstep + kstep, voffB);
        PG8_WAIT_V(6); PG8_BAR;
    }
    for (;;) {
        const bool has_next = S.next(ui + 1, nxt);
        const char* nA = has_next ? (const char*)g.A + (size_t)nxt.pm * tstep : cA; const char* nB = has_next ? (const char*)g.Bt + (size_t)nxt.pn * tstep : cB;
        for (int t = 0; t < nt; t += 2) {
            const bool last = (t == nt - 2);
            const char* a1 = cA + (size_t)(t + 1) * kstep;
            const char* a2 = last ? nA : cA + (size_t)(t + 2) * kstep; const char* b2 = last ? nB : cB + (size_t)(t + 2) * kstep;
            const char* a3 = a2 + kstep; const char* b3 = b2 + kstep;
            if (last && has_next) S.a_ready(nxt);
            if constexpr (SP2) {
            PG8_LDB(B0, 0, 0); PG8_LDB(B1, 0, 1); PG8_SCHED; PG8_LDA(At, 0, 0); PG8_STAGE(PG8_SA(1, 1), a1 + hstep, voffA);
            PG8_WAIT_V(8); PG8_WAIT_L(0); PG8_BAR; PG8_MMA(0, 0, At, B0); PG8_MMA(0, 1, At, B1); PG8_BAR; PG8_SCHED;
            PG8_LDA(At, 0, 1); PG8_STAGE(PG8_SB(0, 0), b2, voffB); PG8_STAGE(PG8_SB(0, 1), b2 + hstep, voffB); PG8_STAGE(PG8_SA(0, 0), a2, voffA);
            PG8_WAIT_V(8); PG8_WAIT_L(0); PG8_BAR; PG8_MMA(1, 0, At, B0); PG8_MMA(1, 1, At, B1); PG8_BAR; PG8_SCHED;
            PG8_LDB(B0, 1, 0); PG8_LDB(B1, 1, 1); PG8_SCHED; PG8_LDA(At, 1, 0); PG8_STAGE(PG8_SA(0, 1), a2 + hstep, voffA);
            PG8_WAIT_V(8); PG8_WAIT_L(0); PG8_BAR; PG8_MMA(0, 0, At, B0); PG8_MMA(0, 1, At, B1); PG8_BAR; PG8_SCHED;
            PG8_LDA(At, 1, 1); PG8_STAGE(PG8_SB(1, 0), b3, voffB); PG8_STAGE(PG8_SB(1, 1), b3 + hstep, voffB); PG8_STAGE(PG8_SA(1, 0), a3, voffA);
            PG8_WAIT_V(8); PG8_WAIT_L(0); PG8_BAR; PG8_MMA(1, 0, At, B0); PG8_MMA(1, 1, At, B1); PG8_BAR; PG8_SCHED;
            } else {
            PG8_LDB(B0, 0, 0); PG8_SCHED; PG8_LDA(At, 0, 0); PG8_STAGE(PG8_SA(1, 1), a1 + hstep, voffA);
            PG8_WAIT_L(8); PG8_BAR; PG8_WAIT_L(0); PG8_MMA(0, 0, At, B0); PG8_BAR; PG8_SCHED;
            PG8_LDB(B1, 0, 1); PG8_STAGE(PG8_SB(0, 0), b2, voffB);
            PG8_BAR; PG8_WAIT_L(0); PG8_MMA(0, 1, At, B1); PG8_BAR;
            PG8_LDA(At, 0, 1); PG8_STAGE(PG8_SA(0, 0), a2, voffA);
            PG8_BAR; PG8_WAIT_L(0); PG8_MMA(1, 0, At, B0); PG8_BAR; PG8_SCHED;
            PG8_STAGE(PG8_SB(0, 1), b2 + hstep, voffB);
            PG8_WAIT_V(6); PG8_BAR; PG8_MMA(1, 1, At, B1); PG8_BAR;
            PG8_LDB(B0, 1, 0); PG8_SCHED; PG8_LDA(At, 1, 0); PG8_STAGE(PG8_SA(0, 1), a2 + hstep, voffA);
            PG8_WAIT_L(8); PG8_BAR; PG8_WAIT_L(0); PG8_MMA(0, 0, At, B0); PG8_BAR; PG8_SCHED;
            PG8_LDB(B1, 1, 1); PG8_STAGE(PG8_SB(1, 0), b3, voffB);
            PG8_BAR; PG8_WAIT_L(0); PG8_MMA(0, 1, At, B1); PG8_BAR;
            PG8_LDA(At, 1, 1); PG8_STAGE(PG8_SA(1, 0), a3, voffA);
            PG8_BAR; PG8_WAIT_L(0); PG8_MMA(1, 0, At, B0); PG8_BAR; PG8_SCHED;
            PG8_STAGE(PG8_SB(1, 1), b3 + hstep, voffB);
            PG8_WAIT_V(6); PG8_BAR; PG8_MMA(1, 1, At, B1); PG8_BAR;
            }
        }
        if constexpr (ALIGN_EPI) { if (wr == 0) PG8_BAR; }
        if constexpr (!Epi::AFTER_DRAIN) { E(acc, cur, wr, wc, fr, fq); S.done(cur); }
        if (!has_next) break;
#pragma unroll
        for (int a = 0; a < 2; ++a)
#pragma unroll
            for (int b = 0; b < 2; ++b)
#pragma unroll
                for (int m = 0; m < 4; ++m)
#pragma unroll
                    for (int n = 0; n < 2; ++n) acc[a][b][m][n] = (f32x4){0.f, 0.f, 0.f, 0.f};
        cur = nxt; cA = nA; cB = nB; ++ui;
        if constexpr (ALIGN_EPI) { if (wr == 1) PG8_BAR; }
    }
    PG8_WAIT_V(0);
    if constexpr (!ALIGN_EPI) { if (wr == 0) PG8_BAR; }
    PG8_BAR;
    if constexpr (Epi::AFTER_DRAIN) { E.fused(acc, cur, wr, wc, fr, fq, lds, wid, lane); S.done(cur); }
#undef PG8_SA
#undef PG8_SB
#undef PG8_STAGE
#undef PG8_LDA
#undef PG8_LDB
#undef PG8_MMA
#undef PG8_WAIT_V
#undef PG8_WAIT_L
#undef PG8_BAR
#undef PG8_SCHED
}
}

#define LAS __attribute__((address_space(3)))
typedef unsigned short bf16_t;
typedef short bf16x8 __attribute__((ext_vector_type(8)));
typedef float f32x4 __attribute__((ext_vector_type(4)));
typedef float f32x2 __attribute__((ext_vector_type(2)));
typedef float f32x16 __attribute__((ext_vector_type(16)));
typedef unsigned u32x4 __attribute__((ext_vector_type(4)));
typedef unsigned u32x2 __attribute__((ext_vector_type(2)));
using pg8::pk2; using pg8::bflo; using pg8::bfhi; using pg8::sigm;

constexpr int NB = 32, SEQ = 2048, DM = 1024, DEPTH = 2, INW = 7440, NINP = 7680, LDU = 7424, FF = 4096;
constexpr int NG = 4, BG = NB / NG, MG = BG * SEQ;
constexpr float LOG2E = 1.4426950408889634f, EPS = 1e-6f;
constexpr int NWAVES = 8, NTHR = 512;
constexpr int LDS_BYTES = 131072 + 1024;

constexpr int UC_FQ = 0, UC_FK = 512, UC_FV = 1024, UC_SQ = 1536, UC_SK = 2048, UC_SV = 2176, UC_MQ = 2304, UC_MK = 2816, UC_MV = 3328, UC_MO = 3840, UC_G = 4352;

constexpr size_t al(size_t x) { return (x + 255) & ~(size_t)255; }
constexpr size_t O_WIN = 0;
constexpr size_t O_WB = O_WIN + al((size_t)DEPTH * NINP * DM * 2);
constexpr size_t O_WOUT = O_WB + al((size_t)DEPTH * 3 * DM * 512 * 2);
constexpr size_t O_WUP = O_WOUT + al((size_t)DEPTH * DM * DM * 2);
constexpr size_t O_WDN = O_WUP + al((size_t)DEPTH * FF * DM * 2);
constexpr size_t O_ROPE = O_WDN + al((size_t)DEPTH * DM * FF * 2);
constexpr size_t O_PAR = O_ROPE + al((size_t)SEQ * 32 * 2 * 4);
constexpr int PAR_FFB = 0, PAR_FQN = 16, PAR_FKN = 144, PAR_SQN = 272, PAR_SKN = 400, PAR_SINK = 528, PAR_CW = 544, PAR_CB = 8736, PAR_IB = 10784, PAR_FB = 10792, PAR_ON = 10800, PAR_N = 11824;
constexpr size_t O_XB = O_PAR + al((size_t)PAR_N * 4);
constexpr size_t O_RS = O_XB + al((size_t)MG * DM * 2);
constexpr size_t O_U = O_RS + al((size_t)MG * 16 * 4);
constexpr size_t O_SG = O_U + al((size_t)MG * LDU * 2);
constexpr size_t O_FC = O_SG + al((size_t)MG * 16 * 4);
constexpr size_t O_MP = O_FC + al((size_t)BG * 8 * SEQ * 4);
constexpr size_t O_ME = O_MP + al((size_t)BG * 4 * SEQ * 4);
constexpr size_t O_MBT = O_ME + al((size_t)BG * 4 * SEQ * 4);
constexpr size_t O_MCH = O_MBT + al((size_t)BG * 4 * SEQ * 4);
constexpr size_t O_FQN = O_MCH + al((size_t)BG * 4 * 16 * 4 * 4);
constexpr size_t O_FKN = O_FQN + (size_t)MG * 512 * 2;
constexpr size_t O_FVT = O_FKN + (size_t)MG * 512 * 2;
constexpr size_t O_SQR = O_FVT + (size_t)MG * 512 * 2;
constexpr size_t O_TMP = O_FQN;
constexpr size_t O_SKR = O_SQR + (size_t)MG * 512 * 2;
constexpr size_t O_SVT = O_SKR + (size_t)MG * 128 * 2;
constexpr size_t O_MQC = O_SVT + (size_t)MG * 128 * 2;
constexpr size_t O_MKC = O_MQC + (size_t)MG * 512 * 2;
constexpr size_t O_MRG = O_MQC;
constexpr size_t O_KT = O_MKC + (size_t)MG * 512 * 2;
constexpr size_t O_MVT = O_KT + (size_t)MG * 512 * 2;
constexpr size_t O_DCT = O_MVT + (size_t)MG * 512 * 2;
constexpr size_t O_DN = O_DCT + (size_t)BG * 4 * 16 * 16384 * 4;
constexpr size_t O_CT = O_DN + al((size_t)BG * 4 * 16 * 128 * 4);
constexpr size_t O_NN = O_CT + (size_t)BG * 4 * 16 * 16384 * 2;
constexpr size_t O_Y = O_NN + al((size_t)BG * 4 * 16 * 128 * 4);
constexpr size_t WS_NEED = O_Y + (size_t)3 * MG * 512 * 2;
static_assert((size_t)MG * FF * 2 <= (size_t)MG * LDU * 2, "ACT overlays U");

struct KP { const float* in[19]; float* out; unsigned char* ws; int ph_lo, ph_hi; };

__device__ __forceinline__ float wave_sum(float v) {
#pragma unroll
    for (int o = 1; o < 64; o <<= 1) v += __shfl_xor(v, o);
    return v;
}
__device__ __forceinline__ float logsig(float x) { return fminf(x, 0.f) - log1pf(__expf(-fabsf(x))); }
#define LDSW() asm volatile("s_waitcnt lgkmcnt(0)" ::: "memory")

__device__ __forceinline__ int win_srccol(int n) {
    if (n < 1536) return n; if (n < 3840) return n + 8; if (n < 7424) return n + 16; if (n < 7432) return n - 7424 + 1536; if (n < 7440) return n - 7432 + 3848; return -1;
}
template <bool REMAP>
__device__ __forceinline__ void tr_item(const float* W, int K, int N, const float* kscale, bf16_t* WT, int item, int nblk, LAS float* scr, int lane) {
    const int kb = item / nblk, nb = item % nblk, k0 = 64 * kb, n0 = 32 * nb;
    const int nd = n0 + (lane & 31); const int ns = REMAP ? win_srccol(nd) : nd;
#pragma unroll 8
    for (int i = 0; i < 32; ++i) { const int kk = 2 * i + (lane >> 5); float v = 0.f; if (ns >= 0) v = W[(size_t)(k0 + kk) * N + ns]; if (kscale) v *= kscale[k0 + kk]; scr[kk * 33 + (lane & 31)] = v; }
    LDSW();
    const int c = lane & 7;
#pragma unroll
    for (int j = 0; j < 4; ++j) { const int n = (lane >> 3) + 8 * j; const LAS float* s = scr + (8 * c) * 33 + n;
        u32x4 o; o.x = pk2(s[0 * 33], s[1 * 33]); o.y = pk2(s[2 * 33], s[3 * 33]); o.z = pk2(s[4 * 33], s[5 * 33]); o.w = pk2(s[6 * 33], s[7 * 33]);
        *(u32x4*)(WT + (size_t)(n0 + n) * K + k0 + 8 * c) = o; }
    LDSW();
}
__device__ __forceinline__ void phase_p0(const KP& p, unsigned char* ws, LAS unsigned char* lds, int gw, int NWV, int wave, int lane) {
    LAS float* scr = (LAS float*)(lds + wave * 16384);
    const float *norm_mix = p.in[1], *w_in = p.in[2], *w_branch = p.in[14], *w_out = p.in[15], *norm_mlp = p.in[16], *w_up = p.in[17], *w_down = p.in[18];
    constexpr int PER = 3840 + 768 + 512 + 2048 + 2048;
    for (int it = gw; it < DEPTH * PER; it += NWV) {
        const int l = it / PER; int r = it % PER;
        if (r < 3840) { tr_item<true>(w_in + (size_t)l * DM * INW, DM, INW, norm_mix + l * DM, (bf16_t*)(ws + O_WIN) + (size_t)l * NINP * DM, r, 240, scr, lane); continue; } r -= 3840;
        if (r < 768) { const int b = r / 256; tr_item<false>(w_branch + (size_t)(l * 3 + b) * 512 * DM, 512, DM, nullptr, (bf16_t*)(ws + O_WB) + (size_t)(l * 3 + b) * DM * 512, r % 256, 32, scr, lane); continue; } r -= 768;
        if (r < 512) { tr_item<false>(w_out + (size_t)l * DM * DM, DM, DM, nullptr, (bf16_t*)(ws + O_WOUT) + (size_t)l * DM * DM, r, 32, scr, lane); continue; } r -= 512;
        if (r < 2048) { tr_item<false>(w_up + (size_t)l * DM * FF, DM, FF, norm_mlp + l * DM, (bf16_t*)(ws + O_WUP) + (size_t)l * FF * DM, r, 128, scr, lane); continue; } r -= 2048;
        tr_item<false>(w_down + (size_t)l * FF * DM, FF, DM, nullptr, (bf16_t*)(ws + O_WDN) + (size_t)l * DM * FF, r, 32, scr, lane);
    }
    { float* par = (float*)(ws + O_PAR); const int t0 = gw * 64 + lane, ts = NWV * 64;
      for (int e = t0; e < 16; e += ts) { par[PAR_FFB + e] = p.in[3][e]; par[PAR_SINK + e] = p.in[8][e]; }
      for (int e = t0; e < 128; e += ts) { par[PAR_FQN + e] = p.in[4][e]; par[PAR_FKN + e] = p.in[5][e]; par[PAR_SQN + e] = p.in[6][e]; par[PAR_SKN + e] = p.in[7][e]; }
      for (int e = t0; e < 8192; e += ts) par[PAR_CW + e] = p.in[9][e];
      for (int e = t0; e < 2048; e += ts) par[PAR_CB + e] = p.in[10][e];
      for (int e = t0; e < 8; e += ts) { par[PAR_IB + e] = p.in[11][e]; par[PAR_FB + e] = p.in[12][e]; }
      for (int e = t0; e < 1024; e += ts) par[PAR_ON + e] = p.in[13][e]; }
    float* rope = (float*)(ws + O_ROPE);
    for (int e = gw * 64 + lane; e < SEQ * 32; e += NWV * 64) {
        const int pos = e >> 5, i = e & 31;
        const float inv = powf(10000.f, -(float)(2 * i) / 64.f), ang = (float)pos * inv;
        rope[2 * e] = cosf(ang); rope[2 * e + 1] = sinf(ang);
    }
}
__device__ __forceinline__ void phase_x0(const float* x, bf16_t* XB, float* RS, int gw, int NWV, int lane) {
    for (int row = gw; row < MG; row += NWV) {
        const f32x4* xr = (const f32x4*)(x + (size_t)row * DM) + lane;
        f32x4 v[4]; float s = 0.f;
#pragma unroll
        for (int j = 0; j < 4; ++j) { v[j] = xr[64 * j]; s += (v[j][0] * v[j][0] + v[j][1] * v[j][1]) + (v[j][2] * v[j][2] + v[j][3] * v[j][3]); }
        s = wave_sum(s);
        u32x2* o = (u32x2*)(XB + (size_t)row * DM) + lane;
#pragma unroll
        for (int j = 0; j < 4; ++j) { u32x2 w; w.x = pk2(v[j][0], v[j][1]); w.y = pk2(v[j][2], v[j][3]); o[64 * j] = w; }
        if (lane < 16) RS[(size_t)row * 16 + lane] = (lane == 0) ? s : 0.f;
    }
}
__device__ __forceinline__ void gate_scan_item(unsigned char* ws, int l, int it, int lane) {
    const float* par = (const float*)(ws + O_PAR); const float* SG = (const float*)(ws + O_SG);
    if (it < BG * 8) {
        const int b = it >> 3, h = it & 7; const float bias = par[PAR_FFB + l * 8 + h];
        const float* src = SG + ((size_t)b * SEQ + lane * 32) * 16 + h;
        float tot = 0.f;
#pragma unroll 4
        for (int j = 0; j < 32; ++j) tot += logsig(src[j * 16] + bias);
        float x = tot;
#pragma unroll
        for (int o = 1; o < 64; o <<= 1) { const float y = __shfl_up(x, o); if (lane >= o) x += y; }
        float run = x - tot;
        float* dst = (float*)(ws + O_FC) + (size_t)it * SEQ + lane * 32;
#pragma unroll 4
        for (int j = 0; j < 32; ++j) { run += logsig(src[j * 16] + bias); dst[j] = run * LOG2E; }
    } else {
        const int sq = it - BG * 8, b = sq >> 2, h = sq & 3;
        const float ibias = par[PAR_IB + l * 4 + h], fbias = par[PAR_FB + l * 4 + h];
        float* MP = (float*)(ws + O_MP) + (size_t)sq * SEQ; float* ME = (float*)(ws + O_ME) + (size_t)sq * SEQ; float* MBT = (float*)(ws + O_MBT) + (size_t)sq * SEQ;
        float* MCH = (float*)(ws + O_MCH) + (size_t)sq * 64;
        float mc = 0.f;
#pragma unroll 1
        for (int c = 0; c < 16; ++c) {
            const float* s0 = SG + ((size_t)b * SEQ + c * 128 + 2 * lane) * 16;
            const float f0 = logsig(s0[12 + h] + fbias), f1 = logsig(s0[16 + 12 + h] + fbias);
            const float i0 = s0[8 + h] + ibias, i1 = s0[16 + 8 + h] + ibias;
            float x = f0 + f1;
#pragma unroll
            for (int o = 1; o < 64; o <<= 1) { const float y = __shfl_up(x, o); if (lane >= o) x += y; }
            const float b1 = x, b0 = x - f1;
            const float p0 = i0 - b0, p1 = i1 - b1;
            float mxs = fmaxf(p0, p1);
#pragma unroll
            for (int o = 1; o < 64; o <<= 1) { const float y = __shfl_up(mxs, o); if (lane >= o) mxs = fmaxf(mxs, y); }
            float prev = __shfl_up(mxs, 1); if (lane == 0) prev = -INFINITY;
            const float u0 = fmaxf(prev, p0), u1 = mxs;
            const float e0 = fmaxf(mc, u0), e1 = fmaxf(mc, u1);
            const int t = c * 128 + 2 * lane;
            *(f32x2*)(MP + t) = (f32x2){p0, p1}; *(f32x2*)(ME + t) = (f32x2){e0, e1}; *(f32x2*)(MBT + t) = (f32x2){b0, b1};
            const float ulast = __shfl(mxs, 63), bL = __shfl(x, 63);
            const float mx = fmaxf(mc, ulast), dec = __expf(mc - mx);
            if (lane == 0) *(f32x4*)(MCH + c * 4) = (f32x4){mc, mx, dec, bL};
            mc = bL + mx;
        }
    }
}
__device__ __forceinline__ void headnorm_lane(unsigned char* ws, int l, int idx) {
    const float* par = (const float*)(ws + O_PAR);
    const int tok = idx / 26, slot = idx % 26;
    int srccol; bf16_t* dst; const float* w; float scale; bool rp;
    if (slot < 8) { srccol = UC_FQ + slot * 64; dst = (bf16_t*)(ws + O_FQN) + (size_t)tok * 512 + slot * 64; w = par + PAR_FQN + l * 64; scale = 0.125f * LOG2E; rp = false; }
    else if (slot < 16) { const int h = slot - 8; srccol = UC_FK + h * 64; dst = (bf16_t*)(ws + O_FKN) + (size_t)tok * 512 + h * 64; w = par + PAR_FKN + l * 64; scale = 1.f; rp = false; }
    else if (slot < 24) { const int h = slot - 16; srccol = UC_SQ + h * 64; dst = (bf16_t*)(ws + O_SQR) + (size_t)tok * 512 + h * 64; w = par + PAR_SQN + l * 64; scale = 0.125f * LOG2E; rp = true; }
    else { const int h = slot - 24; srccol = UC_SK + h * 64; dst = (bf16_t*)(ws + O_SKR) + (size_t)tok * 128 + h * 64; w = par + PAR_SKN + l * 64; scale = 1.f; rp = true; }
    const u32x4* src = (const u32x4*)((const bf16_t*)(ws + O_U) + (size_t)tok * LDU + srccol);
    unsigned xw[32]; float ss = 0.f;
#pragma unroll
    for (int j = 0; j < 8; ++j) { const u32x4 v = src[j]; xw[4 * j] = v.x; xw[4 * j + 1] = v.y; xw[4 * j + 2] = v.z; xw[4 * j + 3] = v.w; }
#pragma unroll
    for (int j = 0; j < 32; ++j) { const float a = bflo(xw[j]), b = bfhi(xw[j]); ss += a * a + b * b; }
    const float rn = rsqrtf(ss * (1.f / 64.f) + EPS) * scale;
    const f32x4* rt = (const f32x4*)((const float*)(ws + O_ROPE) + (size_t)(tok % SEQ) * 64);
#pragma unroll
    for (int j = 0; j < 16; ++j) {
        const f32x2 wa = *(const f32x2*)(w + 2 * j), wb = *(const f32x2*)(w + 2 * j + 32);
        float a0 = bflo(xw[j]) * rn * wa[0], a1 = bfhi(xw[j]) * rn * wa[1], b0 = bflo(xw[j + 16]) * rn * wb[0], b1 = bfhi(xw[j + 16]) * rn * wb[1];
        if (rp) { const f32x4 cs = rt[j];
            const float t0 = a0 * cs[0] - b0 * cs[1], t1 = a0 * cs[1] + b0 * cs[0], t2 = a1 * cs[2] - b1 * cs[3], t3 = a1 * cs[3] + b1 * cs[2];
            a0 = t0; b0 = t1; a1 = t2; b1 = t3; }
        xw[j] = pk2(a0, a1); xw[j + 16] = pk2(b0, b1);
    }
    u32x4* o = (u32x4*)dst;
#pragma unroll
    for (int j = 0; j < 8; ++j) { u32x4 v; v.x = xw[4 * j]; v.y = xw[4 * j + 1]; v.z = xw[4 * j + 2]; v.w = xw[4 * j + 3]; o[j] = v; }
}
__device__ __forceinline__ void stream_item(unsigned char* ws, int l, int item, int lane) {
    const int cb = item % 17, tb = item / 17, tok0 = tb * 64, b = tok0 / SEQ, s0 = tok0 % SEQ;
    const bf16_t* U = (const bf16_t*)(ws + O_U);
    int srccol, chan; bf16_t* dT = nullptr; bf16_t* dN = nullptr; int convch = -1; float oscale = 1.f;
    if (cb < 4) { chan = cb * 128 + 2 * lane; srccol = UC_FV + chan; dT = (bf16_t*)(ws + O_FVT) + ((size_t)b * 512 + chan) * SEQ; }
    else if (cb < 5) { chan = 2 * lane; srccol = UC_SV + chan; dT = (bf16_t*)(ws + O_SVT) + ((size_t)b * 128 + chan) * SEQ; }
    else if (cb < 9) { chan = (cb - 5) * 128 + 2 * lane; srccol = UC_MV + chan; dT = (bf16_t*)(ws + O_MVT) + ((size_t)b * 512 + chan) * SEQ; }
    else if (cb < 13) { chan = (cb - 9) * 128 + 2 * lane; srccol = UC_MQ + chan; dN = (bf16_t*)(ws + O_MQC) + chan; convch = chan; }
    else { chan = (cb - 13) * 128 + 2 * lane; srccol = UC_MK + chan; dN = (bf16_t*)(ws + O_MKC) + chan; dT = (bf16_t*)(ws + O_KT) + ((size_t)b * 512 + chan) * SEQ; convch = 512 + chan; oscale = 0.08838834764831845f; }
    const bf16_t* src = U + (size_t)tok0 * LDU + srccol;
    if (cb < 9) {
#pragma unroll 1
        for (int tg = 0; tg < 8; ++tg) {
            unsigned w[8];
#pragma unroll
            for (int j = 0; j < 8; ++j) w[j] = *(const unsigned*)(src + (size_t)(tg * 8 + j) * LDU);
            u32x4 a, c;
            a.x = (w[0] & 0xffffu) | (w[1] << 16); a.y = (w[2] & 0xffffu) | (w[3] << 16); a.z = (w[4] & 0xffffu) | (w[5] << 16); a.w = (w[6] & 0xffffu) | (w[7] << 16);
            c.x = (w[0] >> 16) | (w[1] & 0xffff0000u); c.y = (w[2] >> 16) | (w[3] & 0xffff0000u); c.z = (w[4] >> 16) | (w[5] & 0xffff0000u); c.w = (w[6] >> 16) | (w[7] & 0xffff0000u);
            *(u32x4*)(dT + s0 + tg * 8) = a; *(u32x4*)(dT + SEQ + s0 + tg * 8) = c;
        }
    } else {
        const float* cw = (const float*)(ws + O_PAR) + PAR_CW + l * 4 * 1024 + convch; const float* cbias = (const float*)(ws + O_PAR) + PAR_CB + l * 1024 + convch;
        const f32x2 w0 = *(const f32x2*)(cw), w1 = *(const f32x2*)(cw + 1024), w2 = *(const f32x2*)(cw + 2048), w3 = *(const f32x2*)(cw + 3072), bb = *(const f32x2*)cbias;
        f32x2 xm3 = {0.f, 0.f}, xm2 = {0.f, 0.f}, xm1 = {0.f, 0.f};
        if (s0 > 0) { const unsigned a = *(const unsigned*)(src - 3 * (size_t)LDU), c = *(const unsigned*)(src - 2 * (size_t)LDU), d = *(const unsigned*)(src - (size_t)LDU);
            xm3 = (f32x2){bflo(a), bfhi(a)}; xm2 = (f32x2){bflo(c), bfhi(c)}; xm1 = (f32x2){bflo(d), bfhi(d)}; }
#pragma unroll 1
        for (int tg = 0; tg < 8; ++tg) {
            float y0[8], y1[8];
#pragma unroll
            for (int j = 0; j < 8; ++j) {
                const unsigned wv = *(const unsigned*)(src + (size_t)(tg * 8 + j) * LDU);
                const f32x2 xc = {bflo(wv), bfhi(wv)};
                f32x2 y = bb + w0 * xm3 + w1 * xm2 + w2 * xm1 + w3 * xc;
                xm3 = xm2; xm2 = xm1; xm1 = xc;
                y0[j] = y[0] * sigm(y[0]) * oscale; y1[j] = y[1] * sigm(y[1]) * oscale;
                *(unsigned*)(dN + (size_t)(tok0 + tg * 8 + j) * 512) = pk2(y0[j], y1[j]);
            }
            if (dT) {
                u32x4 a, c;
                a.x = pk2(y0[0], y0[1]); a.y = pk2(y0[2], y0[3]); a.z = pk2(y0[4], y0[5]); a.w = pk2(y0[6], y0[7]);
                c.x = pk2(y1[0], y1[1]); c.y = pk2(y1[2], y1[3]); c.z = pk2(y1[4], y1[5]); c.w = pk2(y1[6], y1[7]);
                *(u32x4*)(dT + s0 + tg * 8) = a; *(u32x4*)(dT + SEQ + s0 + tg * 8) = c;
            }
        }
    }
}
#define MFMA32(a, b, c) __builtin_amdgcn_mfma_f32_32x32x16_bf16((a), (b), (c), 0, 0, 0)
template <bool SWA>
__device__ __forceinline__ void attn_qtile(const bf16_t* __restrict__ Q, const bf16_t* __restrict__ K, int kpitch, const bf16_t* __restrict__ VT,
                                           const float* __restrict__ C, float sink2, bf16_t* __restrict__ Y, int qt, int lane) {
    const int r = lane & 31, hh = lane >> 5;
    const int pr = ((r >> 2) & 1) * 16 + ((r >> 4) & 1) * 8 + ((r >> 3) & 1) * 4 + (r & 3);
    const int q0 = qt * 32;
    bf16x8 qf[4];
#pragma unroll
    for (int st = 0; st < 4; ++st) qf[st] = *(const bf16x8*)(Q + (size_t)(q0 + r) * 512 + 16 * st + 8 * hh);
    float cq = 0.f; if (!SWA) cq = C[q0 + r];
    float m = -1e30f, lsum = 0.f;
    f32x16 o0, o1;
#pragma unroll
    for (int i = 0; i < 16; ++i) { o0[i] = 0.f; o1[i] = 0.f; }
    const int kt_lo = SWA ? (qt > 4 ? qt - 4 : 0) : 0;
    for (int kt = kt_lo; kt <= qt; ++kt) {
        const int key0 = kt * 32;
        bf16x8 kf[4];
#pragma unroll
        for (int st = 0; st < 4; ++st) kf[st] = *(const bf16x8*)(K + (size_t)(key0 + pr) * kpitch + 16 * st + 8 * hh);
        bf16x8 vf[2][2];
#pragma unroll
        for (int dh = 0; dh < 2; ++dh)
#pragma unroll
            for (int s = 0; s < 2; ++s) vf[dh][s] = *(const bf16x8*)(VT + (size_t)(dh * 32 + r) * SEQ + key0 + 16 * hh + 8 * s);
        f32x16 sc;
#pragma unroll
        for (int i = 0; i < 16; ++i) sc[i] = 0.f;
#pragma unroll
        for (int st = 0; st < 4; ++st) sc = MFMA32(kf[st], qf[st], sc);
        if (!SWA) {
            const f32x4* cp = (const f32x4*)(C + key0 + 16 * hh);
#pragma unroll
            for (int g = 0; g < 4; ++g) { const f32x4 ck = cp[g];
#pragma unroll
                for (int e = 0; e < 4; ++e) sc[4 * g + e] += cq - ck[e]; }
        }
        if (kt == qt) {
#pragma unroll
            for (int i = 0; i < 16; ++i) if (16 * hh + i > r) sc[i] = -INFINITY;
        }
        if (SWA && kt == qt - 4) {
#pragma unroll
            for (int i = 0; i < 16; ++i) if (16 * hh + i <= r) sc[i] = -INFINITY;
        }
        float tm = sc[0];
#pragma unroll
        for (int i = 1; i < 16; ++i) tm = fmaxf(tm, sc[i]);
        tm = fmaxf(tm, __shfl_xor(tm, 32));
        const float mn = fmaxf(m, tm), alpha = __builtin_amdgcn_exp2f(m - mn);
        m = mn;
        float ps = 0.f;
#pragma unroll
        for (int i = 0; i < 16; ++i) { sc[i] = __builtin_amdgcn_exp2f(sc[i] - mn); ps += sc[i]; }
        lsum = lsum * alpha + ps;
#pragma unroll
        for (int i = 0; i < 16; ++i) { o0[i] *= alpha; o1[i] *= alpha; }
        u32x4 pw0, pw1;
        pw0.x = pk2(sc[0], sc[1]); pw0.y = pk2(sc[2], sc[3]); pw0.z = pk2(sc[4], sc[5]); pw0.w = pk2(sc[6], sc[7]);
        pw1.x = pk2(sc[8], sc[9]); pw1.y = pk2(sc[10], sc[11]); pw1.z = pk2(sc[12], sc[13]); pw1.w = pk2(sc[14], sc[15]);
        const bf16x8 pf0 = __builtin_bit_cast(bf16x8, pw0), pf1 = __builtin_bit_cast(bf16x8, pw1);
        o0 = MFMA32(vf[0][0], pf0, o0); o0 = MFMA32(vf[0][1], pf1, o0);
        o1 = MFMA32(vf[1][0], pf0, o1); o1 = MFMA32(vf[1][1], pf1, o1);
    }
    float lt = lsum + __shfl_xor(lsum, 32);
    if (SWA) lt += __builtin_amdgcn_exp2f(sink2 - m);
    const float inv = 1.f / lt;
    bf16_t* yrow = Y + (size_t)(q0 + r) * 512 + 4 * hh;
#pragma unroll
    for (int g = 0; g < 4; ++g) {
        u32x2 a, c;
        a.x = pk2(o0[4 * g] * inv, o0[4 * g + 1] * inv); a.y = pk2(o0[4 * g + 2] * inv, o0[4 * g + 3] * inv);
        c.x = pk2(o1[4 * g] * inv, o1[4 * g + 1] * inv); c.y = pk2(o1[4 * g + 2] * inv, o1[4 * g + 3] * inv);
        *(u32x2*)(yrow + 8 * g) = a; *(u32x2*)(yrow + 32 + 8 * g) = c;
    }
}
__device__ __forceinline__ void m1_item(unsigned char* ws, int it, int lane) {
    const int r = lane & 31, hh = lane >> 5;
    const int dvt = it & 3, c = (it >> 2) & 15, bh = it >> 6;
    const bf16_t* VTp = (const bf16_t*)(ws + O_MVT) + ((size_t)bh * 128 + dvt * 32 + r) * SEQ + c * 128 + 8 * hh;
    const bf16_t* KTp = (const bf16_t*)(ws + O_KT) + ((size_t)bh * 128 + r) * SEQ + c * 128 + 8 * hh;
    const float* MPp = (const float*)(ws + O_MP) + (size_t)bh * SEQ + c * 128 + 8 * hh;
    const float mx = ((const float*)(ws + O_MCH))[(bh * 16 + c) * 4 + 1];
    f32x16 acc[4];
#pragma unroll
    for (int d = 0; d < 4; ++d)
#pragma unroll
        for (int i = 0; i < 16; ++i) acc[d][i] = 0.f;
    float dn[4] = {0.f, 0.f, 0.f, 0.f};
#pragma unroll 1
    for (int st = 0; st < 8; ++st) {
        const bf16x8 vf = *(const bf16x8*)(VTp + 16 * st);
        const f32x4 pa = *(const f32x4*)(MPp + 16 * st), pb = *(const f32x4*)(MPp + 16 * st + 4);
        float wk[8];
#pragma unroll
        for (int e = 0; e < 4; ++e) { wk[e] = __expf(pa[e] - mx); wk[4 + e] = __expf(pb[e] - mx); }
#pragma unroll
        for (int d = 0; d < 4; ++d) {
            const u32x4 kr = *(const u32x4*)(KTp + (size_t)d * 32 * SEQ + 16 * st);
            const float k0 = bflo(kr.x) * wk[0], k1 = bfhi(kr.x) * wk[1], k2 = bflo(kr.y) * wk[2], k3 = bfhi(kr.y) * wk[3];
            const float k4 = bflo(kr.z) * wk[4], k5 = bfhi(kr.z) * wk[5], k6 = bflo(kr.w) * wk[6], k7 = bfhi(kr.w) * wk[7];
            dn[d] += ((k0 + k1) + (k2 + k3)) + ((k4 + k5) + (k6 + k7));
            u32x4 kw; kw.x = pk2(k0, k1); kw.y = pk2(k2, k3); kw.z = pk2(k4, k5); kw.w = pk2(k6, k7);
            acc[d] = MFMA32(vf, __builtin_bit_cast(bf16x8, kw), acc[d]);
        }
    }
    float* DCT = (float*)(ws + O_DCT) + (size_t)(bh * 16 + c) * 16384;
#pragma unroll
    for (int d = 0; d < 4; ++d) {
#pragma unroll
        for (int g4 = 0; g4 < 4; ++g4) { float* pg = DCT + (dvt * 32 + 8 * g4 + 4 * hh) * 128 + d * 32 + r; asm volatile("" : "+v"(pg));
            pg[0] = acc[d][4 * g4]; pg[128] = acc[d][4 * g4 + 1]; pg[256] = acc[d][4 * g4 + 2]; pg[384] = acc[d][4 * g4 + 3]; }
        const float t = dn[d] + __shfl_xor(dn[d], 32);
        if (dvt == 0 && hh == 0) ((float*)(ws + O_DN))[(bh * 16 + c) * 128 + d * 32 + r] = t;
    }
}
__device__ __forceinline__ void phase_m2(unsigned char* ws, int gtid, int NT) {
    const float* MCH = (const float*)(ws + O_MCH);
    for (int e = gtid; e < BG * 4 * 8192; e += NT) {
        const int bh = e >> 13, pp = e & 8191;
        float c0 = 0.f, c1 = 0.f;
        for (int c = 0; c < 16; ++c) {
            const size_t off = (size_t)(bh * 16 + c) * 16384 + 2 * pp;
            *(unsigned*)((bf16_t*)(ws + O_CT) + off) = pk2(c0, c1);
            const float dec = MCH[(bh * 16 + c) * 4 + 2]; const f32x2 d = *(const f32x2*)((const float*)(ws + O_DCT) + off);
            c0 = dec * c0 + d[0]; c1 = dec * c1 + d[1];
        }
    }
    for (int e = gtid; e < BG * 4 * 128; e += NT) {
        const int bh = e >> 7, dk = e & 127; float n = 0.f;
        for (int c = 0; c < 16; ++c) { const size_t off = (size_t)(bh * 16 + c) * 128 + dk; ((float*)(ws + O_NN))[off] = n; n = MCH[(bh * 16 + c) * 4 + 2] * n + ((const float*)(ws + O_DN))[off]; }
    }
}
__device__ __forceinline__ void m3_item(unsigned char* ws, int l, int it, int lane) {
    const int r = lane & 31, hh = lane >> 5;
    const int pr = ((r >> 2) & 1) * 16 + ((r >> 4) & 1) * 8 + ((r >> 3) & 1) * 4 + (r & 3);
    const int tt = 3 - (it & 3), c = (it >> 2) & 15, bh = it >> 6, b = bh >> 2, h = bh & 3;
    const int ts = c * 128 + tt * 32 + r;
    const size_t trow = (size_t)b * SEQ + ts;
    bf16x8 qf[8];
    const bf16_t* Qp = (const bf16_t*)(ws + O_MQC) + trow * 512 + h * 128 + 8 * hh;
#pragma unroll
    for (int k = 0; k < 8; ++k) qf[k] = *(const bf16x8*)(Qp + 16 * k);
    const float Et = ((const float*)(ws + O_ME))[(size_t)bh * SEQ + ts], bt = ((const float*)(ws + O_MBT))[(size_t)bh * SEQ + ts];
    const float mc = ((const float*)(ws + O_MCH))[(bh * 16 + c) * 4];
    const float winter = __expf(mc - Et);
    f32x16 acc[4];
#pragma unroll
    for (int d = 0; d < 4; ++d)
#pragma unroll
        for (int i = 0; i < 16; ++i) acc[d][i] = 0.f;
    const bf16_t* CTp = (const bf16_t*)(ws + O_CT) + (size_t)(bh * 16 + c) * 16384 + (size_t)r * 128 + 8 * hh;
    const float* NNp = (const float*)(ws + O_NN) + (size_t)(bh * 16 + c) * 128 + 8 * hh;
    float qn = 0.f;
#pragma unroll
    for (int k = 0; k < 8; ++k) {
#pragma unroll
        for (int d = 0; d < 4; ++d) acc[d] = MFMA32(*(const bf16x8*)(CTp + (size_t)d * 32 * 128 + 16 * k), qf[k], acc[d]);
        const f32x4 na = *(const f32x4*)(NNp + 16 * k), nb = *(const f32x4*)(NNp + 16 * k + 4);
        const u32x4 qw = __builtin_bit_cast(u32x4, qf[k]);
        qn += bflo(qw.x) * na[0] + bfhi(qw.x) * na[1] + bflo(qw.y) * na[2] + bfhi(qw.y) * na[3] + bflo(qw.z) * nb[0] + bfhi(qw.z) * nb[1] + bflo(qw.w) * nb[2] + bfhi(qw.w) * nb[3];
    }
    qn += __shfl_xor(qn, 32);
#pragma unroll
    for (int d = 0; d < 4; ++d)
#pragma unroll
        for (int i = 0; i < 16; ++i) acc[d][i] *= winter;
    float dpart = 0.f;
    const bf16_t* Kb = (const bf16_t*)(ws + O_MKC) + ((size_t)b * SEQ + c * 128 + pr) * 512 + h * 128 + 8 * hh;
    const bf16_t* Vb = (const bf16_t*)(ws + O_MVT) + ((size_t)bh * 128 + r) * SEQ + c * 128 + 16 * hh;
    const float* MPb = (const float*)(ws + O_MP) + (size_t)bh * SEQ + c * 128 + 16 * hh;
    for (int st = 0; st <= tt; ++st) {
        f32x16 sc;
#pragma unroll
        for (int i = 0; i < 16; ++i) sc[i] = 0.f;
#pragma unroll
        for (int k = 0; k < 8; ++k) sc = MFMA32(*(const bf16x8*)(Kb + (size_t)st * 32 * 512 + 16 * k), qf[k], sc);
#pragma unroll
        for (int g = 0; g < 4; ++g) { const f32x4 pv = *(const f32x4*)(MPb + st * 32 + 4 * g);
#pragma unroll
            for (int e = 0; e < 4; ++e) { const int i = 4 * g + e;
                const bool ok = (st < tt) || (16 * hh + i <= r);
                const float w = ok ? __expf(pv[e] - Et) : 0.f;
                sc[i] = ok ? sc[i] * w : 0.f; dpart += sc[i]; } }
        u32x4 pw0, pw1;
        pw0.x = pk2(sc[0], sc[1]); pw0.y = pk2(sc[2], sc[3]); pw0.z = pk2(sc[4], sc[5]); pw0.w = pk2(sc[6], sc[7]);
        pw1.x = pk2(sc[8], sc[9]); pw1.y = pk2(sc[10], sc[11]); pw1.z = pk2(sc[12], sc[13]); pw1.w = pk2(sc[14], sc[15]);
        const bf16x8 pf0 = __builtin_bit_cast(bf16x8, pw0), pf1 = __builtin_bit_cast(bf16x8, pw1);
#pragma unroll
        for (int d = 0; d < 4; ++d) {
            acc[d] = MFMA32(*(const bf16x8*)(Vb + (size_t)d * 32 * SEQ + st * 32), pf0, acc[d]);
            acc[d] = MFMA32(*(const bf16x8*)(Vb + (size_t)d * 32 * SEQ + st * 32 + 8), pf1, acc[d]);
        }
    }
    const float den = winter * qn + (dpart + __shfl_xor(dpart, 32));
    const float dinv = 1.f / fmaxf(fabsf(den), __expf(-(bt + Et)));
    float ss = 0.f;
#pragma unroll
    for (int d = 0; d < 4; ++d)
#pragma unroll
        for (int i = 0; i < 16; ++i) { acc[d][i] *= dinv; ss += acc[d][i] * acc[d][i]; }
    ss += __shfl_xor(ss, 32);
    const float rn = rsqrtf(ss * (1.f / 128.f) + EPS);
    const float* onorm = (const float*)(ws + O_PAR) + PAR_ON + l * 512 + h * 128 + 4 * hh;
    const bf16_t* mo = (const bf16_t*)(ws + O_U) + trow * LDU + UC_MO + h * 128 + 4 * hh;
    bf16_t* y = (bf16_t*)(ws + O_Y) + (size_t)2 * MG * 512 + trow * 512 + h * 128 + 4 * hh;
#pragma unroll
    for (int d = 0; d < 4; ++d)
#pragma unroll
        for (int g = 0; g < 4; ++g) {
            const int dv = d * 32 + 8 * g;
            const f32x4 wn = *(const f32x4*)(onorm + dv); const u32x2 og = *(const u32x2*)(mo + dv);
            const float y0 = acc[d][4 * g] * rn * wn[0] * sigm(bflo(og.x)), y1 = acc[d][4 * g + 1] * rn * wn[1] * sigm(bfhi(og.x));
            const float y2 = acc[d][4 * g + 2] * rn * wn[2] * sigm(bflo(og.y)), y3 = acc[d][4 * g + 3] * rn * wn[3] * sigm(bfhi(og.y));
            u32x2 o; o.x = pk2(y0, y1); o.y = pk2(y2, y3); *(u32x2*)(y + dv) = o;
        }
}

__global__ void __launch_bounds__(NTHR, 2) fwd_kernel(KP p) {
    extern __shared__ __attribute__((aligned(16))) unsigned char lds_raw[];
    LAS unsigned char* lds = (LAS unsigned char*)lds_raw;
    cg::grid_group grid = cg::this_grid();
    const int tid = threadIdx.x, lane0 = tid & 63, wave = __builtin_amdgcn_readfirstlane(tid >> 6);
    const int G = gridDim.x, gw0 = blockIdx.x * NWAVES + wave, NWV = G * NWAVES, NT = G * NTHR;
    unsigned char* ws0 = p.ws;
    int pc = 0;
#ifndef PM
#define PM 0xFFFF
#endif
#define PH_BEGIN(id) if (((PM >> (id)) & 1) && pc >= p.ph_lo && pc < p.ph_hi) { unsigned char* ws = ws0; int lane = lane0, gw = gw0; asm volatile("" : "+s"(ws), "+v"(lane), "+s"(gw)); const int gtid = gw * 64 + lane; (void)gtid;
#define PH_END } ++pc; if (pc > p.ph_lo && pc < p.ph_hi) grid.sync();

    PH_BEGIN(0) phase_p0(p, ws, lds, gw, NWV, wave, lane); PH_END

    for (int g = 0; g < NG; ++g) {
        const size_t goff = (size_t)g * MG * DM;
#define XB ((bf16_t*)(ws + O_XB))
#define RS ((float*)(ws + O_RS))
#define U ((bf16_t*)(ws + O_U))
        PH_BEGIN(1) phase_x0(p.in[0] + goff, XB, RS, gw, NWV, lane); PH_END
        for (int l = 0; l < DEPTH; ++l) {
            PH_BEGIN(2) {
                pg8::Gemm gm{XB, (const bf16_t*)(ws + O_WIN) + (size_t)l * NINP * DM, MG, NINP, DM}; pg8::StaticOrder S; S.init(MG, NINP, G, (int)blockIdx.x);
                pg8::EpiA E{0, 0, RS, U, LDU, (float*)(ws + O_SG), nullptr, 0, nullptr};
                pg8::gemm_phase<pg8::EpiA, pg8::StaticOrder, true, true>(lds, gm, S, E);
            } PH_END
            PH_BEGIN(3) {
                constexpr int N_SCAN = BG * 12, N_HN = MG * 26 / 64, N_ST = 17 * (MG / 64);
                for (int it = gw; it < N_SCAN + N_HN + N_ST; it += NWV) {
                    if (it < N_SCAN) gate_scan_item(ws, l, it, lane);
                    else if (it < N_SCAN + N_HN) headnorm_lane(ws, l, (it - N_SCAN) * 64 + lane);
                    else stream_item(ws, l, it - N_SCAN - N_HN, lane);
                }
            } PH_END
            PH_BEGIN(4) {
#ifndef PM4
#define PM4 7
#endif
                if (PM4 & 1) for (int it = gw; it < BG * 4 * 16 * 4; it += NWV) m1_item(ws, it, lane);
                if (PM4 & 2) for (int it = gw; it < BG * 8 * 32; it += NWV) {
                    const int b = it >> 8, h = (it >> 5) & 7, pi = it & 31;
                    const bf16_t* Q = (const bf16_t*)(ws + O_FQN) + (size_t)b * SEQ * 512 + h * 64; const bf16_t* K = (const bf16_t*)(ws + O_FKN) + (size_t)b * SEQ * 512 + h * 64;
                    const bf16_t* VT = (const bf16_t*)(ws + O_FVT) + (size_t)(b * 8 + h) * 64 * SEQ; const float* C = (const float*)(ws + O_FC) + (size_t)(b * 8 + h) * SEQ;
                    bf16_t* Y = (bf16_t*)(ws + O_Y) + (size_t)b * SEQ * 512 + h * 64;
                    attn_qtile<false>(Q, K, 512, VT, C, 0.f, Y, 63 - pi, lane);
                    attn_qtile<false>(Q, K, 512, VT, C, 0.f, Y, pi, lane);
                }
                if (PM4 & 4) for (int it = gw; it < BG * 8 * 64; it += NWV) {
                    const int b = it >> 9, hq = (it >> 6) & 7, qt = it & 63, hk = hq >> 2;
                    const bf16_t* Q = (const bf16_t*)(ws + O_SQR) + (size_t)b * SEQ * 512 + hq * 64; const bf16_t* K = (const bf16_t*)(ws + O_SKR) + (size_t)b * SEQ * 128 + hk * 64;
                    const bf16_t* VT = (const bf16_t*)(ws + O_SVT) + (size_t)(b * 2 + hk) * 64 * SEQ;
                    bf16_t* Y = (bf16_t*)(ws + O_Y) + (size_t)MG * 512 + (size_t)b * SEQ * 512 + hq * 64;
                    attn_qtile<true>(Q, K, 128, VT, nullptr, ((const float*)(ws + O_PAR))[PAR_SINK + l * 8 + hq] * LOG2E, Y, qt, lane);
                }
            } PH_END
            PH_BEGIN(5) phase_m2(ws, gtid, NT); PH_END
            PH_BEGIN(6) { for (int it = gw; it < BG * 4 * 16 * 4; it += NWV) m3_item(ws, l, it, lane); } PH_END
            PH_BEGIN(7) {
                for (int b3 = 0; b3 < 3; ++b3) {
                    pg8::Gemm gm{(const bf16_t*)(ws + O_Y) + (size_t)b3 * MG * 512, (const bf16_t*)(ws + O_WB) + (size_t)(l * 3 + b3) * DM * 512, MG, DM, 512}; pg8::StaticOrder S; S.init(MG, DM, G, (int)blockIdx.x);
                    pg8::EpiA E{1, b3, nullptr, (bf16_t*)(ws + O_MRG), DM, nullptr, U + UC_G + b3 * DM, LDU, (float*)(ws + O_TMP)};
                    pg8::gemm_phase<pg8::EpiA, pg8::StaticOrder, true, true>(lds, gm, S, E);
                }
            } PH_END
            PH_BEGIN(8) {
                pg8::Gemm gm{(const bf16_t*)(ws + O_MRG), (const bf16_t*)(ws + O_WOUT) + (size_t)l * DM * DM, MG, DM, DM}; pg8::StaticOrder S; S.init(MG, DM, G, (int)blockIdx.x);
                pg8::EpiB E{(l == 0 ? p.in[0] : (const float*)p.out) + goff, p.out + goff, XB, RS};
                pg8::gemm_phase<pg8::EpiB, pg8::StaticOrder, true, true>(lds, gm, S, E);
            } PH_END
            PH_BEGIN(9) {
                pg8::Gemm gm{XB, (const bf16_t*)(ws + O_WUP) + (size_t)l * FF * DM, MG, FF, DM}; pg8::StaticOrder S; S.init(MG, FF, G, (int)blockIdx.x);
                pg8::EpiA E{2, 0, RS, U  , FF, nullptr, nullptr, 0, nullptr};
                pg8::gemm_phase<pg8::EpiA, pg8::StaticOrder, true, true>(lds, gm, S, E);
            } PH_END
            PH_BEGIN(10) {
                pg8::Gemm gm{U  , (const bf16_t*)(ws + O_WDN) + (size_t)l * DM * FF, MG, DM, FF}; pg8::StaticOrder S; S.init(MG, DM, G, (int)blockIdx.x);
                pg8::EpiB E{(const float*)p.out + goff, p.out + goff, XB, RS};
                pg8::gemm_phase<pg8::EpiB, pg8::StaticOrder, true, true>(lds, gm, S, E);
            } PH_END
        }
    }
}
constexpr int N_PHASES = 1 + NG * (1 + DEPTH * 9);

#ifndef MK_MULTI
#define MK_MULTI 0
#endif
extern "C" void kernel_launch(void* const* d_in, const int* in_sizes, int n_in, void* d_out, int out_size, void* d_ws, size_t ws_size, hipStream_t stream) {
    static int grid = 0;
    if (grid == 0) {
        if (n_in != 19 || out_size != NB * SEQ * DM || ws_size < WS_NEED) { fprintf(stderr, "kernel_launch: unexpected problem (n_in %d out %d ws %zu need %zu)\n", n_in, out_size, ws_size, (size_t)WS_NEED); grid = -1; return; }
        int dev = 0, cus = 0, per_cu = 0;
        hipGetDevice(&dev); hipDeviceGetAttribute(&cus, hipDeviceAttributeMultiprocessorCount, dev);
        if (hipFuncSetAttribute((const void*)fwd_kernel, hipFuncAttributeMaxDynamicSharedMemorySize, LDS_BYTES) != hipSuccess) { fprintf(stderr, "kernel_launch: hipFuncSetAttribute failed\n"); grid = -1; return; }
        hipOccupancyMaxActiveBlocksPerMultiprocessor(&per_cu, (const void*)fwd_kernel, NTHR, LDS_BYTES);
        (void)hipGetLastError();
        if (per_cu < 1) { fprintf(stderr, "kernel_launch: occupancy query says %d blocks per CU\n", per_cu); per_cu = 1; }
        grid = cus;
    }
    if (grid < 0) return;
    KP a{};
    for (int i = 0; i < 19; ++i) a.in[i] = (const float*)d_in[i];
    a.out = (float*)d_out; a.ws = (unsigned char*)d_ws;
#if MK_MULTI
    for (int ph = 0; ph < N_PHASES; ++ph) { a.ph_lo = ph; a.ph_hi = ph + 1; hipLaunchKernelGGL(fwd_kernel, dim3(grid), dim3(NTHR), LDS_BYTES, stream, a); }
#else
    a.ph_lo = 0; a.ph_hi = N_PHASES;
    void* args[] = {&a};
    hipError_t e = hipLaunchCooperativeKernel((const void*)fwd_kernel, dim3(grid), dim3(NTHR), args, LDS_BYTES, stream);
    if (e != hipSuccess) fprintf(stderr, "kernel_launch: cooperative launch failed: %s (grid %d)\n", hipGetErrorString(e), grid);
#endif
}
```

```cpp
#include <hip/hip_runtime.h>
#include <hip/hip_cooperative_groups.h>
#include <cstdio>
#include <cstdint>
#include <cmath>
namespace cg = cooperative_groups;
namespace pg8 {
#define PG8_LAS __attribute__((address_space(3)))
typedef unsigned short bf16_t;
typedef short bf16x8 __attribute__((ext_vector_type(8)));
typedef float f32x4 __attribute__((ext_vector_type(4)));
typedef unsigned u32x4 __attribute__((ext_vector_type(4)));
constexpr int BM = 256, BK = 64, HALF = 128, HTB = HALF * BK * 2  , STAGE_BYTES = 8 * HTB, NXCD = 8, WGM = 8;

__host__ __device__ __forceinline__ int lds_byte(int r, int c) { const int st = (r >> 4) * 2 + (c >> 5), rr = r & 15, cc = c & 31, ob = rr * 64 + cc * 2; return st * 1024 + (ob ^ (((ob >> 9) & 1) << 5)); }
__host__ __device__ __forceinline__ void stage_rc(int b, int& R, int& C) { const int st = b / 1024, sb = b % 1024, swz = sb ^ (((sb >> 9) & 1) << 5); R = (st >> 1) * 16 + swz / 64; C = (st & 1) * 32 + (swz % 64) / 2; }
__host__ __device__ __forceinline__ int perm32(int rho) { const int n = rho >> 4, i = rho & 15; return 8 * (i >> 2) + 4 * n + (i & 3); }

struct Unit { int pm, pn; };
struct Gemm { const bf16_t* A; const bf16_t* Bt; int M, N, K; };

struct StaticOrder {
    int nM, nN, nwg, G, c;
    __host__ __device__ void init(int M, int N, int G_, int c_) { nM = M / BM; nN = N / BM; nwg = nM * nN; G = G_; c = c_; }
    __host__ __device__ bool next(int i, Unit& u) const {
        const long L = (long)i * G + c; if (L >= nwg) return false;
        int wgid = (int)L; { const int q = nwg / NXCD, r = nwg % NXCD, xcd = wgid % NXCD, off = wgid / NXCD; wgid = (xcd < r ? xcd * (q + 1) : r * (q + 1) + (xcd - r) * q) + off; }
        const int nig = WGM * nN, gid = wgid / nig, fm = gid * WGM, gsz = (nM - fm) < WGM ? (nM - fm) : WGM;
        u.pm = fm + ((wgid % nig) % gsz); u.pn = (wgid % nig) / gsz; return true;
    }
    __device__ __forceinline__ void a_ready(const Unit&) const {}
    __device__ __forceinline__ void done(const Unit&) const {}
};


typedef unsigned u32x2 __attribute__((ext_vector_type(2)));
typedef float f32x2_t __attribute__((ext_vector_type(2)));
typedef __bf16 bf16x2_t __attribute__((ext_vector_type(2)));
__device__ __forceinline__ unsigned pk2(float lo, float hi) { f32x2_t v = {lo, hi}; bf16x2_t b = __builtin_convertvector(v, bf16x2_t); return __builtin_bit_cast(unsigned, b); }
__device__ __forceinline__ float bflo(unsigned w) { return __uint_as_float(w << 16); }
__device__ __forceinline__ float bfhi(unsigned w) { return __uint_as_float(w & 0xffff0000u); }
__device__ __forceinline__ float sigm(float x) { return __builtin_amdgcn_rcpf(1.f + __expf(-x)); }
__device__ __forceinline__ float rowscale(const float* rs, int row) {
    const f32x4* p = (const f32x4*)(rs + (size_t)row * 16);
    const f32x4 a = p[0], b = p[1], c = p[2], d = p[3];
    const float s = ((a[0] + a[1]) + (a[2] + a[3])) + ((b[0] + b[1]) + (b[2] + b[3])) + ((c[0] + c[1]) + (c[2] + c[3])) + ((d[0] + d[1]) + (d[2] + d[3]));
    return rsqrtf(s * (1.f / 1024.f) + 1e-6f);
}
struct EpiA {
    static constexpr bool PERM = true, AFTER_DRAIN = false;
    int mode, sub; const float* rs; bf16_t* out; int ldo; float* sg; const bf16_t* gate; int ldg; float* tmp;
    __device__ __forceinline__ void operator()(const f32x4 (&acc)[2][2][4][2], const Unit& u, int wr, int wc, int fr, int fq) const {
        const int row0 = u.pm * BM + wr * 64 + fr, colb = u.pn * BM + wc * 32 + 8 * fq;
#pragma unroll
        for (int ai = 0; ai < 2; ++ai)
#pragma unroll
            for (int m = 0; m < 4; ++m) {
                const int row = row0 + ai * HALF + m * 16;
                float rsv = 1.f; if (mode != 1) rsv = rowscale(rs, row);
#pragma unroll
                for (int bj = 0; bj < 2; ++bj) {
                    const int col = colb + bj * HALF;
                    f32x4 v0 = acc[ai][bj][m][0] * rsv, v1 = acc[ai][bj][m][1] * rsv;
                    if (mode == 0) {
                        if (u.pn == 29) {
                            if (bj == 0 && wc == 0 && fq < 2) { float* q = sg + (size_t)row * 16 + 8 * fq; *(f32x4*)q = v0; *(f32x4*)(q + 4) = v1; }
                        } else {
                            if (u.pn >= 17) {
#pragma unroll
                                for (int e = 0; e < 4; ++e) { v0[e] = sigm(v0[e]); v1[e] = sigm(v1[e]); }
                            }
                            u32x4 w; w.x = pk2(v0[0], v0[1]); w.y = pk2(v0[2], v0[3]); w.z = pk2(v1[0], v1[1]); w.w = pk2(v1[2], v1[3]);
                            *(u32x4*)(out + (size_t)row * ldo + col) = w;
                        }
                    } else if (mode == 1) {
                        const u32x4 g = *(const u32x4*)(gate + (size_t)row * ldg + col);
                        f32x4 p0 = {v0[0] * bflo(g.x), v0[1] * bfhi(g.x), v0[2] * bflo(g.y), v0[3] * bfhi(g.y)};
                        f32x4 p1 = {v1[0] * bflo(g.z), v1[1] * bfhi(g.z), v1[2] * bflo(g.w), v1[3] * bfhi(g.w)};
                        float* tp = tmp + (size_t)row * 1024 + col;
                        if (sub == 0) { *(f32x4*)tp = p0; *(f32x4*)(tp + 4) = p1; }
                        else if (sub == 1) { *(f32x4*)tp = *(const f32x4*)tp + p0; *(f32x4*)(tp + 4) = *(const f32x4*)(tp + 4) + p1; }
                        else { p0 = p0 + *(const f32x4*)tp; p1 = p1 + *(const f32x4*)(tp + 4);
                            u32x4 w; w.x = pk2(p0[0], p0[1]); w.y = pk2(p0[2], p0[3]); w.z = pk2(p1[0], p1[1]); w.w = pk2(p1[2], p1[3]);
                            *(u32x4*)(out + (size_t)row * ldo + col) = w; }
                    } else {
#pragma unroll
                        for (int e = 0; e < 4; ++e) { const float a = fmaxf(v0[e], 0.f), b = fmaxf(v1[e], 0.f); v0[e] = a * a; v1[e] = b * b; }
                        u32x4 w; w.x = pk2(v0[0], v0[1]); w.y = pk2(v0[2], v0[3]); w.z = pk2(v1[0], v1[1]); w.w = pk2(v1[2], v1[3]);
                        *(u32x4*)(out + (size_t)row * ldo + col) = w;
                    }
                }
            }
    }
};
struct EpiB {
    static constexpr bool PERM = false, AFTER_DRAIN = false;
    const float* resid; float* out; bf16_t* xb; float* rs;
    __device__ __forceinline__ void operator()(const f32x4 (&acc)[2][2][4][2], const Unit& u, int wr, int wc, int fr, int fq) const {
        const int row0 = u.pm * BM + wr * 64 + fr, colb = u.pn * BM + wc * 32 + 4 * fq;
#pragma unroll
        for (int ai = 0; ai < 2; ++ai)
#pragma unroll
            for (int m = 0; m < 4; ++m) {
                const int row = row0 + ai * HALF + m * 16; float ss = 0.f;
#pragma unroll
                for (int bj = 0; bj < 2; ++bj)
#pragma unroll
                    for (int n = 0; n < 2; ++n) {
                        const size_t off = (size_t)row * 1024 + colb + bj * HALF + n * 16;
                        const f32x4 x = *(const f32x4*)(resid + off) + acc[ai][bj][m][n];
                        *(f32x4*)(out + off) = x;
                        u32x2 w; w.x = pk2(x[0], x[1]); w.y = pk2(x[2], x[3]); *(u32x2*)(xb + off) = w;
                        ss += (x[0] * x[0] + x[1] * x[1]) + (x[2] * x[2] + x[3] * x[3]);
                    }
                ss += __shfl_xor(ss, 16); ss += __shfl_xor(ss, 32);
                if (fq == 0) rs[(size_t)row * 16 + u.pn * 4 + wc] = ss;
            }
    }
};

template <class Epi, class Sched, bool ALIGN_EPI = false, bool SP2 = false>
__device__ __forceinline__ void gemm_phase(PG8_LAS unsigned char* lds, const Gemm g, const Sched& S, const Epi& E) {
    int tid_ = threadIdx.x; asm volatile("" : "+v"(tid_));
    const int tid = tid_, wid = __builtin_amdgcn_readfirstlane(tid >> 6), lane = tid & 63, wr = wid >> 2, wc = wid & 3, fr = lane & 15, fq = lane >> 4;
    const int K = g.K, nt = K / BK;
    unsigned voffA[2], voffB[2];
#pragma unroll
    for (int i = 0; i < 2; ++i) { int R, C; stage_rc(tid * 16 + i * 8192, R, C); const int Rb = Epi::PERM ? ((R & ~31) + perm32(R & 31)) : R;
        voffA[i] = (unsigned)(R * K + C) * 2u; voffB[i] = (unsigned)(Rb * K + C) * 2u; }
    const size_t kstep = (size_t)(BK * 2);
    const size_t hstep = (size_t)HALF * K * 2;
    const size_t tstep = 2 * hstep;
    const unsigned ldsw = (unsigned)wid * 1024u;
    const int aoff = lds_byte(wr * 64 + fr, fq * 8), boff = lds_byte(wc * 32 + fr, fq * 8);
#define PG8_SA(b, h) (((b) * 2 + (h)) * HTB)
#define PG8_SB(b, h) ((4 + (b) * 2 + (h)) * HTB)
#define PG8_STAGE(bufoff, gbase, voff) do { _Pragma("unroll") for (int _i = 0; _i < 2; ++_i) \
        __builtin_amdgcn_global_load_lds((const unsigned*)((const char*)(gbase) + (voff)[_i]), (PG8_LAS unsigned*)(lds + (bufoff) + ldsw + _i * 8192), 16, 0, 0); } while (0)
#define PG8_LDA(dst, b, h) do { _Pragma("unroll") for (int m = 0; m < 4; ++m) _Pragma("unroll") for (int k = 0; k < 2; ++k) dst[m][k] = *(const PG8_LAS bf16x8*)(lds + PG8_SA(b, h) + aoff + m * 2048 + k * 1024); } while (0)
#define PG8_LDB(dst, b, h) do { _Pragma("unroll") for (int n = 0; n < 2; ++n) _Pragma("unroll") for (int k = 0; k < 2; ++k) dst[n][k] = *(const PG8_LAS bf16x8*)(lds + PG8_SB(b, h) + boff + n * 2048 + k * 1024); } while (0)
#define PG8_MMA(ai, bj, At, Bt) do { __builtin_amdgcn_s_setprio(1); _Pragma("unroll") for (int m = 0; m < 4; ++m) _Pragma("unroll") for (int n = 0; n < 2; ++n) _Pragma("unroll") for (int k = 0; k < 2; ++k) \
        acc[ai][bj][m][n] = __builtin_amdgcn_mfma_f32_16x16x32_bf16(Bt[n][k], At[m][k], acc[ai][bj][m][n], 0, 0, 0); __builtin_amdgcn_s_setprio(0); } while (0)
#define PG8_WAIT_V(n) asm volatile("s_waitcnt vmcnt(" #n ")" ::: "memory")
#define PG8_WAIT_L(n) asm volatile("s_waitcnt lgkmcnt(" #n ")" ::: "memory")
#define PG8_BAR __builtin_amdgcn_s_barrier()
#define PG8_SCHED __builtin_amdgcn_sched_barrier(0)
    Unit cur, nxt; int ui = 0;
    if (!S.next(0, cur)) return;
    f32x4 acc[2][2][4][2];
#pragma unroll
    for (int a = 0; a < 2; ++a)
#pragma unroll
        for (int b = 0; b < 2; ++b)
#pragma unroll
            for (int m = 0; m < 4; ++m)
#pragma unroll
                for (int n = 0; n < 2; ++n) acc[a][b][m][n] = (f32x4){0.f, 0.f, 0.f, 0.f};
    bf16x8 At[4][2], B0[2][2], B1[2][2];
    const char* cA = (const char*)g.A + (size_t)cur.pm * tstep; const char* cB = (const char*)g.Bt + (size_t)cur.pn * tstep;
    S.a_ready(cur);
    if constexpr (SP2) {
        PG8_STAGE(PG8_SB(0, 0), cB, voffB); PG8_STAGE(PG8_SB(0, 1), cB + hstep, voffB); PG8_STAGE(PG8_SA(0, 0), cA, voffA); PG8_STAGE(PG8_SA(0, 1), cA + hstep, voffA);
        if (wr == 1) PG8_BAR;
        PG8_WAIT_V(2); PG8_BAR;
        PG8_STAGE(PG8_SB(1, 0), cB + kstep, voffB); PG8_STAGE(PG8_SA(1, 0), cA + kstep, voffA); PG8_STAGE(PG8_SB(1, 1), cB + hstep + kstep, voffB);
        PG8_WAIT_V(6); PG8_BAR;
    } else {
        PG8_STAGE(PG8_SB(0, 0), cB, voffB); PG8_STAGE(PG8_SA(0, 0), cA, voffA); PG8_STAGE(PG8_SB(0, 1), cB + hstep, voffB); PG8_STAGE(PG8_SA(0, 1), cA + hstep, voffA);
        if (wr == 1) PG8_BAR;
        PG8_WAIT_V(4); PG8_BAR;
        PG8_STAGE(PG8_SB(1, 0), cB + kstep, voffB); PG8_STAGE(PG8_SA(1, 0), cA + kstep, voffA); PG8_STAGE(PG8_SB(1, 1), cB + hstep + kstep, voffB);
        PG8_WAIT_V(6); PG8_BAR;
    }
    for (;;) {
        const bool has_next = S.next(ui + 1, nxt);
        const char* nA = has_next ? (const char*)g.A + (size_t)nxt.pm * tstep : cA; const char* nB = has_next ? (const char*)g.Bt + (size_t)nxt.pn * tstep : cB;
        for (int t = 0; t < nt; t += 2) {
            const bool last = (t == nt - 2);
            const char* a1 = cA + (size_t)(t + 1) * kstep;
            const char* a2 = last ? nA : cA + (size_t)(t + 2) * kstep; const char* b2 = last ? nB : cB + (size_t)(t + 2) * kstep;
            const char* a3 = a2 + kstep; const char* b3 = b2 + kstep;
            if (last && has_next) S.a_ready(nxt);
            if constexpr (SP2) {
            PG8_LDB(B0, 0, 0); PG8_LDB(B1, 0, 1); PG8_SCHED; PG8_LDA(At, 0, 0); PG8_STAGE(PG8_SA(1, 1), a1 + hstep, voffA);
            PG8_WAIT_V(8); PG8_WAIT_L(0); PG8_BAR; PG8_MMA(0, 0, At, B0); PG8_MMA(0, 1, At, B1); PG8_BAR; PG8_SCHED;
            PG8_LDA(At, 0, 1); PG8_STAGE(PG8_SB(0, 0), b2, voffB); PG8_STAGE(PG8_SB(0, 1), b2 + hstep, voffB); PG8_STAGE(PG8_SA(0, 0), a2, voffA);
            PG8_WAIT_V(8); PG8_WAIT_L(0); PG8_BAR; PG8_MMA(1, 0, At, B0); PG8_MMA(1, 1, At, B1); PG8_BAR; PG8_SCHED;
            PG8_LDB(B0, 1, 0); PG8_LDB(B1, 1, 1); PG8_SCHED; PG8_LDA(At, 1, 0); PG8_STAGE(PG8_SA(0, 1), a2 + hstep, voffA);
            PG8_WAIT_V(8); PG8_WAIT_L(0); PG8_BAR; PG8_MMA(0, 0, At, B0); PG8_MMA(0, 1, At, B1); PG8_BAR; PG8_SCHED;
            PG8_LDA(At, 1, 1); PG8_STAGE(PG8_SB(1, 0), b3, voffB); PG8_STAGE(PG8_SB(1, 1), b3 + hstep, voffB); PG8_STAGE(PG8_SA(1, 0), a3, voffA);
            PG8_WAIT_V(8); PG8_WAIT_L(0); PG8_BAR; PG8_MMA(1, 0, At, B0); PG8_MMA(1, 1, At, B1); PG8_BAR; PG8_SCHED;
            } else {
            PG8_LDB(B0, 0, 0); PG8_SCHED; PG8_LDA(At, 0, 0); PG8_STAGE(PG8_SA(1, 1), a1 + hstep, voffA);
            PG8_WAIT_L(8); PG8_BAR; PG8_WAIT_L(0); PG8_MMA(0, 0, At, B0); PG8_BAR; PG8_SCHED;
            PG8_LDB(B1, 0, 1); PG8_STAGE(PG8_SB(0, 0), b2, voffB);
            PG8_BAR; PG8_WAIT_L(0); PG8_MMA(0, 1, At, B1); PG8_BAR;
            PG8_LDA(At, 0, 1); PG8_STAGE(PG8_SA(0, 0), a2, voffA);
            PG8_BAR; PG8_WAIT_L(0); PG8_MMA(1, 0, At, B0); PG8_BAR; PG8_SCHED;
            PG8_STAGE(PG8_SB(0, 1), b2 + hstep, voffB);
            PG8_WAIT_V(6); PG8_BAR; PG8_MMA(1, 1, At, B1); PG8_BAR;
            PG8_LDB(B0, 1, 0); PG8_SCHED; PG8_LDA(At, 1, 0); PG8_STAGE(PG8_SA(0, 1), a2 + hstep, voffA);
            PG8_WAIT_L(8); PG8_BAR; PG8_WAIT_L(0); PG8_MMA(0, 0, At, B0); PG8_BAR; PG8_SCHED;
            PG8_LDB(B1, 1, 1); PG8_STAGE(PG8_SB(1, 0), b3, voffB);
            PG8_BAR; PG8_WAIT_L(0); PG8_MMA(0, 1, At, B1); PG8_BAR;
            PG8_LDA(At, 1, 1); PG8_STAGE(PG8_SA(1, 0), a3, voffA);
            PG8_BAR; PG8_WAIT_L(0); PG8_MMA(1, 0, At, B0); PG8_BAR; PG8_SCHED;
            PG8_STAGE(PG8_SB(1, 1), b3 + hstep, voffB);
            PG8_WAIT_V(6); PG8_BAR; PG8_MMA(1, 1, At, B1); PG8_BAR;
            }
        }
        if constexpr (ALIGN_EPI) { if (wr == 0) PG8_BAR; }
        if constexpr (!Epi::AFTER_DRAIN) { E(acc, cur, wr, wc, fr, fq); S.done(cur); }
        if (!has_next) break;
#pragma unroll
        for (int a = 0; a < 2; ++a)
#pragma unroll
            for (int b = 0; b < 2; ++b)
#pragma unroll
                for (int m = 0; m < 4; ++m)
#pragma unroll
                    for (int n = 0; n < 2; ++n) acc[a][b][m][n] = (f32x4){0.f, 0.f, 0.f, 0.f};
        cur = nxt; cA = nA; cB = nB; ++ui;
        if constexpr (ALIGN_EPI) { if (wr == 1) PG8_BAR; }
    }
    PG8_WAIT_V(0);
    if constexpr (!ALIGN_EPI) { if (wr == 0) PG8_BAR; }
    PG8_BAR;
    if constexpr (Epi::AFTER_DRAIN) { E.fused(acc, cur, wr, wc, fr, fq, lds, wid, lane); S.done(cur); }
#undef PG8_SA
#undef PG8_SB
#undef PG8_STAGE
#undef PG8_LDA
#undef PG8_LDB
#undef PG8_MMA
#undef PG8_WAIT_V
#undef PG8_WAIT_L
#undef PG8_BAR
#undef PG8_SCHED
}
}

#define LAS __attribute__((address_space(3)))
typedef unsigned short bf16_t;
typedef short bf16x8 __attribute__((ext_vector_type(8)));
typedef float f32x4 __attribute__((ext_vector_type(4)));
typedef float f32x2 __attribute__((ext_vector_type(2)));
typedef float f32x16 __attribute__((ext_vector_type(16)));
typedef unsigned u32x4 __attribute__((ext_vector_type(4)));
typedef unsigned u32x2 __attribute__((ext_vector_type(2)));
using pg8::pk2; using pg8::bflo; using pg8::bfhi; using pg8::sigm;

constexpr int NB = 32, SEQ = 2048, DM = 1024, DEPTH = 2, INW = 7440, NINP = 7680, LDU = 7424, FF = 4096;
constexpr int NG = 2, BG = NB / NG, MG = BG * SEQ;
constexpr float LOG2E = 1.4426950408889634f, EPS = 1e-6f;
constexpr int NWAVES = 8, NTHR = 512;
constexpr int LDS_BYTES = 131072 + 1024;

constexpr int UC_FQ = 0, UC_FK = 512, UC_FV = 1024, UC_SQ = 1536, UC_SK = 2048, UC_SV = 2176, UC_MQ = 2304, UC_MK = 2816, UC_MV = 3328, UC_MO = 3840, UC_G = 4352;

constexpr size_t al(size_t x) { return (x + 255) & ~(size_t)255; }
constexpr size_t O_WIN = 0;
constexpr size_t O_WB = O_WIN + al((size_t)DEPTH * NINP * DM * 2);
constexpr size_t O_WOUT = O_WB + al((size_t)DEPTH * 3 * DM * 512 * 2);
constexpr size_t O_WUP = O_WOUT + al((size_t)DEPTH * DM * DM * 2);
constexpr size_t O_WDN = O_WUP + al((size_t)DEPTH * FF * DM * 2);
constexpr size_t O_ROPE = O_WDN + al((size_t)DEPTH * DM * FF * 2);
constexpr size_t O_PAR = O_ROPE + al((size_t)SEQ * 32 * 2 * 4);
constexpr int PAR_FFB = 0, PAR_FQN = 16, PAR_FKN = 144, PAR_SQN = 272, PAR_SKN = 400, PAR_SINK = 528, PAR_CW = 544, PAR_CB = 8736, PAR_IB = 10784, PAR_FB = 10792, PAR_ON = 10800, PAR_N = 11824;
constexpr size_t O_XB = O_PAR + al((size_t)PAR_N * 4);
constexpr size_t O_RS = O_XB + al((size_t)MG * DM * 2);
constexpr size_t O_U = O_RS + al((size_t)MG * 16 * 4);
constexpr size_t O_SG = O_U + al((size_t)MG * LDU * 2);
constexpr size_t O_FC = O_SG + al((size_t)MG * 16 * 4);
constexpr size_t O_MP = O_FC + al((size_t)BG * 8 * SEQ * 4);
constexpr size_t O_ME = O_MP + al((size_t)BG * 4 * SEQ * 4);
constexpr size_t O_MBT = O_ME + al((size_t)BG * 4 * SEQ * 4);
constexpr size_t O_MCH = O_MBT + al((size_t)BG * 4 * SEQ * 4);
constexpr size_t O_FQN = O_MCH + al((size_t)BG * 4 * 16 * 4 * 4);
constexpr size_t O_FKN = O_FQN + (size_t)MG * 512 * 2;
constexpr size_t O_FVT = O_FKN + (size_t)MG * 512 * 2;
constexpr size_t O_SQR = O_FVT + (size_t)MG * 512 * 2;
constexpr size_t O_TMP = O_FQN;
constexpr size_t O_SKR = O_SQR + (size_t)MG * 512 * 2;
constexpr size_t O_SVT = O_SKR + (size_t)MG * 128 * 2;
constexpr size_t O_MQC = O_SVT + (size_t)MG * 128 * 2;
constexpr size_t O_MKC = O_MQC + (size_t)MG * 512 * 2;
constexpr size_t O_MRG = O_MQC;
constexpr size_t O_KT = O_MKC + (size_t)MG * 512 * 2;
constexpr size_t O_MVT = O_KT + (size_t)MG * 512 * 2;
constexpr size_t O_DN = O_MVT + (size_t)MG * 512 * 2;
constexpr size_t O_CT = O_KT;
constexpr size_t O_NN = O_DN + al((size_t)BG * 4 * 16 * 128 * 4);
constexpr size_t O_Y = O_NN + al((size_t)BG * 4 * 16 * 128 * 4);
constexpr size_t O_DCT = O_Y + (size_t)2 * MG * 512 * 2;
constexpr size_t O_BAR = O_Y + (size_t)3 * MG * 512 * 2;
constexpr size_t WS_NEED = O_BAR + 16384;
static_assert((size_t)BG * 4 * 16 * 16384 * 2 == (size_t)MG * 512 * 2, "DCT overlays Y2; CT overlays KT");
static_assert((size_t)MG * FF * 2 <= (size_t)MG * LDU * 2, "ACT overlays U");

struct KP { const float* in[19]; float* out; unsigned char* ws; int ph_lo, ph_hi; };

__device__ __forceinline__ float wave_sum(float v) {
#pragma unroll
    for (int o = 1; o < 64; o <<= 1) v += __shfl_xor(v, o);
    return v;
}
__device__ __forceinline__ float logsig(float x) { return fminf(x, 0.f) - log1pf(__expf(-fabsf(x))); }
#define LDSW() asm volatile("s_waitcnt lgkmcnt(0)" ::: "memory")

__device__ __forceinline__ int win_srccol(int n) {
    if (n < 1536) return n; if (n < 3840) return n + 8; if (n < 7424) return n + 16; if (n < 7432) return n - 7424 + 1536; if (n < 7440) return n - 7432 + 3848; return -1;
}
template <bool REMAP>
__device__ __forceinline__ void tr_item(const float* W, int K, int N, const float* kscale, bf16_t* WT, int item, int nblk, LAS float* scr, int lane) {
    const int kb = item / nblk, nb = item % nblk, k0 = 64 * kb, n0 = 32 * nb;
    const int nd = n0 + (lane & 31); const int ns = REMAP ? win_srccol(nd) : nd;
#pragma unroll 8
    for (int i = 0; i < 32; ++i) { const int kk = 2 * i + (lane >> 5); float v = 0.f; if (ns >= 0) v = W[(size_t)(k0 + kk) * N + ns]; if (kscale) v *= kscale[k0 + kk]; scr[kk * 33 + (lane & 31)] = v; }
    LDSW();
    const int c = lane & 7;
#pragma unroll
    for (int j = 0; j < 4; ++j) { const int n = (lane >> 3) + 8 * j; const LAS float* s = scr + (8 * c) * 33 + n;
        u32x4 o; o.x = pk2(s[0 * 33], s[1 * 33]); o.y = pk2(s[2 * 33], s[3 * 33]); o.z = pk2(s[4 * 33], s[5 * 33]); o.w = pk2(s[6 * 33], s[7 * 33]);
        *(u32x4*)(WT + (size_t)(n0 + n) * K + k0 + 8 * c) = o; }
    LDSW();
}
__device__ __forceinline__ void phase_p0(const KP& p, unsigned char* ws, LAS unsigned char* lds, int gw, int NWV, int wave, int lane) {
    LAS float* scr = (LAS float*)(lds + wave * 16384);
    const float *norm_mix = p.in[1], *w_in = p.in[2], *w_branch = p.in[14], *w_out = p.in[15], *norm_mlp = p.in[16], *w_up = p.in[17], *w_down = p.in[18];
    constexpr int PER = 3840 + 768 + 512 + 2048 + 2048;
    for (int it = gw; it < DEPTH * PER; it += NWV) {
        const int l = it / PER; int r = it % PER;
        if (r < 3840) { tr_item<true>(w_in + (size_t)l * DM * INW, DM, INW, norm_mix + l * DM, (bf16_t*)(ws + O_WIN) + (size_t)l * NINP * DM, r, 240, scr, lane); continue; } r -= 3840;
        if (r < 768) { const int b = r / 256; tr_item<false>(w_branch + (size_t)(l * 3 + b) * 512 * DM, 512, DM, nullptr, (bf16_t*)(ws + O_WB) + (size_t)(l * 3 + b) * DM * 512, r % 256, 32, scr, lane); continue; } r -= 768;
        if (r < 512) { tr_item<false>(w_out + (size_t)l * DM * DM, DM, DM, nullptr, (bf16_t*)(ws + O_WOUT) + (size_t)l * DM * DM, r, 32, scr, lane); continue; } r -= 512;
        if (r < 2048) { tr_item<false>(w_up + (size_t)l * DM * FF, DM, FF, norm_mlp + l * DM, (bf16_t*)(ws + O_WUP) + (size_t)l * FF * DM, r, 128, scr, lane); continue; } r -= 2048;
        tr_item<false>(w_down + (size_t)l * FF * DM, FF, DM, nullptr, (bf16_t*)(ws + O_WDN) + (size_t)l * DM * FF, r, 32, scr, lane);
    }
    { float* par = (float*)(ws + O_PAR); const int t0 = gw * 64 + lane, ts = NWV * 64;
      for (int e = t0; e < 16; e += ts) { par[PAR_FFB + e] = p.in[3][e]; par[PAR_SINK + e] = p.in[8][e]; }
      for (int e = t0; e < 128; e += ts) { par[PAR_FQN + e] = p.in[4][e]; par[PAR_FKN + e] = p.in[5][e]; par[PAR_SQN + e] = p.in[6][e]; par[PAR_SKN + e] = p.in[7][e]; }
      for (int e = t0; e < 8192; e += ts) par[PAR_CW + e] = p.in[9][e];
      for (int e = t0; e < 2048; e += ts) par[PAR_CB + e] = p.in[10][e];
      for (int e = t0; e < 8; e += ts) { par[PAR_IB + e] = p.in[11][e]; par[PAR_FB + e] = p.in[12][e]; }
      for (int e = t0; e < 1024; e += ts) par[PAR_ON + e] = p.in[13][e]; }
    float* rope = (float*)(ws + O_ROPE);
    for (int e = gw * 64 + lane; e < SEQ * 32; e += NWV * 64) {
        const int pos = e >> 5, i = e & 31;
        const float inv = powf(10000.f, -(float)(2 * i) / 64.f), ang = (float)pos * inv;
        rope[2 * e] = cosf(ang); rope[2 * e + 1] = sinf(ang);
    }
}
__device__ __forceinline__ void phase_x0(const float* x, bf16_t* XB, float* RS, int gw, int NWV, int lane) {
    for (int row = gw; row < MG; row += NWV) {
        const f32x4* xr = (const f32x4*)(x + (size_t)row * DM) + lane;
        f32x4 v[4]; float s = 0.f;
#pragma unroll
        for (int j = 0; j < 4; ++j) { v[j] = xr[64 * j]; s += (v[j][0] * v[j][0] + v[j][1] * v[j][1]) + (v[j][2] * v[j][2] + v[j][3] * v[j][3]); }
        s = wave_sum(s);
        u32x2* o = (u32x2*)(XB + (size_t)row * DM) + lane;
#pragma unroll
        for (int j = 0; j < 4; ++j) { u32x2 w; w.x = pk2(v[j][0], v[j][1]); w.y = pk2(v[j][2], v[j][3]); o[64 * j] = w; }
        if (lane < 16) RS[(size_t)row * 16 + lane] = (lane == 0) ? s : 0.f;
    }
}
__device__ __forceinline__ void gate_scan_item(unsigned char* ws, int l, int it, int lane) {
    const float* par = (const float*)(ws + O_PAR); const float* SG = (const float*)(ws + O_SG);
    if (it < BG * 8) {
        const int b = it >> 3, h = it & 7; const float bias = par[PAR_FFB + l * 8 + h];
        const float* src = SG + ((size_t)b * SEQ + lane * 32) * 16 + h;
        float tot = 0.f;
#pragma unroll 4
        for (int j = 0; j < 32; ++j) tot += logsig(src[j * 16] + bias);
        float x = tot;
#pragma unroll
        for (int o = 1; o < 64; o <<= 1) { const float y = __shfl_up(x, o); if (lane >= o) x += y; }
        float run = x - tot;
        float* dst = (float*)(ws + O_FC) + (size_t)it * SEQ + lane * 32;
#pragma unroll 4
        for (int j = 0; j < 32; ++j) { run += logsig(src[j * 16] + bias); dst[j] = run * LOG2E; }
    } else {
        const int sq = it - BG * 8, b = sq >> 2, h = sq & 3;
        const float ibias = par[PAR_IB + l * 4 + h], fbias = par[PAR_FB + l * 4 + h];
        float* MP = (float*)(ws + O_MP) + (size_t)sq * SEQ; float* ME = (float*)(ws + O_ME) + (size_t)sq * SEQ; float* MBT = (float*)(ws + O_MBT) + (size_t)sq * SEQ;
        float* MCH = (float*)(ws + O_MCH) + (size_t)sq * 64;
        float mc = 0.f;
#pragma unroll 1
        for (int c = 0; c < 16; ++c) {
            const float* s0 = SG + ((size_t)b * SEQ + c * 128 + 2 * lane) * 16;
            const float f0 = logsig(s0[12 + h] + fbias), f1 = logsig(s0[16 + 12 + h] + fbias);
            const float i0 = s0[8 + h] + ibias, i1 = s0[16 + 8 + h] + ibias;
            float x = f0 + f1;
#pragma unroll
            for (int o = 1; o < 64; o <<= 1) { const float y = __shfl_up(x, o); if (lane >= o) x += y; }
            const float b1 = x, b0 = x - f1;
            const float p0 = i0 - b0, p1 = i1 - b1;
            float mxs = fmaxf(p0, p1);
#pragma unroll
            for (int o = 1; o < 64; o <<= 1) { const float y = __shfl_up(mxs, o); if (lane >= o) mxs = fmaxf(mxs, y); }
            float prev = __shfl_up(mxs, 1); if (lane == 0) prev = -INFINITY;
            const float u0 = fmaxf(prev, p0), u1 = mxs;
            const float e0 = fmaxf(mc, u0), e1 = fmaxf(mc, u1);
            const int t = c * 128 + 2 * lane;
            *(f32x2*)(MP + t) = (f32x2){p0, p1}; *(f32x2*)(ME + t) = (f32x2){e0, e1}; *(f32x2*)(MBT + t) = (f32x2){b0, b1};
            const float ulast = __shfl(mxs, 63), bL = __shfl(x, 63);
            const float mx = fmaxf(mc, ulast), dec = __expf(mc - mx);
            if (lane == 0) *(f32x4*)(MCH + c * 4) = (f32x4){mc, mx, dec, bL};
            mc = bL + mx;
        }
    }
}
__device__ __forceinline__ void headnorm_lane(unsigned char* ws, int l, int idx) {
    const float* par = (const float*)(ws + O_PAR);
    const int tok = idx / 26, slot = idx % 26;
    int srccol; bf16_t* dst; const float* w; float scale; bool rp;
    if (slot < 8) { srccol = UC_FQ + slot * 64; dst = (bf16_t*)(ws + O_FQN) + (size_t)tok * 512 + slot * 64; w = par + PAR_FQN + l * 64; scale = 0.125f * LOG2E; rp = false; }
    else if (slot < 16) { const int h = slot - 8; srccol = UC_FK + h * 64; dst = (bf16_t*)(ws + O_FKN) + (size_t)tok * 512 + h * 64; w = par + PAR_FKN + l * 64; scale = 1.f; rp = false; }
    else if (slot < 24) { const int h = slot - 16; srccol = UC_SQ + h * 64; dst = (bf16_t*)(ws + O_SQR) + (size_t)tok * 512 + h * 64; w = par + PAR_SQN + l * 64; scale = 0.125f * LOG2E; rp = true; }
    else { const int h = slot - 24; srccol = UC_SK + h * 64; dst = (bf16_t*)(ws + O_SKR) + (size_t)tok * 128 + h * 64; w = par + PAR_SKN + l * 64; scale = 1.f; rp = true; }
    const u32x4* src = (const u32x4*)((const bf16_t*)(ws + O_U) + (size_t)tok * LDU + srccol);
    unsigned xw[32]; float ss = 0.f;
#pragma unroll
    for (int j = 0; j < 8; ++j) { const u32x4 v = src[j]; xw[4 * j] = v.x; xw[4 * j + 1] = v.y; xw[4 * j + 2] = v.z; xw[4 * j + 3] = v.w; }
#pragma unroll
    for (int j = 0; j < 32; ++j) { const float a = bflo(xw[j]), b = bfhi(xw[j]); ss += a * a + b * b; }
    const float rn = rsqrtf(ss * (1.f / 64.f) + EPS) * scale;
    const f32x4* rt = (const f32x4*)((const float*)(ws + O_ROPE) + (size_t)(tok % SEQ) * 64);
#pragma unroll
    for (int j = 0; j < 16; ++j) {
        const f32x2 wa = *(const f32x2*)(w + 2 * j), wb = *(const f32x2*)(w + 2 * j + 32);
        float a0 = bflo(xw[j]) * rn * wa[0], a1 = bfhi(xw[j]) * rn * wa[1], b0 = bflo(xw[j + 16]) * rn * wb[0], b1 = bfhi(xw[j + 16]) * rn * wb[1];
        if (rp) { const f32x4 cs = rt[j];
            const float t0 = a0 * cs[0] - b0 * cs[1], t1 = a0 * cs[1] + b0 * cs[0], t2 = a1 * cs[2] - b1 * cs[3], t3 = a1 * cs[3] + b1 * cs[2];
            a0 = t0; b0 = t1; a1 = t2; b1 = t3; }
        xw[j] = pk2(a0, a1); xw[j + 16] = pk2(b0, b1);
    }
    u32x4* o = (u32x4*)dst;
#pragma unroll
    for (int j = 0; j < 8; ++j) { u32x4 v; v.x = xw[4 * j]; v.y = xw[4 * j + 1]; v.z = xw[4 * j + 2]; v.w = xw[4 * j + 3]; o[j] = v; }
}
__device__ __forceinline__ void stream_item(unsigned char* ws, int l, int item, int lane) {
    const int cb = item % 17, tb = item / 17, tok0 = tb * 64, b = tok0 / SEQ, s0 = tok0 % SEQ;
    const bf16_t* U = (const bf16_t*)(ws + O_U);
    int srccol, chan; bf16_t* dT = nullptr; bf16_t* dN = nullptr; int convch = -1; float oscale = 1.f;
    if (cb < 4) { chan = cb * 128 + 2 * lane; srccol = UC_FV + chan; dT = (bf16_t*)(ws + O_FVT) + ((size_t)b * 512 + chan) * SEQ; }
    else if (cb < 5) { chan = 2 * lane; srccol = UC_SV + chan; dT = (bf16_t*)(ws + O_SVT) + ((size_t)b * 128 + chan) * SEQ; }
    else if (cb < 9) { chan = (cb - 5) * 128 + 2 * lane; srccol = UC_MV + chan; dT = (bf16_t*)(ws + O_MVT) + ((size_t)b * 512 + chan) * SEQ; }
    else if (cb < 13) { chan = (cb - 9) * 128 + 2 * lane; srccol = UC_MQ + chan; dN = (bf16_t*)(ws + O_MQC) + chan; convch = chan; }
    else { chan = (cb - 13) * 128 + 2 * lane; srccol = UC_MK + chan; dN = (bf16_t*)(ws + O_MKC) + chan; dT = (bf16_t*)(ws + O_KT) + ((size_t)b * 512 + chan) * SEQ; convch = 512 + chan; oscale = 0.08838834764831845f; }
    const bf16_t* src = U + (size_t)tok0 * LDU + srccol;
    if (cb < 9) {
#pragma unroll 1
        for (int tg = 0; tg < 8; ++tg) {
            unsigned w[8];
#pragma unroll
            for (int j = 0; j < 8; ++j) w[j] = *(const unsigned*)(src + (size_t)(tg * 8 + j) * LDU);
            u32x4 a, c;
            a.x = (w[0] & 0xffffu) | (w[1] << 16); a.y = (w[2] & 0xffffu) | (w[3] << 16); a.z = (w[4] & 0xffffu) | (w[5] << 16); a.w = (w[6] & 0xffffu) | (w[7] << 16);
            c.x = (w[0] >> 16) | (w[1] & 0xffff0000u); c.y = (w[2] >> 16) | (w[3] & 0xffff0000u); c.z = (w[4] >> 16) | (w[5] & 0xffff0000u); c.w = (w[6] >> 16) | (w[7] & 0xffff0000u);
            *(u32x4*)(dT + s0 + tg * 8) = a; *(u32x4*)(dT + SEQ + s0 + tg * 8) = c;
        }
    } else {
        const float* cw = (const float*)(ws + O_PAR) + PAR_CW + l * 4 * 1024 + convch; const float* cbias = (const float*)(ws + O_PAR) + PAR_CB + l * 1024 + convch;
        const f32x2 w0 = *(const f32x2*)(cw), w1 = *(const f32x2*)(cw + 1024), w2 = *(const f32x2*)(cw + 2048), w3 = *(const f32x2*)(cw + 3072), bb = *(const f32x2*)cbias;
        f32x2 xm3 = {0.f, 0.f}, xm2 = {0.f, 0.f}, xm1 = {0.f, 0.f};
        if (s0 > 0) { const unsigned a = *(const unsigned*)(src - 3 * (size_t)LDU), c = *(const unsigned*)(src - 2 * (size_t)LDU), d = *(const unsigned*)(src - (size_t)LDU);
            xm3 = (f32x2){bflo(a), bfhi(a)}; xm2 = (f32x2){bflo(c), bfhi(c)}; xm1 = (f32x2){bflo(d), bfhi(d)}; }
#pragma unroll 1
        for (int tg = 0; tg < 8; ++tg) {
            float y0[8], y1[8];
#pragma unroll
            for (int j = 0; j < 8; ++j) {
                const unsigned wv = *(const unsigned*)(src + (size_t)(tg * 8 + j) * LDU);
                const f32x2 xc = {bflo(wv), bfhi(wv)};
                f32x2 y = bb + w0 * xm3 + w1 * xm2 + w2 * xm1 + w3 * xc;
                xm3 = xm2; xm2 = xm1; xm1 = xc;
                y0[j] = y[0] * sigm(y[0]) * oscale; y1[j] = y[1] * sigm(y[1]) * oscale;
                *(unsigned*)(dN + (size_t)(tok0 + tg * 8 + j) * 512) = pk2(y0[j], y1[j]);
            }
            if (dT) {
                u32x4 a, c;
                a.x = pk2(y0[0], y0[1]); a.y = pk2(y0[2], y0[3]); a.z = pk2(y0[4], y0[5]); a.w = pk2(y0[6], y0[7]);
                c.x = pk2(y1[0], y1[1]); c.y = pk2(y1[2], y1[3]); c.z = pk2(y1[4], y1[5]); c.w = pk2(y1[6], y1[7]);
                *(u32x4*)(dT + s0 + tg * 8) = a; *(u32x4*)(dT + SEQ + s0 + tg * 8) = c;
            }
        }
    }
}
#define MFMA32(a, b, c) __builtin_amdgcn_mfma_f32_32x32x16_bf16((a), (b), (c), 0, 0, 0)
template <bool SWA>
__device__ __forceinline__ void attn_qtile(const bf16_t* __restrict__ Q, const bf16_t* __restrict__ K, int kpitch, const bf16_t* __restrict__ VT,
                                           const float* __restrict__ C, float sink2, bf16_t* __restrict__ Y, int qt, int lane) {
    const int r = lane & 31, hh = lane >> 5;
    const int pr = ((r >> 2) & 1) * 16 + ((r >> 4) & 1) * 8 + ((r >> 3) & 1) * 4 + (r & 3);
    const int q0 = qt * 32;
    bf16x8 qf[4];
#pragma unroll
    for (int st = 0; st < 4; ++st) qf[st] = *(const bf16x8*)(Q + (size_t)(q0 + r) * 512 + 16 * st + 8 * hh);
    float cq = 0.f; if (!SWA) cq = C[q0 + r];
    float m = -1e30f, lsum = 0.f;
    f32x16 o0, o1;
#pragma unroll
    for (int i = 0; i < 16; ++i) { o0[i] = 0.f; o1[i] = 0.f; }
    const int kt_lo = SWA ? (qt > 4 ? qt - 4 : 0) : 0;
    for (int kt = kt_lo; kt <= qt; ++kt) {
        const int key0 = kt * 32;
        bf16x8 kf[4];
#pragma unroll
        for (int st = 0; st < 4; ++st) kf[st] = *(const bf16x8*)(K + (size_t)(key0 + pr) * kpitch + 16 * st + 8 * hh);
        bf16x8 vf[2][2];
#pragma unroll
        for (int dh = 0; dh < 2; ++dh)
#pragma unroll
            for (int s = 0; s < 2; ++s) vf[dh][s] = *(const bf16x8*)(VT + (size_t)(dh * 32 + r) * SEQ + key0 + 16 * hh + 8 * s);
        f32x16 sc;
#pragma unroll
        for (int i = 0; i < 16; ++i) sc[i] = 0.f;
#pragma unroll
        for (int st = 0; st < 4; ++st) sc = MFMA32(kf[st], qf[st], sc);
        if (!SWA) {
            const f32x4* cp = (const f32x4*)(C + key0 + 16 * hh);
#pragma unroll
            for (int g = 0; g < 4; ++g) { const f32x4 ck = cp[g];
#pragma unroll
                for (int e = 0; e < 4; ++e) sc[4 * g + e] += cq - ck[e]; }
        }
        if (kt == qt) {
#pragma unroll
            for (int i = 0; i < 16; ++i) if (16 * hh + i > r) sc[i] = -INFINITY;
        }
        if (SWA && kt == qt - 4) {
#pragma unroll
            for (int i = 0; i < 16; ++i) if (16 * hh + i <= r) sc[i] = -INFINITY;
        }
        float tm = sc[0];
#pragma unroll
        for (int i = 1; i < 16; ++i) tm = fmaxf(tm, sc[i]);
        tm = fmaxf(tm, __shfl_xor(tm, 32));
        const float mn = fmaxf(m, tm), alpha = __builtin_amdgcn_exp2f(m - mn);
        m = mn;
        float ps = 0.f;
#pragma unroll
        for (int i = 0; i < 16; ++i) { sc[i] = __builtin_amdgcn_exp2f(sc[i] - mn); ps += sc[i]; }
        lsum = lsum * alpha + ps;
#pragma unroll
        for (int i = 0; i < 16; ++i) { o0[i] *= alpha; o1[i] *= alpha; }
        u32x4 pw0, pw1;
        pw0.x = pk2(sc[0], sc[1]); pw0.y = pk2(sc[2], sc[3]); pw0.z = pk2(sc[4], sc[5]); pw0.w = pk2(sc[6], sc[7]);
        pw1.x = pk2(sc[8], sc[9]); pw1.y = pk2(sc[10], sc[11]); pw1.z = pk2(sc[12], sc[13]); pw1.w = pk2(sc[14], sc[15]);
        const bf16x8 pf0 = __builtin_bit_cast(bf16x8, pw0), pf1 = __builtin_bit_cast(bf16x8, pw1);
        o0 = MFMA32(vf[0][0], pf0, o0); o0 = MFMA32(vf[0][1], pf1, o0);
        o1 = MFMA32(vf[1][0], pf0, o1); o1 = MFMA32(vf[1][1], pf1, o1);
    }
    float lt = lsum + __shfl_xor(lsum, 32);
    if (SWA) lt += __builtin_amdgcn_exp2f(sink2 - m);
    const float inv = 1.f / lt;
    bf16_t* yrow = Y + (size_t)(q0 + r) * 512 + 4 * hh;
#pragma unroll
    for (int g = 0; g < 4; ++g) {
        u32x2 a, c;
        a.x = pk2(o0[4 * g] * inv, o0[4 * g + 1] * inv); a.y = pk2(o0[4 * g + 2] * inv, o0[4 * g + 3] * inv);
        c.x = pk2(o1[4 * g] * inv, o1[4 * g + 1] * inv); c.y = pk2(o1[4 * g + 2] * inv, o1[4 * g + 3] * inv);
        *(u32x2*)(yrow + 8 * g) = a; *(u32x2*)(yrow + 32 + 8 * g) = c;
    }
}
__device__ __forceinline__ void m1_item(unsigned char* ws, int it, int lane) {
    const int r = lane & 31, hh = lane >> 5;
    const int dvt = it & 3, c = (it >> 2) & 15, bh = it >> 6;
    const bf16_t* VTp = (const bf16_t*)(ws + O_MVT) + ((size_t)bh * 128 + dvt * 32 + r) * SEQ + c * 128 + 8 * hh;
    const bf16_t* KTp = (const bf16_t*)(ws + O_KT) + ((size_t)bh * 128 + r) * SEQ + c * 128 + 8 * hh;
    const float* MPp = (const float*)(ws + O_MP) + (size_t)bh * SEQ + c * 128 + 8 * hh;
    const float mx = ((const float*)(ws + O_MCH))[(bh * 16 + c) * 4 + 1];
    f32x16 acc[4];
#pragma unroll
    for (int d = 0; d < 4; ++d)
#pragma unroll
        for (int i = 0; i < 16; ++i) acc[d][i] = 0.f;
    float dn[4] = {0.f, 0.f, 0.f, 0.f};
#pragma unroll 1
    for (int st = 0; st < 8; ++st) {
        const bf16x8 vf = *(const bf16x8*)(VTp + 16 * st);
        const f32x4 pa = *(const f32x4*)(MPp + 16 * st), pb = *(const f32x4*)(MPp + 16 * st + 4);
        float wk[8];
#pragma unroll
        for (int e = 0; e < 4; ++e) { wk[e] = __expf(pa[e] - mx); wk[4 + e] = __expf(pb[e] - mx); }
#pragma unroll
        for (int d = 0; d < 4; ++d) {
            const u32x4 kr = *(const u32x4*)(KTp + (size_t)d * 32 * SEQ + 16 * st);
            const float k0 = bflo(kr.x) * wk[0], k1 = bfhi(kr.x) * wk[1], k2 = bflo(kr.y) * wk[2], k3 = bfhi(kr.y) * wk[3];
            const float k4 = bflo(kr.z) * wk[4], k5 = bfhi(kr.z) * wk[5], k6 = bflo(kr.w) * wk[6], k7 = bfhi(kr.w) * wk[7];
            dn[d] += ((k0 + k1) + (k2 + k3)) + ((k4 + k5) + (k6 + k7));
            u32x4 kw; kw.x = pk2(k0, k1); kw.y = pk2(k2, k3); kw.z = pk2(k4, k5); kw.w = pk2(k6, k7);
            acc[d] = MFMA32(vf, __builtin_bit_cast(bf16x8, kw), acc[d]);
        }
    }
    bf16_t* DCT = (bf16_t*)(ws + O_DCT) + (size_t)(bh * 16 + c) * 16384;
#pragma unroll
    for (int d = 0; d < 4; ++d) {
#pragma unroll
        for (int g4 = 0; g4 < 4; ++g4) { bf16_t* pg = DCT + (dvt * 32 + 8 * g4 + 4 * hh) * 128 + d * 32 + r; asm volatile("" : "+v"(pg));
            pg[0] = (bf16_t)pk2(acc[d][4 * g4], 0.f); pg[128] = (bf16_t)pk2(acc[d][4 * g4 + 1], 0.f); pg[256] = (bf16_t)pk2(acc[d][4 * g4 + 2], 0.f); pg[384] = (bf16_t)pk2(acc[d][4 * g4 + 3], 0.f); }
        const float t = dn[d] + __shfl_xor(dn[d], 32);
        if (dvt == 0 && hh == 0) ((float*)(ws + O_DN))[(bh * 16 + c) * 128 + d * 32 + r] = t;
    }
}
__device__ __forceinline__ void phase_m2(unsigned char* ws, int gtid, int NT) {
    const float* MCH = (const float*)(ws + O_MCH);
    for (int e = gtid; e < BG * 4 * 8192; e += NT) {
        const int bh = e >> 13, pp = e & 8191;
        float c0 = 0.f, c1 = 0.f;
        for (int c = 0; c < 16; ++c) {
            const size_t off = (size_t)(bh * 16 + c) * 16384 + 2 * pp;
            *(unsigned*)((bf16_t*)(ws + O_CT) + off) = pk2(c0, c1);
            const float dec = MCH[(bh * 16 + c) * 4 + 2]; const unsigned d = *(const unsigned*)((const bf16_t*)(ws + O_DCT) + off);
            c0 = dec * c0 + bflo(d); c1 = dec * c1 + bfhi(d);
        }
    }
    for (int e = gtid; e < BG * 4 * 128; e += NT) {
        const int bh = e >> 7, dk = e & 127; float n = 0.f;
        for (int c = 0; c < 16; ++c) { const size_t off = (size_t)(bh * 16 + c) * 128 + dk; ((float*)(ws + O_NN))[off] = n; n = MCH[(bh * 16 + c) * 4 + 2] * n + ((const float*)(ws + O_DN))[off]; }
    }
}
__device__ __forceinline__ void m3_item(unsigned char* ws, int l, int it, int lane) {
    const int r = lane & 31, hh = lane >> 5;
    const int pr = ((r >> 2) & 1) * 16 + ((r >> 4) & 1) * 8 + ((r >> 3) & 1) * 4 + (r & 3);
    const int tt = 3 - (it & 3), c = (it >> 2) & 15, bh = it >> 6, b = bh >> 2, h = bh & 3;
    const int ts = c * 128 + tt * 32 + r;
    const size_t trow = (size_t)b * SEQ + ts;
    bf16x8 qf[8];
    const bf16_t* Qp = (const bf16_t*)(ws + O_MQC) + trow * 512 + h * 128 + 8 * hh;
#pragma unroll
    for (int k = 0; k < 8; ++k) qf[k] = *(const bf16x8*)(Qp + 16 * k);
    const float Et = ((const float*)(ws + O_ME))[(size_t)bh * SEQ + ts], bt = ((const float*)(ws + O_MBT))[(size_t)bh * SEQ + ts];
    const float mc = ((const float*)(ws + O_MCH))[(bh * 16 + c) * 4];
    const float winter = __expf(mc - Et);
    f32x16 acc[4];
#pragma unroll
    for (int d = 0; d < 4; ++d)
#pragma unroll
        for (int i = 0; i < 16; ++i) acc[d][i] = 0.f;
    const bf16_t* CTp = (const bf16_t*)(ws + O_CT) + (size_t)(bh * 16 + c) * 16384 + (size_t)r * 128 + 8 * hh;
    const float* NNp = (const float*)(ws + O_NN) + (size_t)(bh * 16 + c) * 128 + 8 * hh;
    float qn = 0.f;
#pragma unroll
    for (int k = 0; k < 8; ++k) {
#pragma unroll
        for (int d = 0; d < 4; ++d) acc[d] = MFMA32(*(const bf16x8*)(CTp + (size_t)d * 32 * 128 + 16 * k), qf[k], acc[d]);
        const f32x4 na = *(const f32x4*)(NNp + 16 * k), nb = *(const f32x4*)(NNp + 16 * k + 4);
        const u32x4 qw = __builtin_bit_cast(u32x4, qf[k]);
        qn += bflo(qw.x) * na[0] + bfhi(qw.x) * na[1] + bflo(qw.y) * na[2] + bfhi(qw.y) * na[3] + bflo(qw.z) * nb[0] + bfhi(qw.z) * nb[1] + bflo(qw.w) * nb[2] + bfhi(qw.w) * nb[3];
        if (k & 1) asm volatile("" ::: "memory");
    }
    qn += __shfl_xor(qn, 32);
#pragma unroll
    for (int d = 0; d < 4; ++d)
#pragma unroll
        for (int i = 0; i < 16; ++i) acc[d][i] *= winter;
    float dpart = 0.f;
    const bf16_t* Kb = (const bf16_t*)(ws + O_MKC) + ((size_t)b * SEQ + c * 128 + pr) * 512 + h * 128 + 8 * hh;
    const bf16_t* Vb = (const bf16_t*)(ws + O_MVT) + ((size_t)bh * 128 + r) * SEQ + c * 128 + 16 * hh;
    const float* MPb = (const float*)(ws + O_MP) + (size_t)bh * SEQ + c * 128 + 16 * hh;
    for (int st = 0; st <= tt; ++st) {
        f32x16 sc;
#pragma unroll
        for (int i = 0; i < 16; ++i) sc[i] = 0.f;
#pragma unroll
        for (int k = 0; k < 8; ++k) { sc = MFMA32(*(const bf16x8*)(Kb + (size_t)st * 32 * 512 + 16 * k), qf[k], sc); if (k == 3) asm volatile("" ::: "memory"); }
        asm volatile("" ::: "memory");
#pragma unroll
        for (int g = 0; g < 4; ++g) { const f32x4 pv = *(const f32x4*)(MPb + st * 32 + 4 * g);
#pragma unroll
            for (int e = 0; e < 4; ++e) { const int i = 4 * g + e;
                const bool ok = (st < tt) || (16 * hh + i <= r);
                const float w = ok ? __expf(pv[e] - Et) : 0.f;
                sc[i] = ok ? sc[i] * w : 0.f; dpart += sc[i]; } }
        u32x4 pw0, pw1;
        pw0.x = pk2(sc[0], sc[1]); pw0.y = pk2(sc[2], sc[3]); pw0.z = pk2(sc[4], sc[5]); pw0.w = pk2(sc[6], sc[7]);
        pw1.x = pk2(sc[8], sc[9]); pw1.y = pk2(sc[10], sc[11]); pw1.z = pk2(sc[12], sc[13]); pw1.w = pk2(sc[14], sc[15]);
        const bf16x8 pf0 = __builtin_bit_cast(bf16x8, pw0), pf1 = __builtin_bit_cast(bf16x8, pw1);
#pragma unroll
        for (int d = 0; d < 4; ++d) {
            acc[d] = MFMA32(*(const bf16x8*)(Vb + (size_t)d * 32 * SEQ + st * 32), pf0, acc[d]);
            acc[d] = MFMA32(*(const bf16x8*)(Vb + (size_t)d * 32 * SEQ + st * 32 + 8), pf1, acc[d]);
        }
    }
    const float den = winter * qn + (dpart + __shfl_xor(dpart, 32));
    const float dinv = 1.f / fmaxf(fabsf(den), __expf(-(bt + Et)));
    float ss = 0.f;
#pragma unroll
    for (int d = 0; d < 4; ++d)
#pragma unroll
        for (int i = 0; i < 16; ++i) { acc[d][i] *= dinv; ss += acc[d][i] * acc[d][i]; }
    ss += __shfl_xor(ss, 32);
    const float rn = rsqrtf(ss * (1.f / 128.f) + EPS);
    const float* onorm = (const float*)(ws + O_PAR) + PAR_ON + l * 512 + h * 128 + 4 * hh;
    const bf16_t* mo = (const bf16_t*)(ws + O_U) + trow * LDU + UC_MO + h * 128 + 4 * hh;
    bf16_t* y = (bf16_t*)(ws + O_Y) + (size_t)2 * MG * 512 + trow * 512 + h * 128 + 4 * hh;
#pragma unroll
    for (int d = 0; d < 4; ++d)
#pragma unroll
        for (int g = 0; g < 4; ++g) {
            const int dv = d * 32 + 8 * g;
            const f32x4 wn = *(const f32x4*)(onorm + dv); const u32x2 og = *(const u32x2*)(mo + dv);
            const float y0 = acc[d][4 * g] * rn * wn[0] * sigm(bflo(og.x)), y1 = acc[d][4 * g + 1] * rn * wn[1] * sigm(bfhi(og.x));
            const float y2 = acc[d][4 * g + 2] * rn * wn[2] * sigm(bflo(og.y)), y3 = acc[d][4 * g + 3] * rn * wn[3] * sigm(bfhi(og.y));
            u32x2 o; o.x = pk2(y0, y1); o.y = pk2(y2, y3); *(u32x2*)(y + dv) = o;
            if (g & 1) asm volatile("" ::: "memory");
        }
}

#define XB_TMO      128
#define XB_XCNT(j)  (256  + 64 * (j))
#define XB_XSUB(j)  (1280 + 64 * (j))
#define XB_XGEN(j)  (2304 + 64 * (j))
#define XB_TOP      3328
#define XB_TOPGEN   3392
#define XCD_BAR_WORDS 3456
#define XB_SPIN_CAP (1u << 18)

__device__ __forceinline__ unsigned xb_ld(unsigned* p)              { return __hip_atomic_load(p, __ATOMIC_RELAXED, __HIP_MEMORY_SCOPE_AGENT); }
__device__ __forceinline__ unsigned xb_add(unsigned* p, unsigned v) { return __hip_atomic_fetch_add(p, v, __ATOMIC_RELAXED, __HIP_MEMORY_SCOPE_AGENT); }
__device__ __forceinline__ unsigned xb_xcc_id() { return (unsigned)__builtin_amdgcn_s_getreg((3 << 11) | 20) & 0xFu; }
#define XB_SPIN(cond, bar) do { unsigned _sp = 0; while (cond) { __builtin_amdgcn_s_sleep(1); \
    if ((++_sp & 255u) == 0u) { if (xb_ld(&(bar)[XB_TMO])) break; if (_sp > XB_SPIN_CAP) { atomicAdd(&(bar)[XB_TMO], 1u); break; } } } } while (0)

struct XcdBarrier {
    unsigned* bar; unsigned x;
    volatile LAS unsigned* st;
};

__device__ __forceinline__ XcdBarrier xcd_barrier_post(unsigned* bar, volatile LAS unsigned* st) {
    XcdBarrier b; b.bar = bar; b.x = xb_xcc_id(); b.st = st;
    if (threadIdx.x == 0) (void)xb_add(&bar[XB_XCNT(b.x)], 1u);
    return b;
}
__device__ __forceinline__ void xcd_barrier_complete(unsigned* bar, unsigned x, unsigned& nloc, unsigned& nx) {
    const unsigned G = gridDim.x * gridDim.y * gridDim.z;
    unsigned sum, cnt, mine, sp = 0u;
    for (;;) {
        sum = 0u; cnt = 0u; mine = 0u;
#pragma unroll
        for (unsigned j = 0; j < 16; ++j) { const unsigned c = xb_ld(&bar[XB_XCNT(j)]); sum += c; cnt += (c > 0u) ? 1u : 0u; mine = (j == x) ? c : mine; }
        if (sum == G) break;
        __builtin_amdgcn_s_sleep(1);
        if ((++sp & 255u) == 0u) { if (xb_ld(&bar[XB_TMO])) break; if (sp > XB_SPIN_CAP) { atomicAdd(&bar[XB_TMO], 1u); break; } }
    }
    nloc = mine > 0u ? mine : 1u; nx = cnt > 0u ? cnt : 1u;
}

__device__ __forceinline__ void xcd_barrier(const XcdBarrier& b) {
    asm volatile("s_waitcnt vmcnt(0)" ::: "memory");
    __syncthreads();
    if (threadIdx.x == 0) {
        unsigned* bar = b.bar;
        __builtin_amdgcn_s_waitcnt(0);
        unsigned nloc = b.st[0], nx = b.st[1];
        if (nloc == 0u) { xcd_barrier_complete(bar, b.x, nloc, nx); b.st[0] = nloc; b.st[1] = nx; }
        const unsigned old = xb_add(&bar[XB_XSUB(b.x)], 1u);
        const unsigned gen = old / nloc;
        if (old + 1u == (gen + 1u) * nloc) {
            __builtin_amdgcn_fence(__ATOMIC_RELEASE, "agent");
            asm volatile("s_waitcnt vmcnt(0)" ::: "memory");
            const unsigned og = xb_add(&bar[XB_TOP], 1u);
            const unsigned tg = og / nx;
            if (og + 1u == (tg + 1u) * nx) xb_add(&bar[XB_TOPGEN], 1u);
            else XB_SPIN(xb_ld(&bar[XB_TOPGEN]) == tg, bar);
            __builtin_amdgcn_fence(__ATOMIC_ACQUIRE, "agent");
            xb_add(&bar[XB_XGEN(b.x)], 1u);
            asm volatile("s_waitcnt vmcnt(0)" ::: "memory");
        } else {
            XB_SPIN(xb_ld(&bar[XB_XGEN(b.x)]) == gen, bar);
            __builtin_amdgcn_fence(__ATOMIC_ACQUIRE, "agent");
            asm volatile("s_waitcnt vmcnt(0)" ::: "memory");
        }
    }
    __syncthreads();
}


__global__ void __launch_bounds__(NTHR, 2) fwd_kernel(KP p) {
    extern __shared__ __attribute__((aligned(16))) unsigned char lds_raw[];
    LAS unsigned char* lds = (LAS unsigned char*)lds_raw;
    cg::grid_group grid = cg::this_grid();
    const int tid = threadIdx.x, lane0 = tid & 63, wave = __builtin_amdgcn_readfirstlane(tid >> 6);
    const int G = gridDim.x, gw0 = blockIdx.x * NWAVES + wave, NWV = G * NWAVES, NT = G * NTHR;
    unsigned char* ws0 = p.ws;
    volatile LAS unsigned* MISC = (volatile LAS unsigned*)(lds + 131072);
    if (tid < 64) MISC[tid] = 0u;
    __syncthreads();
    XcdBarrier bar = xcd_barrier_post((unsigned*)(ws0 + O_BAR), MISC + 8);
    int pc = 0;
#ifndef PM
#define PM 0xFFFF
#endif
#define PH_BEGIN(id) if (((PM >> (id)) & 1) && pc >= p.ph_lo && pc < p.ph_hi) { unsigned char* ws = ws0; int lane = lane0, gw = gw0; asm volatile("" : "+s"(ws), "+v"(lane), "+s"(gw)); const int gtid = gw * 64 + lane; (void)gtid;
#define PH_END } ++pc; if (pc > p.ph_lo && pc < p.ph_hi) { if (pc == 1) grid.sync(); else xcd_barrier(bar); }

    PH_BEGIN(0) phase_p0(p, ws, lds, gw, NWV, wave, lane); PH_END

    for (int g = 0; g < NG; ++g) {
        const size_t goff = (size_t)g * MG * DM;
#define XB ((bf16_t*)(ws + O_XB))
#define RS ((float*)(ws + O_RS))
#define U ((bf16_t*)(ws + O_U))
        PH_BEGIN(1) phase_x0(p.in[0] + goff, XB, RS, gw, NWV, lane); PH_END
        for (int l = 0; l < DEPTH; ++l) {
            PH_BEGIN(2) {
                pg8::Gemm gm{XB, (const bf16_t*)(ws + O_WIN) + (size_t)l * NINP * DM, MG, NINP, DM}; pg8::StaticOrder S; S.init(MG, NINP, G, (int)blockIdx.x);
                pg8::EpiA E{0, 0, RS, U, LDU, (float*)(ws + O_SG), nullptr, 0, nullptr};
                pg8::gemm_phase<pg8::EpiA, pg8::StaticOrder, true, true>(lds, gm, S, E);
            } PH_END
            PH_BEGIN(3) {
                constexpr int N_SCAN = BG * 12, N_HN = MG * 26 / 64, N_ST = 17 * (MG / 64);
                for (int it = gw; it < N_SCAN + N_HN + N_ST; it += NWV) {
                    if (it < N_SCAN) gate_scan_item(ws, l, it, lane);
                    else if (it < N_SCAN + N_HN) headnorm_lane(ws, l, (it - N_SCAN) * 64 + lane);
                    else stream_item(ws, l, it - N_SCAN - N_HN, lane);
                }
            } PH_END
            PH_BEGIN(4) {
#ifndef PM4
#define PM4 7
#endif
                if (PM4 & 1) for (int it = gw; it < BG * 4 * 16 * 4; it += NWV) m1_item(ws, it, lane);
                if (PM4 & 2) for (int it = gw; it < BG * 8 * 32; it += NWV) {
                    const int b = it >> 8, h = (it >> 5) & 7, pi = it & 31;
                    const bf16_t* Q = (const bf16_t*)(ws + O_FQN) + (size_t)b * SEQ * 512 + h * 64; const bf16_t* K = (const bf16_t*)(ws + O_FKN) + (size_t)b * SEQ * 512 + h * 64;
                    const bf16_t* VT = (const bf16_t*)(ws + O_FVT) + (size_t)(b * 8 + h) * 64 * SEQ; const float* C = (const float*)(ws + O_FC) + (size_t)(b * 8 + h) * SEQ;
                    bf16_t* Y = (bf16_t*)(ws + O_Y) + (size_t)b * SEQ * 512 + h * 64;
                    attn_qtile<false>(Q, K, 512, VT, C, 0.f, Y, 63 - pi, lane);
                    attn_qtile<false>(Q, K, 512, VT, C, 0.f, Y, pi, lane);
                }
                if (PM4 & 4) for (int it = gw; it < BG * 8 * 64; it += NWV) {
                    const int b = it >> 9, hq = (it >> 6) & 7, qt = it & 63, hk = hq >> 2;
                    const bf16_t* Q = (const bf16_t*)(ws + O_SQR) + (size_t)b * SEQ * 512 + hq * 64; const bf16_t* K = (const bf16_t*)(ws + O_SKR) + (size_t)b * SEQ * 128 + hk * 64;
                    const bf16_t* VT = (const bf16_t*)(ws + O_SVT) + (size_t)(b * 2 + hk) * 64 * SEQ;
                    bf16_t* Y = (bf16_t*)(ws + O_Y) + (size_t)MG * 512 + (size_t)b * SEQ * 512 + hq * 64;
                    attn_qtile<true>(Q, K, 128, VT, nullptr, ((const float*)(ws + O_PAR))[PAR_SINK + l * 8 + hq] * LOG2E, Y, qt, lane);
                }
            } PH_END
            PH_BEGIN(5) phase_m2(ws, gtid, NT); PH_END
            PH_BEGIN(6) { for (int it = gw; it < BG * 4 * 16 * 4; it += NWV) m3_item(ws, l, it, lane); } PH_END
            PH_BEGIN(7) {
                for (int b3 = 0; b3 < 3; ++b3) {
                    pg8::Gemm gm{(const bf16_t*)(ws + O_Y) + (size_t)b3 * MG * 512, (const bf16_t*)(ws + O_WB) + (size_t)(l * 3 + b3) * DM * 512, MG, DM, 512}; pg8::StaticOrder S; S.init(MG, DM, G, (int)blockIdx.x);
                    pg8::EpiA E{1, b3, nullptr, (bf16_t*)(ws + O_MRG), DM, nullptr, U + UC_G + b3 * DM, LDU, (float*)(ws + O_TMP)};
                    pg8::gemm_phase<pg8::EpiA, pg8::StaticOrder, true, true>(lds, gm, S, E);
                }
            } PH_END
            PH_BEGIN(8) {
                pg8::Gemm gm{(const bf16_t*)(ws + O_MRG), (const bf16_t*)(ws + O_WOUT) + (size_t)l * DM * DM, MG, DM, DM}; pg8::StaticOrder S; S.init(MG, DM, G, (int)blockIdx.x);
                pg8::EpiB E{(l == 0 ? p.in[0] : (const float*)p.out) + goff, p.out + goff, XB, RS};
                pg8::gemm_phase<pg8::EpiB, pg8::StaticOrder, true, true>(lds, gm, S, E);
            } PH_END
            PH_BEGIN(9) {
                pg8::Gemm gm{XB, (const bf16_t*)(ws + O_WUP) + (size_t)l * FF * DM, MG, FF, DM}; pg8::StaticOrder S; S.init(MG, FF, G, (int)blockIdx.x);
                pg8::EpiA E{2, 0, RS, U  , FF, nullptr, nullptr, 0, nullptr};
                pg8::gemm_phase<pg8::EpiA, pg8::StaticOrder, true, true>(lds, gm, S, E);
            } PH_END
            PH_BEGIN(10) {
                pg8::Gemm gm{U  , (const bf16_t*)(ws + O_WDN) + (size_t)l * DM * FF, MG, DM, FF}; pg8::StaticOrder S; S.init(MG, DM, G, (int)blockIdx.x);
                pg8::EpiB E{(const float*)p.out + goff, p.out + goff, XB, RS};
                pg8::gemm_phase<pg8::EpiB, pg8::StaticOrder, true, true>(lds, gm, S, E);
            } PH_END
        }
    }
}
constexpr int N_PHASES = 1 + NG * (1 + DEPTH * 9);

#ifndef MK_MULTI
#define MK_MULTI 0
#endif
extern "C" void kernel_launch(void* const* d_in, const int* in_sizes, int n_in, void* d_out, int out_size, void* d_ws, size_t ws_size, hipStream_t stream) {
    static int grid = 0;
    if (grid == 0) {
        if (n_in != 19 || out_size != NB * SEQ * DM || ws_size < WS_NEED) { fprintf(stderr, "kernel_launch: unexpected problem (n_in %d out %d ws %zu need %zu)\n", n_in, out_size, ws_size, (size_t)WS_NEED); grid = -1; return; }
        int dev = 0, cus = 0, per_cu = 0;
        hipGetDevice(&dev); hipDeviceGetAttribute(&cus, hipDeviceAttributeMultiprocessorCount, dev);
        if (hipFuncSetAttribute((const void*)fwd_kernel, hipFuncAttributeMaxDynamicSharedMemorySize, LDS_BYTES) != hipSuccess) { fprintf(stderr, "kernel_launch: hipFuncSetAttribute failed\n"); grid = -1; return; }
        hipOccupancyMaxActiveBlocksPerMultiprocessor(&per_cu, (const void*)fwd_kernel, NTHR, LDS_BYTES);
        (void)hipGetLastError();
        if (per_cu < 1) { fprintf(stderr, "kernel_launch: occupancy query says %d blocks per CU\n", per_cu); per_cu = 1; }
        grid = cus;
    }
    if (grid < 0) return;
    if (hipMemsetAsync((char*)d_ws + O_BAR, 0, 16384, stream) != hipSuccess) { fprintf(stderr, "kernel_launch: memset failed\n"); return; }
    KP a{};
    for (int i = 0; i < 19; ++i) a.in[i] = (const float*)d_in[i];
    a.out = (float*)d_out; a.ws = (unsigned char*)d_ws;
#if MK_MULTI
    for (int ph = 0; ph < N_PHASES; ++ph) { a.ph_lo = ph; a.ph_hi = ph + 1; hipLaunchKernelGGL(fwd_kernel, dim3(grid), dim3(NTHR), LDS_BYTES, stream, a); }
#else
    a.ph_lo = 0; a.ph_hi = N_PHASES;
    void* args[] = {&a};
    hipError_t e = hipLaunchCooperativeKernel((const void*)fwd_kernel, dim3(grid), dim3(NTHR), args, LDS_BYTES, stream);
    if (e != hipSuccess) fprintf(stderr, "kernel_launch: cooperative launch failed: %s (grid %d)\n", hipGetErrorString(e), grid);
#endif
}
```

```cpp
#include <hip/hip_runtime.h>
#include <hip/hip_cooperative_groups.h>
#include <cstdio>
#include <cstdint>
#include <cmath>
namespace cg = cooperative_groups;
namespace pg8 {
#define PG8_LAS __attribute__((address_space(3)))
typedef unsigned short bf16_t;
typedef short bf16x8 __attribute__((ext_vector_type(8)));
typedef float f32x4 __attribute__((ext_vector_type(4)));
typedef unsigned u32x4 __attribute__((ext_vector_type(4)));
constexpr int BM = 256, BK = 64, HALF = 128, HTB = HALF * BK * 2  , STAGE_BYTES = 8 * HTB, NXCD = 8, WGM = 8;

__host__ __device__ __forceinline__ int lds_byte(int r, int c) { const int st = (r >> 4) * 2 + (c >> 5), rr = r & 15, cc = c & 31, ob = rr * 64 + cc * 2; return st * 1024 + (ob ^ (((ob >> 9) & 1) << 5)); }
__host__ __device__ __forceinline__ void stage_rc(int b, int& R, int& C) { const int st = b / 1024, sb = b % 1024, swz = sb ^ (((sb >> 9) & 1) << 5); R = (st >> 1) * 16 + swz / 64; C = (st & 1) * 32 + (swz % 64) / 2; }
__host__ __device__ __forceinline__ int perm32(int rho) { const int n = rho >> 4, i = rho & 15; return 8 * (i >> 2) + 4 * n + (i & 3); }

struct Unit { int pm, pn; };
struct Gemm { const bf16_t* A; const bf16_t* Bt; int M, N, K; };

struct StaticOrder {
    int nM, nN, nwg, G, c;
    __host__ __device__ void init(int M, int N, int G_, int c_) { nM = M / BM; nN = N / BM; nwg = nM * nN; G = G_; c = c_; }
    __host__ __device__ bool next(int i, Unit& u) const {
        const long L = (long)i * G + c; if (L >= nwg) return false;
        int wgid = (int)L; { const int q = nwg / NXCD, r = nwg % NXCD, xcd = wgid % NXCD, off = wgid / NXCD; wgid = (xcd < r ? xcd * (q + 1) : r * (q + 1) + (xcd - r) * q) + off; }
        const int nig = WGM * nN, gid = wgid / nig, fm = gid * WGM, gsz = (nM - fm) < WGM ? (nM - fm) : WGM;
        u.pm = fm + ((wgid % nig) % gsz); u.pn = (wgid % nig) / gsz; return true;
    }
    __device__ __forceinline__ void a_ready(const Unit&) const {}
    __device__ __forceinline__ void done(const Unit&) const {}
};


typedef unsigned u32x2 __attribute__((ext_vector_type(2)));
typedef float f32x2_t __attribute__((ext_vector_type(2)));
typedef __bf16 bf16x2_t __attribute__((ext_vector_type(2)));
__device__ __forceinline__ unsigned pk2(float lo, float hi) { f32x2_t v = {lo, hi}; bf16x2_t b = __builtin_convertvector(v, bf16x2_t); return __builtin_bit_cast(unsigned, b); }
__device__ __forceinline__ float bflo(unsigned w) { return __uint_as_float(w << 16); }
__device__ __forceinline__ float bfhi(unsigned w) { return __uint_as_float(w & 0xffff0000u); }
__device__ __forceinline__ float sigm(float x) { return __builtin_amdgcn_rcpf(1.f + __expf(-x)); }
__device__ __forceinline__ float rowscale(const float* rs, int row) {
    const f32x4* p = (const f32x4*)(rs + (size_t)row * 16);
    const f32x4 a = p[0], b = p[1], c = p[2], d = p[3];
    const float s = ((a[0] + a[1]) + (a[2] + a[3])) + ((b[0] + b[1]) + (b[2] + b[3])) + ((c[0] + c[1]) + (c[2] + c[3])) + ((d[0] + d[1]) + (d[2] + d[3]));
    return rsqrtf(s * (1.f / 1024.f) + 1e-6f);
}
struct EpiA {
    static constexpr bool PERM = true, AFTER_DRAIN = false;
    int mode, sub; const float* rs; bf16_t* out; int ldo; float* sg; const bf16_t* gate; int ldg; float* tmp;
    __device__ __forceinline__ void operator()(const f32x4 (&acc)[2][2][4][2], const Unit& u, int wr, int wc, int fr, int fq) const {
        const int row0 = u.pm * BM + wr * 64 + fr, colb = u.pn * BM + wc * 32 + 8 * fq;
#pragma unroll
        for (int ai = 0; ai < 2; ++ai)
#pragma unroll
            for (int m = 0; m < 4; ++m) {
                const int row = row0 + ai * HALF + m * 16;
                float rsv = 1.f; if (mode != 1) rsv = rowscale(rs, row);
#pragma unroll
                for (int bj = 0; bj < 2; ++bj) {
                    const int col = colb + bj * HALF;
                    f32x4 v0 = acc[ai][bj][m][0] * rsv, v1 = acc[ai][bj][m][1] * rsv;
                    if (mode == 0) {
                        if (u.pn == 29) {
                            if (bj == 0 && wc == 0 && fq < 2) { float* q = sg + (size_t)row * 16 + 8 * fq; *(f32x4*)q = v0; *(f32x4*)(q + 4) = v1; }
                        } else {
                            if (u.pn >= 17) {
#pragma unroll
                                for (int e = 0; e < 4; ++e) { v0[e] = sigm(v0[e]); v1[e] = sigm(v1[e]); }
                            }
                            u32x4 w; w.x = pk2(v0[0], v0[1]); w.y = pk2(v0[2], v0[3]); w.z = pk2(v1[0], v1[1]); w.w = pk2(v1[2], v1[3]);
                            *(u32x4*)(out + (size_t)row * ldo + col) = w;
                        }
                    } else if (mode == 1) {
                        const u32x4 g = *(const u32x4*)(gate + (size_t)row * ldg + col);
                        f32x4 p0 = {v0[0] * bflo(g.x), v0[1] * bfhi(g.x), v0[2] * bflo(g.y), v0[3] * bfhi(g.y)};
                        f32x4 p1 = {v1[0] * bflo(g.z), v1[1] * bfhi(g.z), v1[2] * bflo(g.w), v1[3] * bfhi(g.w)};
                        float* tp = tmp + (size_t)row * 1024 + col;
                        if (sub == 0) { *(f32x4*)tp = p0; *(f32x4*)(tp + 4) = p1; }
                        else if (sub == 1) { *(f32x4*)tp = *(const f32x4*)tp + p0; *(f32x4*)(tp + 4) = *(const f32x4*)(tp + 4) + p1; }
                        else { p0 = p0 + *(const f32x4*)tp; p1 = p1 + *(const f32x4*)(tp + 4);
                            u32x4 w; w.x = pk2(p0[0], p0[1]); w.y = pk2(p0[2], p0[3]); w.z = pk2(p1[0], p1[1]); w.w = pk2(p1[2], p1[3]);
                            *(u32x4*)(out + (size_t)row * ldo + col) = w; }
                    } else {
#pragma unroll
                        for (int e = 0; e < 4; ++e) { const float a = fmaxf(v0[e], 0.f), b = fmaxf(v1[e], 0.f); v0[e] = a * a; v1[e] = b * b; }
                        u32x4 w; w.x = pk2(v0[0], v0[1]); w.y = pk2(v0[2], v0[3]); w.z = pk2(v1[0], v1[1]); w.w = pk2(v1[2], v1[3]);
                        *(u32x4*)(out + (size_t)row * ldo + col) = w;
                    }
                }
            }
    }
};
struct EpiB {
    static constexpr bool PERM = false, AFTER_DRAIN = false;
    const float* resid; float* out; bf16_t* xb; float* rs;
    __device__ __forceinline__ void operator()(const f32x4 (&acc)[2][2][4][2], const Unit& u, int wr, int wc, int fr, int fq) const {
        const int row0 = u.pm * BM + wr * 64 + fr, colb = u.pn * BM + wc * 32 + 4 * fq;
#pragma unroll
        for (int ai = 0; ai < 2; ++ai)
#pragma unroll
            for (int m = 0; m < 4; ++m) {
                const int row = row0 + ai * HALF + m * 16; float ss = 0.f;
#pragma unroll
                for (int bj = 0; bj < 2; ++bj)
#pragma unroll
                    for (int n = 0; n < 2; ++n) {
                        const size_t off = (size_t)row * 1024 + colb + bj * HALF + n * 16;
                        const f32x4 x = *(const f32x4*)(resid + off) + acc[ai][bj][m][n];
                        *(f32x4*)(out + off) = x;
                        u32x2 w; w.x = pk2(x[0], x[1]); w.y = pk2(x[2], x[3]); *(u32x2*)(xb + off) = w;
                        ss += (x[0] * x[0] + x[1] * x[1]) + (x[2] * x[2] + x[3] * x[3]);
                    }
                ss += __shfl_xor(ss, 16); ss += __shfl_xor(ss, 32);
                if (fq == 0) rs[(size_t)row * 16 + u.pn * 4 + wc] = ss;
            }
    }
};

template <class Epi, class Sched, bool ALIGN_EPI = false, bool SP2 = false>
__device__ __forceinline__ void gemm_phase(PG8_LAS unsigned char* lds, const Gemm g, const Sched& S, const Epi& E) {
    int tid_ = threadIdx.x; asm volatile("" : "+v"(tid_));
    const int tid = tid_, wid = __builtin_amdgcn_readfirstlane(tid >> 6), lane = tid & 63, wr = wid >> 2, wc = wid & 3, fr = lane & 15, fq = lane >> 4;
    const int K = g.K, nt = K / BK;
    unsigned voffA[2], voffB[2];
#pragma unroll
    for (int i = 0; i < 2; ++i) { int R, C; stage_rc(tid * 16 + i * 8192, R, C); const int Rb = Epi::PERM ? ((R & ~31) + perm32(R & 31)) : R;
        voffA[i] = (unsigned)(R * K + C) * 2u; voffB[i] = (unsigned)(Rb * K + C) * 2u; }
    const size_t kstep = (size_t)(BK * 2);
    const size_t hstep = (size_t)HALF * K * 2;
    const size_t tstep = 2 * hstep;
    const unsigned ldsw = (unsigned)wid * 1024u;
    const int aoff = lds_byte(wr * 64 + fr, fq * 8), boff = lds_byte(wc * 32 + fr, fq * 8);
#define PG8_SA(b, h) (((b) * 2 + (h)) * HTB)
#define PG8_SB(b, h) ((4 + (b) * 2 + (h)) * HTB)
#define PG8_STAGE(bufoff, gbase, voff) do { _Pragma("unroll") for (int _i = 0; _i < 2; ++_i) \
        __builtin_amdgcn_global_load_lds((const unsigned*)((const char*)(gbase) + (voff)[_i]), (PG8_LAS unsigned*)(lds + (bufoff) + ldsw + _i * 8192), 16, 0, 0); } while (0)
#define PG8_LDA(dst, b, h) do { _Pragma("unroll") for (int m = 0; m < 4; ++m) _Pragma("unroll") for (int k = 0; k < 2; ++k) dst[m][k] = *(const PG8_LAS bf16x8*)(lds + PG8_SA(b, h) + aoff + m * 2048 + k * 1024); } while (0)
#define PG8_LDB(dst, b, h) do { _Pragma("unroll") for (int n = 0; n < 2; ++n) _Pragma("unroll") for (int k = 0; k < 2; ++k) dst[n][k] = *(const PG8_LAS bf16x8*)(lds + PG8_SB(b, h) + boff + n * 2048 + k * 1024); } while (0)
#define PG8_MMA(ai, bj, At, Bt) do { __builtin_amdgcn_s_setprio(1); _Pragma("unroll") for (int m = 0; m < 4; ++m) _Pragma("unroll") for (int n = 0; n < 2; ++n) _Pragma("unroll") for (int k = 0; k < 2; ++k) \
        acc[ai][bj][m][n] = __builtin_amdgcn_mfma_f32_16x16x32_bf16(Bt[n][k], At[m][k], acc[ai][bj][m][n], 0, 0, 0); __builtin_amdgcn_s_setprio(0); } while (0)
#define PG8_WAIT_V(n) asm volatile("s_waitcnt vmcnt(" #n ")" ::: "memory")
#define PG8_WAIT_L(n) asm volatile("s_waitcnt lgkmcnt(" #n ")" ::: "memory")
#define PG8_BAR __builtin_amdgcn_s_barrier()
#define PG8_SCHED __builtin_amdgcn_sched_barrier(0)
    Unit cur, nxt; int ui = 0;
    if (!S.next(0, cur)) return;
    f32x4 acc[2][2][4][2];
#pragma unroll
    for (int a = 0; a < 2; ++a)
#pragma unroll
        for (int b = 0; b < 2; ++b)
#pragma unroll
            for (int m = 0; m < 4; ++m)
#pragma unroll
                for (int n = 0; n < 2; ++n) acc[a][b][m][n] = (f32x4){0.f, 0.f, 0.f, 0.f};
    bf16x8 At[4][2], B0[2][2], B1[2][2];
    const char* cA = (const char*)g.A + (size_t)cur.pm * tstep; const char* cB = (const char*)g.Bt + (size_t)cur.pn * tstep;
    S.a_ready(cur);
    if constexpr (SP2) {
        PG8_STAGE(PG8_SB(0, 0), cB, voffB); PG8_STAGE(PG8_SB(0, 1), cB + hstep, voffB); PG8_STAGE(PG8_SA(0, 0), cA, voffA); PG8_STAGE(PG8_SA(0, 1), cA + hstep, voffA);
        if (wr == 1) PG8_BAR;
        PG8_WAIT_V(2); PG8_BAR;
        PG8_STAGE(PG8_SB(1, 0), cB + kstep, voffB); PG8_STAGE(PG8_SA(1, 0), cA + kstep, voffA); PG8_STAGE(PG8_SB(1, 1), cB + hstep + kstep, voffB);
        PG8_WAIT_V(6); PG8_BAR;
    } else {
        PG8_STAGE(PG8_SB(0, 0), cB, voffB); PG8_STAGE(PG8_SA(0, 0), cA, voffA); PG8_STAGE(PG8_SB(0, 1), cB + hstep, voffB); PG8_STAGE(PG8_SA(0, 1), cA + hstep, voffA);
        if (wr == 1) PG8_BAR;
        PG8_WAIT_V(4); PG8_BAR;
        PG8_STAGE(PG8_SB(1, 0), cB + kstep, voffB); PG8_STAGE(PG8_SA(1, 0), cA + kstep, voffA); PG8_STAGE(PG8_SB(1, 1), cB + hstep + kstep, voffB);
        PG8_WAIT_V(6); PG8_BAR;
    }
    for (;;) {
        const bool has_next = S.next(ui + 1, nxt);
        const char* nA = has_next ? (const char*)g.A + (size_t)nxt.pm * tstep : cA; const char* nB = has_next ? (const char*)g.Bt + (size_t)nxt.pn * tstep : cB;
        for (int t = 0; t < nt; t += 2) {
            const bool last = (t == nt - 2);
            const char* a1 = cA + (size_t)(t + 1) * kstep;
            const char* a2 = last ? nA : cA + (size_t)(t + 2) * kstep; const char* b2 = last ? nB : cB + (size_t)(t + 2) * kstep;
            const char* a3 = a2 + kstep; const char* b3 = b2 + kstep;
            if (last && has_next) S.a_ready(nxt);
            if constexpr (SP2) {
            PG8_LDB(B0, 0, 0); PG8_LDB(B1, 0, 1); PG8_SCHED; PG8_LDA(At, 0, 0); PG8_STAGE(PG8_SA(1, 1), a1 + hstep, voffA);
            PG8_WAIT_V(8); PG8_WAIT_L(0); PG8_BAR; PG8_MMA(0, 0, At, B0); PG8_MMA(0, 1, At, B1); PG8_BAR; PG8_SCHED;
            PG8_LDA(At, 0, 1); PG8_STAGE(PG8_SB(0, 0), b2, voffB); PG8_STAGE(PG8_SB(0, 1), b2 + hstep, voffB); PG8_STAGE(PG8_SA(0, 0), a2, voffA);
            PG8_WAIT_V(8); PG8_WAIT_L(0); PG8_BAR; PG8_MMA(1, 0, At, B0); PG8_MMA(1, 1, At, B1); PG8_BAR; PG8_SCHED;
            PG8_LDB(B0, 1, 0); PG8_LDB(B1, 1, 1); PG8_SCHED; PG8_LDA(At, 1, 0); PG8_STAGE(PG8_SA(0, 1), a2 + hstep, voffA);
            PG8_WAIT_V(8); PG8_WAIT_L(0); PG8_BAR; PG8_MMA(0, 0, At, B0); PG8_MMA(0, 1, At, B1); PG8_BAR; PG8_SCHED;
            PG8_LDA(At, 1, 1); PG8_STAGE(PG8_SB(1, 0), b3, voffB); PG8_STAGE(PG8_SB(1, 1), b3 + hstep, voffB); PG8_STAGE(PG8_SA(1, 0), a3, voffA);
            PG8_WAIT_V(8); PG8_WAIT_L(0); PG8_BAR; PG8_MMA(1, 0, At, B0); PG8_MMA(1, 1, At, B1); PG8_BAR; PG8_SCHED;
            } else {
            PG8_LDB(B0, 0, 0); PG8_SCHED; PG8_LDA(At, 0, 0); PG8_STAGE(PG8_SA(1, 1), a1 + hstep, voffA);
            PG8_WAIT_L(8); PG8_BAR; PG8_WAIT_L(0); PG8_MMA(0, 0, At, B0); PG8_BAR; PG8_SCHED;
            PG8_LDB(B1, 0, 1); PG8_STAGE(PG8_SB(0, 0), b2, voffB);
            PG8_BAR; PG8_WAIT_L(0); PG8_MMA(0, 1, At, B1); PG8_BAR;
            PG8_LDA(At, 0, 1); PG8_STAGE(PG8_SA(0, 0), a2, voffA);
            PG8_BAR; PG8_WAIT_L(0); PG8_MMA(1, 0, At, B0); PG8_BAR; PG8_SCHED;
            PG8_STAGE(PG8_SB(0, 1), b2 + hstep, voffB);
            PG8_WAIT_V(6); PG8_BAR; PG8_MMA(1, 1, At, B1); PG8_BAR;
            PG8_LDB(B0, 1, 0); PG8_SCHED; PG8_LDA(At, 1, 0); PG8_STAGE(PG8_SA(0, 1), a2 + hstep, voffA);
            PG8_WAIT_L(8); PG8_BAR; PG8_WAIT_L(0); PG8_MMA(0, 0, At, B0); PG8_BAR; PG8_SCHED;
            PG8_LDB(B1, 1, 1); PG8_STAGE(PG8_SB(1, 0), b3, voffB);
            PG8_BAR; PG8_WAIT_L(0); PG8_MMA(0, 1, At, B1); PG8_BAR;
            PG8_LDA(At, 1, 1); PG8_STAGE(PG8_SA(1, 0), a3, voffA);
            PG8_BAR; PG8_WAIT_L(0); PG8_MMA(1, 0, At, B0); PG8_BAR; PG8_SCHED;
            PG8_STAGE(PG8_SB(1, 1), b3 + hstep, voffB);
            PG8_WAIT_V(6); PG8_BAR; PG8_MMA(1, 1, At, B1); PG8_BAR;
            }
        }
        if constexpr (ALIGN_EPI) { if (wr == 0) PG8_BAR; }
        if constexpr (!Epi::AFTER_DRAIN) { E(acc, cur, wr, wc, fr, fq); S.done(cur); }
        if (!has_next) break;
#pragma unroll
        for (int a = 0; a < 2; ++a)
#pragma unroll
            for (int b = 0; b < 2; ++b)
#pragma unroll
                for (int m = 0; m < 4; ++m)
#pragma unroll
                    for (int n = 0; n < 2; ++n) acc[a][b][m][n] = (f32x4){0.f, 0.f, 0.f, 0.f};
        cur = nxt; cA = nA; cB = nB; ++ui;
        if constexpr (ALIGN_EPI) { if (wr == 1) PG8_BAR; }
    }
    PG8_WAIT_V(0);
    if constexpr (!ALIGN_EPI) { if (wr == 0) PG8_BAR; }
    PG8_BAR;
    if constexpr (Epi::AFTER_DRAIN) { E.fused(acc, cur, wr, wc, fr, fq, lds, wid, lane); S.done(cur); }
#undef PG8_SA
#undef PG8_SB
#undef PG8_STAGE
#undef PG8_LDA
#undef PG8_LDB
#undef PG8_MMA
#undef PG8_WAIT_V
#undef PG8_WAIT_L
#undef PG8_BAR
#undef PG8_SCHED
}
}

#define LAS __attribute__((address_space(3)))
typedef unsigned short bf16_t;
typedef short bf16x8 __attribute__((ext_vector_type(8)));
typedef float f32x4 __attribute__((ext_vector_type(4)));
typedef float f32x2 __attribute__((ext_vector_type(2)));
typedef float f32x16 __attribute__((ext_vector_type(16)));
typedef unsigned u32x4 __attribute__((ext_vector_type(4)));
typedef unsigned u32x2 __attribute__((ext_vector_type(2)));
using pg8::pk2; using pg8::bflo; using pg8::bfhi; using pg8::sigm;

constexpr int NB = 32, SEQ = 2048, DM = 1024, DEPTH = 2, INW = 7440, NINP = 7680, LDU = 7424, FF = 4096;
constexpr int NG = 2, BG = NB / NG, MG = BG * SEQ;
constexpr float LOG2E = 1.4426950408889634f, EPS = 1e-6f;
constexpr int NWAVES = 8, NTHR = 512;
constexpr int LDS_BYTES = 131072 + 1024;

constexpr int UC_FQ = 0, UC_FK = 512, UC_FV = 1024, UC_SQ = 1536, UC_SK = 2048, UC_SV = 2176, UC_MQ = 2304, UC_MK = 2816, UC_MV = 3328, UC_MO = 3840, UC_G = 4352;

constexpr size_t al(size_t x) { return (x + 255) & ~(size_t)255; }
constexpr size_t O_WIN = 0;
constexpr size_t O_WB = O_WIN + al((size_t)DEPTH * NINP * DM * 2);
constexpr size_t O_WOUT = O_WB + al((size_t)DEPTH * 3 * DM * 512 * 2);
constexpr size_t O_WUP = O_WOUT + al((size_t)DEPTH * DM * DM * 2);
constexpr size_t O_WDN = O_WUP + al((size_t)DEPTH * FF * DM * 2);
constexpr size_t O_ROPE = O_WDN + al((size_t)DEPTH * DM * FF * 2);
constexpr size_t O_PAR = O_ROPE + al((size_t)SEQ * 32 * 2 * 4);
constexpr int PAR_FFB = 0, PAR_FQN = 16, PAR_FKN = 144, PAR_SQN = 272, PAR_SKN = 400, PAR_SINK = 528, PAR_CW = 544, PAR_CB = 8736, PAR_IB = 10784, PAR_FB = 10792, PAR_ON = 10800, PAR_N = 11824;
constexpr size_t O_XB = O_PAR + al((size_t)PAR_N * 4);
constexpr size_t O_RS = O_XB + al((size_t)MG * DM * 2);
constexpr size_t O_U = O_RS + al((size_t)MG * 16 * 4);
constexpr size_t O_SG = O_U + al((size_t)MG * LDU * 2);
constexpr size_t O_FC = O_SG + al((size_t)MG * 16 * 4);
constexpr size_t O_MP = O_FC + al((size_t)BG * 8 * SEQ * 4);
constexpr size_t O_ME = O_MP + al((size_t)BG * 4 * SEQ * 4);
constexpr size_t O_MBT = O_ME + al((size_t)BG * 4 * SEQ * 4);
constexpr size_t O_MCH = O_MBT + al((size_t)BG * 4 * SEQ * 4);
constexpr size_t O_FQN = O_MCH + al((size_t)BG * 4 * 16 * 4 * 4);
constexpr size_t O_FKN = O_FQN + (size_t)MG * 512 * 2;
constexpr size_t O_FVT = O_FKN + (size_t)MG * 512 * 2;
constexpr size_t O_SQR = O_FVT + (size_t)MG * 512 * 2;
constexpr size_t O_TMP = O_FQN;
constexpr size_t O_SKR = O_SQR + (size_t)MG * 512 * 2;
constexpr size_t O_SVT = O_SKR + (size_t)MG * 128 * 2;
constexpr size_t O_MQC = O_SVT + (size_t)MG * 128 * 2;
constexpr size_t O_MKC = O_MQC + (size_t)MG * 512 * 2;
constexpr size_t O_MRG = O_MQC;
constexpr size_t O_KT = O_MKC + (size_t)MG * 512 * 2;
constexpr size_t O_MVT = O_KT + (size_t)MG * 512 * 2;
constexpr size_t O_DN = O_MVT + (size_t)MG * 512 * 2;
constexpr size_t O_CT = O_KT;
constexpr size_t O_NN = O_DN + al((size_t)BG * 4 * 16 * 128 * 4);
constexpr size_t O_Y = O_NN + al((size_t)BG * 4 * 16 * 128 * 4);
constexpr size_t O_DCT = O_Y + (size_t)2 * MG * 512 * 2;
constexpr size_t O_BAR = O_Y + (size_t)3 * MG * 512 * 2;
constexpr size_t WS_NEED = O_BAR + 16384;
static_assert((size_t)BG * 4 * 16 * 16384 * 2 == (size_t)MG * 512 * 2, "DCT overlays Y2; CT overlays KT");
static_assert((size_t)MG * FF * 2 <= (size_t)MG * LDU * 2, "ACT overlays U");

struct KP { const float* in[19]; float* out; unsigned char* ws; int ph_lo, ph_hi; };

__device__ __forceinline__ float wave_sum(float v) {
#pragma unroll
    for (int o = 1; o < 64; o <<= 1) v += __shfl_xor(v, o);
    return v;
}
__device__ __forceinline__ float logsig(float x) { return fminf(x, 0.f) - log1pf(__expf(-fabsf(x))); }
#define LDSW() asm volatile("s_waitcnt lgkmcnt(0)" ::: "memory")

__device__ __forceinline__ int win_srccol(int n) {
    if (n < 1536) return n; if (n < 3840) return n + 8; if (n < 7424) return n + 16; if (n < 7432) return n - 7424 + 1536; if (n < 7440) return n - 7432 + 3848; return -1;
}
template <bool REMAP>
__device__ __forceinline__ void tr_item(const float* W, int K, int N, const float* kscale, bf16_t* WT, int item, int nblk, LAS float* scr, int lane) {
    const int kb = item / nblk, nb = item % nblk, k0 = 64 * kb, n0 = 32 * nb;
    const int nd = n0 + (lane & 31); const int ns = REMAP ? win_srccol(nd) : nd;
#pragma unroll 8
    for (int i = 0; i < 32; ++i) { const int kk = 2 * i + (lane >> 5); float v = 0.f; if (ns >= 0) v = W[(size_t)(k0 + kk) * N + ns]; if (kscale) v *= kscale[k0 + kk]; scr[kk * 33 + (lane & 31)] = v; }
    LDSW();
    const int c = lane & 7;
#pragma unroll
    for (int j = 0; j < 4; ++j) { const int n = (lane >> 3) + 8 * j; const LAS float* s = scr + (8 * c) * 33 + n;
        u32x4 o; o.x = pk2(s[0 * 33], s[1 * 33]); o.y = pk2(s[2 * 33], s[3 * 33]); o.z = pk2(s[4 * 33], s[5 * 33]); o.w = pk2(s[6 * 33], s[7 * 33]);
        *(u32x4*)(WT + (size_t)(n0 + n) * K + k0 + 8 * c) = o; }
    LDSW();
}
__device__ __forceinline__ void phase_p0(const KP& p, unsigned char* ws, LAS unsigned char* lds, int gw, int NWV, int wave, int lane) {
    LAS float* scr = (LAS float*)(lds + wave * 16384);
    const float *norm_mix = p.in[1], *w_in = p.in[2], *w_branch = p.in[14], *w_out = p.in[15], *norm_mlp = p.in[16], *w_up = p.in[17], *w_down = p.in[18];
    constexpr int PER = 3840 + 768 + 512 + 2048 + 2048;
    for (int it = gw; it < DEPTH * PER; it += NWV) {
        const int l = it / PER; int r = it % PER;
        if (r < 3840) { tr_item<true>(w_in + (size_t)l * DM * INW, DM, INW, norm_mix + l * DM, (bf16_t*)(ws + O_WIN) + (size_t)l * NINP * DM, r, 240, scr, lane); continue; } r -= 3840;
        if (r < 768) { const int b = r / 256; tr_item<false>(w_branch + (size_t)(l * 3 + b) * 512 * DM, 512, DM, nullptr, (bf16_t*)(ws + O_WB) + (size_t)(l * 3 + b) * DM * 512, r % 256, 32, scr, lane); continue; } r -= 768;
        if (r < 512) { tr_item<false>(w_out + (size_t)l * DM * DM, DM, DM, nullptr, (bf16_t*)(ws + O_WOUT) + (size_t)l * DM * DM, r, 32, scr, lane); continue; } r -= 512;
        if (r < 2048) { tr_item<false>(w_up + (size_t)l * DM * FF, DM, FF, norm_mlp + l * DM, (bf16_t*)(ws + O_WUP) + (size_t)l * FF * DM, r, 128, scr, lane); continue; } r -= 2048;
        tr_item<false>(w_down + (size_t)l * FF * DM, FF, DM, nullptr, (bf16_t*)(ws + O_WDN) + (size_t)l * DM * FF, r, 32, scr, lane);
    }
    { float* par = (float*)(ws + O_PAR); const int t0 = gw * 64 + lane, ts = NWV * 64;
      for (int e = t0; e < 16; e += ts) { par[PAR_FFB + e] = p.in[3][e]; par[PAR_SINK + e] = p.in[8][e]; }
      for (int e = t0; e < 128; e += ts) { par[PAR_FQN + e] = p.in[4][e]; par[PAR_FKN + e] = p.in[5][e]; par[PAR_SQN + e] = p.in[6][e]; par[PAR_SKN + e] = p.in[7][e]; }
      for (int e = t0; e < 8192; e += ts) par[PAR_CW + e] = p.in[9][e];
      for (int e = t0; e < 2048; e += ts) par[PAR_CB + e] = p.in[10][e];
      for (int e = t0; e < 8; e += ts) { par[PAR_IB + e] = p.in[11][e]; par[PAR_FB + e] = p.in[12][e]; }
      for (int e = t0; e < 1024; e += ts) par[PAR_ON + e] = p.in[13][e]; }
    float* rope = (float*)(ws + O_ROPE);
    for (int e = gw * 64 + lane; e < SEQ * 32; e += NWV * 64) {
        const int pos = e >> 5, i = e & 31;
        const float inv = powf(10000.f, -(float)(2 * i) / 64.f), ang = (float)pos * inv;
        rope[2 * e] = cosf(ang); rope[2 * e + 1] = sinf(ang);
    }
}
__device__ __forceinline__ void phase_x0(const float* x, bf16_t* XB, float* RS, int gw, int NWV, int lane) {
    for (int row = gw; row < MG; row += NWV) {
        const f32x4* xr = (const f32x4*)(x + (size_t)row * DM) + lane;
        f32x4 v[4]; float s = 0.f;
#pragma unroll
        for (int j = 0; j < 4; ++j) { v[j] = xr[64 * j]; s += (v[j][0] * v[j][0] + v[j][1] * v[j][1]) + (v[j][2] * v[j][2] + v[j][3] * v[j][3]); }
        s = wave_sum(s);
        u32x2* o = (u32x2*)(XB + (size_t)row * DM) + lane;
#pragma unroll
        for (int j = 0; j < 4; ++j) { u32x2 w; w.x = pk2(v[j][0], v[j][1]); w.y = pk2(v[j][2], v[j][3]); o[64 * j] = w; }
        if (lane < 16) RS[(size_t)row * 16 + lane] = (lane == 0) ? s : 0.f;
    }
}
__device__ __forceinline__ void gate_scan_item(unsigned char* ws, int l, int it, int lane) {
    const float* par = (const float*)(ws + O_PAR); const float* SG = (const float*)(ws + O_SG);
    if (it < BG * 8) {
        const int b = it >> 3, h = it & 7; const float bias = par[PAR_FFB + l * 8 + h];
        const float* src = SG + ((size_t)b * SEQ + lane * 32) * 16 + h;
        float tot = 0.f;
#pragma unroll 4
        for (int j = 0; j < 32; ++j) tot += logsig(src[j * 16] + bias);
        float x = tot;
#pragma unroll
        for (int o = 1; o < 64; o <<= 1) { const float y = __shfl_up(x, o); if (lane >= o) x += y; }
        float run = x - tot;
        float* dst = (float*)(ws + O_FC) + (size_t)it * SEQ + lane * 32;
#pragma unroll 4
        for (int j = 0; j < 32; ++j) { run += logsig(src[j * 16] + bias); dst[j] = run * LOG2E; }
    } else {
        const int sq = it - BG * 8, b = sq >> 2, h = sq & 3;
        const float ibias = par[PAR_IB + l * 4 + h], fbias = par[PAR_FB + l * 4 + h];
        float* MP = (float*)(ws + O_MP) + (size_t)sq * SEQ; float* ME = (float*)(ws + O_ME) + (size_t)sq * SEQ; float* MBT = (float*)(ws + O_MBT) + (size_t)sq * SEQ;
        float* MCH = (float*)(ws + O_MCH) + (size_t)sq * 64;
        float mc = 0.f;
#pragma unroll 1
        for (int c = 0; c < 16; ++c) {
            const float* s0 = SG + ((size_t)b * SEQ + c * 128 + 2 * lane) * 16;
            const float f0 = logsig(s0[12 + h] + fbias), f1 = logsig(s0[16 + 12 + h] + fbias);
            const float i0 = s0[8 + h] + ibias, i1 = s0[16 + 8 + h] + ibias;
            float x = f0 + f1;
#pragma unroll
            for (int o = 1; o < 64; o <<= 1) { const float y = __shfl_up(x, o); if (lane >= o) x += y; }
            const float b1 = x, b0 = x - f1;
            const float p0 = i0 - b0, p1 = i1 - b1;
            float mxs = fmaxf(p0, p1);
#pragma unroll
            for (int o = 1; o < 64; o <<= 1) { const float y = __shfl_up(mxs, o); if (lane >= o) mxs = fmaxf(mxs, y); }
            float prev = __shfl_up(mxs, 1); if (lane == 0) prev = -INFINITY;
            const float u0 = fmaxf(prev, p0), u1 = mxs;
            const float e0 = fmaxf(mc, u0), e1 = fmaxf(mc, u1);
            const int t = c * 128 + 2 * lane;
            *(f32x2*)(MP + t) = (f32x2){p0, p1}; *(f32x2*)(ME + t) = (f32x2){e0, e1}; *(f32x2*)(MBT + t) = (f32x2){b0, b1};
            const float ulast = __shfl(mxs, 63), bL = __shfl(x, 63);
            const float mx = fmaxf(mc, ulast), dec = __expf(mc - mx);
            if (lane == 0) *(f32x4*)(MCH + c * 4) = (f32x4){mc, mx, dec, bL};
            mc = bL + mx;
        }
    }
}
__device__ __forceinline__ void headnorm_item(unsigned char* ws, int l, int kind, int item, int lane) {
    const float* par = (const float*)(ws + O_PAR);
    const int c = lane & 7;
    int srccol, dpitch, tstep, tok0, tsub; bf16_t* dbase; const float* w; float scale;
    if (kind == 0) { srccol = UC_FQ + lane * 8; dbase = (bf16_t*)(ws + O_FQN) + lane * 8; dpitch = 512; w = par + PAR_FQN + l * 64; scale = 0.125f * LOG2E; tstep = 1; tok0 = item * 8; tsub = 0; }
    else if (kind == 1) { srccol = UC_FK + lane * 8; dbase = (bf16_t*)(ws + O_FKN) + lane * 8; dpitch = 512; w = par + PAR_FKN + l * 64; scale = 1.f; tstep = 1; tok0 = item * 8; tsub = 0; }
    else if (kind == 2) { srccol = UC_SQ + lane * 8; dbase = (bf16_t*)(ws + O_SQR) + lane * 8; dpitch = 512; w = par + PAR_SQN + l * 64; scale = 0.125f * LOG2E; tstep = 1; tok0 = item * 8; tsub = 0; }
    else { srccol = UC_SK + (lane & 15) * 8; dbase = (bf16_t*)(ws + O_SKR) + (lane & 15) * 8; dpitch = 128; w = par + PAR_SKN + l * 64; scale = 1.f; tstep = 4; tok0 = item * 32; tsub = lane >> 4; }
    const bool rp = kind >= 2;
    const f32x4 w0 = *(const f32x4*)(w + 8 * c), w1 = *(const f32x4*)(w + 8 * c + 4);
    const bf16_t* src = (const bf16_t*)(ws + O_U) + (size_t)(tok0 + tsub) * LDU + srccol;
    u32x4 xv[8];
#pragma unroll
    for (int i = 0; i < 8; ++i) xv[i] = *(const u32x4*)(src + (size_t)(i * tstep) * LDU);
#pragma unroll
    for (int i = 0; i < 8; ++i) {
        const int tok = tok0 + tsub + i * tstep;
        float x[8] = {bflo(xv[i].x), bfhi(xv[i].x), bflo(xv[i].y), bfhi(xv[i].y), bflo(xv[i].z), bfhi(xv[i].z), bflo(xv[i].w), bfhi(xv[i].w)};
        float ss = ((x[0] * x[0] + x[1] * x[1]) + (x[2] * x[2] + x[3] * x[3])) + ((x[4] * x[4] + x[5] * x[5]) + (x[6] * x[6] + x[7] * x[7]));
        ss += __shfl_xor(ss, 1); ss += __shfl_xor(ss, 2); ss += __shfl_xor(ss, 4);
        const float rn = rsqrtf(ss * (1.f / 64.f) + EPS);
        x[0] *= rn * w0[0]; x[1] *= rn * w0[1]; x[2] *= rn * w0[2]; x[3] *= rn * w0[3]; x[4] *= rn * w1[0]; x[5] *= rn * w1[1]; x[6] *= rn * w1[2]; x[7] *= rn * w1[3];
        if (rp) {
            const float* rt = (const float*)(ws + O_ROPE) + ((size_t)(tok % SEQ) * 32 + 8 * (c & 3)) * 2;
            const bool second = (c & 4) != 0;
#pragma unroll
            for (int e = 0; e < 8; e += 2) { const f32x4 cs = *(const f32x4*)(rt + 2 * e);
                const float o0 = __shfl_xor(x[e], 4), o1 = __shfl_xor(x[e + 1], 4);
                x[e] = second ? (o0 * cs[1] + x[e] * cs[0]) : (x[e] * cs[0] - o0 * cs[1]);
                x[e + 1] = second ? (o1 * cs[3] + x[e + 1] * cs[2]) : (x[e + 1] * cs[2] - o1 * cs[3]); }
        }
        u32x4 o; o.x = pk2(x[0] * scale, x[1] * scale); o.y = pk2(x[2] * scale, x[3] * scale); o.z = pk2(x[4] * scale, x[5] * scale); o.w = pk2(x[6] * scale, x[7] * scale);
        *(u32x4*)(dbase + (size_t)tok * dpitch) = o;
    }
}
__device__ __forceinline__ void stream_item(unsigned char* ws, int l, int item, int lane) {
    const int cb = item % 34, tb = item / 34, tok0 = tb * 64, b = tok0 / SEQ, s0 = tok0 % SEQ;
    const int tg = lane >> 3, co = lane & 7;
    const bf16_t* U = (const bf16_t*)(ws + O_U);
    int srccol, chan; bf16_t* dT = nullptr; bf16_t* dN = nullptr; int convch = -1; float oscale = 1.f;
    if (cb < 8) { chan = cb * 64 + co * 8; srccol = UC_FV + chan; dT = (bf16_t*)(ws + O_FVT) + ((size_t)b * 512 + chan) * SEQ; }
    else if (cb < 10) { chan = (cb - 8) * 64 + co * 8; srccol = UC_SV + chan; dT = (bf16_t*)(ws + O_SVT) + ((size_t)b * 128 + chan) * SEQ; }
    else if (cb < 18) { chan = (cb - 10) * 64 + co * 8; srccol = UC_MV + chan; dT = (bf16_t*)(ws + O_MVT) + ((size_t)b * 512 + chan) * SEQ; }
    else if (cb < 26) { chan = (cb - 18) * 64 + co * 8; srccol = UC_MQ + chan; dN = (bf16_t*)(ws + O_MQC) + chan; convch = chan; }
    else { chan = (cb - 26) * 64 + co * 8; srccol = UC_MK + chan; dN = (bf16_t*)(ws + O_MKC) + chan; dT = (bf16_t*)(ws + O_KT) + ((size_t)b * 512 + chan) * SEQ; convch = 512 + chan; oscale = 0.08838834764831845f; }
    const bf16_t* src = U + (size_t)(tok0 + tg * 8) * LDU + srccol;
    u32x4 R[8];
#pragma unroll
    for (int i = 0; i < 8; ++i) R[i] = *(const u32x4*)(src + (size_t)i * LDU);
    if (cb >= 18) {
        u32x4 H[3];
        const bool has_prev = (s0 + tg * 8) > 0;
#pragma unroll
        for (int i = 0; i < 3; ++i) { H[i] = (u32x4){0u, 0u, 0u, 0u}; if (has_prev) H[i] = *(const u32x4*)(src - (size_t)(3 - i) * LDU); }
        const float* cw = (const float*)(ws + O_PAR) + PAR_CW + l * 4 * 1024 + convch; const float* cbias = (const float*)(ws + O_PAR) + PAR_CB + l * 1024 + convch;
        float wt[4][8], bb[8];
#pragma unroll
        for (int j = 0; j < 4; ++j) { const f32x4 a = *(const f32x4*)(cw + j * 1024), c2 = *(const f32x4*)(cw + j * 1024 + 4);
            wt[j][0] = a[0]; wt[j][1] = a[1]; wt[j][2] = a[2]; wt[j][3] = a[3]; wt[j][4] = c2[0]; wt[j][5] = c2[1]; wt[j][6] = c2[2]; wt[j][7] = c2[3]; }
        { const f32x4 a = *(const f32x4*)cbias, c2 = *(const f32x4*)(cbias + 4); bb[0] = a[0]; bb[1] = a[1]; bb[2] = a[2]; bb[3] = a[3]; bb[4] = c2[0]; bb[5] = c2[1]; bb[6] = c2[2]; bb[7] = c2[3]; }
        float xm3[8], xm2[8], xm1[8];
#define UNPK(dst, v) do { dst[0] = bflo(v.x); dst[1] = bfhi(v.x); dst[2] = bflo(v.y); dst[3] = bfhi(v.y); dst[4] = bflo(v.z); dst[5] = bfhi(v.z); dst[6] = bflo(v.w); dst[7] = bfhi(v.w); } while (0)
        UNPK(xm3, H[0]); UNPK(xm2, H[1]); UNPK(xm1, H[2]);
#pragma unroll
        for (int i = 0; i < 8; ++i) {
            float xc[8], y[8]; UNPK(xc, R[i]);
#pragma unroll
            for (int e = 0; e < 8; ++e) { const float v = bb[e] + wt[0][e] * xm3[e] + wt[1][e] * xm2[e] + wt[2][e] * xm1[e] + wt[3][e] * xc[e]; y[e] = v * sigm(v) * oscale; xm3[e] = xm2[e]; xm2[e] = xm1[e]; xm1[e] = xc[e]; }
            u32x4 o; o.x = pk2(y[0], y[1]); o.y = pk2(y[2], y[3]); o.z = pk2(y[4], y[5]); o.w = pk2(y[6], y[7]);
            R[i] = o;
            *(u32x4*)(dN + (size_t)(tok0 + tg * 8 + i) * 512) = o;
        }
#undef UNPK
    }
    if (dT) {
        bf16_t* dst = dT + s0 + tg * 8;
#pragma unroll
        for (int k = 0; k < 4; ++k) {
            u32x4 lo, hi;
            lo.x = (R[0][k] & 0xffffu) | (R[1][k] << 16); lo.y = (R[2][k] & 0xffffu) | (R[3][k] << 16); lo.z = (R[4][k] & 0xffffu) | (R[5][k] << 16); lo.w = (R[6][k] & 0xffffu) | (R[7][k] << 16);
            hi.x = (R[0][k] >> 16) | (R[1][k] & 0xffff0000u); hi.y = (R[2][k] >> 16) | (R[3][k] & 0xffff0000u); hi.z = (R[4][k] >> 16) | (R[5][k] & 0xffff0000u); hi.w = (R[6][k] >> 16) | (R[7][k] & 0xffff0000u);
            *(u32x4*)(dst + (size_t)(2 * k) * SEQ) = lo; *(u32x4*)(dst + (size_t)(2 * k + 1) * SEQ) = hi;
        }
    }
}
#define MFMA32(a, b, c) __builtin_amdgcn_mfma_f32_32x32x16_bf16((a), (b), (c), 0, 0, 0)
template <bool SWA>
__device__ __forceinline__ void attn_qtile(const bf16_t* __restrict__ Q, const bf16_t* __restrict__ K, int kpitch, const bf16_t* __restrict__ VT,
                                           const float* __restrict__ C, float sink2, bf16_t* __restrict__ Y, int qt, int lane) {
    const int r = lane & 31, hh = lane >> 5;
    const int pr = ((r >> 2) & 1) * 16 + ((r >> 4) & 1) * 8 + ((r >> 3) & 1) * 4 + (r & 3);
    const int q0 = qt * 32;
    bf16x8 qf[4];
#pragma unroll
    for (int st = 0; st < 4; ++st) qf[st] = *(const bf16x8*)(Q + (size_t)(q0 + r) * 512 + 16 * st + 8 * hh);
    float cq = 0.f; if (!SWA) cq = C[q0 + r];
    float m = -1e30f, lsum = 0.f;
    f32x16 o0, o1;
#pragma unroll
    for (int i = 0; i < 16; ++i) { o0[i] = 0.f; o1[i] = 0.f; }
    const int kt_lo = SWA ? (qt > 4 ? qt - 4 : 0) : 0;
#define ATT_LOAD(KF, VF, CK, kt_) do { const int k0_ = (kt_) * 32; \
        _Pragma("unroll") for (int st = 0; st < 4; ++st) KF[st] = *(const bf16x8*)(K + (size_t)(k0_ + pr) * kpitch + 16 * st + 8 * hh); \
        _Pragma("unroll") for (int dh = 0; dh < 2; ++dh) _Pragma("unroll") for (int s2 = 0; s2 < 2; ++s2) VF[dh][s2] = *(const bf16x8*)(VT + (size_t)(dh * 32 + r) * SEQ + k0_ + 16 * hh + 8 * s2); \
        if (!SWA) { _Pragma("unroll") for (int g = 0; g < 4; ++g) CK[g] = *(const f32x4*)(C + k0_ + 16 * hh + 4 * g); } } while (0)
    bf16x8 kfn[4], vfn[2][2]; f32x4 ckn[4];
#pragma unroll
    for (int g = 0; g < 4; ++g) ckn[g] = (f32x4){0.f, 0.f, 0.f, 0.f};
    ATT_LOAD(kfn, vfn, ckn, kt_lo);
    for (int kt = kt_lo; kt <= qt; ++kt) {
        bf16x8 kf[4], vf[2][2]; f32x4 ckc[4];
#pragma unroll
        for (int st = 0; st < 4; ++st) kf[st] = kfn[st];
#pragma unroll
        for (int dh = 0; dh < 2; ++dh) { vf[dh][0] = vfn[dh][0]; vf[dh][1] = vfn[dh][1]; }
#pragma unroll
        for (int g = 0; g < 4; ++g) ckc[g] = ckn[g];
        if (kt < qt) ATT_LOAD(kfn, vfn, ckn, kt + 1);
        f32x16 sc;
#pragma unroll
        for (int i = 0; i < 16; ++i) sc[i] = 0.f;
#pragma unroll
        for (int st = 0; st < 4; ++st) sc = MFMA32(kf[st], qf[st], sc);
        if (!SWA) {
#pragma unroll
            for (int g = 0; g < 4; ++g) { const f32x4 ck = ckc[g];
#pragma unroll
                for (int e = 0; e < 4; ++e) sc[4 * g + e] += cq - ck[e]; }
        }
        if (kt == qt) {
#pragma unroll
            for (int i = 0; i < 16; ++i) if (16 * hh + i > r) sc[i] = -INFINITY;
        }
        if (SWA && kt == qt - 4) {
#pragma unroll
            for (int i = 0; i < 16; ++i) if (16 * hh + i <= r) sc[i] = -INFINITY;
        }
        float tm = sc[0];
#pragma unroll
        for (int i = 1; i < 16; ++i) tm = fmaxf(tm, sc[i]);
        tm = fmaxf(tm, __shfl_xor(tm, 32));
        const float mn = fmaxf(m, tm), alpha = __builtin_amdgcn_exp2f(m - mn);
        m = mn;
        float ps = 0.f;
#pragma unroll
        for (int i = 0; i < 16; ++i) { sc[i] = __builtin_amdgcn_exp2f(sc[i] - mn); ps += sc[i]; }
        lsum = lsum * alpha + ps;
#pragma unroll
        for (int i = 0; i < 16; ++i) { o0[i] *= alpha; o1[i] *= alpha; }
        u32x4 pw0, pw1;
        pw0.x = pk2(sc[0], sc[1]); pw0.y = pk2(sc[2], sc[3]); pw0.z = pk2(sc[4], sc[5]); pw0.w = pk2(sc[6], sc[7]);
        pw1.x = pk2(sc[8], sc[9]); pw1.y = pk2(sc[10], sc[11]); pw1.z = pk2(sc[12], sc[13]); pw1.w = pk2(sc[14], sc[15]);
        const bf16x8 pf0 = __builtin_bit_cast(bf16x8, pw0), pf1 = __builtin_bit_cast(bf16x8, pw1);
        o0 = MFMA32(vf[0][0], pf0, o0); o0 = MFMA32(vf[0][1], pf1, o0);
        o1 = MFMA32(vf[1][0], pf0, o1); o1 = MFMA32(vf[1][1], pf1, o1);
    }
    float lt = lsum + __shfl_xor(lsum, 32);
    if (SWA) lt += __builtin_amdgcn_exp2f(sink2 - m);
    const float inv = 1.f / lt;
    bf16_t* yrow = Y + (size_t)(q0 + r) * 512 + 4 * hh;
#pragma unroll
    for (int g = 0; g < 4; ++g) {
        u32x2 a, c;
        a.x = pk2(o0[4 * g] * inv, o0[4 * g + 1] * inv); a.y = pk2(o0[4 * g + 2] * inv, o0[4 * g + 3] * inv);
        c.x = pk2(o1[4 * g] * inv, o1[4 * g + 1] * inv); c.y = pk2(o1[4 * g + 2] * inv, o1[4 * g + 3] * inv);
        *(u32x2*)(yrow + 8 * g) = a; *(u32x2*)(yrow + 32 + 8 * g) = c;
    }
}
__device__ __forceinline__ void m1_item(unsigned char* ws, int it, int lane) {
    const int r = lane & 31, hh = lane >> 5;
    const int dvt = it & 3, c = (it >> 2) & 15, bh = it >> 6;
    const bf16_t* VTp = (const bf16_t*)(ws + O_MVT) + ((size_t)bh * 128 + dvt * 32 + r) * SEQ + c * 128 + 8 * hh;
    const bf16_t* KTp = (const bf16_t*)(ws + O_KT) + ((size_t)bh * 128 + r) * SEQ + c * 128 + 8 * hh;
    const float* MPp = (const float*)(ws + O_MP) + (size_t)bh * SEQ + c * 128 + 8 * hh;
    const float mx = ((const float*)(ws + O_MCH))[(bh * 16 + c) * 4 + 1];
    f32x16 acc[4];
#pragma unroll
    for (int d = 0; d < 4; ++d)
#pragma unroll
        for (int i = 0; i < 16; ++i) acc[d][i] = 0.f;
    float dn[4] = {0.f, 0.f, 0.f, 0.f};
#pragma unroll 1
    for (int st = 0; st < 8; ++st) {
        const bf16x8 vf = *(const bf16x8*)(VTp + 16 * st);
        const f32x4 pa = *(const f32x4*)(MPp + 16 * st), pb = *(const f32x4*)(MPp + 16 * st + 4);
        float wk[8];
#pragma unroll
        for (int e = 0; e < 4; ++e) { wk[e] = __expf(pa[e] - mx); wk[4 + e] = __expf(pb[e] - mx); }
#pragma unroll
        for (int d = 0; d < 4; ++d) {
            const u32x4 kr = *(const u32x4*)(KTp + (size_t)d * 32 * SEQ + 16 * st);
            const float k0 = bflo(kr.x) * wk[0], k1 = bfhi(kr.x) * wk[1], k2 = bflo(kr.y) * wk[2], k3 = bfhi(kr.y) * wk[3];
            const float k4 = bflo(kr.z) * wk[4], k5 = bfhi(kr.z) * wk[5], k6 = bflo(kr.w) * wk[6], k7 = bfhi(kr.w) * wk[7];
            dn[d] += ((k0 + k1) + (k2 + k3)) + ((k4 + k5) + (k6 + k7));
            u32x4 kw; kw.x = pk2(k0, k1); kw.y = pk2(k2, k3); kw.z = pk2(k4, k5); kw.w = pk2(k6, k7);
            acc[d] = MFMA32(vf, __builtin_bit_cast(bf16x8, kw), acc[d]);
        }
    }
    bf16_t* DCT = (bf16_t*)(ws + O_DCT) + (size_t)(bh * 16 + c) * 16384;
#pragma unroll
    for (int d = 0; d < 4; ++d) {
#pragma unroll
        for (int g4 = 0; g4 < 4; ++g4) { bf16_t* pg = DCT + (dvt * 32 + 8 * g4 + 4 * hh) * 128 + d * 32 + r; asm volatile("" : "+v"(pg));
            pg[0] = (bf16_t)pk2(acc[d][4 * g4], 0.f); pg[128] = (bf16_t)pk2(acc[d][4 * g4 + 1], 0.f); pg[256] = (bf16_t)pk2(acc[d][4 * g4 + 2], 0.f); pg[384] = (bf16_t)pk2(acc[d][4 * g4 + 3], 0.f); }
        const float t = dn[d] + __shfl_xor(dn[d], 32);
        if (dvt == 0 && hh == 0) ((float*)(ws + O_DN))[(bh * 16 + c) * 128 + d * 32 + r] = t;
    }
}
__device__ __forceinline__ void phase_m2(unsigned char* ws, int gtid, int NT) {
    const float* MCH = (const float*)(ws + O_MCH);
    for (int e = gtid; e < BG * 4 * 8192; e += NT) {
        const int bh = e >> 13, pp = e & 8191;
        float c0 = 0.f, c1 = 0.f;
        for (int c = 0; c < 16; ++c) {
            const size_t off = (size_t)(bh * 16 + c) * 16384 + 2 * pp;
            *(unsigned*)((bf16_t*)(ws + O_CT) + off) = pk2(c0, c1);
            const float dec = MCH[(bh * 16 + c) * 4 + 2]; const unsigned d = *(const unsigned*)((const bf16_t*)(ws + O_DCT) + off);
            c0 = dec * c0 + bflo(d); c1 = dec * c1 + bfhi(d);
        }
    }
    for (int e = gtid; e < BG * 4 * 128; e += NT) {
        const int bh = e >> 7, dk = e & 127; float n = 0.f;
        for (int c = 0; c < 16; ++c) { const size_t off = (size_t)(bh * 16 + c) * 128 + dk; ((float*)(ws + O_NN))[off] = n; n = MCH[(bh * 16 + c) * 4 + 2] * n + ((const float*)(ws + O_DN))[off]; }
    }
}
__device__ __forceinline__ void m3_item(unsigned char* ws, int l, int it, int lane) {
    const int r = lane & 31, hh = lane >> 5;
    const int pr = ((r >> 2) & 1) * 16 + ((r >> 4) & 1) * 8 + ((r >> 3) & 1) * 4 + (r & 3);
    const int tt = 3 - (it & 3), c = (it >> 2) & 15, bh = it >> 6, b = bh >> 2, h = bh & 3;
    const int ts = c * 128 + tt * 32 + r;
    const size_t trow = (size_t)b * SEQ + ts;
    bf16x8 qf[8];
    const bf16_t* Qp = (const bf16_t*)(ws + O_MQC) + trow * 512 + h * 128 + 8 * hh;
#pragma unroll
    for (int k = 0; k < 8; ++k) qf[k] = *(const bf16x8*)(Qp + 16 * k);
    const float Et = ((const float*)(ws + O_ME))[(size_t)bh * SEQ + ts], bt = ((const float*)(ws + O_MBT))[(size_t)bh * SEQ + ts];
    const float mc = ((const float*)(ws + O_MCH))[(bh * 16 + c) * 4];
    const float winter = __expf(mc - Et);
    f32x16 acc[4];
#pragma unroll
    for (int d = 0; d < 4; ++d)
#pragma unroll
        for (int i = 0; i < 16; ++i) acc[d][i] = 0.f;
    const bf16_t* CTp = (const bf16_t*)(ws + O_CT) + (size_t)(bh * 16 + c) * 16384 + (size_t)r * 128 + 8 * hh;
    const float* NNp = (const float*)(ws + O_NN) + (size_t)(bh * 16 + c) * 128 + 8 * hh;
    float qn = 0.f;
#pragma unroll
    for (int k = 0; k < 8; ++k) {
#pragma unroll
        for (int d = 0; d < 4; ++d) acc[d] = MFMA32(*(const bf16x8*)(CTp + (size_t)d * 32 * 128 + 16 * k), qf[k], acc[d]);
        const f32x4 na = *(const f32x4*)(NNp + 16 * k), nb = *(const f32x4*)(NNp + 16 * k + 4);
        const u32x4 qw = __builtin_bit_cast(u32x4, qf[k]);
        qn += bflo(qw.x) * na[0] + bfhi(qw.x) * na[1] + bflo(qw.y) * na[2] + bfhi(qw.y) * na[3] + bflo(qw.z) * nb[0] + bfhi(qw.z) * nb[1] + bflo(qw.w) * nb[2] + bfhi(qw.w) * nb[3];
        if (k & 1) asm volatile("" ::: "memory");
    }
    qn += __shfl_xor(qn, 32);
#pragma unroll
    for (int d = 0; d < 4; ++d)
#pragma unroll
        for (int i = 0; i < 16; ++i) acc[d][i] *= winter;
    float dpart = 0.f;
    const bf16_t* Kb = (const bf16_t*)(ws + O_MKC) + ((size_t)b * SEQ + c * 128 + pr) * 512 + h * 128 + 8 * hh;
    const bf16_t* Vb = (const bf16_t*)(ws + O_MVT) + ((size_t)bh * 128 + r) * SEQ + c * 128 + 16 * hh;
    const float* MPb = (const float*)(ws + O_MP) + (size_t)bh * SEQ + c * 128 + 16 * hh;
    for (int st = 0; st <= tt; ++st) {
        f32x16 sc;
#pragma unroll
        for (int i = 0; i < 16; ++i) sc[i] = 0.f;
#pragma unroll
        for (int k = 0; k < 8; ++k) { sc = MFMA32(*(const bf16x8*)(Kb + (size_t)st * 32 * 512 + 16 * k), qf[k], sc); if (k == 3) asm volatile("" ::: "memory"); }
        asm volatile("" ::: "memory");
#pragma unroll
        for (int g = 0; g < 4; ++g) { const f32x4 pv = *(const f32x4*)(MPb + st * 32 + 4 * g);
#pragma unroll
            for (int e = 0; e < 4; ++e) { const int i = 4 * g + e;
                const bool ok = (st < tt) || (16 * hh + i <= r);
                const float w = ok ? __expf(pv[e] - Et) : 0.f;
                sc[i] = ok ? sc[i] * w : 0.f; dpart += sc[i]; } }
        u32x4 pw0, pw1;
        pw0.x = pk2(sc[0], sc[1]); pw0.y = pk2(sc[2], sc[3]); pw0.z = pk2(sc[4], sc[5]); pw0.w = pk2(sc[6], sc[7]);
        pw1.x = pk2(sc[8], sc[9]); pw1.y = pk2(sc[10], sc[11]); pw1.z = pk2(sc[12], sc[13]); pw1.w = pk2(sc[14], sc[15]);
        const bf16x8 pf0 = __builtin_bit_cast(bf16x8, pw0), pf1 = __builtin_bit_cast(bf16x8, pw1);
#pragma unroll
        for (int d = 0; d < 4; ++d) {
            acc[d] = MFMA32(*(const bf16x8*)(Vb + (size_t)d * 32 * SEQ + st * 32), pf0, acc[d]);
            acc[d] = MFMA32(*(const bf16x8*)(Vb + (size_t)d * 32 * SEQ + st * 32 + 8), pf1, acc[d]);
        }
    }
    const float den = winter * qn + (dpart + __shfl_xor(dpart, 32));
    const float dinv = 1.f / fmaxf(fabsf(den), __expf(-(bt + Et)));
    float ss = 0.f;
#pragma unroll
    for (int d = 0; d < 4; ++d)
#pragma unroll
        for (int i = 0; i < 16; ++i) { acc[d][i] *= dinv; ss += acc[d][i] * acc[d][i]; }
    ss += __shfl_xor(ss, 32);
    const float rn = rsqrtf(ss * (1.f / 128.f) + EPS);
    const float* onorm = (const float*)(ws + O_PAR) + PAR_ON + l * 512 + h * 128 + 4 * hh;
    const bf16_t* mo = (const bf16_t*)(ws + O_U) + trow * LDU + UC_MO + h * 128 + 4 * hh;
    bf16_t* y = (bf16_t*)(ws + O_Y) + (size_t)2 * MG * 512 + trow * 512 + h * 128 + 4 * hh;
#pragma unroll
    for (int d = 0; d < 4; ++d)
#pragma unroll
        for (int g = 0; g < 4; ++g) {
            const int dv = d * 32 + 8 * g;
            const f32x4 wn = *(const f32x4*)(onorm + dv); const u32x2 og = *(const u32x2*)(mo + dv);
            const float y0 = acc[d][4 * g] * rn * wn[0] * sigm(bflo(og.x)), y1 = acc[d][4 * g + 1] * rn * wn[1] * sigm(bfhi(og.x));
            const float y2 = acc[d][4 * g + 2] * rn * wn[2] * sigm(bflo(og.y)), y3 = acc[d][4 * g + 3] * rn * wn[3] * sigm(bfhi(og.y));
            u32x2 o; o.x = pk2(y0, y1); o.y = pk2(y2, y3); *(u32x2*)(y + dv) = o;
            if (g & 1) asm volatile("" ::: "memory");
        }
}

#define XB_TMO      128
#define XB_XCNT(j)  (256  + 64 * (j))
#define XB_XSUB(j)  (1280 + 64 * (j))
#define XB_XGEN(j)  (2304 + 64 * (j))
#define XB_TOP      3328
#define XB_TOPGEN   3392
#define XCD_BAR_WORDS 3456
#define XB_SPIN_CAP (1u << 18)

__device__ __forceinline__ unsigned xb_ld(unsigned* p)              { return __hip_atomic_load(p, __ATOMIC_RELAXED, __HIP_MEMORY_SCOPE_AGENT); }
__device__ __forceinline__ unsigned xb_add(unsigned* p, unsigned v) { return __hip_atomic_fetch_add(p, v, __ATOMIC_RELAXED, __HIP_MEMORY_SCOPE_AGENT); }
__device__ __forceinline__ unsigned xb_xcc_id() { return (unsigned)__builtin_amdgcn_s_getreg((3 << 11) | 20) & 0xFu; }
#define XB_SPIN(cond, bar) do { unsigned _sp = 0; while (cond) { __builtin_amdgcn_s_sleep(1); \
    if ((++_sp & 255u) == 0u) { if (xb_ld(&(bar)[XB_TMO])) break; if (_sp > XB_SPIN_CAP) { atomicAdd(&(bar)[XB_TMO], 1u); break; } } } } while (0)

struct XcdBarrier {
    unsigned* bar; unsigned x;
    volatile LAS unsigned* st;
};

__device__ __forceinline__ XcdBarrier xcd_barrier_post(unsigned* bar, volatile LAS unsigned* st) {
    XcdBarrier b; b.bar = bar; b.x = xb_xcc_id(); b.st = st;
    if (threadIdx.x == 0) (void)xb_add(&bar[XB_XCNT(b.x)], 1u);
    return b;
}
__device__ __forceinline__ void xcd_barrier_complete(unsigned* bar, unsigned x, unsigned& nloc, unsigned& nx) {
    const unsigned G = gridDim.x * gridDim.y * gridDim.z;
    unsigned sum, cnt, mine, sp = 0u;
    for (;;) {
        sum = 0u; cnt = 0u; mine = 0u;
#pragma unroll
        for (unsigned j = 0; j < 16; ++j) { const unsigned c = xb_ld(&bar[XB_XCNT(j)]); sum += c; cnt += (c > 0u) ? 1u : 0u; mine = (j == x) ? c : mine; }
        if (sum == G) break;
        __builtin_amdgcn_s_sleep(1);
        if ((++sp & 255u) == 0u) { if (xb_ld(&bar[XB_TMO])) break; if (sp > XB_SPIN_CAP) { atomicAdd(&bar[XB_TMO], 1u); break; } }
    }
    nloc = mine > 0u ? mine : 1u; nx = cnt > 0u ? cnt : 1u;
}

__device__ __forceinline__ void xcd_barrier(const XcdBarrier& b) {
    asm volatile("s_waitcnt vmcnt(0)" ::: "memory");
    __syncthreads();
    if (threadIdx.x == 0) {
        unsigned* bar = b.bar;
        __builtin_amdgcn_s_waitcnt(0);
        unsigned nloc = b.st[0], nx = b.st[1];
        if (nloc == 0u) { xcd_barrier_complete(bar, b.x, nloc, nx); b.st[0] = nloc; b.st[1] = nx; }
        const unsigned old = xb_add(&bar[XB_XSUB(b.x)], 1u);
        const unsigned gen = old / nloc;
        if (old + 1u == (gen + 1u) * nloc) {
            __builtin_amdgcn_fence(__ATOMIC_RELEASE, "agent");
            asm volatile("s_waitcnt vmcnt(0)" ::: "memory");
            const unsigned og = xb_add(&bar[XB_TOP], 1u);
            const unsigned tg = og / nx;
            if (og + 1u == (tg + 1u) * nx) xb_add(&bar[XB_TOPGEN], 1u);
            else XB_SPIN(xb_ld(&bar[XB_TOPGEN]) == tg, bar);
            __builtin_amdgcn_fence(__ATOMIC_ACQUIRE, "agent");
            xb_add(&bar[XB_XGEN(b.x)], 1u);
            asm volatile("s_waitcnt vmcnt(0)" ::: "memory");
        } else {
            XB_SPIN(xb_ld(&bar[XB_XGEN(b.x)]) == gen, bar);
            __builtin_amdgcn_fence(__ATOMIC_ACQUIRE, "agent");
            asm volatile("s_waitcnt vmcnt(0)" ::: "memory");
        }
    }
    __syncthreads();
}


__global__ void __launch_bounds__(NTHR, 2) fwd_kernel(KP p) {
    extern __shared__ __attribute__((aligned(16))) unsigned char lds_raw[];
    LAS unsigned char* lds = (LAS unsigned char*)lds_raw;
    cg::grid_group grid = cg::this_grid();
    const int tid = threadIdx.x, lane0 = tid & 63, wave = __builtin_amdgcn_readfirstlane(tid >> 6);
    const int G = gridDim.x, gw0 = blockIdx.x * NWAVES + wave, NWV = G * NWAVES, NT = G * NTHR;
    unsigned char* ws0 = p.ws;
    volatile LAS unsigned* MISC = (volatile LAS unsigned*)(lds + 131072);
    if (tid < 64) MISC[tid] = 0u;
    __syncthreads();
    XcdBarrier bar = xcd_barrier_post((unsigned*)(ws0 + O_BAR), MISC + 8);
    int pc = 0;
#ifndef PM
#define PM 0xFFFF
#endif
#ifndef PROBE_ID
#define PROBE_ID -1
#define PROBE_REP 1
#endif
#define PH_BEGIN(id) if (((PM >> (id)) & 1) && pc >= p.ph_lo && pc < p.ph_hi) { for (int rep_ = 0; rep_ < ((PROBE_ID == (id)) ? PROBE_REP : 1); ++rep_) { unsigned char* ws = ws0; int lane = lane0, gw = gw0; asm volatile("" : "+s"(ws), "+v"(lane), "+s"(gw)); const int gtid = gw * 64 + lane; (void)gtid;
#define PH_END } } ++pc; if (pc > p.ph_lo && pc < p.ph_hi) { if (pc == 1) grid.sync(); else xcd_barrier(bar); }

    PH_BEGIN(0) phase_p0(p, ws, lds, gw, NWV, wave, lane); PH_END

    for (int g = 0; g < NG; ++g) {
        const size_t goff = (size_t)g * MG * DM;
#define XB ((bf16_t*)(ws + O_XB))
#define RS ((float*)(ws + O_RS))
#define U ((bf16_t*)(ws + O_U))
        PH_BEGIN(1) phase_x0(p.in[0] + goff, XB, RS, gw, NWV, lane); PH_END
        for (int l = 0; l < DEPTH; ++l) {
            PH_BEGIN(2) {
                pg8::Gemm gm{XB, (const bf16_t*)(ws + O_WIN) + (size_t)l * NINP * DM, MG, NINP, DM}; pg8::StaticOrder S; S.init(MG, NINP, G, (int)blockIdx.x);
                pg8::EpiA E{0, 0, RS, U, LDU, (float*)(ws + O_SG), nullptr, 0, nullptr};
                pg8::gemm_phase<pg8::EpiA, pg8::StaticOrder, true, true>(lds, gm, S, E);
            } PH_END
            PH_BEGIN(3) {
                constexpr int N_SCAN = BG * 12, N_HN3 = 3 * (MG / 8), N_HK = MG / 32, N_ST = 34 * (MG / 64);
                for (int it = gw; it < N_SCAN + N_HN3 + N_HK + N_ST; it += NWV) {
                    if (it < N_SCAN) gate_scan_item(ws, l, it, lane);
                    else if (it < N_SCAN + N_HN3) { const int r_ = it - N_SCAN; headnorm_item(ws, l, r_ % 3, r_ / 3, lane); }
                    else if (it < N_SCAN + N_HN3 + N_HK) headnorm_item(ws, l, 3, it - N_SCAN - N_HN3, lane);
                    else stream_item(ws, l, it - N_SCAN - N_HN3 - N_HK, lane);
                }
            } PH_END
            PH_BEGIN(4) {
#ifndef PM4
#define PM4 7
#endif
                if (PM4 & 1) for (int it = gw; it < BG * 4 * 16 * 4; it += NWV) m1_item(ws, it, lane);
                if (PM4 & 2) for (int it = gw; it < BG * 8 * 32; it += NWV) {
                    const int b = it >> 8, h = (it >> 5) & 7, pi = it & 31;
                    const bf16_t* Q = (const bf16_t*)(ws + O_FQN) + (size_t)b * SEQ * 512 + h * 64; const bf16_t* K = (const bf16_t*)(ws + O_FKN) + (size_t)b * SEQ * 512 + h * 64;
                    const bf16_t* VT = (const bf16_t*)(ws + O_FVT) + (size_t)(b * 8 + h) * 64 * SEQ; const float* C = (const float*)(ws + O_FC) + (size_t)(b * 8 + h) * SEQ;
                    bf16_t* Y = (bf16_t*)(ws + O_Y) + (size_t)b * SEQ * 512 + h * 64;
                    attn_qtile<false>(Q, K, 512, VT, C, 0.f, Y, 63 - pi, lane);
                    attn_qtile<false>(Q, K, 512, VT, C, 0.f, Y, pi, lane);
                }
                if (PM4 & 4) for (int it = gw; it < BG * 8 * 64; it += NWV) {
                    const int b = it >> 9, hq = (it >> 6) & 7, qt = it & 63, hk = hq >> 2;
                    const bf16_t* Q = (const bf16_t*)(ws + O_SQR) + (size_t)b * SEQ * 512 + hq * 64; const bf16_t* K = (const bf16_t*)(ws + O_SKR) + (size_t)b * SEQ * 128 + hk * 64;
                    const bf16_t* VT = (const bf16_t*)(ws + O_SVT) + (size_t)(b * 2 + hk) * 64 * SEQ;
                    bf16_t* Y = (bf16_t*)(ws + O_Y) + (size_t)MG * 512 + (size_t)b * SEQ * 512 + hq * 64;
                    attn_qtile<true>(Q, K, 128, VT, nullptr, ((const float*)(ws + O_PAR))[PAR_SINK + l * 8 + hq] * LOG2E, Y, qt, lane);
                }
            } PH_END
            PH_BEGIN(5) phase_m2(ws, gtid, NT); PH_END
            PH_BEGIN(6) { for (int it = gw; it < BG * 4 * 16 * 4; it += NWV) m3_item(ws, l, it, lane); } PH_END
            PH_BEGIN(7) {
                for (int b3 = 0; b3 < 3; ++b3) {
                    pg8::Gemm gm{(const bf16_t*)(ws + O_Y) + (size_t)b3 * MG * 512, (const bf16_t*)(ws + O_WB) + (size_t)(l * 3 + b3) * DM * 512, MG, DM, 512}; pg8::StaticOrder S; S.init(MG, DM, G, (int)blockIdx.x);
                    pg8::EpiA E{1, b3, nullptr, (bf16_t*)(ws + O_MRG), DM, nullptr, U + UC_G + b3 * DM, LDU, (float*)(ws + O_TMP)};
                    pg8::gemm_phase<pg8::EpiA, pg8::StaticOrder, true, true>(lds, gm, S, E);
                }
            } PH_END
            PH_BEGIN(8) {
                pg8::Gemm gm{(const bf16_t*)(ws + O_MRG), (const bf16_t*)(ws + O_WOUT) + (size_t)l * DM * DM, MG, DM, DM}; pg8::StaticOrder S; S.init(MG, DM, G, (int)blockIdx.x);
                pg8::EpiB E{(l == 0 ? p.in[0] : (const float*)p.out) + goff, p.out + goff, XB, RS};
                pg8::gemm_phase<pg8::EpiB, pg8::StaticOrder, true, true>(lds, gm, S, E);
            } PH_END
            PH_BEGIN(9) {
                pg8::Gemm gm{XB, (const bf16_t*)(ws + O_WUP) + (size_t)l * FF * DM, MG, FF, DM}; pg8::StaticOrder S; S.init(MG, FF, G, (int)blockIdx.x);
                pg8::EpiA E{2, 0, RS, U  , FF, nullptr, nullptr, 0, nullptr};
                pg8::gemm_phase<pg8::EpiA, pg8::StaticOrder, true, true>(lds, gm, S, E);
            } PH_END
            PH_BEGIN(10) {
                pg8::Gemm gm{U  , (const bf16_t*)(ws + O_WDN) + (size_t)l * DM * FF, MG, DM, FF}; pg8::StaticOrder S; S.init(MG, DM, G, (int)blockIdx.x);
                pg8::EpiB E{(const float*)p.out + goff, p.out + goff, XB, RS};
                pg8::gemm_phase<pg8::EpiB, pg8::StaticOrder, true, true>(lds, gm, S, E);
            } PH_END
        }
    }
}
constexpr int N_PHASES = 1 + NG * (1 + DEPTH * 9);

#ifndef MK_MULTI
#define MK_MULTI 0
#endif
extern "C" void kernel_launch(void* const* d_in, const int* in_sizes, int n_in, void* d_out, int out_size, void* d_ws, size_t ws_size, hipStream_t stream) {
    static int grid = 0;
    if (grid == 0) {
        if (n_in != 19 || out_size != NB * SEQ * DM || ws_size < WS_NEED) { fprintf(stderr, "kernel_launch: unexpected problem (n_in %d out %d ws %zu need %zu)\n", n_in, out_size, ws_size, (size_t)WS_NEED); grid = -1; return; }
        int dev = 0, cus = 0, per_cu = 0;
        hipGetDevice(&dev); hipDeviceGetAttribute(&cus, hipDeviceAttributeMultiprocessorCount, dev);
        if (hipFuncSetAttribute((const void*)fwd_kernel, hipFuncAttributeMaxDynamicSharedMemorySize, LDS_BYTES) != hipSuccess) { fprintf(stderr, "kernel_launch: hipFuncSetAttribute failed\n"); grid = -1; return; }
        hipOccupancyMaxActiveBlocksPerMultiprocessor(&per_cu, (const void*)fwd_kernel, NTHR, LDS_BYTES);
        (void)hipGetLastError();
        if (per_cu < 1) { fprintf(stderr, "kernel_launch: occupancy query says %d blocks per CU\n", per_cu); per_cu = 1; }
        grid = cus;
    }
    if (grid < 0) return;
    if (hipMemsetAsync((char*)d_ws + O_BAR, 0, 16384, stream) != hipSuccess) { fprintf(stderr, "kernel_launch: memset failed\n"); return; }
    KP a{};
    for (int i = 0; i < 19; ++i) a.in[i] = (const float*)d_in[i];
    a.out = (float*)d_out; a.ws = (unsigned char*)d_ws;
#if MK_MULTI
    for (int ph = 0; ph < N_PHASES; ++ph) { a.ph_lo = ph; a.ph_hi = ph + 1; hipLaunchKernelGGL(fwd_kernel, dim3(grid), dim3(NTHR), LDS_BYTES, stream, a); }
#else
    a.ph_lo = 0; a.ph_hi = N_PHASES;
    void* args[] = {&a};
    hipError_t e = hipLaunchCooperativeKernel((const void*)fwd_kernel, dim3(grid), dim3(NTHR), args, LDS_BYTES, stream);
    if (e != hipSuccess) fprintf(stderr, "kernel_launch: cooperative launch failed: %s (grid %d)\n", hipGetErrorString(e), grid);
#endif
}
```

```cpp
#include <hip/hip_runtime.h>
#include <hip/hip_cooperative_groups.h>
#include <cstdio>
#include <cstdint>
#include <cmath>
namespace cg = cooperative_groups;
namespace pg8 {
#define PG8_LAS __attribute__((address_space(3)))
typedef unsigned short bf16_t;
typedef short bf16x8 __attribute__((ext_vector_type(8)));
typedef float f32x4 __attribute__((ext_vector_type(4)));
typedef unsigned u32x4 __attribute__((ext_vector_type(4)));
constexpr int BM = 256, BK = 64, HALF = 128, HTB = HALF * BK * 2  , STAGE_BYTES = 8 * HTB, NXCD = 8, WGM = 8;

__host__ __device__ __forceinline__ int lds_byte(int r, int c) { const int st = (r >> 4) * 2 + (c >> 5), rr = r & 15, cc = c & 31, ob = rr * 64 + cc * 2; return st * 1024 + (ob ^ (((ob >> 9) & 1) << 5)); }
__host__ __device__ __forceinline__ void stage_rc(int b, int& R, int& C) { const int st = b / 1024, sb = b % 1024, swz = sb ^ (((sb >> 9) & 1) << 5); R = (st >> 1) * 16 + swz / 64; C = (st & 1) * 32 + (swz % 64) / 2; }
__host__ __device__ __forceinline__ int perm32(int rho) { const int n = rho >> 4, i = rho & 15; return 8 * (i >> 2) + 4 * n + (i & 3); }

struct Unit { int pm, pn; };
struct Gemm { const bf16_t* A; const bf16_t* Bt; int M, N, K; };

struct StaticOrder {
    int nM, nN, nwg, G, c;
    __host__ __device__ void init(int M, int N, int G_, int c_) { nM = M / BM; nN = N / BM; nwg = nM * nN; G = G_; c = c_; }
    __host__ __device__ bool next(int i, Unit& u) const {
        const long L = (long)i * G + c; if (L >= nwg) return false;
        int wgid = (int)L; { const int q = nwg / NXCD, r = nwg % NXCD, xcd = wgid % NXCD, off = wgid / NXCD; wgid = (xcd < r ? xcd * (q + 1) : r * (q + 1) + (xcd - r) * q) + off; }
        const int nig = WGM * nN, gid = wgid / nig, fm = gid * WGM, gsz = (nM - fm) < WGM ? (nM - fm) : WGM;
        u.pm = fm + ((wgid % nig) % gsz); u.pn = (wgid % nig) / gsz; return true;
    }
    __device__ __forceinline__ void a_ready(const Unit&) const {}
    __device__ __forceinline__ void done(const Unit&) const {}
};


typedef unsigned u32x2 __attribute__((ext_vector_type(2)));
typedef float f32x2_t __attribute__((ext_vector_type(2)));
typedef __bf16 bf16x2_t __attribute__((ext_vector_type(2)));
__device__ __forceinline__ unsigned pk2(float lo, float hi) { f32x2_t v = {lo, hi}; bf16x2_t b = __builtin_convertvector(v, bf16x2_t); return __builtin_bit_cast(unsigned, b); }
__device__ __forceinline__ float bflo(unsigned w) { return __uint_as_float(w << 16); }
__device__ __forceinline__ float bfhi(unsigned w) { return __uint_as_float(w & 0xffff0000u); }
__device__ __forceinline__ float sigm(float x) { return __builtin_amdgcn_rcpf(1.f + __expf(-x)); }
__device__ __forceinline__ float rowscale(const float* rs, int row) {
    const f32x4* p = (const f32x4*)(rs + (size_t)row * 16);
    const f32x4 a = p[0], b = p[1], c = p[2], d = p[3];
    const float s = ((a[0] + a[1]) + (a[2] + a[3])) + ((b[0] + b[1]) + (b[2] + b[3])) + ((c[0] + c[1]) + (c[2] + c[3])) + ((d[0] + d[1]) + (d[2] + d[3]));
    return rsqrtf(s * (1.f / 1024.f) + 1e-6f);
}
struct EpiA {
    static constexpr bool PERM = true, AFTER_DRAIN = false;
    int mode, sub; const float* rs; bf16_t* out; int ldo; float* sg; const bf16_t* gate; int ldg; float* tmp;
    __device__ __forceinline__ void operator()(const f32x4 (&acc)[2][2][4][2], const Unit& u, int wr, int wc, int fr, int fq) const {
        const int row0 = u.pm * BM + wr * 64 + fr, colb = u.pn * BM + wc * 32 + 8 * fq;
#pragma unroll
        for (int ai = 0; ai < 2; ++ai)
#pragma unroll
            for (int m = 0; m < 4; ++m) {
                const int row = row0 + ai * HALF + m * 16;
                float rsv = 1.f; if (mode != 1) rsv = rowscale(rs, row);
#pragma unroll
                for (int bj = 0; bj < 2; ++bj) {
                    const int col = colb + bj * HALF;
                    f32x4 v0 = acc[ai][bj][m][0] * rsv, v1 = acc[ai][bj][m][1] * rsv;
                    if (mode == 0) {
                        if (u.pn == 29) {
                            if (bj == 0 && wc == 0 && fq < 2) { float* q = sg + (size_t)row * 16 + 8 * fq; *(f32x4*)q = v0; *(f32x4*)(q + 4) = v1; }
                        } else {
                            if (u.pn >= 17) {
#pragma unroll
                                for (int e = 0; e < 4; ++e) { v0[e] = sigm(v0[e]); v1[e] = sigm(v1[e]); }
                            }
                            u32x4 w; w.x = pk2(v0[0], v0[1]); w.y = pk2(v0[2], v0[3]); w.z = pk2(v1[0], v1[1]); w.w = pk2(v1[2], v1[3]);
                            *(u32x4*)(out + (size_t)row * ldo + col) = w;
                        }
                    } else if (mode == 1) {
                        const u32x4 g = *(const u32x4*)(gate + (size_t)row * ldg + col);
                        f32x4 p0 = {v0[0] * bflo(g.x), v0[1] * bfhi(g.x), v0[2] * bflo(g.y), v0[3] * bfhi(g.y)};
                        f32x4 p1 = {v1[0] * bflo(g.z), v1[1] * bfhi(g.z), v1[2] * bflo(g.w), v1[3] * bfhi(g.w)};
                        float* tp = tmp + (size_t)row * 1024 + col;
                        if (sub == 0) { *(f32x4*)tp = p0; *(f32x4*)(tp + 4) = p1; }
                        else if (sub == 1) { *(f32x4*)tp = *(const f32x4*)tp + p0; *(f32x4*)(tp + 4) = *(const f32x4*)(tp + 4) + p1; }
                        else { p0 = p0 + *(const f32x4*)tp; p1 = p1 + *(const f32x4*)(tp + 4);
                            u32x4 w; w.x = pk2(p0[0], p0[1]); w.y = pk2(p0[2], p0[3]); w.z = pk2(p1[0], p1[1]); w.w = pk2(p1[2], p1[3]);
                            *(u32x4*)(out + (size_t)row * ldo + col) = w; }
                    } else {
#pragma unroll
                        for (int e = 0; e < 4; ++e) { const float a = fmaxf(v0[e], 0.f), b = fmaxf(v1[e], 0.f); v0[e] = a * a; v1[e] = b * b; }
                        u32x4 w; w.x = pk2(v0[0], v0[1]); w.y = pk2(v0[2], v0[3]); w.z = pk2(v1[0], v1[1]); w.w = pk2(v1[2], v1[3]);
                        *(u32x4*)(out + (size_t)row * ldo + col) = w;
                    }
                }
            }
    }
};
struct EpiB {
    static constexpr bool PERM = false, AFTER_DRAIN = false;
    const float* resid; float* out; bf16_t* xb; float* rs;
    __device__ __forceinline__ void operator()(const f32x4 (&acc)[2][2][4][2], const Unit& u, int wr, int wc, int fr, int fq) const {
        const int row0 = u.pm * BM + wr * 64 + fr, colb = u.pn * BM + wc * 32 + 4 * fq;
#pragma unroll
        for (int ai = 0; ai < 2; ++ai)
#pragma unroll
            for (int m = 0; m < 4; ++m) {
                const int row = row0 + ai * HALF + m * 16; float ss = 0.f;
#pragma unroll
                for (int bj = 0; bj < 2; ++bj)
#pragma unroll
                    for (int n = 0; n < 2; ++n) {
                        const size_t off = (size_t)row * 1024 + colb + bj * HALF + n * 16;
                        const f32x4 x = *(const f32x4*)(resid + off) + acc[ai][bj][m][n];
                        *(f32x4*)(out + off) = x;
                        u32x2 w; w.x = pk2(x[0], x[1]); w.y = pk2(x[2], x[3]); *(u32x2*)(xb + off) = w;
                        ss += (x[0] * x[0] + x[1] * x[1]) + (x[2] * x[2] + x[3] * x[3]);
                    }
                ss += __shfl_xor(ss, 16); ss += __shfl_xor(ss, 32);
                if (fq == 0) rs[(size_t)row * 16 + u.pn * 4 + wc] = ss;
            }
    }
};

struct EpiM {
    static constexpr bool PERM = true, AFTER_DRAIN = false;
    int nM; bf16_t* out; const bf16_t* gate; int ldg; float* tmp;
    __device__ __forceinline__ void operator()(const f32x4 (&acc)[2][2][4][2], const Unit& u, int wr, int wc, int fr, int fq) const {
        const int sub = u.pn >> 2, pm = u.pm - sub * nM, pn = u.pn & 3;
        const int row0 = pm * BM + wr * 64 + fr, colb = pn * BM + wc * 32 + 8 * fq;
        const bf16_t* gb = gate + sub * 1024;
#pragma unroll
        for (int ai = 0; ai < 2; ++ai)
#pragma unroll
            for (int m = 0; m < 4; ++m) {
                const int row = row0 + ai * HALF + m * 16;
#pragma unroll
                for (int bj = 0; bj < 2; ++bj) {
                    const int col = colb + bj * HALF;
                    const f32x4 v0 = acc[ai][bj][m][0], v1 = acc[ai][bj][m][1];
                    const u32x4 g = *(const u32x4*)(gb + (size_t)row * ldg + col);
                    f32x4 p0 = {v0[0] * bflo(g.x), v0[1] * bfhi(g.x), v0[2] * bflo(g.y), v0[3] * bfhi(g.y)};
                    f32x4 p1 = {v1[0] * bflo(g.z), v1[1] * bfhi(g.z), v1[2] * bflo(g.w), v1[3] * bfhi(g.w)};
                    float* tp = tmp + (size_t)row * 1024 + col;
                    if (sub == 0) { *(f32x4*)tp = p0; *(f32x4*)(tp + 4) = p1; }
                    else if (sub == 1) { *(f32x4*)tp = *(const f32x4*)tp + p0; *(f32x4*)(tp + 4) = *(const f32x4*)(tp + 4) + p1; }
                    else { p0 = p0 + *(const f32x4*)tp; p1 = p1 + *(const f32x4*)(tp + 4);
                        u32x4 w; w.x = pk2(p0[0], p0[1]); w.y = pk2(p0[2], p0[3]); w.z = pk2(p1[0], p1[1]); w.w = pk2(p1[2], p1[3]);
                        *(u32x4*)(out + (size_t)row * 1024 + col) = w; }
                }
            }
    }
};
struct DiagOrder {
    StaticOrder S; int nM;
    __host__ __device__ void init(int M, int N, int G_, int c_) { S.init(M, N, G_, c_); nM = M / BM; }
    __host__ __device__ bool next(int i, Unit& u) const { Unit v; if (!S.next(i / 3, v)) return false; const int b = i % 3; u.pm = b * nM + v.pm; u.pn = b * 4 + v.pn; return true; }
    __device__ __forceinline__ void a_ready(const Unit&) const {}
    __device__ __forceinline__ void done(const Unit&) const {}
};

template <class Epi, class Sched, bool ALIGN_EPI = false, bool SP2 = false>
__device__ __forceinline__ void gemm_phase(PG8_LAS unsigned char* lds, const Gemm g, const Sched& S, const Epi& E) {
    int tid_ = threadIdx.x; asm volatile("" : "+v"(tid_));
    const int tid = tid_, wid = __builtin_amdgcn_readfirstlane(tid >> 6), lane = tid & 63, wr = wid >> 2, wc = wid & 3, fr = lane & 15, fq = lane >> 4;
    const int K = g.K, nt = K / BK;
    unsigned voffA[2], voffB[2];
#pragma unroll
    for (int i = 0; i < 2; ++i) { int R, C; stage_rc(tid * 16 + i * 8192, R, C); const int Rb = Epi::PERM ? ((R & ~31) + perm32(R & 31)) : R;
        voffA[i] = (unsigned)(R * K + C) * 2u; voffB[i] = (unsigned)(Rb * K + C) * 2u; }
    const size_t kstep = (size_t)(BK * 2);
    const size_t hstep = (size_t)HALF * K * 2;
    const size_t tstep = 2 * hstep;
    const unsigned ldsw = (unsigned)wid * 1024u;
    const int aoff = lds_byte(wr * 64 + fr, fq * 8), boff = lds_byte(wc * 32 + fr, fq * 8);
#define PG8_SA(b, h) (((b) * 2 + (h)) * HTB)
#define PG8_SB(b, h) ((4 + (b) * 2 + (h)) * HTB)
#define PG8_STAGE(bufoff, gbase, voff) do { _Pragma("unroll") for (int _i = 0; _i < 2; ++_i) \
        __builtin_amdgcn_global_load_lds((const unsigned*)((const char*)(gbase) + (voff)[_i]), (PG8_LAS unsigned*)(lds + (bufoff) + ldsw + _i * 8192), 16, 0, 0); } while (0)
#define PG8_LDA(dst, b, h) do { _Pragma("unroll") for (int m = 0; m < 4; ++m) _Pragma("unroll") for (int k = 0; k < 2; ++k) dst[m][k] = *(const PG8_LAS bf16x8*)(lds + PG8_SA(b, h) + aoff + m * 2048 + k * 1024); } while (0)
#define PG8_LDB(dst, b, h) do { _Pragma("unroll") for (int n = 0; n < 2; ++n) _Pragma("unroll") for (int k = 0; k < 2; ++k) dst[n][k] = *(const PG8_LAS bf16x8*)(lds + PG8_SB(b, h) + boff + n * 2048 + k * 1024); } while (0)
#define PG8_MMA(ai, bj, At, Bt) do { __builtin_amdgcn_s_setprio(1); _Pragma("unroll") for (int m = 0; m < 4; ++m) _Pragma("unroll") for (int n = 0; n < 2; ++n) _Pragma("unroll") for (int k = 0; k < 2; ++k) \
        acc[ai][bj][m][n] = __builtin_amdgcn_mfma_f32_16x16x32_bf16(Bt[n][k], At[m][k], acc[ai][bj][m][n], 0, 0, 0); __builtin_amdgcn_s_setprio(0); } while (0)
#define PG8_WAIT_V(n) asm volatile("s_waitcnt vmcnt(" #n ")" ::: "memory")
#define PG8_WAIT_L(n) asm volatile("s_waitcnt lgkmcnt(" #n ")" ::: "memory")
#define PG8_BAR __builtin_amdgcn_s_barrier()
#define PG8_SCHED __builtin_amdgcn_sched_barrier(0)
    Unit cur, nxt; int ui = 0;
    if (!S.next(0, cur)) return;
    f32x4 acc[2][2][4][2];
#pragma unroll
    for (int a = 0; a < 2; ++a)
#pragma unroll
        for (int b = 0; b < 2; ++b)
#pragma unroll
            for (int m = 0; m < 4; ++m)
#pragma unroll
                for (int n = 0; n < 2; ++n) acc[a][b][m][n] = (f32x4){0.f, 0.f, 0.f, 0.f};
    bf16x8 At[4][2], B0[2][2], B1[2][2];
    const char* cA = (const char*)g.A + (size_t)cur.pm * tstep; const char* cB = (const char*)g.Bt + (size_t)cur.pn * tstep;
    S.a_ready(cur);
    if constexpr (SP2) {
        PG8_STAGE(PG8_SB(0, 0), cB, voffB); PG8_STAGE(PG8_SB(0, 1), cB + hstep, voffB); PG8_STAGE(PG8_SA(0, 0), cA, voffA); PG8_STAGE(PG8_SA(0, 1), cA + hstep, voffA);
        if (wr == 1) PG8_BAR;
        PG8_WAIT_V(2); PG8_BAR;
        PG8_STAGE(PG8_SB(1, 0), cB + kstep, voffB); PG8_STAGE(PG8_SA(1, 0), cA + kstep, voffA); PG8_STAGE(PG8_SB(1, 1), cB + hstep + kstep, voffB);
        PG8_WAIT_V(6); PG8_BAR;
    } else {
        PG8_STAGE(PG8_SB(0, 0), cB, voffB); PG8_STAGE(PG8_SA(0, 0), cA, voffA); PG8_STAGE(PG8_SB(0, 1), cB + hstep, voffB); PG8_STAGE(PG8_SA(0, 1), cA + hstep, voffA);
        if (wr == 1) PG8_BAR;
        PG8_WAIT_V(4); PG8_BAR;
        PG8_STAGE(PG8_SB(1, 0), cB + kstep, voffB); PG8_STAGE(PG8_SA(1, 0), cA + kstep, voffA); PG8_STAGE(PG8_SB(1, 1), cB + hstep + kstep, voffB);
        PG8_WAIT_V(6); PG8_BAR;
    }
    for (;;) {
        const bool has_next = S.next(ui + 1, nxt);
        const char* nA = has_next ? (const char*)g.A + (size_t)nxt.pm * tstep : cA; const char* nB = has_next ? (const char*)g.Bt + (size_t)nxt.pn * tstep : cB;
        for (int t = 0; t < nt; t += 2) {
            const bool last = (t == nt - 2);
            const char* a1 = cA + (size_t)(t + 1) * kstep;
            const char* a2 = last ? nA : cA + (size_t)(t + 2) * kstep; const char* b2 = last ? nB : cB + (size_t)(t + 2) * kstep;
            const char* a3 = a2 + kstep; const char* b3 = b2 + kstep;
            if (last && has_next) S.a_ready(nxt);
            if constexpr (SP2) {
            PG8_LDB(B0, 0, 0); PG8_LDB(B1, 0, 1); PG8_SCHED; PG8_LDA(At, 0, 0); PG8_STAGE(PG8_SA(1, 1), a1 + hstep, voffA);
            PG8_WAIT_V(8); PG8_WAIT_L(0); PG8_BAR; PG8_MMA(0, 0, At, B0); PG8_MMA(0, 1, At, B1); PG8_BAR; PG8_SCHED;
            PG8_LDA(At, 0, 1); PG8_STAGE(PG8_SB(0, 0), b2, voffB); PG8_STAGE(PG8_SB(0, 1), b2 + hstep, voffB); PG8_STAGE(PG8_SA(0, 0), a2, voffA);
            PG8_WAIT_V(8); PG8_WAIT_L(0); PG8_BAR; PG8_MMA(1, 0, At, B0); PG8_MMA(1, 1, At, B1); PG8_BAR; PG8_SCHED;
            PG8_LDB(B0, 1, 0); PG8_LDB(B1, 1, 1); PG8_SCHED; PG8_LDA(At, 1, 0); PG8_STAGE(PG8_SA(0, 1), a2 + hstep, voffA);
            PG8_WAIT_V(8); PG8_WAIT_L(0); PG8_BAR; PG8_MMA(0, 0, At, B0); PG8_MMA(0, 1, At, B1); PG8_BAR; PG8_SCHED;
            PG8_LDA(At, 1, 1); PG8_STAGE(PG8_SB(1, 0), b3, voffB); PG8_STAGE(PG8_SB(1, 1), b3 + hstep, voffB); PG8_STAGE(PG8_SA(1, 0), a3, voffA);
            PG8_WAIT_V(8); PG8_WAIT_L(0); PG8_BAR; PG8_MMA(1, 0, At, B0); PG8_MMA(1, 1, At, B1); PG8_BAR; PG8_SCHED;
            } else {
            PG8_LDB(B0, 0, 0); PG8_SCHED; PG8_LDA(At, 0, 0); PG8_STAGE(PG8_SA(1, 1), a1 + hstep, voffA);
            PG8_WAIT_L(8); PG8_BAR; PG8_WAIT_L(0); PG8_MMA(0, 0, At, B0); PG8_BAR; PG8_SCHED;
            PG8_LDB(B1, 0, 1); PG8_STAGE(PG8_SB(0, 0), b2, voffB);
            PG8_BAR; PG8_WAIT_L(0); PG8_MMA(0, 1, At, B1); PG8_BAR;
            PG8_LDA(At, 0, 1); PG8_STAGE(PG8_SA(0, 0), a2, voffA);
            PG8_BAR; PG8_WAIT_L(0); PG8_MMA(1, 0, At, B0); PG8_BAR; PG8_SCHED;
            PG8_STAGE(PG8_SB(0, 1), b2 + hstep, voffB);
            PG8_WAIT_V(6); PG8_BAR; PG8_MMA(1, 1, At, B1); PG8_BAR;
            PG8_LDB(B0, 1, 0); PG8_SCHED; PG8_LDA(At, 1, 0); PG8_STAGE(PG8_SA(0, 1), a2 + hstep, voffA);
            PG8_WAIT_L(8); PG8_BAR; PG8_WAIT_L(0); PG8_MMA(0, 0, At, B0); PG8_BAR; PG8_SCHED;
            PG8_LDB(B1, 1, 1); PG8_STAGE(PG8_SB(1, 0), b3, voffB);
            PG8_BAR; PG8_WAIT_L(0); PG8_MMA(0, 1, At, B1); PG8_BAR;
            PG8_LDA(At, 1, 1); PG8_STAGE(PG8_SA(1, 0), a3, voffA);
            PG8_BAR; PG8_WAIT_L(0); PG8_MMA(1, 0, At, B0); PG8_BAR; PG8_SCHED;
            PG8_STAGE(PG8_SB(1, 1), b3 + hstep, voffB);
            PG8_WAIT_V(6); PG8_BAR; PG8_MMA(1, 1, At, B1); PG8_BAR;
            }
        }
        if constexpr (ALIGN_EPI) { if (wr == 0) PG8_BAR; }
        if constexpr (!Epi::AFTER_DRAIN) { E(acc, cur, wr, wc, fr, fq); S.done(cur); }
        if (!has_next) break;
#pragma unroll
        for (int a = 0; a < 2; ++a)
#pragma unroll
            for (int b = 0; b < 2; ++b)
#pragma unroll
                for (int m = 0; m < 4; ++m)
#pragma unroll
                    for (int n = 0; n < 2; ++n) acc[a][b][m][n] = (f32x4){0.f, 0.f, 0.f, 0.f};
        cur = nxt; cA = nA; cB = nB; ++ui;
        if constexpr (ALIGN_EPI) { if (wr == 1) PG8_BAR; }
    }
    PG8_WAIT_V(0);
    if constexpr (!ALIGN_EPI) { if (wr == 0) PG8_BAR; }
    PG8_BAR;
    if constexpr (Epi::AFTER_DRAIN) { E.fused(acc, cur, wr, wc, fr, fq, lds, wid, lane); S.done(cur); }
#undef PG8_SA
#undef PG8_SB
#undef PG8_STAGE
#undef PG8_LDA
#undef PG8_LDB
#undef PG8_MMA
#undef PG8_WAIT_V
#undef PG8_WAIT_L
#undef PG8_BAR
#undef PG8_SCHED
}
}

#define LAS __attribute__((address_space(3)))
typedef unsigned short bf16_t;
typedef short bf16x8 __attribute__((ext_vector_type(8)));
typedef float f32x4 __attribute__((ext_vector_type(4)));
typedef float f32x2 __attribute__((ext_vector_type(2)));
typedef float f32x16 __attribute__((ext_vector_type(16)));
typedef unsigned u32x4 __attribute__((ext_vector_type(4)));
typedef unsigned u32x2 __attribute__((ext_vector_type(2)));
using pg8::pk2; using pg8::bflo; using pg8::bfhi; using pg8::sigm;

constexpr int NB = 32, SEQ = 2048, DM = 1024, DEPTH = 2, INW = 7440, NINP = 7680, LDU = 7424, FF = 4096;
constexpr int NG = 2, BG = NB / NG, MG = BG * SEQ;
constexpr float LOG2E = 1.4426950408889634f, EPS = 1e-6f;
constexpr int NWAVES = 8, NTHR = 512;
constexpr int LDS_BYTES = 131072 + 1024;

constexpr int UC_FQ = 0, UC_FK = 512, UC_FV = 1024, UC_SQ = 1536, UC_SK = 2048, UC_SV = 2176, UC_MQ = 2304, UC_MK = 2816, UC_MV = 3328, UC_MO = 3840, UC_G = 4352;

constexpr size_t al(size_t x) { return (x + 255) & ~(size_t)255; }
constexpr size_t O_WIN = 0;
constexpr size_t O_WB = O_WIN + al((size_t)DEPTH * NINP * DM * 2);
constexpr size_t O_WOUT = O_WB + al((size_t)DEPTH * 3 * DM * 512 * 2);
constexpr size_t O_WUP = O_WOUT + al((size_t)DEPTH * DM * DM * 2);
constexpr size_t O_WDN = O_WUP + al((size_t)DEPTH * FF * DM * 2);
constexpr size_t O_ROPE = O_WDN + al((size_t)DEPTH * DM * FF * 2);
constexpr size_t O_PAR = O_ROPE + al((size_t)SEQ * 32 * 2 * 4);
constexpr int PAR_FFB = 0, PAR_FQN = 16, PAR_FKN = 144, PAR_SQN = 272, PAR_SKN = 400, PAR_SINK = 528, PAR_CW = 544, PAR_CB = 8736, PAR_IB = 10784, PAR_FB = 10792, PAR_ON = 10800, PAR_N = 11824;
constexpr size_t O_XB = O_PAR + al((size_t)PAR_N * 4);
constexpr size_t O_RS = O_XB + al((size_t)MG * DM * 2);
constexpr size_t O_U = O_RS + al((size_t)MG * 16 * 4);
constexpr size_t O_SG = O_U + al((size_t)MG * LDU * 2);
constexpr size_t O_FC = O_SG + al((size_t)MG * 16 * 4);
constexpr size_t O_MP = O_FC + al((size_t)BG * 8 * SEQ * 4);
constexpr size_t O_ME = O_MP + al((size_t)BG * 4 * SEQ * 4);
constexpr size_t O_MBT = O_ME + al((size_t)BG * 4 * SEQ * 4);
constexpr size_t O_MCH = O_MBT + al((size_t)BG * 4 * SEQ * 4);
constexpr size_t O_FQN = O_MCH + al((size_t)BG * 4 * 16 * 4 * 4);
constexpr size_t O_FKN = O_FQN + (size_t)MG * 512 * 2;
constexpr size_t O_FVT = O_FKN + (size_t)MG * 512 * 2;
constexpr size_t O_SQR = O_FVT + (size_t)MG * 512 * 2;
constexpr size_t O_TMP = O_FQN;
constexpr size_t O_SKR = O_SQR + (size_t)MG * 512 * 2;
constexpr size_t O_SVT = O_SKR + (size_t)MG * 128 * 2;
constexpr size_t O_MQC = O_SVT + (size_t)MG * 128 * 2;
constexpr size_t O_MKC = O_MQC + (size_t)MG * 512 * 2;
constexpr size_t O_MRG = O_MQC;
constexpr size_t O_KT = O_MKC + (size_t)MG * 512 * 2;
constexpr size_t O_MVT = O_KT + (size_t)MG * 512 * 2;
constexpr size_t O_DN = O_MVT + (size_t)MG * 512 * 2;
constexpr size_t O_CT = O_KT;
constexpr size_t O_NN = O_DN + al((size_t)BG * 4 * 16 * 128 * 4);
constexpr size_t O_Y = O_NN + al((size_t)BG * 4 * 16 * 128 * 4);
constexpr size_t O_DCT = O_Y + (size_t)2 * MG * 512 * 2;
constexpr size_t O_BAR = O_Y + (size_t)3 * MG * 512 * 2;
constexpr size_t WS_NEED = O_BAR + 16384;
static_assert((size_t)BG * 4 * 16 * 16384 * 2 == (size_t)MG * 512 * 2, "DCT overlays Y2; CT overlays KT");
static_assert((size_t)MG * FF * 2 <= (size_t)MG * LDU * 2, "ACT overlays U");

struct KP { const float* in[19]; float* out; unsigned char* ws; int ph_lo, ph_hi; };

__device__ __forceinline__ float wave_sum(float v) {
#pragma unroll
    for (int o = 1; o < 64; o <<= 1) v += __shfl_xor(v, o);
    return v;
}
__device__ __forceinline__ float logsig(float x) { return fminf(x, 0.f) - log1pf(__expf(-fabsf(x))); }
#define LDSW() asm volatile("s_waitcnt lgkmcnt(0)" ::: "memory")

__device__ __forceinline__ int win_srccol(int n) {
    if (n < 1536) return n; if (n < 3840) return n + 8; if (n < 7424) return n + 16; if (n < 7432) return n - 7424 + 1536; if (n < 7440) return n - 7432 + 3848; return -1;
}
template <bool REMAP>
__device__ __forceinline__ void tr_item(const float* W, int K, int N, const float* kscale, bf16_t* WT, int item, int nblk, LAS float* scr, int lane) {
    const int kb = item / nblk, nb = item % nblk, k0 = 64 * kb, n0 = 32 * nb;
    const int nd = n0 + (lane & 31); const int ns = REMAP ? win_srccol(nd) : nd;
#pragma unroll 8
    for (int i = 0; i < 32; ++i) { const int kk = 2 * i + (lane >> 5); float v = 0.f; if (ns >= 0) v = W[(size_t)(k0 + kk) * N + ns]; if (kscale) v *= kscale[k0 + kk]; scr[kk * 33 + (lane & 31)] = v; }
    LDSW();
    const int c = lane & 7;
#pragma unroll
    for (int j = 0; j < 4; ++j) { const int n = (lane >> 3) + 8 * j; const LAS float* s = scr + (8 * c) * 33 + n;
        u32x4 o; o.x = pk2(s[0 * 33], s[1 * 33]); o.y = pk2(s[2 * 33], s[3 * 33]); o.z = pk2(s[4 * 33], s[5 * 33]); o.w = pk2(s[6 * 33], s[7 * 33]);
        *(u32x4*)(WT + (size_t)(n0 + n) * K + k0 + 8 * c) = o; }
    LDSW();
}
__device__ __forceinline__ void phase_p0(const KP& p, unsigned char* ws, LAS unsigned char* lds, int gw, int NWV, int wave, int lane) {
    LAS float* scr = (LAS float*)(lds + wave * 16384);
    const float *norm_mix = p.in[1], *w_in = p.in[2], *w_branch = p.in[14], *w_out = p.in[15], *norm_mlp = p.in[16], *w_up = p.in[17], *w_down = p.in[18];
    constexpr int PER = 3840 + 768 + 512 + 2048 + 2048;
    for (int it = gw; it < DEPTH * PER; it += NWV) {
        const int l = it / PER; int r = it % PER;
        if (r < 3840) { tr_item<true>(w_in + (size_t)l * DM * INW, DM, INW, norm_mix + l * DM, (bf16_t*)(ws + O_WIN) + (size_t)l * NINP * DM, r, 240, scr, lane); continue; } r -= 3840;
        if (r < 768) { const int b = r / 256; tr_item<false>(w_branch + (size_t)(l * 3 + b) * 512 * DM, 512, DM, nullptr, (bf16_t*)(ws + O_WB) + (size_t)(l * 3 + b) * DM * 512, r % 256, 32, scr, lane); continue; } r -= 768;
        if (r < 512) { tr_item<false>(w_out + (size_t)l * DM * DM, DM, DM, nullptr, (bf16_t*)(ws + O_WOUT) + (size_t)l * DM * DM, r, 32, scr, lane); continue; } r -= 512;
        if (r < 2048) { tr_item<false>(w_up + (size_t)l * DM * FF, DM, FF, norm_mlp + l * DM, (bf16_t*)(ws + O_WUP) + (size_t)l * FF * DM, r, 128, scr, lane); continue; } r -= 2048;
        tr_item<false>(w_down + (size_t)l * FF * DM, FF, DM, nullptr, (bf16_t*)(ws + O_WDN) + (size_t)l * DM * FF, r, 32, scr, lane);
    }
    { float* par = (float*)(ws + O_PAR); const int t0 = gw * 64 + lane, ts = NWV * 64;
      for (int e = t0; e < 16; e += ts) { par[PAR_FFB + e] = p.in[3][e]; par[PAR_SINK + e] = p.in[8][e]; }
      for (int e = t0; e < 128; e += ts) { par[PAR_FQN + e] = p.in[4][e]; par[PAR_FKN + e] = p.in[5][e]; par[PAR_SQN + e] = p.in[6][e]; par[PAR_SKN + e] = p.in[7][e]; }
      for (int e = t0; e < 8192; e += ts) par[PAR_CW + e] = p.in[9][e];
      for (int e = t0; e < 2048; e += ts) par[PAR_CB + e] = p.in[10][e];
      for (int e = t0; e < 8; e += ts) { par[PAR_IB + e] = p.in[11][e]; par[PAR_FB + e] = p.in[12][e]; }
      for (int e = t0; e < 1024; e += ts) par[PAR_ON + e] = p.in[13][e]; }
    float* rope = (float*)(ws + O_ROPE);
    for (int e = gw * 64 + lane; e < SEQ * 32; e += NWV * 64) {
        const int pos = e >> 5, i = e & 31;
        const float inv = powf(10000.f, -(float)(2 * i) / 64.f), ang = (float)pos * inv;
        rope[2 * e] = cosf(ang); rope[2 * e + 1] = sinf(ang);
    }
}
__device__ __forceinline__ void phase_x0(const float* x, bf16_t* XB, float* RS, int gw, int NWV, int lane) {
    for (int row = gw; row < MG; row += NWV) {
        const f32x4* xr = (const f32x4*)(x + (size_t)row * DM) + lane;
        f32x4 v[4]; float s = 0.f;
#pragma unroll
        for (int j = 0; j < 4; ++j) { v[j] = xr[64 * j]; s += (v[j][0] * v[j][0] + v[j][1] * v[j][1]) + (v[j][2] * v[j][2] + v[j][3] * v[j][3]); }
        s = wave_sum(s);
        u32x2* o = (u32x2*)(XB + (size_t)row * DM) + lane;
#pragma unroll
        for (int j = 0; j < 4; ++j) { u32x2 w; w.x = pk2(v[j][0], v[j][1]); w.y = pk2(v[j][2], v[j][3]); o[64 * j] = w; }
        if (lane < 16) RS[(size_t)row * 16 + lane] = (lane == 0) ? s : 0.f;
    }
}
__device__ __forceinline__ void gate_scan_item(unsigned char* ws, int l, int it, int lane) {
    const float* par = (const float*)(ws + O_PAR); const float* SG = (const float*)(ws + O_SG);
    if (it < BG * 8) {
        const int b = it >> 3, h = it & 7; const float bias = par[PAR_FFB + l * 8 + h];
        const float* src = SG + ((size_t)b * SEQ + lane * 32) * 16 + h;
        float tot = 0.f;
#pragma unroll 4
        for (int j = 0; j < 32; ++j) tot += logsig(src[j * 16] + bias);
        float x = tot;
#pragma unroll
        for (int o = 1; o < 64; o <<= 1) { const float y = __shfl_up(x, o); if (lane >= o) x += y; }
        float run = x - tot;
        float* dst = (float*)(ws + O_FC) + (size_t)it * SEQ + lane * 32;
#pragma unroll 4
        for (int j = 0; j < 32; ++j) { run += logsig(src[j * 16] + bias); dst[j] = run * LOG2E; }
    } else {
        const int sq = it - BG * 8, b = sq >> 2, h = sq & 3;
        const float ibias = par[PAR_IB + l * 4 + h], fbias = par[PAR_FB + l * 4 + h];
        float* MP = (float*)(ws + O_MP) + (size_t)sq * SEQ; float* ME = (float*)(ws + O_ME) + (size_t)sq * SEQ; float* MBT = (float*)(ws + O_MBT) + (size_t)sq * SEQ;
        float* MCH = (float*)(ws + O_MCH) + (size_t)sq * 64;
        float mc = 0.f;
#pragma unroll 1
        for (int c = 0; c < 16; ++c) {
            const float* s0 = SG + ((size_t)b * SEQ + c * 128 + 2 * lane) * 16;
            const float f0 = logsig(s0[12 + h] + fbias), f1 = logsig(s0[16 + 12 + h] + fbias);
            const float i0 = s0[8 + h] + ibias, i1 = s0[16 + 8 + h] + ibias;
            float x = f0 + f1;
#pragma unroll
            for (int o = 1; o < 64; o <<= 1) { const float y = __shfl_up(x, o); if (lane >= o) x += y; }
            const float b1 = x, b0 = x - f1;
            const float p0 = i0 - b0, p1 = i1 - b1;
            float mxs = fmaxf(p0, p1);
#pragma unroll
            for (int o = 1; o < 64; o <<= 1) { const float y = __shfl_up(mxs, o); if (lane >= o) mxs = fmaxf(mxs, y); }
            float prev = __shfl_up(mxs, 1); if (lane == 0) prev = -INFINITY;
            const float u0 = fmaxf(prev, p0), u1 = mxs;
            const float e0 = fmaxf(mc, u0), e1 = fmaxf(mc, u1);
            const int t = c * 128 + 2 * lane;
            *(f32x2*)(MP + t) = (f32x2){p0, p1}; *(f32x2*)(ME + t) = (f32x2){e0, e1}; *(f32x2*)(MBT + t) = (f32x2){b0, b1};
            const float ulast = __shfl(mxs, 63), bL = __shfl(x, 63);
            const float mx = fmaxf(mc, ulast), dec = __expf(mc - mx);
            if (lane == 0) *(f32x4*)(MCH + c * 4) = (f32x4){mc, mx, dec, bL};
            mc = bL + mx;
        }
    }
}
__device__ __forceinline__ void headnorm_item(unsigned char* ws, int l, int kind, int item, int lane) {
    const float* par = (const float*)(ws + O_PAR);
    const int c = lane & 7;
    int srccol, dpitch, tstep, tok0, tsub; bf16_t* dbase; const float* w; float scale;
    if (kind == 0) { srccol = UC_FQ + lane * 8; dbase = (bf16_t*)(ws + O_FQN) + lane * 8; dpitch = 512; w = par + PAR_FQN + l * 64; scale = 0.125f * LOG2E; tstep = 1; tok0 = item * 8; tsub = 0; }
    else if (kind == 1) { srccol = UC_FK + lane * 8; dbase = (bf16_t*)(ws + O_FKN) + lane * 8; dpitch = 512; w = par + PAR_FKN + l * 64; scale = 1.f; tstep = 1; tok0 = item * 8; tsub = 0; }
    else if (kind == 2) { srccol = UC_SQ + lane * 8; dbase = (bf16_t*)(ws + O_SQR) + lane * 8; dpitch = 512; w = par + PAR_SQN + l * 64; scale = 0.125f * LOG2E; tstep = 1; tok0 = item * 8; tsub = 0; }
    else { srccol = UC_SK + (lane & 15) * 8; dbase = (bf16_t*)(ws + O_SKR) + (lane & 15) * 8; dpitch = 128; w = par + PAR_SKN + l * 64; scale = 1.f; tstep = 4; tok0 = item * 32; tsub = lane >> 4; }
    const bool rp = kind >= 2;
    const f32x4 w0 = *(const f32x4*)(w + 8 * c), w1 = *(const f32x4*)(w + 8 * c + 4);
    const bf16_t* src = (const bf16_t*)(ws + O_U) + (size_t)(tok0 + tsub) * LDU + srccol;
    u32x4 xv[8];
#pragma unroll
    for (int i = 0; i < 8; ++i) xv[i] = *(const u32x4*)(src + (size_t)(i * tstep) * LDU);
#pragma unroll
    for (int i = 0; i < 8; ++i) {
        const int tok = tok0 + tsub + i * tstep;
        float x[8] = {bflo(xv[i].x), bfhi(xv[i].x), bflo(xv[i].y), bfhi(xv[i].y), bflo(xv[i].z), bfhi(xv[i].z), bflo(xv[i].w), bfhi(xv[i].w)};
        float ss = ((x[0] * x[0] + x[1] * x[1]) + (x[2] * x[2] + x[3] * x[3])) + ((x[4] * x[4] + x[5] * x[5]) + (x[6] * x[6] + x[7] * x[7]));
        ss += __shfl_xor(ss, 1); ss += __shfl_xor(ss, 2); ss += __shfl_xor(ss, 4);
        const float rn = rsqrtf(ss * (1.f / 64.f) + EPS);
        x[0] *= rn * w0[0]; x[1] *= rn * w0[1]; x[2] *= rn * w0[2]; x[3] *= rn * w0[3]; x[4] *= rn * w1[0]; x[5] *= rn * w1[1]; x[6] *= rn * w1[2]; x[7] *= rn * w1[3];
        if (rp) {
            const float* rt = (const float*)(ws + O_ROPE) + ((size_t)(tok % SEQ) * 32 + 8 * (c & 3)) * 2;
            const bool second = (c & 4) != 0;
#pragma unroll
            for (int e = 0; e < 8; e += 2) { const f32x4 cs = *(const f32x4*)(rt + 2 * e);
                const float o0 = __shfl_xor(x[e], 4), o1 = __shfl_xor(x[e + 1], 4);
                x[e] = second ? (o0 * cs[1] + x[e] * cs[0]) : (x[e] * cs[0] - o0 * cs[1]);
                x[e + 1] = second ? (o1 * cs[3] + x[e + 1] * cs[2]) : (x[e + 1] * cs[2] - o1 * cs[3]); }
        }
        u32x4 o; o.x = pk2(x[0] * scale, x[1] * scale); o.y = pk2(x[2] * scale, x[3] * scale); o.z = pk2(x[4] * scale, x[5] * scale); o.w = pk2(x[6] * scale, x[7] * scale);
        *(u32x4*)(dbase + (size_t)tok * dpitch) = o;
    }
}
__device__ __forceinline__ void stream_item(unsigned char* ws, int l, int item, int lane) {
    const int cb = item % 34, tb = item / 34, tok0 = tb * 64, b = tok0 / SEQ, s0 = tok0 % SEQ;
    const int tg = lane >> 3, co = lane & 7;
    const bf16_t* U = (const bf16_t*)(ws + O_U);
    int srccol, chan; bf16_t* dT = nullptr; bf16_t* dN = nullptr; int convch = -1; float oscale = 1.f;
    if (cb < 8) { chan = cb * 64 + co * 8; srccol = UC_FV + chan; dT = (bf16_t*)(ws + O_FVT) + ((size_t)b * 512 + chan) * SEQ; }
    else if (cb < 10) { chan = (cb - 8) * 64 + co * 8; srccol = UC_SV + chan; dT = (bf16_t*)(ws + O_SVT) + ((size_t)b * 128 + chan) * SEQ; }
    else if (cb < 18) { chan = (cb - 10) * 64 + co * 8; srccol = UC_MV + chan; dT = (bf16_t*)(ws + O_MVT) + ((size_t)b * 512 + chan) * SEQ; }
    else if (cb < 26) { chan = (cb - 18) * 64 + co * 8; srccol = UC_MQ + chan; dN = (bf16_t*)(ws + O_MQC) + chan; convch = chan; }
    else { chan = (cb - 26) * 64 + co * 8; srccol = UC_MK + chan; dN = (bf16_t*)(ws + O_MKC) + chan; dT = (bf16_t*)(ws + O_KT) + ((size_t)b * 512 + chan) * SEQ; convch = 512 + chan; oscale = 0.08838834764831845f; }
    const bf16_t* src = U + (size_t)(tok0 + tg * 8) * LDU + srccol;
    u32x4 R[8];
#pragma unroll
    for (int i = 0; i < 8; ++i) R[i] = *(const u32x4*)(src + (size_t)i * LDU);
    if (cb >= 18) {
        u32x4 H[3];
        const bool has_prev = (s0 + tg * 8) > 0;
#pragma unroll
        for (int i = 0; i < 3; ++i) { H[i] = (u32x4){0u, 0u, 0u, 0u}; if (has_prev) H[i] = *(const u32x4*)(src - (size_t)(3 - i) * LDU); }
        const float* cw = (const float*)(ws + O_PAR) + PAR_CW + l * 4 * 1024 + convch; const float* cbias = (const float*)(ws + O_PAR) + PAR_CB + l * 1024 + convch;
        float wt[4][8], bb[8];
#pragma unroll
        for (int j = 0; j < 4; ++j) { const f32x4 a = *(const f32x4*)(cw + j * 1024), c2 = *(const f32x4*)(cw + j * 1024 + 4);
            wt[j][0] = a[0]; wt[j][1] = a[1]; wt[j][2] = a[2]; wt[j][3] = a[3]; wt[j][4] = c2[0]; wt[j][5] = c2[1]; wt[j][6] = c2[2]; wt[j][7] = c2[3]; }
        { const f32x4 a = *(const f32x4*)cbias, c2 = *(const f32x4*)(cbias + 4); bb[0] = a[0]; bb[1] = a[1]; bb[2] = a[2]; bb[3] = a[3]; bb[4] = c2[0]; bb[5] = c2[1]; bb[6] = c2[2]; bb[7] = c2[3]; }
        float xm3[8], xm2[8], xm1[8];
#define UNPK(dst, v) do { dst[0] = bflo(v.x); dst[1] = bfhi(v.x); dst[2] = bflo(v.y); dst[3] = bfhi(v.y); dst[4] = bflo(v.z); dst[5] = bfhi(v.z); dst[6] = bflo(v.w); dst[7] = bfhi(v.w); } while (0)
        UNPK(xm3, H[0]); UNPK(xm2, H[1]); UNPK(xm1, H[2]);
#pragma unroll
        for (int i = 0; i < 8; ++i) {
            float xc[8], y[8]; UNPK(xc, R[i]);
#pragma unroll
            for (int e = 0; e < 8; ++e) { const float v = bb[e] + wt[0][e] * xm3[e] + wt[1][e] * xm2[e] + wt[2][e] * xm1[e] + wt[3][e] * xc[e]; y[e] = v * sigm(v) * oscale; xm3[e] = xm2[e]; xm2[e] = xm1[e]; xm1[e] = xc[e]; }
            u32x4 o; o.x = pk2(y[0], y[1]); o.y = pk2(y[2], y[3]); o.z = pk2(y[4], y[5]); o.w = pk2(y[6], y[7]);
            R[i] = o;
            *(u32x4*)(dN + (size_t)(tok0 + tg * 8 + i) * 512) = o;
        }
#undef UNPK
    }
    if (dT) {
        bf16_t* dst = dT + s0 + tg * 8;
#pragma unroll
        for (int k = 0; k < 4; ++k) {
            u32x4 lo, hi;
            lo.x = (R[0][k] & 0xffffu) | (R[1][k] << 16); lo.y = (R[2][k] & 0xffffu) | (R[3][k] << 16); lo.z = (R[4][k] & 0xffffu) | (R[5][k] << 16); lo.w = (R[6][k] & 0xffffu) | (R[7][k] << 16);
            hi.x = (R[0][k] >> 16) | (R[1][k] & 0xffff0000u); hi.y = (R[2][k] >> 16) | (R[3][k] & 0xffff0000u); hi.z = (R[4][k] >> 16) | (R[5][k] & 0xffff0000u); hi.w = (R[6][k] >> 16) | (R[7][k] & 0xffff0000u);
            *(u32x4*)(dst + (size_t)(2 * k) * SEQ) = lo; *(u32x4*)(dst + (size_t)(2 * k + 1) * SEQ) = hi;
        }
    }
}
#define MFMA32(a, b, c) __builtin_amdgcn_mfma_f32_32x32x16_bf16((a), (b), (c), 0, 0, 0)
template <bool SWA>
__device__ __forceinline__ void attn_qtile(const bf16_t* __restrict__ Q, const bf16_t* __restrict__ K, int kpitch, const bf16_t* __restrict__ VT,
                                           const float* __restrict__ C, float sink2, bf16_t* __restrict__ Y, int qt, int lane) {
    const int r = lane & 31, hh = lane >> 5;
    const int pr = ((r >> 2) & 1) * 16 + ((r >> 4) & 1) * 8 + ((r >> 3) & 1) * 4 + (r & 3);
    const int q0 = qt * 32;
    bf16x8 qf[4];
#pragma unroll
    for (int st = 0; st < 4; ++st) qf[st] = *(const bf16x8*)(Q + (size_t)(q0 + r) * 512 + 16 * st + 8 * hh);
    float cq = 0.f; if (!SWA) cq = C[q0 + r];
    float m = -1e30f, lsum = 0.f;
    f32x16 o0, o1;
#pragma unroll
    for (int i = 0; i < 16; ++i) { o0[i] = 0.f; o1[i] = 0.f; }
    const int kt_lo = SWA ? (qt > 4 ? qt - 4 : 0) : 0;
#define ATT_LOAD(KF, VF, CK, kt_) do { const int k0_ = (kt_) * 32; \
        _Pragma("unroll") for (int st = 0; st < 4; ++st) KF[st] = *(const bf16x8*)(K + (size_t)(k0_ + pr) * kpitch + 16 * st + 8 * hh); \
        _Pragma("unroll") for (int dh = 0; dh < 2; ++dh) _Pragma("unroll") for (int s2 = 0; s2 < 2; ++s2) VF[dh][s2] = *(const bf16x8*)(VT + (size_t)(dh * 32 + r) * SEQ + k0_ + 16 * hh + 8 * s2); \
        if (!SWA) { _Pragma("unroll") for (int g = 0; g < 4; ++g) CK[g] = *(const f32x4*)(C + k0_ + 16 * hh + 4 * g); } } while (0)
    bf16x8 kfn[4], vfn[2][2]; f32x4 ckn[4];
#pragma unroll
    for (int g = 0; g < 4; ++g) ckn[g] = (f32x4){0.f, 0.f, 0.f, 0.f};
    ATT_LOAD(kfn, vfn, ckn, kt_lo);
    for (int kt = kt_lo; kt <= qt; ++kt) {
        bf16x8 kf[4], vf[2][2]; f32x4 ckc[4];
#pragma unroll
        for (int st = 0; st < 4; ++st) kf[st] = kfn[st];
#pragma unroll
        for (int dh = 0; dh < 2; ++dh) { vf[dh][0] = vfn[dh][0]; vf[dh][1] = vfn[dh][1]; }
#pragma unroll
        for (int g = 0; g < 4; ++g) ckc[g] = ckn[g];
        if (kt < qt) ATT_LOAD(kfn, vfn, ckn, kt + 1);
        f32x16 sc;
#pragma unroll
        for (int i = 0; i < 16; ++i) sc[i] = 0.f;
#pragma unroll
        for (int st = 0; st < 4; ++st) sc = MFMA32(kf[st], qf[st], sc);
        if (!SWA) {
#pragma unroll
            for (int g = 0; g < 4; ++g) { const f32x4 ck = ckc[g];
#pragma unroll
                for (int e = 0; e < 4; ++e) sc[4 * g + e] += cq - ck[e]; }
        }
        if (kt == qt) {
#pragma unroll
            for (int i = 0; i < 16; ++i) if (16 * hh + i > r) sc[i] = -INFINITY;
        }
        if (SWA && kt == qt - 4) {
#pragma unroll
            for (int i = 0; i < 16; ++i) if (16 * hh + i <= r) sc[i] = -INFINITY;
        }
        float tm = sc[0];
#pragma unroll
        for (int i = 1; i < 16; ++i) tm = fmaxf(tm, sc[i]);
        tm = fmaxf(tm, __shfl_xor(tm, 32));
        const float mn = fmaxf(m, tm), alpha = __builtin_amdgcn_exp2f(m - mn);
        m = mn;
        float ps = 0.f;
#pragma unroll
        for (int i = 0; i < 16; ++i) { sc[i] = __builtin_amdgcn_exp2f(sc[i] - mn); ps += sc[i]; }
        lsum = lsum * alpha + ps;
#pragma unroll
        for (int i = 0; i < 16; ++i) { o0[i] *= alpha; o1[i] *= alpha; }
        u32x4 pw0, pw1;
        pw0.x = pk2(sc[0], sc[1]); pw0.y = pk2(sc[2], sc[3]); pw0.z = pk2(sc[4], sc[5]); pw0.w = pk2(sc[6], sc[7]);
        pw1.x = pk2(sc[8], sc[9]); pw1.y = pk2(sc[10], sc[11]); pw1.z = pk2(sc[12], sc[13]); pw1.w = pk2(sc[14], sc[15]);
        const bf16x8 pf0 = __builtin_bit_cast(bf16x8, pw0), pf1 = __builtin_bit_cast(bf16x8, pw1);
        o0 = MFMA32(vf[0][0], pf0, o0); o0 = MFMA32(vf[0][1], pf1, o0);
        o1 = MFMA32(vf[1][0], pf0, o1); o1 = MFMA32(vf[1][1], pf1, o1);
    }
    float lt = lsum + __shfl_xor(lsum, 32);
    if (SWA) lt += __builtin_amdgcn_exp2f(sink2 - m);
    const float inv = 1.f / lt;
    bf16_t* yrow = Y + (size_t)(q0 + r) * 512 + 4 * hh;
#pragma unroll
    for (int g = 0; g < 4; ++g) {
        u32x2 a, c;
        a.x = pk2(o0[4 * g] * inv, o0[4 * g + 1] * inv); a.y = pk2(o0[4 * g + 2] * inv, o0[4 * g + 3] * inv);
        c.x = pk2(o1[4 * g] * inv, o1[4 * g + 1] * inv); c.y = pk2(o1[4 * g + 2] * inv, o1[4 * g + 3] * inv);
        *(u32x2*)(yrow + 8 * g) = a; *(u32x2*)(yrow + 32 + 8 * g) = c;
    }
}
constexpr int AT_SLOT = 10240, AT_K = 0, AT_V = 4608, AT_C = 9728;
template <bool SWA>
__device__ __forceinline__ void attn_block(LAS unsigned char* lds, const bf16_t* __restrict__ Q, const bf16_t* __restrict__ K, int kpitch, const bf16_t* __restrict__ VT,
                                           const float* __restrict__ C, float sink2, bf16_t* __restrict__ Y, int qt, int t_lo, int t_hi, int wave, int lane) {
    const int r = lane & 31, hh = lane >> 5;
    const int pr = ((r >> 2) & 1) * 16 + ((r >> 4) & 1) * 8 + ((r >> 3) & 1) * 4 + (r & 3);
    const int q0 = qt * 32;
    const bool isK = wave < 4; const int chunk = (wave & 3) * 64 + lane;
    const bf16_t* gsrc = isK ? K + (size_t)(chunk >> 3) * kpitch + (chunk & 7) * 8 : VT + (size_t)(chunk >> 2) * SEQ + (chunk & 3) * 8;
    const int gstep = isK ? 32 * kpitch : 32;
    const int ldst = isK ? AT_K + (chunk >> 3) * 144 + (chunk & 7) * 16 : AT_V + (chunk >> 2) * 80 + (chunk & 3) * 16;
    const bool doC = !SWA && wave == 0 && lane < 8;
#define AB_LD(t_) (*(const u32x4*)(gsrc + (size_t)((t_) < t_hi ? (t_) : t_hi) * gstep))
#define AB_LDC(t_) (*(const u32x4*)(C + ((t_) < t_hi ? (t_) : t_hi) * 32 + lane * 4))
#define AB_WR(t_, v_, c_) do { LAS unsigned char* sl_ = lds + ((t_) % 3) * AT_SLOT; *(LAS u32x4*)(sl_ + ldst) = (v_); if (doC) *(LAS u32x4*)(sl_ + AT_C + lane * 16) = (c_); } while (0)
    u32x4 sa = AB_LD(t_lo), s0 = AB_LD(t_lo + 1), s1 = AB_LD(t_lo + 2), s2;
    u32x4 ca = {0u, 0u, 0u, 0u}, c0 = ca, c1 = ca, c2 = ca;
    if (doC) { ca = AB_LDC(t_lo); c0 = AB_LDC(t_lo + 1); c1 = AB_LDC(t_lo + 2); }
    bf16x8 qf[4];
#pragma unroll
    for (int st = 0; st < 4; ++st) qf[st] = *(const bf16x8*)(Q + (size_t)(q0 + r) * 512 + 16 * st + 8 * hh);
    float cq = 0.f; if (!SWA) cq = C[q0 + r];
    float m = -1e30f, lsum = 0.f;
    f32x16 o0, o1;
#pragma unroll
    for (int i = 0; i < 16; ++i) { o0[i] = 0.f; o1[i] = 0.f; }
    AB_WR(t_lo, sa, ca);
    for (int t = t_lo; t <= t_hi; ++t) {
        s2 = AB_LD(t + 3); if (doC) c2 = AB_LDC(t + 3);
        if (t + 1 <= t_hi) AB_WR(t + 1, s0, c0);
        s0 = s1; s1 = s2; c0 = c1; c1 = c2;
        __syncthreads();
        const bool active = SWA ? (t <= qt && t >= qt - 4) : (t <= qt);
        if (active) {
            const LAS unsigned char* sl = lds + (t % 3) * AT_SLOT;
            bf16x8 kf[4], vf[2][2]; f32x4 ckv[4];
#pragma unroll
            for (int st = 0; st < 4; ++st) kf[st] = *(const LAS bf16x8*)(sl + AT_K + pr * 144 + 32 * st + 16 * hh);
            if (!SWA) {
#pragma unroll
                for (int g = 0; g < 4; ++g) ckv[g] = *(const LAS f32x4*)(sl + AT_C + 64 * hh + 16 * g);
            }
#pragma unroll
            for (int dh = 0; dh < 2; ++dh)
#pragma unroll
                for (int s = 0; s < 2; ++s) vf[dh][s] = *(const LAS bf16x8*)(sl + AT_V + (dh * 32 + r) * 80 + 32 * hh + 16 * s);
            __builtin_amdgcn_sched_barrier(0);
            f32x16 sc;
#pragma unroll
            for (int i = 0; i < 16; ++i) sc[i] = 0.f;
#pragma unroll
            for (int st = 0; st < 4; ++st) sc = MFMA32(kf[st], qf[st], sc);
            if (!SWA) {
#pragma unroll
                for (int g = 0; g < 4; ++g) { const f32x4 ck = ckv[g];
#pragma unroll
                    for (int e = 0; e < 4; ++e) sc[4 * g + e] += cq - ck[e]; }
            }
            if (t == qt) {
#pragma unroll
                for (int i = 0; i < 16; ++i) if (16 * hh + i > r) sc[i] = -INFINITY;
            }
            if (SWA && t == qt - 4) {
#pragma unroll
                for (int i = 0; i < 16; ++i) if (16 * hh + i <= r) sc[i] = -INFINITY;
            }
            float tm = sc[0];
#pragma unroll
            for (int i = 1; i < 16; ++i) tm = fmaxf(tm, sc[i]);
            tm = fmaxf(tm, __shfl_xor(tm, 32));
            if (__any(tm > m)) {
                const float mn = fmaxf(m, tm), alpha = __builtin_amdgcn_exp2f(m - mn);
                m = mn; lsum *= alpha;
#pragma unroll
                for (int i = 0; i < 16; ++i) { o0[i] *= alpha; o1[i] *= alpha; }
            }
            float ps = 0.f;
#pragma unroll
            for (int i = 0; i < 16; ++i) { sc[i] = __builtin_amdgcn_exp2f(sc[i] - m); ps += sc[i]; }
            lsum += ps;
            u32x4 pw0, pw1;
            pw0.x = pk2(sc[0], sc[1]); pw0.y = pk2(sc[2], sc[3]); pw0.z = pk2(sc[4], sc[5]); pw0.w = pk2(sc[6], sc[7]);
            pw1.x = pk2(sc[8], sc[9]); pw1.y = pk2(sc[10], sc[11]); pw1.z = pk2(sc[12], sc[13]); pw1.w = pk2(sc[14], sc[15]);
            const bf16x8 pf0 = __builtin_bit_cast(bf16x8, pw0), pf1 = __builtin_bit_cast(bf16x8, pw1);
            o0 = MFMA32(vf[0][0], pf0, o0); o0 = MFMA32(vf[0][1], pf1, o0);
            o1 = MFMA32(vf[1][0], pf0, o1); o1 = MFMA32(vf[1][1], pf1, o1);
        }
    }
    __syncthreads();
#undef AB_LD
#undef AB_LDC
#undef AB_WR
    float lt = lsum + __shfl_xor(lsum, 32);
    if (SWA) lt += __builtin_amdgcn_exp2f(sink2 - m);
    const float inv = 1.f / lt;
    bf16_t* yrow = Y + (size_t)(q0 + r) * 512 + 4 * hh;
#pragma unroll
    for (int g = 0; g < 4; ++g) {
        u32x2 a, c;
        a.x = pk2(o0[4 * g] * inv, o0[4 * g + 1] * inv); a.y = pk2(o0[4 * g + 2] * inv, o0[4 * g + 3] * inv);
        c.x = pk2(o1[4 * g] * inv, o1[4 * g + 1] * inv); c.y = pk2(o1[4 * g + 2] * inv, o1[4 * g + 3] * inv);
        *(u32x2*)(yrow + 8 * g) = a; *(u32x2*)(yrow + 32 + 8 * g) = c;
    }
}
__device__ __forceinline__ void m1_item(unsigned char* ws, int it, int lane) {
    const int r = lane & 31, hh = lane >> 5;
    const int dvt = it & 3, c = (it >> 2) & 15, bh = it >> 6;
    const bf16_t* VTp = (const bf16_t*)(ws + O_MVT) + ((size_t)bh * 128 + dvt * 32 + r) * SEQ + c * 128 + 8 * hh;
    const bf16_t* KTp = (const bf16_t*)(ws + O_KT) + ((size_t)bh * 128 + r) * SEQ + c * 128 + 8 * hh;
    const float* MPp = (const float*)(ws + O_MP) + (size_t)bh * SEQ + c * 128 + 8 * hh;
    const float mx = ((const float*)(ws + O_MCH))[(bh * 16 + c) * 4 + 1];
    f32x16 acc[4];
#pragma unroll
    for (int d = 0; d < 4; ++d)
#pragma unroll
        for (int i = 0; i < 16; ++i) acc[d][i] = 0.f;
    float dn[4] = {0.f, 0.f, 0.f, 0.f};
#pragma unroll 1
    for (int st = 0; st < 8; ++st) {
        const bf16x8 vf = *(const bf16x8*)(VTp + 16 * st);
        const f32x4 pa = *(const f32x4*)(MPp + 16 * st), pb = *(const f32x4*)(MPp + 16 * st + 4);
        float wk[8];
#pragma unroll
        for (int e = 0; e < 4; ++e) { wk[e] = __expf(pa[e] - mx); wk[4 + e] = __expf(pb[e] - mx); }
#pragma unroll
        for (int d = 0; d < 4; ++d) {
            const u32x4 kr = *(const u32x4*)(KTp + (size_t)d * 32 * SEQ + 16 * st);
            const float k0 = bflo(kr.x) * wk[0], k1 = bfhi(kr.x) * wk[1], k2 = bflo(kr.y) * wk[2], k3 = bfhi(kr.y) * wk[3];
            const float k4 = bflo(kr.z) * wk[4], k5 = bfhi(kr.z) * wk[5], k6 = bflo(kr.w) * wk[6], k7 = bfhi(kr.w) * wk[7];
            dn[d] += ((k0 + k1) + (k2 + k3)) + ((k4 + k5) + (k6 + k7));
            u32x4 kw; kw.x = pk2(k0, k1); kw.y = pk2(k2, k3); kw.z = pk2(k4, k5); kw.w = pk2(k6, k7);
            acc[d] = MFMA32(vf, __builtin_bit_cast(bf16x8, kw), acc[d]);
        }
    }
    bf16_t* DCT = (bf16_t*)(ws + O_DCT) + (size_t)(bh * 16 + c) * 16384;
#pragma unroll
    for (int d = 0; d < 4; ++d) {
#pragma unroll
        for (int g4 = 0; g4 < 4; ++g4) { int og = (dvt * 32 + 8 * g4 + 4 * hh) * 128 + d * 32 + r; asm volatile("" : "+v"(og)); bf16_t* pg = DCT + og;
            pg[0] = (bf16_t)pk2(acc[d][4 * g4], 0.f); pg[128] = (bf16_t)pk2(acc[d][4 * g4 + 1], 0.f); pg[256] = (bf16_t)pk2(acc[d][4 * g4 + 2], 0.f); pg[384] = (bf16_t)pk2(acc[d][4 * g4 + 3], 0.f); }
        const float t = dn[d] + __shfl_xor(dn[d], 32);
        if (dvt == 0 && hh == 0) ((float*)(ws + O_DN))[(bh * 16 + c) * 128 + d * 32 + r] = t;
    }
}
__device__ __forceinline__ void phase_m2(unsigned char* ws, int gtid, int NT) {
    const float* MCH = (const float*)(ws + O_MCH);
    for (int e = gtid; e < BG * 4 * 8192; e += NT) {
        const int bh = e >> 13, pp = e & 8191;
        float c0 = 0.f, c1 = 0.f;
        for (int c = 0; c < 16; ++c) {
            const size_t off = (size_t)(bh * 16 + c) * 16384 + 2 * pp;
            *(unsigned*)((bf16_t*)(ws + O_CT) + off) = pk2(c0, c1);
            const float dec = MCH[(bh * 16 + c) * 4 + 2]; const unsigned d = *(const unsigned*)((const bf16_t*)(ws + O_DCT) + off);
            c0 = dec * c0 + bflo(d); c1 = dec * c1 + bfhi(d);
        }
    }
    for (int e = gtid; e < BG * 4 * 128; e += NT) {
        const int bh = e >> 7, dk = e & 127; float n = 0.f;
        for (int c = 0; c < 16; ++c) { const size_t off = (size_t)(bh * 16 + c) * 128 + dk; ((float*)(ws + O_NN))[off] = n; n = MCH[(bh * 16 + c) * 4 + 2] * n + ((const float*)(ws + O_DN))[off]; }
    }
}
__device__ __forceinline__ void m3_item(unsigned char* ws, int l, int it, int lane) {
    const int r = lane & 31, hh = lane >> 5;
    const int pr = ((r >> 2) & 1) * 16 + ((r >> 4) & 1) * 8 + ((r >> 3) & 1) * 4 + (r & 3);
    const int tt = 3 - (it & 3), c = (it >> 2) & 15, bh = it >> 6, b = bh >> 2, h = bh & 3;
    const int ts = c * 128 + tt * 32 + r;
    const size_t trow = (size_t)b * SEQ + ts;
    bf16x8 qf[8];
    const bf16_t* Qp = (const bf16_t*)(ws + O_MQC) + trow * 512 + h * 128 + 8 * hh;
#pragma unroll
    for (int k = 0; k < 8; ++k) qf[k] = *(const bf16x8*)(Qp + 16 * k);
    const float Et = ((const float*)(ws + O_ME))[(size_t)bh * SEQ + ts], bt = ((const float*)(ws + O_MBT))[(size_t)bh * SEQ + ts];
    const float mc = ((const float*)(ws + O_MCH))[(bh * 16 + c) * 4];
    const float winter = __expf(mc - Et);
    f32x16 acc[4];
#pragma unroll
    for (int d = 0; d < 4; ++d)
#pragma unroll
        for (int i = 0; i < 16; ++i) acc[d][i] = 0.f;
    const bf16_t* CTp = (const bf16_t*)(ws + O_CT) + (size_t)(bh * 16 + c) * 16384 + (size_t)r * 128 + 8 * hh;
    const float* NNp = (const float*)(ws + O_NN) + (size_t)(bh * 16 + c) * 128 + 8 * hh;
    float qn = 0.f;
#pragma unroll
    for (int k = 0; k < 8; ++k) {
#pragma unroll
        for (int d = 0; d < 4; ++d) acc[d] = MFMA32(*(const bf16x8*)(CTp + (size_t)d * 32 * 128 + 16 * k), qf[k], acc[d]);
        const f32x4 na = *(const f32x4*)(NNp + 16 * k), nb = *(const f32x4*)(NNp + 16 * k + 4);
        const u32x4 qw = __builtin_bit_cast(u32x4, qf[k]);
        qn += bflo(qw.x) * na[0] + bfhi(qw.x) * na[1] + bflo(qw.y) * na[2] + bfhi(qw.y) * na[3] + bflo(qw.z) * nb[0] + bfhi(qw.z) * nb[1] + bflo(qw.w) * nb[2] + bfhi(qw.w) * nb[3];
        asm volatile("" ::: "memory");
    }
    qn += __shfl_xor(qn, 32);
#pragma unroll
    for (int d = 0; d < 4; ++d)
#pragma unroll
        for (int i = 0; i < 16; ++i) acc[d][i] *= winter;
    float dpart = 0.f;
    const bf16_t* Kb = (const bf16_t*)(ws + O_MKC) + ((size_t)b * SEQ + c * 128 + pr) * 512 + h * 128 + 8 * hh;
    const bf16_t* Vb = (const bf16_t*)(ws + O_MVT) + ((size_t)bh * 128 + r) * SEQ + c * 128 + 16 * hh;
    const float* MPb = (const float*)(ws + O_MP) + (size_t)bh * SEQ + c * 128 + 16 * hh;
    for (int st = 0; st <= tt; ++st) {
        f32x16 sc;
#pragma unroll
        for (int i = 0; i < 16; ++i) sc[i] = 0.f;
#pragma unroll
        for (int k = 0; k < 8; ++k) { sc = MFMA32(*(const bf16x8*)(Kb + (size_t)st * 32 * 512 + 16 * k), qf[k], sc); if (k == 3) asm volatile("" ::: "memory"); }
        asm volatile("" ::: "memory");
#pragma unroll
        for (int g = 0; g < 4; ++g) { const f32x4 pv = *(const f32x4*)(MPb + st * 32 + 4 * g);
#pragma unroll
            for (int e = 0; e < 4; ++e) { const int i = 4 * g + e;
                const bool ok = (st < tt) || (16 * hh + i <= r);
                const float w = ok ? __expf(pv[e] - Et) : 0.f;
                sc[i] = ok ? sc[i] * w : 0.f; dpart += sc[i]; } }
        u32x4 pw0, pw1;
        pw0.x = pk2(sc[0], sc[1]); pw0.y = pk2(sc[2], sc[3]); pw0.z = pk2(sc[4], sc[5]); pw0.w = pk2(sc[6], sc[7]);
        pw1.x = pk2(sc[8], sc[9]); pw1.y = pk2(sc[10], sc[11]); pw1.z = pk2(sc[12], sc[13]); pw1.w = pk2(sc[14], sc[15]);
        const bf16x8 pf0 = __builtin_bit_cast(bf16x8, pw0), pf1 = __builtin_bit_cast(bf16x8, pw1);
#pragma unroll
        for (int d = 0; d < 4; ++d) {
            acc[d] = MFMA32(*(const bf16x8*)(Vb + (size_t)d * 32 * SEQ + st * 32), pf0, acc[d]);
            acc[d] = MFMA32(*(const bf16x8*)(Vb + (size_t)d * 32 * SEQ + st * 32 + 8), pf1, acc[d]);
            if (d == 1) asm volatile("" ::: "memory");
        }
    }
    const float den = winter * qn + (dpart + __shfl_xor(dpart, 32));
    const float dinv = 1.f / fmaxf(fabsf(den), __expf(-(bt + Et)));
    float ss = 0.f;
#pragma unroll
    for (int d = 0; d < 4; ++d)
#pragma unroll
        for (int i = 0; i < 16; ++i) { acc[d][i] *= dinv; ss += acc[d][i] * acc[d][i]; }
    ss += __shfl_xor(ss, 32);
    const float rn = rsqrtf(ss * (1.f / 128.f) + EPS);
    const float* onorm = (const float*)(ws + O_PAR) + PAR_ON + l * 512 + h * 128 + 4 * hh;
    const bf16_t* mo = (const bf16_t*)(ws + O_U) + trow * LDU + UC_MO + h * 128 + 4 * hh;
    bf16_t* y = (bf16_t*)(ws + O_Y) + (size_t)2 * MG * 512 + trow * 512 + h * 128 + 4 * hh;
#pragma unroll
    for (int d = 0; d < 4; ++d)
#pragma unroll
        for (int g = 0; g < 4; ++g) {
            const int dv = d * 32 + 8 * g;
            const f32x4 wn = *(const f32x4*)(onorm + dv); const u32x2 og = *(const u32x2*)(mo + dv);
            const float y0 = acc[d][4 * g] * rn * wn[0] * sigm(bflo(og.x)), y1 = acc[d][4 * g + 1] * rn * wn[1] * sigm(bfhi(og.x));
            const float y2 = acc[d][4 * g + 2] * rn * wn[2] * sigm(bflo(og.y)), y3 = acc[d][4 * g + 3] * rn * wn[3] * sigm(bfhi(og.y));
            u32x2 o; o.x = pk2(y0, y1); o.y = pk2(y2, y3); *(u32x2*)(y + dv) = o;
            if (g & 1) asm volatile("" ::: "memory");
        }
}

#define XB_TMO      128
#define XB_XCNT(j)  (256  + 64 * (j))
#define XB_XSUB(j)  (1280 + 64 * (j))
#define XB_XGEN(j)  (2304 + 64 * (j))
#define XB_TOP      3328
#define XB_TOPGEN   3392
#define XCD_BAR_WORDS 3456
#define XB_SPIN_CAP (1u << 18)

__device__ __forceinline__ unsigned xb_ld(unsigned* p)              { return __hip_atomic_load(p, __ATOMIC_RELAXED, __HIP_MEMORY_SCOPE_AGENT); }
__device__ __forceinline__ unsigned xb_add(unsigned* p, unsigned v) { return __hip_atomic_fetch_add(p, v, __ATOMIC_RELAXED, __HIP_MEMORY_SCOPE_AGENT); }
__device__ __forceinline__ unsigned xb_xcc_id() { return (unsigned)__builtin_amdgcn_s_getreg((3 << 11) | 20) & 0xFu; }
#define XB_SPIN(cond, bar) do { unsigned _sp = 0; while (cond) { __builtin_amdgcn_s_sleep(1); \
    if ((++_sp & 255u) == 0u) { if (xb_ld(&(bar)[XB_TMO])) break; if (_sp > XB_SPIN_CAP) { atomicAdd(&(bar)[XB_TMO], 1u); break; } } } } while (0)

struct XcdBarrier {
    unsigned* bar; unsigned x;
    volatile LAS unsigned* st;
};

__device__ __forceinline__ XcdBarrier xcd_barrier_post(unsigned* bar, volatile LAS unsigned* st) {
    XcdBarrier b; b.bar = bar; b.x = xb_xcc_id(); b.st = st;
    if (threadIdx.x == 0) (void)xb_add(&bar[XB_XCNT(b.x)], 1u);
    return b;
}
__device__ __forceinline__ void xcd_barrier_complete(unsigned* bar, unsigned x, unsigned& nloc, unsigned& nx) {
    const unsigned G = gridDim.x * gridDim.y * gridDim.z;
    unsigned sum, cnt, mine, sp = 0u;
    for (;;) {
        sum = 0u; cnt = 0u; mine = 0u;
#pragma unroll
        for (unsigned j = 0; j < 16; ++j) { const unsigned c = xb_ld(&bar[XB_XCNT(j)]); sum += c; cnt += (c > 0u) ? 1u : 0u; mine = (j == x) ? c : mine; }
        if (sum == G) break;
        __builtin_amdgcn_s_sleep(1);
        if ((++sp & 255u) == 0u) { if (xb_ld(&bar[XB_TMO])) break; if (sp > XB_SPIN_CAP) { atomicAdd(&bar[XB_TMO], 1u); break; } }
    }
    nloc = mine > 0u ? mine : 1u; nx = cnt > 0u ? cnt : 1u;
}

__device__ __forceinline__ void xcd_barrier(const XcdBarrier& b) {
    asm volatile("s_waitcnt vmcnt(0)" ::: "memory");
    __syncthreads();
    if (threadIdx.x == 0) {
        unsigned* bar = b.bar;
        __builtin_amdgcn_s_waitcnt(0);
        unsigned nloc = b.st[0], nx = b.st[1];
        if (nloc == 0u) { xcd_barrier_complete(bar, b.x, nloc, nx); b.st[0] = nloc; b.st[1] = nx; }
        const unsigned old = xb_add(&bar[XB_XSUB(b.x)], 1u);
        const unsigned gen = old / nloc;
        if (old + 1u == (gen + 1u) * nloc) {
            __builtin_amdgcn_fence(__ATOMIC_RELEASE, "agent");
            asm volatile("s_waitcnt vmcnt(0)" ::: "memory");
            const unsigned og = xb_add(&bar[XB_TOP], 1u);
            const unsigned tg = og / nx;
            if (og + 1u == (tg + 1u) * nx) xb_add(&bar[XB_TOPGEN], 1u);
            else XB_SPIN(xb_ld(&bar[XB_TOPGEN]) == tg, bar);
            __builtin_amdgcn_fence(__ATOMIC_ACQUIRE, "agent");
            xb_add(&bar[XB_XGEN(b.x)], 1u);
            asm volatile("s_waitcnt vmcnt(0)" ::: "memory");
        } else {
            XB_SPIN(xb_ld(&bar[XB_XGEN(b.x)]) == gen, bar);
            __builtin_amdgcn_fence(__ATOMIC_ACQUIRE, "agent");
            asm volatile("s_waitcnt vmcnt(0)" ::: "memory");
        }
    }
    __syncthreads();
}


__global__ void __launch_bounds__(NTHR, 2) fwd_kernel(KP p) {
    extern __shared__ __attribute__((aligned(16))) unsigned char lds_raw[];
    LAS unsigned char* lds = (LAS unsigned char*)lds_raw;
    cg::grid_group grid = cg::this_grid();
    const int tid = threadIdx.x, lane0 = tid & 63, wave = __builtin_amdgcn_readfirstlane(tid >> 6);
    const int G = gridDim.x, gw0 = blockIdx.x * NWAVES + wave, NWV = G * NWAVES, NT = G * NTHR;
    unsigned char* ws0 = p.ws;
    volatile LAS unsigned* MISC = (volatile LAS unsigned*)(lds + 131072);
    if (tid < 64) MISC[tid] = 0u;
    __syncthreads();
    XcdBarrier bar = xcd_barrier_post((unsigned*)(ws0 + O_BAR), MISC + 8);
#ifndef PM
#define PM 0xFFFF
#endif
#ifndef PROBE_ID
#define PROBE_ID -1
#define PROBE_REP 1
#endif
#ifndef PM4
#define PM4 7
#endif
#define XB ((bf16_t*)(ws + O_XB))
#define RS ((float*)(ws + O_RS))
#define U ((bf16_t*)(ws + O_U))
    for (int pc = p.ph_lo; pc < p.ph_hi; ++pc) {
        int id = 0, g = 0, l = 0;
        if (pc > 0) { const int q_ = pc - 1, r_ = q_ % (1 + DEPTH * 9); g = q_ / (1 + DEPTH * 9); if (r_ == 0) id = 1; else { l = (r_ - 1) / 9; id = 2 + (r_ - 1) % 9; } }
        const size_t goff = (size_t)g * MG * DM;
        const int nrep = (PROBE_ID == id) ? PROBE_REP : 1;
        for (int rep_ = 0; rep_ < nrep; ++rep_) {
            size_t zo_ = 0; int lane = lane0, gw = gw0; asm volatile("" : "+s"(zo_), "+v"(lane), "+s"(gw));
            unsigned char* ws = p.ws + zo_;
            const int gtid = gw * 64 + lane; (void)gtid;
            if (!((PM >> id) & 1)) continue;
            switch (id) {
    case 0: { phase_p0(p, ws, lds, gw, NWV, wave, lane); } break;

        case 1: { phase_x0(p.in[0] + goff, XB, RS, gw, NWV, lane); } break;
            case 2: { {
                pg8::Gemm gm{XB, (const bf16_t*)(ws + O_WIN) + (size_t)l * NINP * DM, MG, NINP, DM}; pg8::StaticOrder S; S.init(MG, NINP, G, (int)blockIdx.x);
                pg8::EpiA E{0, 0, RS, U, LDU, (float*)(ws + O_SG), nullptr, 0, nullptr};
                pg8::gemm_phase<pg8::EpiA, pg8::StaticOrder, true, true>(lds, gm, S, E);
            } } break;
            case 3: { {
                constexpr int N_SCAN = BG * 12, N_HN3 = 3 * (MG / 8), N_HK = MG / 32, N_ST = 34 * (MG / 64);
                const int sw = (wave == 7 && (int)blockIdx.x < N_SCAN) ? (int)blockIdx.x : -1;
                if (sw >= 0) { for (int it = sw; it < N_SCAN; it += G) gate_scan_item(ws, l, it, lane); }
                else {
                    const int nscanw = (N_SCAN < G ? N_SCAN : G);
                    const int wi = (int)blockIdx.x < nscanw ? (int)blockIdx.x * 7 + wave : nscanw * 7 + ((int)blockIdx.x - nscanw) * 8 + wave;
                    const int nw = NWV - nscanw;
                    for (int it = wi; it < N_HN3 + N_HK + N_ST; it += nw) {
                        if (it < N_HN3) headnorm_item(ws, l, it % 3, it / 3, lane);
                        else if (it < N_HN3 + N_HK) headnorm_item(ws, l, 3, it - N_HN3, lane);
                        else stream_item(ws, l, it - N_HN3 - N_HK, lane);
                    }
                }
            } } break;
            case 4: { {
                if (PM4 & 1) for (int it = gw; it < BG * 4 * 16 * 4; it += NWV) m1_item(ws, it, lane);
                __syncthreads();
                if (PM4 & 2) for (int it = (int)blockIdx.x; it < BG * 8 * 4; it += G) {
                    const int b = it >> 5, h = (it >> 2) & 7, jp = it & 3;
                    const bf16_t* Q = (const bf16_t*)(ws + O_FQN) + (size_t)b * SEQ * 512 + h * 64; const bf16_t* K = (const bf16_t*)(ws + O_FKN) + (size_t)b * SEQ * 512 + h * 64;
                    const bf16_t* VT = (const bf16_t*)(ws + O_FVT) + (size_t)(b * 8 + h) * 64 * SEQ; const float* C = (const float*)(ws + O_FC) + (size_t)(b * 8 + h) * SEQ;
                    bf16_t* Y = (bf16_t*)(ws + O_Y) + (size_t)b * SEQ * 512 + h * 64;
                    attn_block<false>(lds, Q, K, 512, VT, C, 0.f, Y, 8 * (7 - jp) + wave, 0, 8 * (7 - jp) + 7, wave, lane);
                    attn_block<false>(lds, Q, K, 512, VT, C, 0.f, Y, 8 * jp + wave, 0, 8 * jp + 7, wave, lane);
                }
                if (PM4 & 4) for (int it = (int)blockIdx.x; it < BG * 2 * 32; it += G) {
                    const int b = it >> 6, hk = (it >> 5) & 1, u = it & 31, hq = hk * 4 + (wave & 3), qt = 2 * u + (wave >> 2);
                    const bf16_t* Q = (const bf16_t*)(ws + O_SQR) + (size_t)b * SEQ * 512 + hq * 64; const bf16_t* K = (const bf16_t*)(ws + O_SKR) + (size_t)b * SEQ * 128 + hk * 64;
                    const bf16_t* VT = (const bf16_t*)(ws + O_SVT) + (size_t)(b * 2 + hk) * 64 * SEQ;
                    bf16_t* Y = (bf16_t*)(ws + O_Y) + (size_t)MG * 512 + (size_t)b * SEQ * 512 + hq * 64;
                    attn_block<true>(lds, Q, K, 128, VT, nullptr, ((const float*)(ws + O_PAR))[PAR_SINK + l * 8 + hq] * LOG2E, Y, qt, (2 * u > 4 ? 2 * u - 4 : 0), 2 * u + 1, wave, lane);
                }
            } } break;
            case 5: { phase_m2(ws, gtid, NT); } break;
            case 6: { { for (int it = gw; it < BG * 4 * 16 * 4; it += NWV) m3_item(ws, l, it, lane); } } break;
            case 7: { {
                pg8::Gemm gm{(const bf16_t*)(ws + O_Y), (const bf16_t*)(ws + O_WB) + (size_t)l * 3 * DM * 512, 3 * MG, 3 * DM, 512}; pg8::DiagOrder S; S.init(MG, DM, G, (int)blockIdx.x);
                pg8::EpiM E{MG / 256, (bf16_t*)(ws + O_MRG), U + UC_G, LDU, (float*)(ws + O_TMP)};
                pg8::gemm_phase<pg8::EpiM, pg8::DiagOrder, true, true>(lds, gm, S, E);
            } } break;
            case 8: { {
                pg8::Gemm gm{(const bf16_t*)(ws + O_MRG), (const bf16_t*)(ws + O_WOUT) + (size_t)l * DM * DM, MG, DM, DM}; pg8::StaticOrder S; S.init(MG, DM, G, (int)blockIdx.x);
                pg8::EpiB E{(l == 0 ? p.in[0] : (const float*)p.out) + goff, p.out + goff, XB, RS};
                pg8::gemm_phase<pg8::EpiB, pg8::StaticOrder, true, true>(lds, gm, S, E);
            } } break;
            case 9: { {
                pg8::Gemm gm{XB, (const bf16_t*)(ws + O_WUP) + (size_t)l * FF * DM, MG, FF, DM}; pg8::StaticOrder S; S.init(MG, FF, G, (int)blockIdx.x);
                pg8::EpiA E{2, 0, RS, U  , FF, nullptr, nullptr, 0, nullptr};
                pg8::gemm_phase<pg8::EpiA, pg8::StaticOrder, true, true>(lds, gm, S, E);
            } } break;
            case 10: { {
                pg8::Gemm gm{U  , (const bf16_t*)(ws + O_WDN) + (size_t)l * DM * FF, MG, DM, FF}; pg8::StaticOrder S; S.init(MG, DM, G, (int)blockIdx.x);
                pg8::EpiB E{(const float*)p.out + goff, p.out + goff, XB, RS};
                pg8::gemm_phase<pg8::EpiB, pg8::StaticOrder, true, true>(lds, gm, S, E);
            } } break;
            default: break;
            }
        }
        if (pc + 1 < p.ph_hi) { if (pc == 0) grid.sync(); else xcd_barrier(bar); }
    }
}
constexpr int N_PHASES = 1 + NG * (1 + DEPTH * 9);

#ifndef MK_MULTI
#define MK_MULTI 0
#endif
extern "C" void kernel_launch(void* const* d_in, const int* in_sizes, int n_in, void* d_out, int out_size, void* d_ws, size_t ws_size, hipStream_t stream) {
    static int grid = 0;
    if (grid == 0) {
        if (n_in != 19 || out_size != NB * SEQ * DM || ws_size < WS_NEED) { fprintf(stderr, "kernel_launch: unexpected problem (n_in %d out %d ws %zu need %zu)\n", n_in, out_size, ws_size, (size_t)WS_NEED); grid = -1; return; }
        int dev = 0, cus = 0, per_cu = 0;
        hipGetDevice(&dev); hipDeviceGetAttribute(&cus, hipDeviceAttributeMultiprocessorCount, dev);
        if (hipFuncSetAttribute((const void*)fwd_kernel, hipFuncAttributeMaxDynamicSharedMemorySize, LDS_BYTES) != hipSuccess) { fprintf(stderr, "kernel_launch: hipFuncSetAttribute failed\n"); grid = -1; return; }
        hipOccupancyMaxActiveBlocksPerMultiprocessor(&per_cu, (const void*)fwd_kernel, NTHR, LDS_BYTES);
        (void)hipGetLastError();
        if (per_cu < 1) { fprintf(stderr, "kernel_launch: occupancy query says %d blocks per CU\n", per_cu); per_cu = 1; }
        grid = cus;
    }
    if (grid < 0) return;
    if (hipMemsetAsync((char*)d_ws + O_BAR, 0, 16384, stream) != hipSuccess) { fprintf(stderr, "kernel_launch: memset failed\n"); return; }
    KP a{};
    for (int i = 0; i < 19; ++i) a.in[i] = (const float*)d_in[i];
    a.out = (float*)d_out; a.ws = (unsigned char*)d_ws;
#if MK_MULTI
    for (int ph = 0; ph < N_PHASES; ++ph) { a.ph_lo = ph; a.ph_hi = ph + 1; hipLaunchKernelGGL(fwd_kernel, dim3(grid), dim3(NTHR), LDS_BYTES, stream, a); }
#else
    a.ph_lo = 0; a.ph_hi = N_PHASES;
    void* args[] = {&a};
    hipError_t e = hipLaunchCooperativeKernel((const void*)fwd_kernel, dim3(grid), dim3(NTHR), args, LDS_BYTES, stream);
    if (e != hipSuccess) fprintf(stderr, "kernel_launch: cooperative launch failed: %s (grid %d)\n", hipGetErrorString(e), grid);
#endif
}
```

```cpp
#include <hip/hip_runtime.h>
#include <hip/hip_cooperative_groups.h>
#include <cstdio>
#include <cstdint>
#include <cmath>
namespace cg = cooperative_groups;
namespace pg8 {
#define PG8_LAS __attribute__((address_space(3)))
typedef unsigned short bf16_t;
typedef short bf16x8 __attribute__((ext_vector_type(8)));
typedef float f32x4 __attribute__((ext_vector_type(4)));
typedef unsigned u32x4 __attribute__((ext_vector_type(4)));
constexpr int BM = 256, BK = 64, HALF = 128, HTB = HALF * BK * 2  , STAGE_BYTES = 8 * HTB, NXCD = 8, WGM = 8;

__host__ __device__ __forceinline__ int lds_byte(int r, int c) { const int st = (r >> 4) * 2 + (c >> 5), rr = r & 15, cc = c & 31, ob = rr * 64 + cc * 2; return st * 1024 + (ob ^ (((ob >> 9) & 1) << 5)); }
__host__ __device__ __forceinline__ void stage_rc(int b, int& R, int& C) { const int st = b / 1024, sb = b % 1024, swz = sb ^ (((sb >> 9) & 1) << 5); R = (st >> 1) * 16 + swz / 64; C = (st & 1) * 32 + (swz % 64) / 2; }
__host__ __device__ __forceinline__ int perm32(int rho) { const int n = rho >> 4, i = rho & 15; return 8 * (i >> 2) + 4 * n + (i & 3); }

struct Unit { int pm, pn; };
struct Gemm { const bf16_t* A; const bf16_t* Bt; int M, N, K; };

struct StaticOrder {
    int nM, nN, nwg, G, c;
    __host__ __device__ void init(int M, int N, int G_, int c_) { nM = M / BM; nN = N / BM; nwg = nM * nN; G = G_; c = c_; }
    __host__ __device__ bool next(int i, Unit& u) const {
        const long L = (long)i * G + c; if (L >= nwg) return false;
        int wgid = (int)L; { const int q = nwg / NXCD, r = nwg % NXCD, xcd = wgid % NXCD, off = wgid / NXCD; wgid = (xcd < r ? xcd * (q + 1) : r * (q + 1) + (xcd - r) * q) + off; }
        const int nig = WGM * nN, gid = wgid / nig, fm = gid * WGM, gsz = (nM - fm) < WGM ? (nM - fm) : WGM;
        u.pm = fm + ((wgid % nig) % gsz); u.pn = (wgid % nig) / gsz; return true;
    }
    __device__ __forceinline__ void a_ready(const Unit&) const {}
    __device__ __forceinline__ void done(const Unit&) const {}
};


typedef unsigned u32x2 __attribute__((ext_vector_type(2)));
typedef float f32x2_t __attribute__((ext_vector_type(2)));
typedef __bf16 bf16x2_t __attribute__((ext_vector_type(2)));
__device__ __forceinline__ unsigned pk2(float lo, float hi) { f32x2_t v = {lo, hi}; bf16x2_t b = __builtin_convertvector(v, bf16x2_t); return __builtin_bit_cast(unsigned, b); }
__device__ __forceinline__ float bflo(unsigned w) { return __uint_as_float(w << 16); }
__device__ __forceinline__ float bfhi(unsigned w) { return __uint_as_float(w & 0xffff0000u); }
__device__ __forceinline__ float sigm(float x) { return __builtin_amdgcn_rcpf(1.f + __expf(-x)); }
__device__ __forceinline__ float rowscale(const float* rs, int row) {
    const f32x4* p = (const f32x4*)(rs + (size_t)row * 16);
    const f32x4 a = p[0], b = p[1], c = p[2], d = p[3];
    const float s = ((a[0] + a[1]) + (a[2] + a[3])) + ((b[0] + b[1]) + (b[2] + b[3])) + ((c[0] + c[1]) + (c[2] + c[3])) + ((d[0] + d[1]) + (d[2] + d[3]));
    return rsqrtf(s * (1.f / 1024.f) + 1e-6f);
}
struct EpiA {
    static constexpr bool PERM = true, AFTER_DRAIN = false;
    int mode, sub; const float* rs; bf16_t* out; int ldo; float* sg; const bf16_t* gate; int ldg; float* tmp;
    __device__ __forceinline__ void operator()(const f32x4 (&acc)[2][2][4][2], const Unit& u, int wr, int wc, int fr, int fq) const {
        const int row0 = u.pm * BM + wr * 64 + fr, colb = u.pn * BM + wc * 32 + 8 * fq;
        float rsv8[2][4];
        if (mode != 1) {
            f32x4 part[2][4];
#pragma unroll
            for (int ai = 0; ai < 2; ++ai)
#pragma unroll
                for (int m = 0; m < 4; ++m) part[ai][m] = *(const f32x4*)(rs + (size_t)(row0 + ai * HALF + m * 16) * 16 + 4 * fq);
#pragma unroll
            for (int ai = 0; ai < 2; ++ai)
#pragma unroll
                for (int m = 0; m < 4; ++m) { float sp = (part[ai][m][0] + part[ai][m][1]) + (part[ai][m][2] + part[ai][m][3]); sp += __shfl_xor(sp, 16); sp += __shfl_xor(sp, 32); rsv8[ai][m] = rsqrtf(sp * (1.f / 1024.f) + 1e-6f); }
        } else {
#pragma unroll
            for (int ai = 0; ai < 2; ++ai)
#pragma unroll
                for (int m = 0; m < 4; ++m) rsv8[ai][m] = 1.f;
        }
#pragma unroll
        for (int ai = 0; ai < 2; ++ai)
#pragma unroll
            for (int m = 0; m < 4; ++m) {
                const int row = row0 + ai * HALF + m * 16;
                const float rsv = rsv8[ai][m];
#pragma unroll
                for (int bj = 0; bj < 2; ++bj) {
                    const int col = colb + bj * HALF;
                    f32x4 v0 = acc[ai][bj][m][0] * rsv, v1 = acc[ai][bj][m][1] * rsv;
                    if (mode == 0) {
                        if (u.pn == 29) {
                            if (bj == 0 && wc == 0 && fq < 2) { float* q = sg + (size_t)row * 16 + 8 * fq; *(f32x4*)q = v0; *(f32x4*)(q + 4) = v1; }
                        } else {
                            if (u.pn >= 17) {
#pragma unroll
                                for (int e = 0; e < 4; ++e) { v0[e] = sigm(v0[e]); v1[e] = sigm(v1[e]); }
                            }
                            u32x4 w; w.x = pk2(v0[0], v0[1]); w.y = pk2(v0[2], v0[3]); w.z = pk2(v1[0], v1[1]); w.w = pk2(v1[2], v1[3]);
                            *(u32x4*)(out + (size_t)row * ldo + col) = w;
                        }
                    } else if (mode == 1) {
                        const u32x4 g = *(const u32x4*)(gate + (size_t)row * ldg + col);
                        f32x4 p0 = {v0[0] * bflo(g.x), v0[1] * bfhi(g.x), v0[2] * bflo(g.y), v0[3] * bfhi(g.y)};
                        f32x4 p1 = {v1[0] * bflo(g.z), v1[1] * bfhi(g.z), v1[2] * bflo(g.w), v1[3] * bfhi(g.w)};
                        float* tp = tmp + (size_t)row * 1024 + col;
                        if (sub == 0) { *(f32x4*)tp = p0; *(f32x4*)(tp + 4) = p1; }
                        else if (sub == 1) { *(f32x4*)tp = *(const f32x4*)tp + p0; *(f32x4*)(tp + 4) = *(const f32x4*)(tp + 4) + p1; }
                        else { p0 = p0 + *(const f32x4*)tp; p1 = p1 + *(const f32x4*)(tp + 4);
                            u32x4 w; w.x = pk2(p0[0], p0[1]); w.y = pk2(p0[2], p0[3]); w.z = pk2(p1[0], p1[1]); w.w = pk2(p1[2], p1[3]);
                            *(u32x4*)(out + (size_t)row * ldo + col) = w; }
                    } else {
#pragma unroll
                        for (int e = 0; e < 4; ++e) { const float a = fmaxf(v0[e], 0.f), b = fmaxf(v1[e], 0.f); v0[e] = a * a; v1[e] = b * b; }
                        u32x4 w; w.x = pk2(v0[0], v0[1]); w.y = pk2(v0[2], v0[3]); w.z = pk2(v1[0], v1[1]); w.w = pk2(v1[2], v1[3]);
                        *(u32x4*)(out + (size_t)row * ldo + col) = w;
                    }
                }
            }
    }
};
struct EpiB {
    static constexpr bool PERM = false, AFTER_DRAIN = false;
    const float* resid; float* out; bf16_t* xb; float* rs;
    __device__ __forceinline__ void operator()(const f32x4 (&acc)[2][2][4][2], const Unit& u, int wr, int wc, int fr, int fq) const {
        const int row0 = u.pm * BM + wr * 64 + fr, colb = u.pn * BM + wc * 32 + 4 * fq;
#pragma unroll
        for (int ai = 0; ai < 2; ++ai)
#pragma unroll
            for (int m = 0; m < 4; ++m) {
                const int row = row0 + ai * HALF + m * 16; float ss = 0.f;
#pragma unroll
                for (int bj = 0; bj < 2; ++bj)
#pragma unroll
                    for (int n = 0; n < 2; ++n) {
                        const size_t off = (size_t)row * 1024 + colb + bj * HALF + n * 16;
                        const f32x4 x = *(const f32x4*)(resid + off) + acc[ai][bj][m][n];
                        *(f32x4*)(out + off) = x;
                        u32x2 w; w.x = pk2(x[0], x[1]); w.y = pk2(x[2], x[3]); *(u32x2*)(xb + off) = w;
                        ss += (x[0] * x[0] + x[1] * x[1]) + (x[2] * x[2] + x[3] * x[3]);
                    }
                ss += __shfl_xor(ss, 16); ss += __shfl_xor(ss, 32);
                if (fq == 0) rs[(size_t)row * 16 + u.pn * 4 + wc] = ss;
            }
    }
};

struct EpiM {
    static constexpr bool PERM = true, AFTER_DRAIN = false;
    int nM; bf16_t* out; const bf16_t* gate; int ldg; float* tmp;
    __device__ __forceinline__ void operator()(const f32x4 (&acc)[2][2][4][2], const Unit& u, int wr, int wc, int fr, int fq) const {
        const int sub = u.pn >> 2, pm = u.pm - sub * nM, pn = u.pn & 3;
        const int row0 = pm * BM + wr * 64 + fr, colb = pn * BM + wc * 32 + 8 * fq;
        const bf16_t* gb = gate + sub * 1024;
#pragma unroll
        for (int ai = 0; ai < 2; ++ai)
#pragma unroll
            for (int m = 0; m < 4; ++m) {
                const int row = row0 + ai * HALF + m * 16;
#pragma unroll
                for (int bj = 0; bj < 2; ++bj) {
                    const int col = colb + bj * HALF;
                    const f32x4 v0 = acc[ai][bj][m][0], v1 = acc[ai][bj][m][1];
                    const u32x4 g = *(const u32x4*)(gb + (size_t)row * ldg + col);
                    f32x4 p0 = {v0[0] * bflo(g.x), v0[1] * bfhi(g.x), v0[2] * bflo(g.y), v0[3] * bfhi(g.y)};
                    f32x4 p1 = {v1[0] * bflo(g.z), v1[1] * bfhi(g.z), v1[2] * bflo(g.w), v1[3] * bfhi(g.w)};
                    float* tp = tmp + (size_t)row * 1024 + col;
                    if (sub == 0) { *(f32x4*)tp = p0; *(f32x4*)(tp + 4) = p1; }
                    else if (sub == 1) { *(f32x4*)tp = *(const f32x4*)tp + p0; *(f32x4*)(tp + 4) = *(const f32x4*)(tp + 4) + p1; }
                    else { p0 = p0 + *(const f32x4*)tp; p1 = p1 + *(const f32x4*)(tp + 4);
                        u32x4 w; w.x = pk2(p0[0], p0[1]); w.y = pk2(p0[2], p0[3]); w.z = pk2(p1[0], p1[1]); w.w = pk2(p1[2], p1[3]);
                        *(u32x4*)(out + (size_t)row * 1024 + col) = w; }
                }
            }
    }
};
struct DiagOrder {
    StaticOrder S; int nM;
    __host__ __device__ void init(int M, int N, int G_, int c_) { S.init(M, N, G_, c_); nM = M / BM; }
    __host__ __device__ bool next(int i, Unit& u) const { Unit v; if (!S.next(i / 3, v)) return false; const int b = i % 3; u.pm = b * nM + v.pm; u.pn = b * 4 + v.pn; return true; }
    __device__ __forceinline__ void a_ready(const Unit&) const {}
    __device__ __forceinline__ void done(const Unit&) const {}
};

template <class Epi, class Sched, bool ALIGN_EPI = false, bool SP2 = false>
__device__ __forceinline__ void gemm_phase(PG8_LAS unsigned char* lds, const Gemm g, const Sched& S, const Epi& E) {
    int tid_ = threadIdx.x; asm volatile("" : "+v"(tid_));
    const int tid = tid_, wid = __builtin_amdgcn_readfirstlane(tid >> 6), lane = tid & 63, wr = wid >> 2, wc = wid & 3, fr = lane & 15, fq = lane >> 4;
    const int K = g.K, nt = K / BK;
    unsigned voffA[2], voffB[2];
#pragma unroll
    for (int i = 0; i < 2; ++i) { int R, C; stage_rc(tid * 16 + i * 8192, R, C); const int Rb = Epi::PERM ? ((R & ~31) + perm32(R & 31)) : R;
        voffA[i] = (unsigned)(R * K + C) * 2u; voffB[i] = (unsigned)(Rb * K + C) * 2u; }
    const size_t kstep = (size_t)(BK * 2);
    const size_t hstep = (size_t)HALF * K * 2;
    const size_t tstep = 2 * hstep;
    const unsigned ldsw = (unsigned)wid * 1024u;
    const int aoff = lds_byte(wr * 64 + fr, fq * 8), boff = lds_byte(wc * 32 + fr, fq * 8);
#define PG8_SA(b, h) (((b) * 2 + (h)) * HTB)
#define PG8_SB(b, h) ((4 + (b) * 2 + (h)) * HTB)
#define PG8_STAGE(bufoff, gbase, voff) do { _Pragma("unroll") for (int _i = 0; _i < 2; ++_i) \
        __builtin_amdgcn_global_load_lds((const unsigned*)((const char*)(gbase) + (voff)[_i]), (PG8_LAS unsigned*)(lds + (bufoff) + ldsw + _i * 8192), 16, 0, 0); } while (0)
#define PG8_LDA(dst, b, h) do { _Pragma("unroll") for (int m = 0; m < 4; ++m) _Pragma("unroll") for (int k = 0; k < 2; ++k) dst[m][k] = *(const PG8_LAS bf16x8*)(lds + PG8_SA(b, h) + aoff + m * 2048 + k * 1024); } while (0)
#define PG8_LDB(dst, b, h) do { _Pragma("unroll") for (int n = 0; n < 2; ++n) _Pragma("unroll") for (int k = 0; k < 2; ++k) dst[n][k] = *(const PG8_LAS bf16x8*)(lds + PG8_SB(b, h) + boff + n * 2048 + k * 1024); } while (0)
#define PG8_MMA(ai, bj, At, Bt) do { __builtin_amdgcn_s_setprio(1); _Pragma("unroll") for (int m = 0; m < 4; ++m) _Pragma("unroll") for (int n = 0; n < 2; ++n) _Pragma("unroll") for (int k = 0; k < 2; ++k) \
        acc[ai][bj][m][n] = __builtin_amdgcn_mfma_f32_16x16x32_bf16(Bt[n][k], At[m][k], acc[ai][bj][m][n], 0, 0, 0); __builtin_amdgcn_s_setprio(0); } while (0)
#define PG8_WAIT_V(n) asm volatile("s_waitcnt vmcnt(" #n ")" ::: "memory")
#define PG8_WAIT_L(n) asm volatile("s_waitcnt lgkmcnt(" #n ")" ::: "memory")
#define PG8_BAR __builtin_amdgcn_s_barrier()
#define PG8_SCHED __builtin_amdgcn_sched_barrier(0)
    Unit cur, nxt; int ui = 0;
    if (!S.next(0, cur)) return;
    f32x4 acc[2][2][4][2];
#pragma unroll
    for (int a = 0; a < 2; ++a)
#pragma unroll
        for (int b = 0; b < 2; ++b)
#pragma unroll
            for (int m = 0; m < 4; ++m)
#pragma unroll
                for (int n = 0; n < 2; ++n) acc[a][b][m][n] = (f32x4){0.f, 0.f, 0.f, 0.f};
    bf16x8 At[4][2], B0[2][2], B1[2][2];
    const char* cA = (const char*)g.A + (size_t)cur.pm * tstep; const char* cB = (const char*)g.Bt + (size_t)cur.pn * tstep;
    S.a_ready(cur);
    if constexpr (SP2) {
        PG8_STAGE(PG8_SB(0, 0), cB, voffB); PG8_STAGE(PG8_SB(0, 1), cB + hstep, voffB); PG8_STAGE(PG8_SA(0, 0), cA, voffA); PG8_STAGE(PG8_SA(0, 1), cA + hstep, voffA);
        if (wr == 1) PG8_BAR;
        PG8_WAIT_V(2); PG8_BAR;
        PG8_STAGE(PG8_SB(1, 0), cB + kstep, voffB); PG8_STAGE(PG8_SA(1, 0), cA + kstep, voffA); PG8_STAGE(PG8_SB(1, 1), cB + hstep + kstep, voffB);
        PG8_WAIT_V(6); PG8_BAR;
    } else {
        PG8_STAGE(PG8_SB(0, 0), cB, voffB); PG8_STAGE(PG8_SA(0, 0), cA, voffA); PG8_STAGE(PG8_SB(0, 1), cB + hstep, voffB); PG8_STAGE(PG8_SA(0, 1), cA + hstep, voffA);
        if (wr == 1) PG8_BAR;
        PG8_WAIT_V(4); PG8_BAR;
        PG8_STAGE(PG8_SB(1, 0), cB + kstep, voffB); PG8_STAGE(PG8_SA(1, 0), cA + kstep, voffA); PG8_STAGE(PG8_SB(1, 1), cB + hstep + kstep, voffB);
        PG8_WAIT_V(6); PG8_BAR;
    }
    for (;;) {
        const bool has_next = S.next(ui + 1, nxt);
        const char* nA = has_next ? (const char*)g.A + (size_t)nxt.pm * tstep : cA; const char* nB = has_next ? (const char*)g.Bt + (size_t)nxt.pn * tstep : cB;
        for (int t = 0; t < nt; t += 2) {
            const bool last = (t == nt - 2);
            const char* a1 = cA + (size_t)(t + 1) * kstep;
            const char* a2 = last ? nA : cA + (size_t)(t + 2) * kstep; const char* b2 = last ? nB : cB + (size_t)(t + 2) * kstep;
            const char* a3 = a2 + kstep; const char* b3 = b2 + kstep;
            if (last && has_next) S.a_ready(nxt);
            if constexpr (SP2) {
            PG8_LDB(B0, 0, 0); PG8_LDB(B1, 0, 1); PG8_SCHED; PG8_LDA(At, 0, 0); PG8_STAGE(PG8_SA(1, 1), a1 + hstep, voffA);
            PG8_WAIT_V(8); PG8_WAIT_L(0); PG8_BAR; PG8_MMA(0, 0, At, B0); PG8_MMA(0, 1, At, B1); PG8_BAR; PG8_SCHED;
            PG8_LDA(At, 0, 1); PG8_STAGE(PG8_SB(0, 0), b2, voffB); PG8_STAGE(PG8_SB(0, 1), b2 + hstep, voffB); PG8_STAGE(PG8_SA(0, 0), a2, voffA);
            PG8_WAIT_V(8); PG8_WAIT_L(0); PG8_BAR; PG8_MMA(1, 0, At, B0); PG8_MMA(1, 1, At, B1); PG8_BAR; PG8_SCHED;
            PG8_LDB(B0, 1, 0); PG8_LDB(B1, 1, 1); PG8_SCHED; PG8_LDA(At, 1, 0); PG8_STAGE(PG8_SA(0, 1), a2 + hstep, voffA);
            PG8_WAIT_V(8); PG8_WAIT_L(0); PG8_BAR; PG8_MMA(0, 0, At, B0); PG8_MMA(0, 1, At, B1); PG8_BAR; PG8_SCHED;
            PG8_LDA(At, 1, 1); PG8_STAGE(PG8_SB(1, 0), b3, voffB); PG8_STAGE(PG8_SB(1, 1), b3 + hstep, voffB); PG8_STAGE(PG8_SA(1, 0), a3, voffA);
            PG8_WAIT_V(8); PG8_WAIT_L(0); PG8_BAR; PG8_MMA(1, 0, At, B0); PG8_MMA(1, 1, At, B1); PG8_BAR; PG8_SCHED;
            } else {
            PG8_LDB(B0, 0, 0); PG8_SCHED; PG8_LDA(At, 0, 0); PG8_STAGE(PG8_SA(1, 1), a1 + hstep, voffA);
            PG8_WAIT_L(8); PG8_BAR; PG8_WAIT_L(0); PG8_MMA(0, 0, At, B0); PG8_BAR; PG8_SCHED;
            PG8_LDB(B1, 0, 1); PG8_STAGE(PG8_SB(0, 0), b2, voffB);
            PG8_BAR; PG8_WAIT_L(0); PG8_MMA(0, 1, At, B1); PG8_BAR;
            PG8_LDA(At, 0, 1); PG8_STAGE(PG8_SA(0, 0), a2, voffA);
            PG8_BAR; PG8_WAIT_L(0); PG8_MMA(1, 0, At, B0); PG8_BAR; PG8_SCHED;
            PG8_STAGE(PG8_SB(0, 1), b2 + hstep, voffB);
            PG8_WAIT_V(6); PG8_BAR; PG8_MMA(1, 1, At, B1); PG8_BAR;
            PG8_LDB(B0, 1, 0); PG8_SCHED; PG8_LDA(At, 1, 0); PG8_STAGE(PG8_SA(0, 1), a2 + hstep, voffA);
            PG8_WAIT_L(8); PG8_BAR; PG8_WAIT_L(0); PG8_MMA(0, 0, At, B0); PG8_BAR; PG8_SCHED;
            PG8_LDB(B1, 1, 1); PG8_STAGE(PG8_SB(1, 0), b3, voffB);
            PG8_BAR; PG8_WAIT_L(0); PG8_MMA(0, 1, At, B1); PG8_BAR;
            PG8_LDA(At, 1, 1); PG8_STAGE(PG8_SA(1, 0), a3, voffA);
            PG8_BAR; PG8_WAIT_L(0); PG8_MMA(1, 0, At, B0); PG8_BAR; PG8_SCHED;
            PG8_STAGE(PG8_SB(1, 1), b3 + hstep, voffB);
            PG8_WAIT_V(6); PG8_BAR; PG8_MMA(1, 1, At, B1); PG8_BAR;
            }
        }
        if constexpr (ALIGN_EPI) { if (wr == 0) PG8_BAR; }
        if constexpr (!Epi::AFTER_DRAIN) { E(acc, cur, wr, wc, fr, fq); S.done(cur); }
        if (!has_next) break;
#pragma unroll
        for (int a = 0; a < 2; ++a)
#pragma unroll
            for (int b = 0; b < 2; ++b)
#pragma unroll
                for (int m = 0; m < 4; ++m)
#pragma unroll
                    for (int n = 0; n < 2; ++n) acc[a][b][m][n] = (f32x4){0.f, 0.f, 0.f, 0.f};
        cur = nxt; cA = nA; cB = nB; ++ui;
        if constexpr (ALIGN_EPI) { if (wr == 1) PG8_BAR; }
    }
    PG8_WAIT_V(0);
    if constexpr (!ALIGN_EPI) { if (wr == 0) PG8_BAR; }
    PG8_BAR;
    if constexpr (Epi::AFTER_DRAIN) { E.fused(acc, cur, wr, wc, fr, fq, lds, wid, lane); S.done(cur); }
#undef PG8_SA
#undef PG8_SB
#undef PG8_STAGE
#undef PG8_LDA
#undef PG8_LDB
#undef PG8_MMA
#undef PG8_WAIT_V
#undef PG8_WAIT_L
#undef PG8_BAR
#undef PG8_SCHED
}
}

#define LAS __attribute__((address_space(3)))
typedef unsigned short bf16_t;
typedef short bf16x8 __attribute__((ext_vector_type(8)));
typedef float f32x4 __attribute__((ext_vector_type(4)));
typedef float f32x2 __attribute__((ext_vector_type(2)));
typedef float f32x16 __attribute__((ext_vector_type(16)));
typedef unsigned u32x4 __attribute__((ext_vector_type(4)));
typedef unsigned u32x2 __attribute__((ext_vector_type(2)));
using pg8::pk2; using pg8::bflo; using pg8::bfhi; using pg8::sigm;

constexpr int NB = 32, SEQ = 2048, DM = 1024, DEPTH = 2, INW = 7440, NINP = 7680, LDU = 7424, FF = 4096;
constexpr int NG = 2, BG = NB / NG, MG = BG * SEQ;
constexpr float LOG2E = 1.4426950408889634f, EPS = 1e-6f;
constexpr int NWAVES = 8, NTHR = 512;
constexpr int LDS_BYTES = 131072 + 1024;

constexpr int UC_FQ = 0, UC_FK = 512, UC_FV = 1024, UC_SQ = 1536, UC_SK = 2048, UC_SV = 2176, UC_MQ = 2304, UC_MK = 2816, UC_MV = 3328, UC_MO = 3840, UC_G = 4352;

constexpr size_t al(size_t x) { return (x + 255) & ~(size_t)255; }
constexpr size_t O_WIN = 0;
constexpr size_t O_WB = O_WIN + al((size_t)DEPTH * NINP * DM * 2);
constexpr size_t O_WOUT = O_WB + al((size_t)DEPTH * 3 * DM * 512 * 2);
constexpr size_t O_WUP = O_WOUT + al((size_t)DEPTH * DM * DM * 2);
constexpr size_t O_WDN = O_WUP + al((size_t)DEPTH * FF * DM * 2);
constexpr size_t O_ROPE = O_WDN + al((size_t)DEPTH * DM * FF * 2);
constexpr size_t O_PAR = O_ROPE + al((size_t)SEQ * 32 * 2 * 4);
constexpr int PAR_FFB = 0, PAR_FQN = 16, PAR_FKN = 144, PAR_SQN = 272, PAR_SKN = 400, PAR_SINK = 528, PAR_CW = 544, PAR_CB = 8736, PAR_IB = 10784, PAR_FB = 10792, PAR_ON = 10800, PAR_N = 11824;
constexpr size_t O_XB = O_PAR + al((size_t)PAR_N * 4);
constexpr size_t O_RS = O_XB + al((size_t)MG * DM * 2);
constexpr size_t O_U = O_RS + al((size_t)MG * 16 * 4);
constexpr size_t O_SG = O_U + al((size_t)MG * LDU * 2);
constexpr size_t O_FC = O_SG + al((size_t)MG * 16 * 4);
constexpr size_t O_MP = O_FC + al((size_t)BG * 8 * SEQ * 4);
constexpr size_t O_ME = O_MP + al((size_t)BG * 4 * SEQ * 4);
constexpr size_t O_MBT = O_ME + al((size_t)BG * 4 * SEQ * 4);
constexpr size_t O_MCH = O_MBT + al((size_t)BG * 4 * SEQ * 4);
constexpr size_t O_FQN = O_MCH + al((size_t)BG * 4 * 16 * 4 * 4);
constexpr size_t O_FKN = O_FQN + (size_t)MG * 512 * 2;
constexpr size_t O_FVT = O_FKN + (size_t)MG * 512 * 2;
constexpr size_t O_SQR = O_FVT + (size_t)MG * 512 * 2;
constexpr size_t O_TMP = O_FQN;
constexpr size_t O_SKR = O_SQR + (size_t)MG * 512 * 2;
constexpr size_t O_SVT = O_SKR + (size_t)MG * 128 * 2;
constexpr size_t O_MQC = O_SVT + (size_t)MG * 128 * 2;
constexpr size_t O_MKC = O_MQC + (size_t)MG * 512 * 2;
constexpr size_t O_MRG = O_MQC;
constexpr size_t O_KT = O_MKC + (size_t)MG * 512 * 2;
constexpr size_t O_MVT = O_KT + (size_t)MG * 512 * 2;
constexpr size_t O_DN = O_MVT + (size_t)MG * 512 * 2;
constexpr size_t O_CT = O_KT;
constexpr size_t O_NN = O_DN + al((size_t)BG * 4 * 16 * 128 * 4);
constexpr size_t O_Y = O_NN + al((size_t)BG * 4 * 16 * 128 * 4);
constexpr size_t O_DCT = O_Y + (size_t)2 * MG * 512 * 2;
constexpr size_t O_BAR = O_Y + (size_t)3 * MG * 512 * 2;
constexpr size_t WS_NEED = O_BAR + 16384;
static_assert((size_t)BG * 4 * 16 * 16384 * 2 == (size_t)MG * 512 * 2, "DCT overlays Y2; CT overlays KT");
static_assert((size_t)MG * FF * 2 <= (size_t)MG * LDU * 2, "ACT overlays U");

struct KP { const float* in[19]; float* out; unsigned char* ws; int ph_lo, ph_hi; };

__device__ __forceinline__ float wave_sum(float v) {
#pragma unroll
    for (int o = 1; o < 64; o <<= 1) v += __shfl_xor(v, o);
    return v;
}
__device__ __forceinline__ float logsig(float x) { return fminf(x, 0.f) - log1pf(__expf(-fabsf(x))); }
#define LDSW() asm volatile("s_waitcnt lgkmcnt(0)" ::: "memory")

__device__ __forceinline__ int win_srccol(int n) {
    if (n < 1536) return n; if (n < 3840) return n + 8; if (n < 7424) return n + 16; if (n < 7432) return n - 7424 + 1536; if (n < 7440) return n - 7432 + 3848; return -1;
}
template <bool REMAP>
__device__ __forceinline__ void tr_item(const float* W, int K, int N, const float* kscale, bf16_t* WT, int item, int nblk, LAS float* scr, int lane) {
    const int kb = item / nblk, nb = item % nblk, k0 = 64 * kb, n0 = 32 * nb;
    const int nd = n0 + (lane & 31); const int ns = REMAP ? win_srccol(nd) : nd;
#pragma unroll 8
    for (int i = 0; i < 32; ++i) { const int kk = 2 * i + (lane >> 5); float v = 0.f; if (ns >= 0) v = W[(size_t)(k0 + kk) * N + ns]; if (kscale) v *= kscale[k0 + kk]; scr[kk * 33 + (lane & 31)] = v; }
    LDSW();
    const int c = lane & 7;
#pragma unroll
    for (int j = 0; j < 4; ++j) { const int n = (lane >> 3) + 8 * j; const LAS float* s = scr + (8 * c) * 33 + n;
        u32x4 o; o.x = pk2(s[0 * 33], s[1 * 33]); o.y = pk2(s[2 * 33], s[3 * 33]); o.z = pk2(s[4 * 33], s[5 * 33]); o.w = pk2(s[6 * 33], s[7 * 33]);
        *(u32x4*)(WT + (size_t)(n0 + n) * K + k0 + 8 * c) = o; }
    LDSW();
}
__device__ __forceinline__ void phase_p0(const KP& p, unsigned char* ws, LAS unsigned char* lds, int gw, int NWV, int wave, int lane) {
    LAS float* scr = (LAS float*)(lds + wave * 16384);
    const float *norm_mix = p.in[1], *w_in = p.in[2], *w_branch = p.in[14], *w_out = p.in[15], *norm_mlp = p.in[16], *w_up = p.in[17], *w_down = p.in[18];
    constexpr int PER = 3840 + 768 + 512 + 2048 + 2048;
    for (int it = gw; it < DEPTH * PER; it += NWV) {
        const int l = it / PER; int r = it % PER;
        if (r < 3840) { tr_item<true>(w_in + (size_t)l * DM * INW, DM, INW, norm_mix + l * DM, (bf16_t*)(ws + O_WIN) + (size_t)l * NINP * DM, r, 240, scr, lane); continue; } r -= 3840;
        if (r < 768) { const int b = r / 256; tr_item<false>(w_branch + (size_t)(l * 3 + b) * 512 * DM, 512, DM, nullptr, (bf16_t*)(ws + O_WB) + (size_t)(l * 3 + b) * DM * 512, r % 256, 32, scr, lane); continue; } r -= 768;
        if (r < 512) { tr_item<false>(w_out + (size_t)l * DM * DM, DM, DM, nullptr, (bf16_t*)(ws + O_WOUT) + (size_t)l * DM * DM, r, 32, scr, lane); continue; } r -= 512;
        if (r < 2048) { tr_item<false>(w_up + (size_t)l * DM * FF, DM, FF, norm_mlp + l * DM, (bf16_t*)(ws + O_WUP) + (size_t)l * FF * DM, r, 128, scr, lane); continue; } r -= 2048;
        tr_item<false>(w_down + (size_t)l * FF * DM, FF, DM, nullptr, (bf16_t*)(ws + O_WDN) + (size_t)l * DM * FF, r, 32, scr, lane);
    }
    { float* par = (float*)(ws + O_PAR); const int t0 = gw * 64 + lane, ts = NWV * 64;
      for (int e = t0; e < 16; e += ts) { par[PAR_FFB + e] = p.in[3][e]; par[PAR_SINK + e] = p.in[8][e]; }
      for (int e = t0; e < 128; e += ts) { par[PAR_FQN + e] = p.in[4][e]; par[PAR_FKN + e] = p.in[5][e]; par[PAR_SQN + e] = p.in[6][e]; par[PAR_SKN + e] = p.in[7][e]; }
      for (int e = t0; e < 8192; e += ts) par[PAR_CW + e] = p.in[9][e];
      for (int e = t0; e < 2048; e += ts) par[PAR_CB + e] = p.in[10][e];
      for (int e = t0; e < 8; e += ts) { par[PAR_IB + e] = p.in[11][e]; par[PAR_FB + e] = p.in[12][e]; }
      for (int e = t0; e < 1024; e += ts) par[PAR_ON + e] = p.in[13][e]; }
    float* rope = (float*)(ws + O_ROPE);
    for (int e = gw * 64 + lane; e < SEQ * 32; e += NWV * 64) {
        const int pos = e >> 5, i = e & 31;
        const float inv = powf(10000.f, -(float)(2 * i) / 64.f), ang = (float)pos * inv;
        rope[2 * e] = cosf(ang); rope[2 * e + 1] = sinf(ang);
    }
}
__device__ __forceinline__ void phase_x0(const float* x, bf16_t* XB, float* RS, int gw, int NWV, int lane) {
    for (int row = gw; row < MG; row += NWV) {
        const f32x4* xr = (const f32x4*)(x + (size_t)row * DM) + lane;
        f32x4 v[4]; float s = 0.f;
#pragma unroll
        for (int j = 0; j < 4; ++j) { v[j] = xr[64 * j]; s += (v[j][0] * v[j][0] + v[j][1] * v[j][1]) + (v[j][2] * v[j][2] + v[j][3] * v[j][3]); }
        s = wave_sum(s);
        u32x2* o = (u32x2*)(XB + (size_t)row * DM) + lane;
#pragma unroll
        for (int j = 0; j < 4; ++j) { u32x2 w; w.x = pk2(v[j][0], v[j][1]); w.y = pk2(v[j][2], v[j][3]); o[64 * j] = w; }
        if (lane < 16) RS[(size_t)row * 16 + lane] = (lane == 0) ? s : 0.f;
    }
}
__device__ __forceinline__ void gate_scan_item(unsigned char* ws, int l, int it, int lane) {
    const float* par = (const float*)(ws + O_PAR); const float* SG = (const float*)(ws + O_SG);
    if (it < BG * 8) {
        const int b = it >> 3, h = it & 7; const float bias = par[PAR_FFB + l * 8 + h];
        const float* src = SG + ((size_t)b * SEQ + lane * 32) * 16 + h;
        float tot = 0.f;
#pragma unroll 4
        for (int j = 0; j < 32; ++j) tot += logsig(src[j * 16] + bias);
        float x = tot;
#pragma unroll
        for (int o = 1; o < 64; o <<= 1) { const float y = __shfl_up(x, o); if (lane >= o) x += y; }
        float run = x - tot;
        float* dst = (float*)(ws + O_FC) + (size_t)it * SEQ + lane * 32;
#pragma unroll 4
        for (int j = 0; j < 32; ++j) { run += logsig(src[j * 16] + bias); dst[j] = run * LOG2E; }
    } else {
        const int sq = it - BG * 8, b = sq >> 2, h = sq & 3;
        const float ibias = par[PAR_IB + l * 4 + h], fbias = par[PAR_FB + l * 4 + h];
        float* MP = (float*)(ws + O_MP) + (size_t)sq * SEQ; float* ME = (float*)(ws + O_ME) + (size_t)sq * SEQ; float* MBT = (float*)(ws + O_MBT) + (size_t)sq * SEQ;
        float* MCH = (float*)(ws + O_MCH) + (size_t)sq * 64;
        float mc = 0.f;
#pragma unroll 1
        for (int c = 0; c < 16; ++c) {
            const float* s0 = SG + ((size_t)b * SEQ + c * 128 + 2 * lane) * 16;
            const float f0 = logsig(s0[12 + h] + fbias), f1 = logsig(s0[16 + 12 + h] + fbias);
            const float i0 = s0[8 + h] + ibias, i1 = s0[16 + 8 + h] + ibias;
            float x = f0 + f1;
#pragma unroll
            for (int o = 1; o < 64; o <<= 1) { const float y = __shfl_up(x, o); if (lane >= o) x += y; }
            const float b1 = x, b0 = x - f1;
            const float p0 = i0 - b0, p1 = i1 - b1;
            float mxs = fmaxf(p0, p1);
#pragma unroll
            for (int o = 1; o < 64; o <<= 1) { const float y = __shfl_up(mxs, o); if (lane >= o) mxs = fmaxf(mxs, y); }
            float prev = __shfl_up(mxs, 1); if (lane == 0) prev = -INFINITY;
            const float u0 = fmaxf(prev, p0), u1 = mxs;
            const float e0 = fmaxf(mc, u0), e1 = fmaxf(mc, u1);
            const int t = c * 128 + 2 * lane;
            *(f32x2*)(MP + t) = (f32x2){p0, p1}; *(f32x2*)(ME + t) = (f32x2){e0, e1}; *(f32x2*)(MBT + t) = (f32x2){b0, b1};
            const float ulast = __shfl(mxs, 63), bL = __shfl(x, 63);
            const float mx = fmaxf(mc, ulast), dec = __expf(mc - mx);
            if (lane == 0) *(f32x4*)(MCH + c * 4) = (f32x4){mc, mx, dec, bL};
            mc = bL + mx;
        }
    }
}
__device__ __forceinline__ void headnorm_item(unsigned char* ws, int l, int kind, int item, int lane) {
    const float* par = (const float*)(ws + O_PAR);
    const int c = lane & 7;
    int srccol, dpitch, tstep, tok0, tsub; bf16_t* dbase; const float* w; float scale;
    if (kind == 0) { srccol = UC_FQ + lane * 8; dbase = (bf16_t*)(ws + O_FQN) + lane * 8; dpitch = 512; w = par + PAR_FQN + l * 64; scale = 0.125f * LOG2E; tstep = 1; tok0 = item * 8; tsub = 0; }
    else if (kind == 1) { srccol = UC_FK + lane * 8; dbase = (bf16_t*)(ws + O_FKN) + lane * 8; dpitch = 512; w = par + PAR_FKN + l * 64; scale = 1.f; tstep = 1; tok0 = item * 8; tsub = 0; }
    else if (kind == 2) { srccol = UC_SQ + lane * 8; dbase = (bf16_t*)(ws + O_SQR) + lane * 8; dpitch = 512; w = par + PAR_SQN + l * 64; scale = 0.125f * LOG2E; tstep = 1; tok0 = item * 8; tsub = 0; }
    else { srccol = UC_SK + (lane & 15) * 8; dbase = (bf16_t*)(ws + O_SKR) + (lane & 15) * 8; dpitch = 128; w = par + PAR_SKN + l * 64; scale = 1.f; tstep = 4; tok0 = item * 32; tsub = lane >> 4; }
    const bool rp = kind >= 2;
    const f32x4 w0 = *(const f32x4*)(w + 8 * c), w1 = *(const f32x4*)(w + 8 * c + 4);
    const bf16_t* src = (const bf16_t*)(ws + O_U) + (size_t)(tok0 + tsub) * LDU + srccol;
    u32x4 xv[8];
#pragma unroll
    for (int i = 0; i < 8; ++i) xv[i] = *(const u32x4*)(src + (size_t)(i * tstep) * LDU);
#pragma unroll
    for (int i = 0; i < 8; ++i) {
        const int tok = tok0 + tsub + i * tstep;
        float x[8] = {bflo(xv[i].x), bfhi(xv[i].x), bflo(xv[i].y), bfhi(xv[i].y), bflo(xv[i].z), bfhi(xv[i].z), bflo(xv[i].w), bfhi(xv[i].w)};
        float ss = ((x[0] * x[0] + x[1] * x[1]) + (x[2] * x[2] + x[3] * x[3])) + ((x[4] * x[4] + x[5] * x[5]) + (x[6] * x[6] + x[7] * x[7]));
        ss += __shfl_xor(ss, 1); ss += __shfl_xor(ss, 2); ss += __shfl_xor(ss, 4);
        const float rn = rsqrtf(ss * (1.f / 64.f) + EPS);
        x[0] *= rn * w0[0]; x[1] *= rn * w0[1]; x[2] *= rn * w0[2]; x[3] *= rn * w0[3]; x[4] *= rn * w1[0]; x[5] *= rn * w1[1]; x[6] *= rn * w1[2]; x[7] *= rn * w1[3];
        if (rp) {
            const float* rt = (const float*)(ws + O_ROPE) + ((size_t)(tok % SEQ) * 32 + 8 * (c & 3)) * 2;
            const bool second = (c & 4) != 0;
#pragma unroll
            for (int e = 0; e < 8; e += 2) { const f32x4 cs = *(const f32x4*)(rt + 2 * e);
                const float o0 = __shfl_xor(x[e], 4), o1 = __shfl_xor(x[e + 1], 4);
                x[e] = second ? (o0 * cs[1] + x[e] * cs[0]) : (x[e] * cs[0] - o0 * cs[1]);
                x[e + 1] = second ? (o1 * cs[3] + x[e + 1] * cs[2]) : (x[e + 1] * cs[2] - o1 * cs[3]); }
        }
        u32x4 o; o.x = pk2(x[0] * scale, x[1] * scale); o.y = pk2(x[2] * scale, x[3] * scale); o.z = pk2(x[4] * scale, x[5] * scale); o.w = pk2(x[6] * scale, x[7] * scale);
        *(u32x4*)(dbase + (size_t)tok * dpitch) = o;
    }
}
__device__ __forceinline__ void stream_item(unsigned char* ws, int l, int item, int lane) {
    const int cb = item % 34, tb = item / 34, tok0 = tb * 64, b = tok0 / SEQ, s0 = tok0 % SEQ;
    const int tg = lane >> 3, co = lane & 7;
    const bf16_t* U = (const bf16_t*)(ws + O_U);
    int srccol, chan; bf16_t* dT = nullptr; bf16_t* dN = nullptr; int convch = -1; float oscale = 1.f;
    if (cb < 8) { chan = cb * 64 + co * 8; srccol = UC_FV + chan; dT = (bf16_t*)(ws + O_FVT) + ((size_t)b * 512 + chan) * SEQ; }
    else if (cb < 10) { chan = (cb - 8) * 64 + co * 8; srccol = UC_SV + chan; dT = (bf16_t*)(ws + O_SVT) + ((size_t)b * 128 + chan) * SEQ; }
    else if (cb < 18) { chan = (cb - 10) * 64 + co * 8; srccol = UC_MV + chan; dT = (bf16_t*)(ws + O_MVT) + ((size_t)b * 512 + chan) * SEQ; }
    else if (cb < 26) { chan = (cb - 18) * 64 + co * 8; srccol = UC_MQ + chan; dN = (bf16_t*)(ws + O_MQC) + chan; convch = chan; }
    else { chan = (cb - 26) * 64 + co * 8; srccol = UC_MK + chan; dN = (bf16_t*)(ws + O_MKC) + chan; dT = (bf16_t*)(ws + O_KT) + ((size_t)b * 512 + chan) * SEQ; convch = 512 + chan; oscale = 0.08838834764831845f; }
    const bf16_t* src = U + (size_t)(tok0 + tg * 8) * LDU + srccol;
    u32x4 R[8];
#pragma unroll
    for (int i = 0; i < 8; ++i) R[i] = *(const u32x4*)(src + (size_t)i * LDU);
    if (cb >= 18) {
        u32x4 H[3];
        const bool has_prev = (s0 + tg * 8) > 0;
#pragma unroll
        for (int i = 0; i < 3; ++i) { H[i] = (u32x4){0u, 0u, 0u, 0u}; if (has_prev) H[i] = *(const u32x4*)(src - (size_t)(3 - i) * LDU); }
        const float* cw = (const float*)(ws + O_PAR) + PAR_CW + l * 4 * 1024 + convch; const float* cbias = (const float*)(ws + O_PAR) + PAR_CB + l * 1024 + convch;
        float wt[4][8], bb[8];
#pragma unroll
        for (int j = 0; j < 4; ++j) { const f32x4 a = *(const f32x4*)(cw + j * 1024), c2 = *(const f32x4*)(cw + j * 1024 + 4);
            wt[j][0] = a[0]; wt[j][1] = a[1]; wt[j][2] = a[2]; wt[j][3] = a[3]; wt[j][4] = c2[0]; wt[j][5] = c2[1]; wt[j][6] = c2[2]; wt[j][7] = c2[3]; }
        { const f32x4 a = *(const f32x4*)cbias, c2 = *(const f32x4*)(cbias + 4); bb[0] = a[0]; bb[1] = a[1]; bb[2] = a[2]; bb[3] = a[3]; bb[4] = c2[0]; bb[5] = c2[1]; bb[6] = c2[2]; bb[7] = c2[3]; }
        float xm3[8], xm2[8], xm1[8];
#define UNPK(dst, v) do { dst[0] = bflo(v.x); dst[1] = bfhi(v.x); dst[2] = bflo(v.y); dst[3] = bfhi(v.y); dst[4] = bflo(v.z); dst[5] = bfhi(v.z); dst[6] = bflo(v.w); dst[7] = bfhi(v.w); } while (0)
        UNPK(xm3, H[0]); UNPK(xm2, H[1]); UNPK(xm1, H[2]);
#pragma unroll
        for (int i = 0; i < 8; ++i) {
            float xc[8], y[8]; UNPK(xc, R[i]);
#pragma unroll
            for (int e = 0; e < 8; ++e) { const float v = bb[e] + wt[0][e] * xm3[e] + wt[1][e] * xm2[e] + wt[2][e] * xm1[e] + wt[3][e] * xc[e]; y[e] = v * sigm(v) * oscale; xm3[e] = xm2[e]; xm2[e] = xm1[e]; xm1[e] = xc[e]; }
            u32x4 o; o.x = pk2(y[0], y[1]); o.y = pk2(y[2], y[3]); o.z = pk2(y[4], y[5]); o.w = pk2(y[6], y[7]);
            R[i] = o;
            *(u32x4*)(dN + (size_t)(tok0 + tg * 8 + i) * 512) = o;
        }
#undef UNPK
    }
    if (dT) {
        bf16_t* dst = dT + s0 + tg * 8;
#pragma unroll
        for (int k = 0; k < 4; ++k) {
            u32x4 lo, hi;
            lo.x = (R[0][k] & 0xffffu) | (R[1][k] << 16); lo.y = (R[2][k] & 0xffffu) | (R[3][k] << 16); lo.z = (R[4][k] & 0xffffu) | (R[5][k] << 16); lo.w = (R[6][k] & 0xffffu) | (R[7][k] << 16);
            hi.x = (R[0][k] >> 16) | (R[1][k] & 0xffff0000u); hi.y = (R[2][k] >> 16) | (R[3][k] & 0xffff0000u); hi.z = (R[4][k] >> 16) | (R[5][k] & 0xffff0000u); hi.w = (R[6][k] >> 16) | (R[7][k] & 0xffff0000u);
            *(u32x4*)(dst + (size_t)(2 * k) * SEQ) = lo; *(u32x4*)(dst + (size_t)(2 * k + 1) * SEQ) = hi;
        }
    }
}
#define MFMA32(a, b, c) __builtin_amdgcn_mfma_f32_32x32x16_bf16((a), (b), (c), 0, 0, 0)
template <bool SWA>
__device__ __forceinline__ void attn_qtile(const bf16_t* __restrict__ Q, const bf16_t* __restrict__ K, int kpitch, const bf16_t* __restrict__ VT,
                                           const float* __restrict__ C, float sink2, bf16_t* __restrict__ Y, int qt, int lane) {
    const int r = lane & 31, hh = lane >> 5;
    const int pr = ((r >> 2) & 1) * 16 + ((r >> 4) & 1) * 8 + ((r >> 3) & 1) * 4 + (r & 3);
    const int q0 = qt * 32;
    bf16x8 qf[4];
#pragma unroll
    for (int st = 0; st < 4; ++st) qf[st] = *(const bf16x8*)(Q + (size_t)(q0 + r) * 512 + 16 * st + 8 * hh);
    float cq = 0.f; if (!SWA) cq = C[q0 + r];
    float m = -1e30f, lsum = 0.f;
    f32x16 o0, o1;
#pragma unroll
    for (int i = 0; i < 16; ++i) { o0[i] = 0.f; o1[i] = 0.f; }
    const int kt_lo = SWA ? (qt > 4 ? qt - 4 : 0) : 0;
#define ATT_LOAD(KF, VF, CK, kt_) do { const int k0_ = (kt_) * 32; \
        _Pragma("unroll") for (int st = 0; st < 4; ++st) KF[st] = *(const bf16x8*)(K + (size_t)(k0_ + pr) * kpitch + 16 * st + 8 * hh); \
        _Pragma("unroll") for (int dh = 0; dh < 2; ++dh) _Pragma("unroll") for (int s2 = 0; s2 < 2; ++s2) VF[dh][s2] = *(const bf16x8*)(VT + (size_t)(dh * 32 + r) * SEQ + k0_ + 16 * hh + 8 * s2); \
        if (!SWA) { _Pragma("unroll") for (int g = 0; g < 4; ++g) CK[g] = *(const f32x4*)(C + k0_ + 16 * hh + 4 * g); } } while (0)
    bf16x8 kfn[4], vfn[2][2]; f32x4 ckn[4];
#pragma unroll
    for (int g = 0; g < 4; ++g) ckn[g] = (f32x4){0.f, 0.f, 0.f, 0.f};
    ATT_LOAD(kfn, vfn, ckn, kt_lo);
    for (int kt = kt_lo; kt <= qt; ++kt) {
        bf16x8 kf[4], vf[2][2]; f32x4 ckc[4];
#pragma unroll
        for (int st = 0; st < 4; ++st) kf[st] = kfn[st];
#pragma unroll
        for (int dh = 0; dh < 2; ++dh) { vf[dh][0] = vfn[dh][0]; vf[dh][1] = vfn[dh][1]; }
#pragma unroll
        for (int g = 0; g < 4; ++g) ckc[g] = ckn[g];
        if (kt < qt) ATT_LOAD(kfn, vfn, ckn, kt + 1);
        f32x16 sc;
#pragma unroll
        for (int i = 0; i < 16; ++i) sc[i] = 0.f;
#pragma unroll
        for (int st = 0; st < 4; ++st) sc = MFMA32(kf[st], qf[st], sc);
        if (!SWA) {
#pragma unroll
            for (int g = 0; g < 4; ++g) { const f32x4 ck = ckc[g];
#pragma unroll
                for (int e = 0; e < 4; ++e) sc[4 * g + e] += cq - ck[e]; }
        }
        if (kt == qt) {
#pragma unroll
            for (int i = 0; i < 16; ++i) if (16 * hh + i > r) sc[i] = -INFINITY;
        }
        if (SWA && kt == qt - 4) {
#pragma unroll
            for (int i = 0; i < 16; ++i) if (16 * hh + i <= r) sc[i] = -INFINITY;
        }
        float tm = sc[0];
#pragma unroll
        for (int i = 1; i < 16; ++i) tm = fmaxf(tm, sc[i]);
        tm = fmaxf(tm, __shfl_xor(tm, 32));
        const float mn = fmaxf(m, tm), alpha = __builtin_amdgcn_exp2f(m - mn);
        m = mn;
        float ps = 0.f;
#pragma unroll
        for (int i = 0; i < 16; ++i) { sc[i] = __builtin_amdgcn_exp2f(sc[i] - mn); ps += sc[i]; }
        lsum = lsum * alpha + ps;
#pragma unroll
        for (int i = 0; i < 16; ++i) { o0[i] *= alpha; o1[i] *= alpha; }
        u32x4 pw0, pw1;
        pw0.x = pk2(sc[0], sc[1]); pw0.y = pk2(sc[2], sc[3]); pw0.z = pk2(sc[4], sc[5]); pw0.w = pk2(sc[6], sc[7]);
        pw1.x = pk2(sc[8], sc[9]); pw1.y = pk2(sc[10], sc[11]); pw1.z = pk2(sc[12], sc[13]); pw1.w = pk2(sc[14], sc[15]);
        const bf16x8 pf0 = __builtin_bit_cast(bf16x8, pw0), pf1 = __builtin_bit_cast(bf16x8, pw1);
        o0 = MFMA32(vf[0][0], pf0, o0); o0 = MFMA32(vf[0][1], pf1, o0);
        o1 = MFMA32(vf[1][0], pf0, o1); o1 = MFMA32(vf[1][1], pf1, o1);
    }
    float lt = lsum + __shfl_xor(lsum, 32);
    if (SWA) lt += __builtin_amdgcn_exp2f(sink2 - m);
    const float inv = 1.f / lt;
    bf16_t* yrow = Y + (size_t)(q0 + r) * 512 + 4 * hh;
#pragma unroll
    for (int g = 0; g < 4; ++g) {
        u32x2 a, c;
        a.x = pk2(o0[4 * g] * inv, o0[4 * g + 1] * inv); a.y = pk2(o0[4 * g + 2] * inv, o0[4 * g + 3] * inv);
        c.x = pk2(o1[4 * g] * inv, o1[4 * g + 1] * inv); c.y = pk2(o1[4 * g + 2] * inv, o1[4 * g + 3] * inv);
        *(u32x2*)(yrow + 8 * g) = a; *(u32x2*)(yrow + 32 + 8 * g) = c;
    }
}
constexpr int AT_SLOT = 10240, AT_K = 0, AT_V = 4608, AT_C = 9728;
template <bool SWA>
__device__ __forceinline__ void attn_compute(const LAS unsigned char* sl, const bf16x8 (&qf)[4], float cq, float& m, float& lsum, f32x16& o0, f32x16& o1,
                                             bool diag, bool wedge, int pr, int r, int hh) {
    bf16x8 kf[4], vf[2][2]; f32x4 ckv[4];
#pragma unroll
    for (int st = 0; st < 4; ++st) kf[st] = *(const LAS bf16x8*)(sl + AT_K + pr * 144 + 32 * st + 16 * hh);
    if (!SWA) {
#pragma unroll
        for (int g = 0; g < 4; ++g) ckv[g] = *(const LAS f32x4*)(sl + AT_C + 64 * hh + 16 * g);
    }
#pragma unroll
    for (int dh = 0; dh < 2; ++dh)
#pragma unroll
        for (int s = 0; s < 2; ++s) vf[dh][s] = *(const LAS bf16x8*)(sl + AT_V + (dh * 32 + r) * 80 + 32 * hh + 16 * s);
    __builtin_amdgcn_sched_barrier(0);
    f32x16 sc;
#pragma unroll
    for (int i = 0; i < 16; ++i) sc[i] = 0.f;
#pragma unroll
    for (int st = 0; st < 4; ++st) sc = MFMA32(kf[st], qf[st], sc);
    if (!SWA) {
#pragma unroll
        for (int g = 0; g < 4; ++g)
#pragma unroll
            for (int e = 0; e < 4; ++e) sc[4 * g + e] += cq - ckv[g][e];
    }
    if (diag) {
#pragma unroll
        for (int i = 0; i < 16; ++i) if (16 * hh + i > r) sc[i] = -INFINITY;
    }
    if (SWA && wedge) {
#pragma unroll
        for (int i = 0; i < 16; ++i) if (16 * hh + i <= r) sc[i] = -INFINITY;
    }
    float tm = sc[0];
#pragma unroll
    for (int i = 1; i < 16; ++i) tm = fmaxf(tm, sc[i]);
    tm = fmaxf(tm, __shfl_xor(tm, 32));
    if (__any(tm > m)) {
        const float mn = fmaxf(m, tm), alpha = __builtin_amdgcn_exp2f(m - mn);
        m = mn; lsum *= alpha;
#pragma unroll
        for (int i = 0; i < 16; ++i) { o0[i] *= alpha; o1[i] *= alpha; }
    }
    float ps = 0.f;
#pragma unroll
    for (int i = 0; i < 16; ++i) { sc[i] = __builtin_amdgcn_exp2f(sc[i] - m); ps += sc[i]; }
    lsum += ps;
    u32x4 pw0, pw1;
    pw0.x = pk2(sc[0], sc[1]); pw0.y = pk2(sc[2], sc[3]); pw0.z = pk2(sc[4], sc[5]); pw0.w = pk2(sc[6], sc[7]);
    pw1.x = pk2(sc[8], sc[9]); pw1.y = pk2(sc[10], sc[11]); pw1.z = pk2(sc[12], sc[13]); pw1.w = pk2(sc[14], sc[15]);
    const bf16x8 pf0 = __builtin_bit_cast(bf16x8, pw0), pf1 = __builtin_bit_cast(bf16x8, pw1);
    o0 = MFMA32(vf[0][0], pf0, o0); o0 = MFMA32(vf[0][1], pf1, o0);
    o1 = MFMA32(vf[1][0], pf0, o1); o1 = MFMA32(vf[1][1], pf1, o1);
}
template <bool SWA>
__device__ __forceinline__ void attn_block(LAS unsigned char* lds, const bf16_t* __restrict__ Q, const bf16_t* __restrict__ K, int kpitch, const bf16_t* __restrict__ VT,
                                           const float* __restrict__ C, float sink2, bf16_t* __restrict__ Y, int qt, int t_lo, int t_hi, int wave, int lane) {
    const int r = lane & 31, hh = lane >> 5;
    const int pr = ((r >> 2) & 1) * 16 + ((r >> 4) & 1) * 8 + ((r >> 3) & 1) * 4 + (r & 3);
    const int q0 = qt * 32;
    const bool isK = wave < 4; const int chunk = (wave & 3) * 64 + lane;
    const bf16_t* gsrc = isK ? K + (size_t)(chunk >> 3) * kpitch + (chunk & 7) * 8 : VT + (size_t)(chunk >> 2) * SEQ + (chunk & 3) * 8;
    const int gstep = isK ? 32 * kpitch : 32;
    const int ldst = isK ? AT_K + (chunk >> 3) * 144 + (chunk & 7) * 16 : AT_V + (chunk >> 2) * 80 + (chunk & 3) * 16;
    const bool doC = !SWA && wave == 0 && lane < 8;
#define AB_LD(t_) (*(const u32x4*)(gsrc + (size_t)((t_) < t_hi ? (t_) : t_hi) * gstep))
#define AB_LDC(t_) (*(const u32x4*)(C + ((t_) < t_hi ? (t_) : t_hi) * 32 + lane * 4))
#define AB_WR(slot_, v_, c_) do { LAS unsigned char* sl_ = lds + (slot_) * AT_SLOT; *(LAS u32x4*)(sl_ + ldst) = (v_); if (doC) *(LAS u32x4*)(sl_ + AT_C + lane * 16) = (c_); } while (0)
    u32x4 R0 = AB_LD(t_lo), R1 = AB_LD(t_lo + 1), R2 = AB_LD(t_lo + 2);
    u32x4 C0 = {0u, 0u, 0u, 0u}, C1 = C0, C2 = C0;
    if (doC) { C0 = AB_LDC(t_lo); C1 = AB_LDC(t_lo + 1); C2 = AB_LDC(t_lo + 2); }
    bf16x8 qf[4];
#pragma unroll
    for (int st = 0; st < 4; ++st) qf[st] = *(const bf16x8*)(Q + (size_t)(q0 + r) * 512 + 16 * st + 8 * hh);
    float cq = 0.f; if (!SWA) cq = C[q0 + r];
    float m = -1e30f, lsum = 0.f;
    f32x16 o0, o1;
#pragma unroll
    for (int i = 0; i < 16; ++i) { o0[i] = 0.f; o1[i] = 0.f; }
    AB_WR(0, R0, C0);
#define AB_ITER(t_, RL, CL, RW, CW, SLOT_CUR, SLOT_NEXT) do { \
        RL = AB_LD((t_) + 3); if (doC) CL = AB_LDC((t_) + 3); \
        if ((t_) + 1 <= t_hi) AB_WR(SLOT_NEXT, RW, CW); \
        __syncthreads(); \
        const bool active_ = SWA ? ((t_) <= qt && (t_) >= qt - 4) : ((t_) <= qt); \
        if (active_) attn_compute<SWA>(lds + (SLOT_CUR) * AT_SLOT, qf, cq, m, lsum, o0, o1, (t_) == qt, (t_) == qt - 4, pr, r, hh); \
    } while (0)
    for (int t = t_lo; t <= t_hi; t += 3) {
        AB_ITER(t, R0, C0, R1, C1, 0, 1);
        if (t + 1 > t_hi) break;
        AB_ITER(t + 1, R1, C1, R2, C2, 1, 2);
        if (t + 2 > t_hi) break;
        AB_ITER(t + 2, R2, C2, R0, C0, 2, 0);
    }
    __syncthreads();
#undef AB_ITER
#undef AB_LD
#undef AB_LDC
#undef AB_WR
    float lt = lsum + __shfl_xor(lsum, 32);
    if (SWA) lt += __builtin_amdgcn_exp2f(sink2 - m);
    const float inv = 1.f / lt;
    bf16_t* yrow = Y + (size_t)(q0 + r) * 512 + 4 * hh;
#pragma unroll
    for (int g = 0; g < 4; ++g) {
        u32x2 a, c;
        a.x = pk2(o0[4 * g] * inv, o0[4 * g + 1] * inv); a.y = pk2(o0[4 * g + 2] * inv, o0[4 * g + 3] * inv);
        c.x = pk2(o1[4 * g] * inv, o1[4 * g + 1] * inv); c.y = pk2(o1[4 * g + 2] * inv, o1[4 * g + 3] * inv);
        *(u32x2*)(yrow + 8 * g) = a; *(u32x2*)(yrow + 32 + 8 * g) = c;
    }
}
__device__ __forceinline__ void m1_item(unsigned char* ws, int it, int lane) {
    const int r = lane & 31, hh = lane >> 5;
    const int dvt = it & 3, c = (it >> 2) & 15, bh = it >> 6;
    const bf16_t* VTp = (const bf16_t*)(ws + O_MVT) + ((size_t)bh * 128 + dvt * 32 + r) * SEQ + c * 128 + 8 * hh;
    const bf16_t* KTp = (const bf16_t*)(ws + O_KT) + ((size_t)bh * 128 + r) * SEQ + c * 128 + 8 * hh;
    const float* MPp = (const float*)(ws + O_MP) + (size_t)bh * SEQ + c * 128 + 8 * hh;
    const float mx = ((const float*)(ws + O_MCH))[(bh * 16 + c) * 4 + 1];
    f32x16 acc[4];
#pragma unroll
    for (int d = 0; d < 4; ++d)
#pragma unroll
        for (int i = 0; i < 16; ++i) acc[d][i] = 0.f;
    float dn[4] = {0.f, 0.f, 0.f, 0.f};
#pragma unroll 1
    for (int st = 0; st < 8; ++st) {
        const bf16x8 vf = *(const bf16x8*)(VTp + 16 * st);
        const f32x4 pa = *(const f32x4*)(MPp + 16 * st), pb = *(const f32x4*)(MPp + 16 * st + 4);
        float wk[8];
#pragma unroll
        for (int e = 0; e < 4; ++e) { wk[e] = __expf(pa[e] - mx); wk[4 + e] = __expf(pb[e] - mx); }
#pragma unroll
        for (int d = 0; d < 4; ++d) {
            const u32x4 kr = *(const u32x4*)(KTp + (size_t)d * 32 * SEQ + 16 * st);
            const float k0 = bflo(kr.x) * wk[0], k1 = bfhi(kr.x) * wk[1], k2 = bflo(kr.y) * wk[2], k3 = bfhi(kr.y) * wk[3];
            const float k4 = bflo(kr.z) * wk[4], k5 = bfhi(kr.z) * wk[5], k6 = bflo(kr.w) * wk[6], k7 = bfhi(kr.w) * wk[7];
            dn[d] += ((k0 + k1) + (k2 + k3)) + ((k4 + k5) + (k6 + k7));
            u32x4 kw; kw.x = pk2(k0, k1); kw.y = pk2(k2, k3); kw.z = pk2(k4, k5); kw.w = pk2(k6, k7);
            acc[d] = MFMA32(vf, __builtin_bit_cast(bf16x8, kw), acc[d]);
        }
    }
    bf16_t* DCT = (bf16_t*)(ws + O_DCT) + (size_t)(bh * 16 + c) * 16384;
#pragma unroll
    for (int d = 0; d < 4; ++d) {
#pragma unroll
        for (int g4 = 0; g4 < 4; ++g4) { int og = (dvt * 32 + 8 * g4 + 4 * hh) * 128 + d * 32 + r; asm volatile("" : "+v"(og)); bf16_t* pg = DCT + og;
            pg[0] = (bf16_t)pk2(acc[d][4 * g4], 0.f); pg[128] = (bf16_t)pk2(acc[d][4 * g4 + 1], 0.f); pg[256] = (bf16_t)pk2(acc[d][4 * g4 + 2], 0.f); pg[384] = (bf16_t)pk2(acc[d][4 * g4 + 3], 0.f); }
        const float t = dn[d] + __shfl_xor(dn[d], 32);
        if (dvt == 0 && hh == 0) ((float*)(ws + O_DN))[(bh * 16 + c) * 128 + d * 32 + r] = t;
    }
}
__device__ __forceinline__ void phase_m2(unsigned char* ws, int gtid, int NT) {
    const float* MCH = (const float*)(ws + O_MCH);
    for (int e = gtid; e < BG * 4 * 2048; e += NT) {
        const int bh = e >> 11, pp = e & 2047;
        const bf16_t* src = (const bf16_t*)(ws + O_DCT) + (size_t)bh * 16 * 16384 + 8 * pp;
        bf16_t* dst = (bf16_t*)(ws + O_CT) + (size_t)bh * 16 * 16384 + 8 * pp;
        u32x4 d[15]; float dec[15];
#pragma unroll
        for (int c = 0; c < 15; ++c) { d[c] = *(const u32x4*)(src + (size_t)c * 16384); dec[c] = MCH[(bh * 16 + c) * 4 + 2]; }
        float cs[8] = {0.f, 0.f, 0.f, 0.f, 0.f, 0.f, 0.f, 0.f};
        *(u32x4*)dst = (u32x4){0u, 0u, 0u, 0u};
#pragma unroll
        for (int c = 0; c < 15; ++c) {
            cs[0] = dec[c] * cs[0] + bflo(d[c].x); cs[1] = dec[c] * cs[1] + bfhi(d[c].x); cs[2] = dec[c] * cs[2] + bflo(d[c].y); cs[3] = dec[c] * cs[3] + bfhi(d[c].y);
            cs[4] = dec[c] * cs[4] + bflo(d[c].z); cs[5] = dec[c] * cs[5] + bfhi(d[c].z); cs[6] = dec[c] * cs[6] + bflo(d[c].w); cs[7] = dec[c] * cs[7] + bfhi(d[c].w);
            u32x4 o; o.x = pk2(cs[0], cs[1]); o.y = pk2(cs[2], cs[3]); o.z = pk2(cs[4], cs[5]); o.w = pk2(cs[6], cs[7]);
            *(u32x4*)(dst + (size_t)(c + 1) * 16384) = o;
        }
    }
    for (int e = gtid; e < BG * 4 * 128; e += NT) {
        const int bh = e >> 7, dk = e & 127; float n = 0.f;
        for (int c = 0; c < 16; ++c) { const size_t off = (size_t)(bh * 16 + c) * 128 + dk; ((float*)(ws + O_NN))[off] = n; n = MCH[(bh * 16 + c) * 4 + 2] * n + ((const float*)(ws + O_DN))[off]; }
    }
}
__device__ __forceinline__ void m3_item(unsigned char* ws, int l, int it, int lane) {
    const int r = lane & 31, hh = lane >> 5;
    const int pr = ((r >> 2) & 1) * 16 + ((r >> 4) & 1) * 8 + ((r >> 3) & 1) * 4 + (r & 3);
    const int tt = 3 - (it & 3), c = (it >> 2) & 15, bh = it >> 6, b = bh >> 2, h = bh & 3;
    const int ts = c * 128 + tt * 32 + r;
    const size_t trow = (size_t)b * SEQ + ts;
    bf16x8 qf[8];
    const bf16_t* Qp = (const bf16_t*)(ws + O_MQC) + trow * 512 + h * 128 + 8 * hh;
#pragma unroll
    for (int k = 0; k < 8; ++k) qf[k] = *(const bf16x8*)(Qp + 16 * k);
    const float Et = ((const float*)(ws + O_ME))[(size_t)bh * SEQ + ts], bt = ((const float*)(ws + O_MBT))[(size_t)bh * SEQ + ts];
    const float mc = ((const float*)(ws + O_MCH))[(bh * 16 + c) * 4];
    const float winter = __expf(mc - Et);
    f32x16 acc[4];
#pragma unroll
    for (int d = 0; d < 4; ++d)
#pragma unroll
        for (int i = 0; i < 16; ++i) acc[d][i] = 0.f;
    const bf16_t* CTp = (const bf16_t*)(ws + O_CT) + (size_t)(bh * 16 + c) * 16384 + (size_t)r * 128 + 8 * hh;
    const float* NNp = (const float*)(ws + O_NN) + (size_t)(bh * 16 + c) * 128 + 8 * hh;
    float qn = 0.f;
#pragma unroll
    for (int k = 0; k < 8; ++k) {
#pragma unroll
        for (int d = 0; d < 4; ++d) acc[d] = MFMA32(*(const bf16x8*)(CTp + (size_t)d * 32 * 128 + 16 * k), qf[k], acc[d]);
        const f32x4 na = *(const f32x4*)(NNp + 16 * k), nb = *(const f32x4*)(NNp + 16 * k + 4);
        const u32x4 qw = __builtin_bit_cast(u32x4, qf[k]);
        qn += bflo(qw.x) * na[0] + bfhi(qw.x) * na[1] + bflo(qw.y) * na[2] + bfhi(qw.y) * na[3] + bflo(qw.z) * nb[0] + bfhi(qw.z) * nb[1] + bflo(qw.w) * nb[2] + bfhi(qw.w) * nb[3];
        asm volatile("" ::: "memory");
    }
    qn += __shfl_xor(qn, 32);
#pragma unroll
    for (int d = 0; d < 4; ++d)
#pragma unroll
        for (int i = 0; i < 16; ++i) acc[d][i] *= winter;
    float dpart = 0.f;
    const bf16_t* Kb = (const bf16_t*)(ws + O_MKC) + ((size_t)b * SEQ + c * 128 + pr) * 512 + h * 128 + 8 * hh;
    const bf16_t* Vb = (const bf16_t*)(ws + O_MVT) + ((size_t)bh * 128 + r) * SEQ + c * 128 + 16 * hh;
    const float* MPb = (const float*)(ws + O_MP) + (size_t)bh * SEQ + c * 128 + 16 * hh;
    for (int st = 0; st <= tt; ++st) {
        f32x16 sc;
#pragma unroll
        for (int i = 0; i < 16; ++i) sc[i] = 0.f;
#pragma unroll
        for (int k = 0; k < 8; ++k) { sc = MFMA32(*(const bf16x8*)(Kb + (size_t)st * 32 * 512 + 16 * k), qf[k], sc); if (k == 3) asm volatile("" ::: "memory"); }
        asm volatile("" ::: "memory");
#pragma unroll
        for (int g = 0; g < 4; ++g) { const f32x4 pv = *(const f32x4*)(MPb + st * 32 + 4 * g);
#pragma unroll
            for (int e = 0; e < 4; ++e) { const int i = 4 * g + e;
                const bool ok = (st < tt) || (16 * hh + i <= r);
                const float w = ok ? __expf(pv[e] - Et) : 0.f;
                sc[i] = ok ? sc[i] * w : 0.f; dpart += sc[i]; } }
        u32x4 pw0, pw1;
        pw0.x = pk2(sc[0], sc[1]); pw0.y = pk2(sc[2], sc[3]); pw0.z = pk2(sc[4], sc[5]); pw0.w = pk2(sc[6], sc[7]);
        pw1.x = pk2(sc[8], sc[9]); pw1.y = pk2(sc[10], sc[11]); pw1.z = pk2(sc[12], sc[13]); pw1.w = pk2(sc[14], sc[15]);
        const bf16x8 pf0 = __builtin_bit_cast(bf16x8, pw0), pf1 = __builtin_bit_cast(bf16x8, pw1);
#pragma unroll
        for (int d = 0; d < 4; ++d) {
            acc[d] = MFMA32(*(const bf16x8*)(Vb + (size_t)d * 32 * SEQ + st * 32), pf0, acc[d]);
            acc[d] = MFMA32(*(const bf16x8*)(Vb + (size_t)d * 32 * SEQ + st * 32 + 8), pf1, acc[d]);
            if (d == 1) asm volatile("" ::: "memory");
        }
    }
    const float den = winter * qn + (dpart + __shfl_xor(dpart, 32));
    const float dinv = 1.f / fmaxf(fabsf(den), __expf(-(bt + Et)));
    float ss = 0.f;
#pragma unroll
    for (int d = 0; d < 4; ++d)
#pragma unroll
        for (int i = 0; i < 16; ++i) { acc[d][i] *= dinv; ss += acc[d][i] * acc[d][i]; }
    ss += __shfl_xor(ss, 32);
    const float rn = rsqrtf(ss * (1.f / 128.f) + EPS);
    const float* onorm = (const float*)(ws + O_PAR) + PAR_ON + l * 512 + h * 128 + 4 * hh;
    const bf16_t* mo = (const bf16_t*)(ws + O_U) + trow * LDU + UC_MO + h * 128 + 4 * hh;
    bf16_t* y = (bf16_t*)(ws + O_Y) + (size_t)2 * MG * 512 + trow * 512 + h * 128 + 4 * hh;
#pragma unroll
    for (int d = 0; d < 4; ++d)
#pragma unroll
        for (int g = 0; g < 4; ++g) {
            const int dv = d * 32 + 8 * g;
            const f32x4 wn = *(const f32x4*)(onorm + dv); const u32x2 og = *(const u32x2*)(mo + dv);
            const float y0 = acc[d][4 * g] * rn * wn[0] * sigm(bflo(og.x)), y1 = acc[d][4 * g + 1] * rn * wn[1] * sigm(bfhi(og.x));
            const float y2 = acc[d][4 * g + 2] * rn * wn[2] * sigm(bflo(og.y)), y3 = acc[d][4 * g + 3] * rn * wn[3] * sigm(bfhi(og.y));
            u32x2 o; o.x = pk2(y0, y1); o.y = pk2(y2, y3); *(u32x2*)(y + dv) = o;
            if (g & 1) asm volatile("" ::: "memory");
        }
}

#define XB_TMO      128
#define XB_XCNT(j)  (256  + 64 * (j))
#define XB_XSUB(j)  (1280 + 64 * (j))
#define XB_XGEN(j)  (2304 + 64 * (j))
#define XB_TOP      3328
#define XB_TOPGEN   3392
#define XCD_BAR_WORDS 3456
#define XB_SPIN_CAP (1u << 18)

__device__ __forceinline__ unsigned xb_ld(unsigned* p)              { return __hip_atomic_load(p, __ATOMIC_RELAXED, __HIP_MEMORY_SCOPE_AGENT); }
__device__ __forceinline__ unsigned xb_add(unsigned* p, unsigned v) { return __hip_atomic_fetch_add(p, v, __ATOMIC_RELAXED, __HIP_MEMORY_SCOPE_AGENT); }
__device__ __forceinline__ unsigned xb_xcc_id() { return (unsigned)__builtin_amdgcn_s_getreg((3 << 11) | 20) & 0xFu; }
#define XB_SPIN(cond, bar) do { unsigned _sp = 0; while (cond) { __builtin_amdgcn_s_sleep(1); \
    if ((++_sp & 255u) == 0u) { if (xb_ld(&(bar)[XB_TMO])) break; if (_sp > XB_SPIN_CAP) { atomicAdd(&(bar)[XB_TMO], 1u); break; } } } } while (0)

struct XcdBarrier {
    unsigned* bar; unsigned x;
    volatile LAS unsigned* st;
};

__device__ __forceinline__ XcdBarrier xcd_barrier_post(unsigned* bar, volatile LAS unsigned* st) {
    XcdBarrier b; b.bar = bar; b.x = xb_xcc_id(); b.st = st;
    if (threadIdx.x == 0) (void)xb_add(&bar[XB_XCNT(b.x)], 1u);
    return b;
}
__device__ __forceinline__ void xcd_barrier_complete(unsigned* bar, unsigned x, unsigned& nloc, unsigned& nx) {
    const unsigned G = gridDim.x * gridDim.y * gridDim.z;
    unsigned sum, cnt, mine, sp = 0u;
    for (;;) {
        sum = 0u; cnt = 0u; mine = 0u;
#pragma unroll
        for (unsigned j = 0; j < 16; ++j) { const unsigned c = xb_ld(&bar[XB_XCNT(j)]); sum += c; cnt += (c > 0u) ? 1u : 0u; mine = (j == x) ? c : mine; }
        if (sum == G) break;
        __builtin_amdgcn_s_sleep(1);
        if ((++sp & 255u) == 0u) { if (xb_ld(&bar[XB_TMO])) break; if (sp > XB_SPIN_CAP) { atomicAdd(&bar[XB_TMO], 1u); break; } }
    }
    nloc = mine > 0u ? mine : 1u; nx = cnt > 0u ? cnt : 1u;
}

__device__ __forceinline__ void xcd_barrier(const XcdBarrier& b) {
    asm volatile("s_waitcnt vmcnt(0)" ::: "memory");
    __syncthreads();
    if (threadIdx.x == 0) {
        unsigned* bar = b.bar;
        __builtin_amdgcn_s_waitcnt(0);
        unsigned nloc = b.st[0], nx = b.st[1];
        if (nloc == 0u) { xcd_barrier_complete(bar, b.x, nloc, nx); b.st[0] = nloc; b.st[1] = nx; }
        const unsigned old = xb_add(&bar[XB_XSUB(b.x)], 1u);
        const unsigned gen = old / nloc;
        if (old + 1u == (gen + 1u) * nloc) {
            __builtin_amdgcn_fence(__ATOMIC_RELEASE, "agent");
            asm volatile("s_waitcnt vmcnt(0)" ::: "memory");
            const unsigned og = xb_add(&bar[XB_TOP], 1u);
            const unsigned tg = og / nx;
            if (og + 1u == (tg + 1u) * nx) xb_add(&bar[XB_TOPGEN], 1u);
            else XB_SPIN(xb_ld(&bar[XB_TOPGEN]) == tg, bar);
            __builtin_amdgcn_fence(__ATOMIC_ACQUIRE, "agent");
            xb_add(&bar[XB_XGEN(b.x)], 1u);
            asm volatile("s_waitcnt vmcnt(0)" ::: "memory");
        } else {
            XB_SPIN(xb_ld(&bar[XB_XGEN(b.x)]) == gen, bar);
            __builtin_amdgcn_fence(__ATOMIC_ACQUIRE, "agent");
            asm volatile("s_waitcnt vmcnt(0)" ::: "memory");
        }
    }
    __syncthreads();
}


__global__ void __launch_bounds__(NTHR, 2) fwd_kernel(KP p) {
    extern __shared__ __attribute__((aligned(16))) unsigned char lds_raw[];
    LAS unsigned char* lds = (LAS unsigned char*)lds_raw;
    cg::grid_group grid = cg::this_grid();
    const int tid = threadIdx.x, lane0 = tid & 63, wave = __builtin_amdgcn_readfirstlane(tid >> 6);
    const int G = gridDim.x, gw0 = blockIdx.x * NWAVES + wave, NWV = G * NWAVES, NT = G * NTHR;
    unsigned char* ws0 = p.ws;
    volatile LAS unsigned* MISC = (volatile LAS unsigned*)(lds + 131072);
    if (tid < 64) MISC[tid] = 0u;
    __syncthreads();
    XcdBarrier bar = xcd_barrier_post((unsigned*)(ws0 + O_BAR), MISC + 8);
#ifndef PM
#define PM 0xFFFF
#endif
#ifndef PROBE_ID
#define PROBE_ID -1
#define PROBE_REP 1
#endif
#ifndef PM4
#define PM4 7
#endif
#define XB ((bf16_t*)(ws + O_XB))
#define RS ((float*)(ws + O_RS))
#define U ((bf16_t*)(ws + O_U))
    for (int pc = p.ph_lo; pc < p.ph_hi; ++pc) {
        int id = 0, g = 0, l = 0;
        if (pc > 0) { const int q_ = pc - 1, r_ = q_ % (1 + DEPTH * 9); g = q_ / (1 + DEPTH * 9); if (r_ == 0) id = 1; else { l = (r_ - 1) / 9; id = 2 + (r_ - 1) % 9; } }
        const size_t goff = (size_t)g * MG * DM;
        const int nrep = (PROBE_ID == id) ? PROBE_REP : 1;
        for (int rep_ = 0; rep_ < nrep; ++rep_) {
            size_t zo_ = 0; int lane = lane0, gw = gw0; asm volatile("" : "+s"(zo_), "+v"(lane), "+s"(gw));
            unsigned char* ws = p.ws + zo_;
            const int gtid = gw * 64 + lane; (void)gtid;
            if (!((PM >> id) & 1)) continue;
            switch (id) {
    case 0: { phase_p0(p, ws, lds, gw, NWV, wave, lane); } break;

        case 1: { phase_x0(p.in[0] + goff, XB, RS, gw, NWV, lane); } break;
            case 2: { {
                pg8::Gemm gm{XB, (const bf16_t*)(ws + O_WIN) + (size_t)l * NINP * DM, MG, NINP, DM}; pg8::StaticOrder S; S.init(MG, NINP, G, (int)blockIdx.x);
                pg8::EpiA E{0, 0, RS, U, LDU, (float*)(ws + O_SG), nullptr, 0, nullptr};
                pg8::gemm_phase<pg8::EpiA, pg8::StaticOrder, true, true>(lds, gm, S, E);
            } } break;
            case 3: { {
                constexpr int N_SCAN = BG * 12, N_HN3 = 3 * (MG / 8), N_HK = MG / 32, N_ST = 34 * (MG / 64);
                const int sw = (wave == 7 && (int)blockIdx.x < N_SCAN) ? (int)blockIdx.x : -1;
                if (sw >= 0) { for (int it = sw; it < N_SCAN; it += G) gate_scan_item(ws, l, it, lane); }
                else {
                    const int nscanw = (N_SCAN < G ? N_SCAN : G);
                    const int wi = (int)blockIdx.x < nscanw ? (int)blockIdx.x * 7 + wave : nscanw * 7 + ((int)blockIdx.x - nscanw) * 8 + wave;
                    const int nw = NWV - nscanw;
                    for (int it = wi; it < N_HN3 + N_HK + N_ST; it += nw) {
                        if (it < N_HN3) headnorm_item(ws, l, it % 3, it / 3, lane);
                        else if (it < N_HN3 + N_HK) headnorm_item(ws, l, 3, it - N_HN3, lane);
                        else stream_item(ws, l, it - N_HN3 - N_HK, lane);
                    }
                }
            } } break;
            case 4: { {
                if (PM4 & 1) for (int it = gw; it < BG * 4 * 16 * 4; it += NWV) m1_item(ws, it, lane);
                __syncthreads();
                if (PM4 & 2) for (int it = (int)blockIdx.x; it < BG * 8 * 4; it += G) {
                    const int b = it >> 5, h = (it >> 2) & 7, jp = it & 3;
                    const bf16_t* Q = (const bf16_t*)(ws + O_FQN) + (size_t)b * SEQ * 512 + h * 64; const bf16_t* K = (const bf16_t*)(ws + O_FKN) + (size_t)b * SEQ * 512 + h * 64;
                    const bf16_t* VT = (const bf16_t*)(ws + O_FVT) + (size_t)(b * 8 + h) * 64 * SEQ; const float* C = (const float*)(ws + O_FC) + (size_t)(b * 8 + h) * SEQ;
                    bf16_t* Y = (bf16_t*)(ws + O_Y) + (size_t)b * SEQ * 512 + h * 64;
                    attn_block<false>(lds, Q, K, 512, VT, C, 0.f, Y, 8 * (7 - jp) + wave, 0, 8 * (7 - jp) + 7, wave, lane);
                    attn_block<false>(lds, Q, K, 512, VT, C, 0.f, Y, 8 * jp + wave, 0, 8 * jp + 7, wave, lane);
                }
                if (PM4 & 4) for (int it = (int)blockIdx.x; it < BG * 2 * 32; it += G) {
                    const int b = it >> 6, hk = (it >> 5) & 1, u = it & 31, hq = hk * 4 + (wave & 3), qt = 2 * u + (wave >> 2);
                    const bf16_t* Q = (const bf16_t*)(ws + O_SQR) + (size_t)b * SEQ * 512 + hq * 64; const bf16_t* K = (const bf16_t*)(ws + O_SKR) + (size_t)b * SEQ * 128 + hk * 64;
                    const bf16_t* VT = (const bf16_t*)(ws + O_SVT) + (size_t)(b * 2 + hk) * 64 * SEQ;
                    bf16_t* Y = (bf16_t*)(ws + O_Y) + (size_t)MG * 512 + (size_t)b * SEQ * 512 + hq * 64;
                    attn_block<true>(lds, Q, K, 128, VT, nullptr, ((const float*)(ws + O_PAR))[PAR_SINK + l * 8 + hq] * LOG2E, Y, qt, (2 * u > 4 ? 2 * u - 4 : 0), 2 * u + 1, wave, lane);
                }
            } } break;
            case 5: { phase_m2(ws, gtid, NT); } break;
            case 6: { { for (int it = gw; it < BG * 4 * 16 * 4; it += NWV) m3_item(ws, l, it, lane); } } break;
            case 7: { {
                pg8::Gemm gm{(const bf16_t*)(ws + O_Y), (const bf16_t*)(ws + O_WB) + (size_t)l * 3 * DM * 512, 3 * MG, 3 * DM, 512}; pg8::DiagOrder S; S.init(MG, DM, G, (int)blockIdx.x);
                pg8::EpiM E{MG / 256, (bf16_t*)(ws + O_MRG), U + UC_G, LDU, (float*)(ws + O_TMP)};
                pg8::gemm_phase<pg8::EpiM, pg8::DiagOrder, true, true>(lds, gm, S, E);
            } } break;
            case 8: { {
                pg8::Gemm gm{(const bf16_t*)(ws + O_MRG), (const bf16_t*)(ws + O_WOUT) + (size_t)l * DM * DM, MG, DM, DM}; pg8::StaticOrder S; S.init(MG, DM, G, (int)blockIdx.x);
                pg8::EpiB E{(l == 0 ? p.in[0] : (const float*)p.out) + goff, p.out + goff, XB, RS};
                pg8::gemm_phase<pg8::EpiB, pg8::StaticOrder, true, true>(lds, gm, S, E);
            } } break;
            case 9: { {
                pg8::Gemm gm{XB, (const bf16_t*)(ws + O_WUP) + (size_t)l * FF * DM, MG, FF, DM}; pg8::StaticOrder S; S.init(MG, FF, G, (int)blockIdx.x);
                pg8::EpiA E{2, 0, RS, U  , FF, nullptr, nullptr, 0, nullptr};
                pg8::gemm_phase<pg8::EpiA, pg8::StaticOrder, true, true>(lds, gm, S, E);
            } } break;
            case 10: { {
                pg8::Gemm gm{U  , (const bf16_t*)(ws + O_WDN) + (size_t)l * DM * FF, MG, DM, FF}; pg8::StaticOrder S; S.init(MG, DM, G, (int)blockIdx.x);
                pg8::EpiB E{(const float*)p.out + goff, p.out + goff, XB, RS};
                pg8::gemm_phase<pg8::EpiB, pg8::StaticOrder, true, true>(lds, gm, S, E);
            } } break;
            default: break;
            }
        }
        if (pc + 1 < p.ph_hi) { if (pc == 0) grid.sync(); else xcd_barrier(bar); }
    }
}
constexpr int N_PHASES = 1 + NG * (1 + DEPTH * 9);

#ifndef MK_MULTI
#define MK_MULTI 0
#endif
extern "C" void kernel_launch(void* const* d_in, const int* in_sizes, int n_in, void* d_out, int out_size, void* d_ws, size_t ws_size, hipStream_t stream) {
    static int grid = 0;
    if (grid == 0) {
        if (n_in != 19 || out_size != NB * SEQ * DM || ws_size < WS_NEED) { fprintf(stderr, "kernel_launch: unexpected problem (n_in %d out %d ws %zu need %zu)\n", n_in, out_size, ws_size, (size_t)WS_NEED); grid = -1; return; }
        int dev = 0, cus = 0, per_cu = 0;
        hipGetDevice(&dev); hipDeviceGetAttribute(&cus, hipDeviceAttributeMultiprocessorCount, dev);
        if (hipFuncSetAttribute((const void*)fwd_kernel, hipFuncAttributeMaxDynamicSharedMemorySize, LDS_BYTES) != hipSuccess) { fprintf(stderr, "kernel_launch: hipFuncSetAttribute failed\n"); grid = -1; return; }
        hipOccupancyMaxActiveBlocksPerMultiprocessor(&per_cu, (const void*)fwd_kernel, NTHR, LDS_BYTES);
        (void)hipGetLastError();
        if (per_cu < 1) { fprintf(stderr, "kernel_launch: occupancy query says %d blocks per CU\n", per_cu); per_cu = 1; }
        grid = cus;
    }
    if (grid < 0) return;
    if (hipMemsetAsync((char*)d_ws + O_BAR, 0, 16384, stream) != hipSuccess) { fprintf(stderr, "kernel_launch: memset failed\n"); return; }
    KP a{};
    for (int i = 0; i < 19; ++i) a.in[i] = (const float*)d_in[i];
    a.out = (float*)d_out; a.ws = (unsigned char*)d_ws;
#if MK_MULTI
    for (int ph = 0; ph < N_PHASES; ++ph) { a.ph_lo = ph; a.ph_hi = ph + 1; hipLaunchKernelGGL(fwd_kernel, dim3(grid), dim3(NTHR), LDS_BYTES, stream, a); }
#else
    a.ph_lo = 0; a.ph_hi = N_PHASES;
    void* args[] = {&a};
    hipError_t e = hipLaunchCooperativeKernel((const void*)fwd_kernel, dim3(grid), dim3(NTHR), args, LDS_BYTES, stream);
    if (e != hipSuccess) fprintf(stderr, "kernel_launch: cooperative launch failed: %s (grid %d)\n", hipGetErrorString(e), grid);
#endif
}
```

```cpp
#include <hip/hip_runtime.h>
#include <hip/hip_cooperative_groups.h>
#include <cstdio>
#include <cstdint>
#include <cmath>
namespace cg = cooperative_groups;
namespace pg8 {
#define PG8_LAS __attribute__((address_space(3)))
typedef unsigned short bf16_t;
typedef short bf16x8 __attribute__((ext_vector_type(8)));
typedef float f32x4 __attribute__((ext_vector_type(4)));
typedef unsigned u32x4 __attribute__((ext_vector_type(4)));
constexpr int BM = 256, BK = 64, HALF = 128, HTB = HALF * BK * 2  , STAGE_BYTES = 8 * HTB, NXCD = 8, WGM = 8;

__host__ __device__ __forceinline__ int lds_byte(int r, int c) { const int st = (r >> 4) * 2 + (c >> 5), rr = r & 15, cc = c & 31, ob = rr * 64 + cc * 2; return st * 1024 + (ob ^ (((ob >> 9) & 1) << 5)); }
__host__ __device__ __forceinline__ void stage_rc(int b, int& R, int& C) { const int st = b / 1024, sb = b % 1024, swz = sb ^ (((sb >> 9) & 1) << 5); R = (st >> 1) * 16 + swz / 64; C = (st & 1) * 32 + (swz % 64) / 2; }
__host__ __device__ __forceinline__ int perm32(int rho) { const int n = rho >> 4, i = rho & 15; return 8 * (i >> 2) + 4 * n + (i & 3); }

struct Unit { int pm, pn; };
struct Gemm { const bf16_t* A; const bf16_t* Bt; int M, N, K; };

struct StaticOrder {
    int nM, nN, nwg, G, c;
    __host__ __device__ void init(int M, int N, int G_, int c_) { nM = M / BM; nN = N / BM; nwg = nM * nN; G = G_; c = c_; }
    __host__ __device__ bool next(int i, Unit& u) const {
        const long L = (long)i * G + c; if (L >= nwg) return false;
        int wgid = (int)L; { const int q = nwg / NXCD, r = nwg % NXCD, xcd = wgid % NXCD, off = wgid / NXCD; wgid = (xcd < r ? xcd * (q + 1) : r * (q + 1) + (xcd - r) * q) + off; }
        const int nig = WGM * nN, gid = wgid / nig, fm = gid * WGM, gsz = (nM - fm) < WGM ? (nM - fm) : WGM;
        u.pm = fm + ((wgid % nig) % gsz); u.pn = (wgid % nig) / gsz; return true;
    }
    __device__ __forceinline__ void a_ready(const Unit&) const {}
    __device__ __forceinline__ void done(const Unit&) const {}
};


typedef unsigned u32x2 __attribute__((ext_vector_type(2)));
typedef float f32x2_t __attribute__((ext_vector_type(2)));
typedef __bf16 bf16x2_t __attribute__((ext_vector_type(2)));
__device__ __forceinline__ unsigned pk2(float lo, float hi) { f32x2_t v = {lo, hi}; bf16x2_t b = __builtin_convertvector(v, bf16x2_t); return __builtin_bit_cast(unsigned, b); }
__device__ __forceinline__ float bflo(unsigned w) { return __uint_as_float(w << 16); }
__device__ __forceinline__ float bfhi(unsigned w) { return __uint_as_float(w & 0xffff0000u); }
__device__ __forceinline__ float sigm(float x) { return __builtin_amdgcn_rcpf(1.f + __expf(-x)); }
__device__ __forceinline__ float rowscale(const float* rs, int row) {
    const f32x4* p = (const f32x4*)(rs + (size_t)row * 16);
    const f32x4 a = p[0], b = p[1], c = p[2], d = p[3];
    const float s = ((a[0] + a[1]) + (a[2] + a[3])) + ((b[0] + b[1]) + (b[2] + b[3])) + ((c[0] + c[1]) + (c[2] + c[3])) + ((d[0] + d[1]) + (d[2] + d[3]));
    return rsqrtf(s * (1.f / 1024.f) + 1e-6f);
}
struct EpiA {
    static constexpr bool PERM = true, AFTER_DRAIN = false;
    int mode, sub; const float* rs; bf16_t* out; int ldo; float* sg; const bf16_t* gate; int ldg; float* tmp;
    __device__ __forceinline__ void operator()(const f32x4 (&acc)[2][2][4][2], const Unit& u, int wr, int wc, int fr, int fq) const {
        const int row0 = u.pm * BM + wr * 64 + fr, colb = u.pn * BM + wc * 32 + 8 * fq;
        float rsv8[2][4];
        if (mode != 1) {
            f32x4 part[2][4];
#pragma unroll
            for (int ai = 0; ai < 2; ++ai)
#pragma unroll
                for (int m = 0; m < 4; ++m) part[ai][m] = *(const f32x4*)(rs + (size_t)(row0 + ai * HALF + m * 16) * 16 + 4 * fq);
#pragma unroll
            for (int ai = 0; ai < 2; ++ai)
#pragma unroll
                for (int m = 0; m < 4; ++m) { float sp = (part[ai][m][0] + part[ai][m][1]) + (part[ai][m][2] + part[ai][m][3]); sp += __shfl_xor(sp, 16); sp += __shfl_xor(sp, 32); rsv8[ai][m] = rsqrtf(sp * (1.f / 1024.f) + 1e-6f); }
        } else {
#pragma unroll
            for (int ai = 0; ai < 2; ++ai)
#pragma unroll
                for (int m = 0; m < 4; ++m) rsv8[ai][m] = 1.f;
        }
#pragma unroll
        for (int ai = 0; ai < 2; ++ai)
#pragma unroll
            for (int m = 0; m < 4; ++m) {
                const int row = row0 + ai * HALF + m * 16;
                const float rsv = rsv8[ai][m];
#pragma unroll
                for (int bj = 0; bj < 2; ++bj) {
                    const int col = colb + bj * HALF;
                    f32x4 v0 = acc[ai][bj][m][0] * rsv, v1 = acc[ai][bj][m][1] * rsv;
                    if (mode == 0) {
                        if (u.pn == 29) {
                            if (bj == 0 && wc == 0 && fq < 2) { float* q = sg + (size_t)row * 16 + 8 * fq; *(f32x4*)q = v0; *(f32x4*)(q + 4) = v1; }
                        } else {
                            if (u.pn >= 17) {
#pragma unroll
                                for (int e = 0; e < 4; ++e) { v0[e] = sigm(v0[e]); v1[e] = sigm(v1[e]); }
                            }
                            u32x4 w; w.x = pk2(v0[0], v0[1]); w.y = pk2(v0[2], v0[3]); w.z = pk2(v1[0], v1[1]); w.w = pk2(v1[2], v1[3]);
                            *(u32x4*)(out + (size_t)row * ldo + col) = w;
                        }
                    } else if (mode == 1) {
                        const u32x4 g = *(const u32x4*)(gate + (size_t)row * ldg + col);
                        f32x4 p0 = {v0[0] * bflo(g.x), v0[1] * bfhi(g.x), v0[2] * bflo(g.y), v0[3] * bfhi(g.y)};
                        f32x4 p1 = {v1[0] * bflo(g.z), v1[1] * bfhi(g.z), v1[2] * bflo(g.w), v1[3] * bfhi(g.w)};
                        float* tp = tmp + (size_t)row * 1024 + col;
                        if (sub == 0) { *(f32x4*)tp = p0; *(f32x4*)(tp + 4) = p1; }
                        else if (sub == 1) { *(f32x4*)tp = *(const f32x4*)tp + p0; *(f32x4*)(tp + 4) = *(const f32x4*)(tp + 4) + p1; }
                        else { p0 = p0 + *(const f32x4*)tp; p1 = p1 + *(const f32x4*)(tp + 4);
                            u32x4 w; w.x = pk2(p0[0], p0[1]); w.y = pk2(p0[2], p0[3]); w.z = pk2(p1[0], p1[1]); w.w = pk2(p1[2], p1[3]);
                            *(u32x4*)(out + (size_t)row * ldo + col) = w; }
                    } else {
#pragma unroll
                        for (int e = 0; e < 4; ++e) { const float a = fmaxf(v0[e], 0.f), b = fmaxf(v1[e], 0.f); v0[e] = a * a; v1[e] = b * b; }
                        u32x4 w; w.x = pk2(v0[0], v0[1]); w.y = pk2(v0[2], v0[3]); w.z = pk2(v1[0], v1[1]); w.w = pk2(v1[2], v1[3]);
                        *(u32x4*)(out + (size_t)row * ldo + col) = w;
                    }
                }
            }
    }
};
struct EpiB {
    static constexpr bool PERM = false, AFTER_DRAIN = false;
    const float* resid; float* out; bf16_t* xb; float* rs;
    __device__ __forceinline__ void operator()(const f32x4 (&acc)[2][2][4][2], const Unit& u, int wr, int wc, int fr, int fq) const {
        const int row0 = u.pm * BM + wr * 64 + fr, colb = u.pn * BM + wc * 32 + 4 * fq;
#pragma unroll
        for (int ai = 0; ai < 2; ++ai)
#pragma unroll
            for (int m = 0; m < 4; ++m) {
                const int row = row0 + ai * HALF + m * 16; float ss = 0.f;
#pragma unroll
                for (int bj = 0; bj < 2; ++bj)
#pragma unroll
                    for (int n = 0; n < 2; ++n) {
                        const size_t off = (size_t)row * 1024 + colb + bj * HALF + n * 16;
                        const f32x4 x = *(const f32x4*)(resid + off) + acc[ai][bj][m][n];
                        *(f32x4*)(out + off) = x;
                        u32x2 w; w.x = pk2(x[0], x[1]); w.y = pk2(x[2], x[3]); *(u32x2*)(xb + off) = w;
                        ss += (x[0] * x[0] + x[1] * x[1]) + (x[2] * x[2] + x[3] * x[3]);
                    }
                ss += __shfl_xor(ss, 16); ss += __shfl_xor(ss, 32);
                if (fq == 0) rs[(size_t)row * 16 + u.pn * 4 + wc] = ss;
            }
    }
};

struct EpiM {
    static constexpr bool PERM = true, AFTER_DRAIN = false;
    int nM; bf16_t* out; const bf16_t* gate; int ldg; float* tmp;
    __device__ __forceinline__ void operator()(const f32x4 (&acc)[2][2][4][2], const Unit& u, int wr, int wc, int fr, int fq) const {
        const int sub = u.pn >> 2, pm = u.pm - sub * nM, pn = u.pn & 3;
        const int row0 = pm * BM + wr * 64 + fr, colb = pn * BM + wc * 32 + 8 * fq;
        const bf16_t* gb = gate + sub * 1024;
#pragma unroll
        for (int ai = 0; ai < 2; ++ai)
#pragma unroll
            for (int m = 0; m < 4; ++m) {
                const int row = row0 + ai * HALF + m * 16;
#pragma unroll
                for (int bj = 0; bj < 2; ++bj) {
                    const int col = colb + bj * HALF;
                    const f32x4 v0 = acc[ai][bj][m][0], v1 = acc[ai][bj][m][1];
                    const u32x4 g = *(const u32x4*)(gb + (size_t)row * ldg + col);
                    f32x4 p0 = {v0[0] * bflo(g.x), v0[1] * bfhi(g.x), v0[2] * bflo(g.y), v0[3] * bfhi(g.y)};
                    f32x4 p1 = {v1[0] * bflo(g.z), v1[1] * bfhi(g.z), v1[2] * bflo(g.w), v1[3] * bfhi(g.w)};
                    float* tp = tmp + (size_t)row * 1024 + col;
                    if (sub == 0) { *(f32x4*)tp = p0; *(f32x4*)(tp + 4) = p1; }
                    else if (sub == 1) { *(f32x4*)tp = *(const f32x4*)tp + p0; *(f32x4*)(tp + 4) = *(const f32x4*)(tp + 4) + p1; }
                    else { p0 = p0 + *(const f32x4*)tp; p1 = p1 + *(const f32x4*)(tp + 4);
                        u32x4 w; w.x = pk2(p0[0], p0[1]); w.y = pk2(p0[2], p0[3]); w.z = pk2(p1[0], p1[1]); w.w = pk2(p1[2], p1[3]);
                        *(u32x4*)(out + (size_t)row * 1024 + col) = w; }
                }
            }
    }
};
struct DiagOrder {
    StaticOrder S; int nM;
    __host__ __device__ void init(int M, int N, int G_, int c_) { S.init(M, N, G_, c_); nM = M / BM; }
    __host__ __device__ bool next(int i, Unit& u) const { Unit v; if (!S.next(i / 3, v)) return false; const int b = i % 3; u.pm = b * nM + v.pm; u.pn = b * 4 + v.pn; return true; }
    __device__ __forceinline__ void a_ready(const Unit&) const {}
    __device__ __forceinline__ void done(const Unit&) const {}
};

template <class Epi, class Sched, bool ALIGN_EPI = false, bool SP2 = false>
__device__ __forceinline__ void gemm_phase(PG8_LAS unsigned char* lds, const Gemm g, const Sched& S, const Epi& E) {
    int tid_ = threadIdx.x; asm volatile("" : "+v"(tid_));
    const int tid = tid_, wid = __builtin_amdgcn_readfirstlane(tid >> 6), lane = tid & 63, wr = wid >> 2, wc = wid & 3, fr = lane & 15, fq = lane >> 4;
    const int K = g.K, nt = K / BK;
    unsigned voffA[2], voffB[2];
#pragma unroll
    for (int i = 0; i < 2; ++i) { int R, C; stage_rc(tid * 16 + i * 8192, R, C); const int Rb = Epi::PERM ? ((R & ~31) + perm32(R & 31)) : R;
        voffA[i] = (unsigned)(R * K + C) * 2u; voffB[i] = (unsigned)(Rb * K + C) * 2u; }
    const size_t kstep = (size_t)(BK * 2);
    const size_t hstep = (size_t)HALF * K * 2;
    const size_t tstep = 2 * hstep;
    const unsigned ldsw = (unsigned)wid * 1024u;
    const int aoff = lds_byte(wr * 64 + fr, fq * 8), boff = lds_byte(wc * 32 + fr, fq * 8);
#define PG8_SA(b, h) (((b) * 2 + (h)) * HTB)
#define PG8_SB(b, h) ((4 + (b) * 2 + (h)) * HTB)
#define PG8_STAGE(bufoff, gbase, voff) do { _Pragma("unroll") for (int _i = 0; _i < 2; ++_i) \
        __builtin_amdgcn_global_load_lds((const unsigned*)((const char*)(gbase) + (voff)[_i]), (PG8_LAS unsigned*)(lds + (bufoff) + ldsw + _i * 8192), 16, 0, 0); } while (0)
#define PG8_LDA(dst, b, h) do { _Pragma("unroll") for (int m = 0; m < 4; ++m) _Pragma("unroll") for (int k = 0; k < 2; ++k) dst[m][k] = *(const PG8_LAS bf16x8*)(lds + PG8_SA(b, h) + aoff + m * 2048 + k * 1024); } while (0)
#define PG8_LDB(dst, b, h) do { _Pragma("unroll") for (int n = 0; n < 2; ++n) _Pragma("unroll") for (int k = 0; k < 2; ++k) dst[n][k] = *(const PG8_LAS bf16x8*)(lds + PG8_SB(b, h) + boff + n * 2048 + k * 1024); } while (0)
#define PG8_MMA(ai, bj, At, Bt) do { __builtin_amdgcn_s_setprio(1); _Pragma("unroll") for (int m = 0; m < 4; ++m) _Pragma("unroll") for (int n = 0; n < 2; ++n) _Pragma("unroll") for (int k = 0; k < 2; ++k) \
        acc[ai][bj][m][n] = __builtin_amdgcn_mfma_f32_16x16x32_bf16(Bt[n][k], At[m][k], acc[ai][bj][m][n], 0, 0, 0); __builtin_amdgcn_s_setprio(0); } while (0)
#define PG8_WAIT_V(n) asm volatile("s_waitcnt vmcnt(" #n ")" ::: "memory")
#define PG8_WAIT_L(n) asm volatile("s_waitcnt lgkmcnt(" #n ")" ::: "memory")
#define PG8_BAR __builtin_amdgcn_s_barrier()
#define PG8_SCHED __builtin_amdgcn_sched_barrier(0)
    Unit cur, nxt; int ui = 0;
    if (!S.next(0, cur)) return;
    f32x4 acc[2][2][4][2];
#pragma unroll
    for (int a = 0; a < 2; ++a)
#pragma unroll
        for (int b = 0; b < 2; ++b)
#pragma unroll
            for (int m = 0; m < 4; ++m)
#pragma unroll
                for (int n = 0; n < 2; ++n) acc[a][b][m][n] = (f32x4){0.f, 0.f, 0.f, 0.f};
    bf16x8 At[4][2], B0[2][2], B1[2][2];
    const char* cA = (const char*)g.A + (size_t)cur.pm * tstep; const char* cB = (const char*)g.Bt + (size_t)cur.pn * tstep;
    S.a_ready(cur);
    if constexpr (SP2) {
        PG8_STAGE(PG8_SB(0, 0), cB, voffB); PG8_STAGE(PG8_SB(0, 1), cB + hstep, voffB); PG8_STAGE(PG8_SA(0, 0), cA, voffA); PG8_STAGE(PG8_SA(0, 1), cA + hstep, voffA);
        if (wr == 1) PG8_BAR;
        PG8_WAIT_V(2); PG8_BAR;
        PG8_STAGE(PG8_SB(1, 0), cB + kstep, voffB); PG8_STAGE(PG8_SA(1, 0), cA + kstep, voffA); PG8_STAGE(PG8_SB(1, 1), cB + hstep + kstep, voffB);
        PG8_WAIT_V(6); PG8_BAR;
    } else {
        PG8_STAGE(PG8_SB(0, 0), cB, voffB); PG8_STAGE(PG8_SA(0, 0), cA, voffA); PG8_STAGE(PG8_SB(0, 1), cB + hstep, voffB); PG8_STAGE(PG8_SA(0, 1), cA + hstep, voffA);
        if (wr == 1) PG8_BAR;
        PG8_WAIT_V(4); PG8_BAR;
        PG8_STAGE(PG8_SB(1, 0), cB + kstep, voffB); PG8_STAGE(PG8_SA(1, 0), cA + kstep, voffA); PG8_STAGE(PG8_SB(1, 1), cB + hstep + kstep, voffB);
        PG8_WAIT_V(6); PG8_BAR;
    }
    for (;;) {
        const bool has_next = S.next(ui + 1, nxt);
        const char* nA = has_next ? (const char*)g.A + (size_t)nxt.pm * tstep : cA; const char* nB = has_next ? (const char*)g.Bt + (size_t)nxt.pn * tstep : cB;
        for (int t = 0; t < nt; t += 2) {
            const bool last = (t == nt - 2);
            const char* a1 = cA + (size_t)(t + 1) * kstep;
            const char* a2 = last ? nA : cA + (size_t)(t + 2) * kstep; const char* b2 = last ? nB : cB + (size_t)(t + 2) * kstep;
            const char* a3 = a2 + kstep; const char* b3 = b2 + kstep;
            if (last && has_next) S.a_ready(nxt);
            if constexpr (SP2) {
            PG8_LDB(B0, 0, 0); PG8_LDB(B1, 0, 1); PG8_SCHED; PG8_LDA(At, 0, 0); PG8_STAGE(PG8_SA(1, 1), a1 + hstep, voffA);
            PG8_WAIT_V(8); PG8_WAIT_L(0); PG8_BAR; PG8_MMA(0, 0, At, B0); PG8_MMA(0, 1, At, B1); PG8_BAR; PG8_SCHED;
            PG8_LDA(At, 0, 1); PG8_STAGE(PG8_SB(0, 0), b2, voffB); PG8_STAGE(PG8_SB(0, 1), b2 + hstep, voffB); PG8_STAGE(PG8_SA(0, 0), a2, voffA);
            PG8_WAIT_V(8); PG8_WAIT_L(0); PG8_BAR; PG8_MMA(1, 0, At, B0); PG8_MMA(1, 1, At, B1); PG8_BAR; PG8_SCHED;
            PG8_LDB(B0, 1, 0); PG8_LDB(B1, 1, 1); PG8_SCHED; PG8_LDA(At, 1, 0); PG8_STAGE(PG8_SA(0, 1), a2 + hstep, voffA);
            PG8_WAIT_V(8); PG8_WAIT_L(0); PG8_BAR; PG8_MMA(0, 0, At, B0); PG8_MMA(0, 1, At, B1); PG8_BAR; PG8_SCHED;
            PG8_LDA(At, 1, 1); PG8_STAGE(PG8_SB(1, 0), b3, voffB); PG8_STAGE(PG8_SB(1, 1), b3 + hstep, voffB); PG8_STAGE(PG8_SA(1, 0), a3, voffA);
            PG8_WAIT_V(8); PG8_WAIT_L(0); PG8_BAR; PG8_MMA(1, 0, At, B0); PG8_MMA(1, 1, At, B1); PG8_BAR; PG8_SCHED;
            } else {
            PG8_LDB(B0, 0, 0); PG8_SCHED; PG8_LDA(At, 0, 0); PG8_STAGE(PG8_SA(1, 1), a1 + hstep, voffA);
            PG8_WAIT_L(8); PG8_BAR; PG8_WAIT_L(0); PG8_MMA(0, 0, At, B0); PG8_BAR; PG8_SCHED;
            PG8_LDB(B1, 0, 1); PG8_STAGE(PG8_SB(0, 0), b2, voffB);
            PG8_BAR; PG8_WAIT_L(0); PG8_MMA(0, 1, At, B1); PG8_BAR;
            PG8_LDA(At, 0, 1); PG8_STAGE(PG8_SA(0, 0), a2, voffA);
            PG8_BAR; PG8_WAIT_L(0); PG8_MMA(1, 0, At, B0); PG8_BAR; PG8_SCHED;
            PG8_STAGE(PG8_SB(0, 1), b2 + hstep, voffB);
            PG8_WAIT_V(6); PG8_BAR; PG8_MMA(1, 1, At, B1); PG8_BAR;
            PG8_LDB(B0, 1, 0); PG8_SCHED; PG8_LDA(At, 1, 0); PG8_STAGE(PG8_SA(0, 1), a2 + hstep, voffA);
            PG8_WAIT_L(8); PG8_BAR; PG8_WAIT_L(0); PG8_MMA(0, 0, At, B0); PG8_BAR; PG8_SCHED;
            PG8_LDB(B1, 1, 1); PG8_STAGE(PG8_SB(1, 0), b3, voffB);
            PG8_BAR; PG8_WAIT_L(0); PG8_MMA(0, 1, At, B1); PG8_BAR;
            PG8_LDA(At, 1, 1); PG8_STAGE(PG8_SA(1, 0), a3, voffA);
            PG8_BAR; PG8_WAIT_L(0); PG8_MMA(1, 0, At, B0); PG8_BAR; PG8_SCHED;
            PG8_STAGE(PG8_SB(1, 1), b3 + hstep, voffB);
            PG8_WAIT_V(6); PG8_BAR; PG8_MMA(1, 1, At, B1); PG8_BAR;
            }
        }
        if constexpr (ALIGN_EPI) { if (wr == 0) PG8_BAR; }
        if constexpr (!Epi::AFTER_DRAIN) { E(acc, cur, wr, wc, fr, fq); S.done(cur); }
        if (!has_next) break;
#pragma unroll
        for (int a = 0; a < 2; ++a)
#pragma unroll
            for (int b = 0; b < 2; ++b)
#pragma unroll
                for (int m = 0; m < 4; ++m)
#pragma unroll
                    for (int n = 0; n < 2; ++n) acc[a][b][m][n] = (f32x4){0.f, 0.f, 0.f, 0.f};
        cur = nxt; cA = nA; cB = nB; ++ui;
        if constexpr (ALIGN_EPI) { if (wr == 1) PG8_BAR; }
    }
    PG8_WAIT_V(0);
    if constexpr (!ALIGN_EPI) { if (wr == 0) PG8_BAR; }
    PG8_BAR;
    if constexpr (Epi::AFTER_DRAIN) { E.fused(acc, cur, wr, wc, fr, fq, lds, wid, lane); S.done(cur); }
#undef PG8_SA
#undef PG8_SB
#undef PG8_STAGE
#undef PG8_LDA
#undef PG8_LDB
#undef PG8_MMA
#undef PG8_WAIT_V
#undef PG8_WAIT_L
#undef PG8_BAR
#undef PG8_SCHED
}
}

#define LAS __attribute__((address_space(3)))
typedef unsigned short bf16_t;
typedef short bf16x8 __attribute__((ext_vector_type(8)));
typedef float f32x4 __attribute__((ext_vector_type(4)));
typedef float f32x2 __attribute__((ext_vector_type(2)));
typedef float f32x16 __attribute__((ext_vector_type(16)));
typedef unsigned u32x4 __attribute__((ext_vector_type(4)));
typedef unsigned u32x2 __attribute__((ext_vector_type(2)));
using pg8::pk2; using pg8::bflo; using pg8::bfhi; using pg8::sigm;

constexpr int NB = 32, SEQ = 2048, DM = 1024, DEPTH = 2, INW = 7440, NINP = 7680, LDU = 7424, FF = 4096;
constexpr int NG = 2, BG = NB / NG, MG = BG * SEQ;
constexpr float LOG2E = 1.4426950408889634f, EPS = 1e-6f;
constexpr int NWAVES = 8, NTHR = 512;
constexpr int LDS_BYTES = 131072 + 1024;

constexpr int UC_FQ = 0, UC_FK = 512, UC_FV = 1024, UC_SQ = 1536, UC_SK = 2048, UC_SV = 2176, UC_MQ = 2304, UC_MK = 2816, UC_MV = 3328, UC_MO = 3840, UC_G = 4352;

constexpr size_t al(size_t x) { return (x + 255) & ~(size_t)255; }
constexpr size_t O_WIN = 0;
constexpr size_t O_WB = O_WIN + al((size_t)DEPTH * NINP * DM * 2);
constexpr size_t O_WOUT = O_WB + al((size_t)DEPTH * 3 * DM * 512 * 2);
constexpr size_t O_WUP = O_WOUT + al((size_t)DEPTH * DM * DM * 2);
constexpr size_t O_WDN = O_WUP + al((size_t)DEPTH * FF * DM * 2);
constexpr size_t O_ROPE = O_WDN + al((size_t)DEPTH * DM * FF * 2);
constexpr size_t O_PAR = O_ROPE + al((size_t)SEQ * 32 * 2 * 4);
constexpr int PAR_FFB = 0, PAR_FQN = 16, PAR_FKN = 144, PAR_SQN = 272, PAR_SKN = 400, PAR_SINK = 528, PAR_CW = 544, PAR_CB = 8736, PAR_IB = 10784, PAR_FB = 10792, PAR_ON = 10800, PAR_N = 11824;
constexpr size_t O_XB = O_PAR + al((size_t)PAR_N * 4);
constexpr size_t O_RS = O_XB + al((size_t)MG * DM * 2);
constexpr size_t O_U = O_RS + al((size_t)MG * 16 * 4);
constexpr size_t O_SG = O_U + al((size_t)MG * LDU * 2);
constexpr size_t O_FC = O_SG + al((size_t)MG * 16 * 4);
constexpr size_t O_MP = O_FC + al((size_t)BG * 8 * SEQ * 4);
constexpr size_t O_ME = O_MP + al((size_t)BG * 4 * SEQ * 4);
constexpr size_t O_MBT = O_ME + al((size_t)BG * 4 * SEQ * 4);
constexpr size_t O_MCH = O_MBT + al((size_t)BG * 4 * SEQ * 4);
constexpr size_t O_FQN = O_MCH + al((size_t)BG * 4 * 16 * 4 * 4);
constexpr size_t O_FKN = O_FQN + (size_t)MG * 512 * 2;
constexpr size_t O_FVT = O_FKN + (size_t)MG * 512 * 2;
constexpr size_t O_SQR = O_FVT + (size_t)MG * 512 * 2;
constexpr size_t O_TMP = O_FQN;
constexpr size_t O_SKR = O_SQR + (size_t)MG * 512 * 2;
constexpr size_t O_SVT = O_SKR + (size_t)MG * 128 * 2;
constexpr size_t O_MQC = O_SVT + (size_t)MG * 128 * 2;
constexpr size_t O_MKC = O_MQC + (size_t)MG * 512 * 2;
constexpr size_t O_MRG = O_MQC;
constexpr size_t O_KT = O_MKC + (size_t)MG * 512 * 2;
constexpr size_t O_MVT = O_KT + (size_t)MG * 512 * 2;
constexpr size_t O_DN = O_MVT + (size_t)MG * 512 * 2;
constexpr size_t O_CT = O_KT;
constexpr size_t O_NN = O_DN + al((size_t)BG * 4 * 16 * 128 * 4);
constexpr size_t O_Y = O_NN + al((size_t)BG * 4 * 16 * 128 * 4);
constexpr size_t O_DCT = O_Y + (size_t)2 * MG * 512 * 2;
constexpr size_t O_BAR = O_Y + (size_t)3 * MG * 512 * 2;
constexpr size_t WS_NEED = O_BAR + 16384;
static_assert((size_t)BG * 4 * 16 * 16384 * 2 == (size_t)MG * 512 * 2, "DCT overlays Y2; CT overlays KT");
static_assert((size_t)MG * FF * 2 <= (size_t)MG * LDU * 2, "ACT overlays U");

struct KP { const float* in[19]; float* out; unsigned char* ws; int ph_lo, ph_hi; };

__device__ __forceinline__ float wave_sum(float v) {
#pragma unroll
    for (int o = 1; o < 64; o <<= 1) v += __shfl_xor(v, o);
    return v;
}
__device__ __forceinline__ float logsig(float x) { return fminf(x, 0.f) - log1pf(__expf(-fabsf(x))); }
#define LDSW() asm volatile("s_waitcnt lgkmcnt(0)" ::: "memory")

__device__ __forceinline__ int win_srccol(int n) {
    if (n < 1536) return n; if (n < 3840) return n + 8; if (n < 7424) return n + 16; if (n < 7432) return n - 7424 + 1536; if (n < 7440) return n - 7432 + 3848; return -1;
}
template <bool REMAP>
__device__ __forceinline__ void tr_item(const float* W, int K, int N, const float* kscale, bf16_t* WT, int item, int nblk, LAS float* scr, int lane) {
    const int kb = item / nblk, nb = item % nblk, k0 = 64 * kb, n0 = 32 * nb;
    const int nd = n0 + (lane & 31); const int ns = REMAP ? win_srccol(nd) : nd;
#pragma unroll 8
    for (int i = 0; i < 32; ++i) { const int kk = 2 * i + (lane >> 5); float v = 0.f; if (ns >= 0) v = W[(size_t)(k0 + kk) * N + ns]; if (kscale) v *= kscale[k0 + kk]; scr[kk * 33 + (lane & 31)] = v; }
    LDSW();
    const int c = lane & 7;
#pragma unroll
    for (int j = 0; j < 4; ++j) { const int n = (lane >> 3) + 8 * j; const LAS float* s = scr + (8 * c) * 33 + n;
        u32x4 o; o.x = pk2(s[0 * 33], s[1 * 33]); o.y = pk2(s[2 * 33], s[3 * 33]); o.z = pk2(s[4 * 33], s[5 * 33]); o.w = pk2(s[6 * 33], s[7 * 33]);
        *(u32x4*)(WT + (size_t)(n0 + n) * K + k0 + 8 * c) = o; }
    LDSW();
}
__device__ __forceinline__ void phase_p0(const KP& p, unsigned char* ws, LAS unsigned char* lds, int gw, int NWV, int wave, int lane) {
    LAS float* scr = (LAS float*)(lds + wave * 16384);
    const float *norm_mix = p.in[1], *w_in = p.in[2], *w_branch = p.in[14], *w_out = p.in[15], *norm_mlp = p.in[16], *w_up = p.in[17], *w_down = p.in[18];
    constexpr int PER = 3840 + 768 + 512 + 2048 + 2048;
    for (int it = gw; it < DEPTH * PER; it += NWV) {
        const int l = it / PER; int r = it % PER;
        if (r < 3840) { tr_item<true>(w_in + (size_t)l * DM * INW, DM, INW, norm_mix + l * DM, (bf16_t*)(ws + O_WIN) + (size_t)l * NINP * DM, r, 240, scr, lane); continue; } r -= 3840;
        if (r < 768) { const int b = r / 256; tr_item<false>(w_branch + (size_t)(l * 3 + b) * 512 * DM, 512, DM, nullptr, (bf16_t*)(ws + O_WB) + (size_t)(l * 3 + b) * DM * 512, r % 256, 32, scr, lane); continue; } r -= 768;
        if (r < 512) { tr_item<false>(w_out + (size_t)l * DM * DM, DM, DM, nullptr, (bf16_t*)(ws + O_WOUT) + (size_t)l * DM * DM, r, 32, scr, lane); continue; } r -= 512;
        if (r < 2048) { tr_item<false>(w_up + (size_t)l * DM * FF, DM, FF, norm_mlp + l * DM, (bf16_t*)(ws + O_WUP) + (size_t)l * FF * DM, r, 128, scr, lane); continue; } r -= 2048;
        tr_item<false>(w_down + (size_t)l * FF * DM, FF, DM, nullptr, (bf16_t*)(ws + O_WDN) + (size_t)l * DM * FF, r, 32, scr, lane);
    }
    { float* par = (float*)(ws + O_PAR); const int t0 = gw * 64 + lane, ts = NWV * 64;
      for (int e = t0; e < 16; e += ts) { par[PAR_FFB + e] = p.in[3][e]; par[PAR_SINK + e] = p.in[8][e]; }
      for (int e = t0; e < 128; e += ts) { par[PAR_FQN + e] = p.in[4][e]; par[PAR_FKN + e] = p.in[5][e]; par[PAR_SQN + e] = p.in[6][e]; par[PAR_SKN + e] = p.in[7][e]; }
      for (int e = t0; e < 8192; e += ts) par[PAR_CW + e] = p.in[9][e];
      for (int e = t0; e < 2048; e += ts) par[PAR_CB + e] = p.in[10][e];
      for (int e = t0; e < 8; e += ts) { par[PAR_IB + e] = p.in[11][e]; par[PAR_FB + e] = p.in[12][e]; }
      for (int e = t0; e < 1024; e += ts) par[PAR_ON + e] = p.in[13][e]; }
    float* rope = (float*)(ws + O_ROPE);
    for (int e = gw * 64 + lane; e < SEQ * 32; e += NWV * 64) {
        const int pos = e >> 5, i = e & 31;
        const float inv = powf(10000.f, -(float)(2 * i) / 64.f), ang = (float)pos * inv;
        rope[2 * e] = cosf(ang); rope[2 * e + 1] = sinf(ang);
    }
}
__device__ __forceinline__ void phase_x0(const float* x, bf16_t* XB, float* RS, int gw, int NWV, int lane) {
    for (int row = gw; row < MG; row += NWV) {
        const f32x4* xr = (const f32x4*)(x + (size_t)row * DM) + lane;
        f32x4 v[4]; float s = 0.f;
#pragma unroll
        for (int j = 0; j < 4; ++j) { v[j] = xr[64 * j]; s += (v[j][0] * v[j][0] + v[j][1] * v[j][1]) + (v[j][2] * v[j][2] + v[j][3] * v[j][3]); }
        s = wave_sum(s);
        u32x2* o = (u32x2*)(XB + (size_t)row * DM) + lane;
#pragma unroll
        for (int j = 0; j < 4; ++j) { u32x2 w; w.x = pk2(v[j][0], v[j][1]); w.y = pk2(v[j][2], v[j][3]); o[64 * j] = w; }
        if (lane < 16) RS[(size_t)row * 16 + lane] = (lane == 0) ? s : 0.f;
    }
}
__device__ __forceinline__ void gate_scan_item(unsigned char* ws, int l, int it, int lane) {
    const float* par = (const float*)(ws + O_PAR); const float* SG = (const float*)(ws + O_SG);
    if (it < BG * 8) {
        const int b = it >> 3, h = it & 7; const float bias = par[PAR_FFB + l * 8 + h];
        const float* src = SG + ((size_t)b * SEQ + lane * 32) * 16 + h;
        float tot = 0.f;
#pragma unroll 4
        for (int j = 0; j < 32; ++j) tot += logsig(src[j * 16] + bias);
        float x = tot;
#pragma unroll
        for (int o = 1; o < 64; o <<= 1) { const float y = __shfl_up(x, o); if (lane >= o) x += y; }
        float run = x - tot;
        float* dst = (float*)(ws + O_FC) + (size_t)it * SEQ + lane * 32;
#pragma unroll 4
        for (int j = 0; j < 32; ++j) { run += logsig(src[j * 16] + bias); dst[j] = run * LOG2E; }
    } else {
        const int sq = it - BG * 8, b = sq >> 2, h = sq & 3;
        const float ibias = par[PAR_IB + l * 4 + h], fbias = par[PAR_FB + l * 4 + h];
        float* MP = (float*)(ws + O_MP) + (size_t)sq * SEQ; float* ME = (float*)(ws + O_ME) + (size_t)sq * SEQ; float* MBT = (float*)(ws + O_MBT) + (size_t)sq * SEQ;
        float* MCH = (float*)(ws + O_MCH) + (size_t)sq * 64;
        float mc = 0.f;
#pragma unroll 1
        for (int c = 0; c < 16; ++c) {
            const float* s0 = SG + ((size_t)b * SEQ + c * 128 + 2 * lane) * 16;
            const float f0 = logsig(s0[12 + h] + fbias), f1 = logsig(s0[16 + 12 + h] + fbias);
            const float i0 = s0[8 + h] + ibias, i1 = s0[16 + 8 + h] + ibias;
            float x = f0 + f1;
#pragma unroll
            for (int o = 1; o < 64; o <<= 1) { const float y = __shfl_up(x, o); if (lane >= o) x += y; }
            const float b1 = x, b0 = x - f1;
            const float p0 = i0 - b0, p1 = i1 - b1;
            float mxs = fmaxf(p0, p1);
#pragma unroll
            for (int o = 1; o < 64; o <<= 1) { const float y = __shfl_up(mxs, o); if (lane >= o) mxs = fmaxf(mxs, y); }
            float prev = __shfl_up(mxs, 1); if (lane == 0) prev = -INFINITY;
            const float u0 = fmaxf(prev, p0), u1 = mxs;
            const float e0 = fmaxf(mc, u0), e1 = fmaxf(mc, u1);
            const int t = c * 128 + 2 * lane;
            *(f32x2*)(MP + t) = (f32x2){p0, p1}; *(f32x2*)(ME + t) = (f32x2){e0, e1}; *(f32x2*)(MBT + t) = (f32x2){b0, b1};
            const float ulast = __shfl(mxs, 63), bL = __shfl(x, 63);
            const float mx = fmaxf(mc, ulast), dec = __expf(mc - mx);
            if (lane == 0) *(f32x4*)(MCH + c * 4) = (f32x4){mc, mx, dec, bL};
            mc = bL + mx;
        }
    }
}
__device__ __forceinline__ void headnorm_item(unsigned char* ws, int l, int kind, int item, int lane) {
    const float* par = (const float*)(ws + O_PAR);
    const int c = lane & 7;
    int srccol, dpitch, tstep, tok0, tsub; bf16_t* dbase; const float* w; float scale;
    if (kind == 0) { srccol = UC_FQ + lane * 8; dbase = (bf16_t*)(ws + O_FQN) + lane * 8; dpitch = 512; w = par + PAR_FQN + l * 64; scale = 0.125f * LOG2E; tstep = 1; tok0 = item * 8; tsub = 0; }
    else if (kind == 1) { srccol = UC_FK + lane * 8; dbase = (bf16_t*)(ws + O_FKN) + lane * 8; dpitch = 512; w = par + PAR_FKN + l * 64; scale = 1.f; tstep = 1; tok0 = item * 8; tsub = 0; }
    else if (kind == 2) { srccol = UC_SQ + lane * 8; dbase = (bf16_t*)(ws + O_SQR) + lane * 8; dpitch = 512; w = par + PAR_SQN + l * 64; scale = 0.125f * LOG2E; tstep = 1; tok0 = item * 8; tsub = 0; }
    else { srccol = UC_SK + (lane & 15) * 8; dbase = (bf16_t*)(ws + O_SKR) + (lane & 15) * 8; dpitch = 128; w = par + PAR_SKN + l * 64; scale = 1.f; tstep = 4; tok0 = item * 32; tsub = lane >> 4; }
    const bool rp = kind >= 2;
    const f32x4 w0 = *(const f32x4*)(w + 8 * c), w1 = *(const f32x4*)(w + 8 * c + 4);
    const bf16_t* src = (const bf16_t*)(ws + O_U) + (size_t)(tok0 + tsub) * LDU + srccol;
    u32x4 xv[8];
#pragma unroll
    for (int i = 0; i < 8; ++i) xv[i] = *(const u32x4*)(src + (size_t)(i * tstep) * LDU);
#pragma unroll
    for (int i = 0; i < 8; ++i) {
        const int tok = tok0 + tsub + i * tstep;
        float x[8] = {bflo(xv[i].x), bfhi(xv[i].x), bflo(xv[i].y), bfhi(xv[i].y), bflo(xv[i].z), bfhi(xv[i].z), bflo(xv[i].w), bfhi(xv[i].w)};
        float ss = ((x[0] * x[0] + x[1] * x[1]) + (x[2] * x[2] + x[3] * x[3])) + ((x[4] * x[4] + x[5] * x[5]) + (x[6] * x[6] + x[7] * x[7]));
        ss += __shfl_xor(ss, 1); ss += __shfl_xor(ss, 2); ss += __shfl_xor(ss, 4);
        const float rn = rsqrtf(ss * (1.f / 64.f) + EPS);
        x[0] *= rn * w0[0]; x[1] *= rn * w0[1]; x[2] *= rn * w0[2]; x[3] *= rn * w0[3]; x[4] *= rn * w1[0]; x[5] *= rn * w1[1]; x[6] *= rn * w1[2]; x[7] *= rn * w1[3];
        if (rp) {
            const float* rt = (const float*)(ws + O_ROPE) + ((size_t)(tok % SEQ) * 32 + 8 * (c & 3)) * 2;
            const bool second = (c & 4) != 0;
#pragma unroll
            for (int e = 0; e < 8; e += 2) { const f32x4 cs = *(const f32x4*)(rt + 2 * e);
                const float o0 = __shfl_xor(x[e], 4), o1 = __shfl_xor(x[e + 1], 4);
                x[e] = second ? (o0 * cs[1] + x[e] * cs[0]) : (x[e] * cs[0] - o0 * cs[1]);
                x[e + 1] = second ? (o1 * cs[3] + x[e + 1] * cs[2]) : (x[e + 1] * cs[2] - o1 * cs[3]); }
        }
        u32x4 o; o.x = pk2(x[0] * scale, x[1] * scale); o.y = pk2(x[2] * scale, x[3] * scale); o.z = pk2(x[4] * scale, x[5] * scale); o.w = pk2(x[6] * scale, x[7] * scale);
        *(u32x4*)(dbase + (size_t)tok * dpitch) = o;
    }
}
__device__ __forceinline__ void stream_item(unsigned char* ws, int l, int item, int lane) {
    const int cb = item % 34, tb = item / 34, tok0 = tb * 64, b = tok0 / SEQ, s0 = tok0 % SEQ;
    const int tg = lane >> 3, co = lane & 7;
    const bf16_t* U = (const bf16_t*)(ws + O_U);
    int srccol, chan; bf16_t* dT = nullptr; bf16_t* dN = nullptr; int convch = -1; float oscale = 1.f;
    if (cb < 8) { chan = cb * 64 + co * 8; srccol = UC_FV + chan; dT = (bf16_t*)(ws + O_FVT) + ((size_t)b * 512 + chan) * SEQ; }
    else if (cb < 10) { chan = (cb - 8) * 64 + co * 8; srccol = UC_SV + chan; dT = (bf16_t*)(ws + O_SVT) + ((size_t)b * 128 + chan) * SEQ; }
    else if (cb < 18) { chan = (cb - 10) * 64 + co * 8; srccol = UC_MV + chan; dT = (bf16_t*)(ws + O_MVT) + ((size_t)b * 512 + chan) * SEQ; }
    else if (cb < 26) { chan = (cb - 18) * 64 + co * 8; srccol = UC_MQ + chan; dN = (bf16_t*)(ws + O_MQC) + chan; convch = chan; }
    else { chan = (cb - 26) * 64 + co * 8; srccol = UC_MK + chan; dN = (bf16_t*)(ws + O_MKC) + chan; dT = (bf16_t*)(ws + O_KT) + ((size_t)b * 512 + chan) * SEQ; convch = 512 + chan; oscale = 0.08838834764831845f; }
    const bf16_t* src = U + (size_t)(tok0 + tg * 8) * LDU + srccol;
    u32x4 R[8];
#pragma unroll
    for (int i = 0; i < 8; ++i) R[i] = *(const u32x4*)(src + (size_t)i * LDU);
    if (cb >= 18) {
        u32x4 H[3];
        const bool has_prev = (s0 + tg * 8) > 0;
#pragma unroll
        for (int i = 0; i < 3; ++i) { H[i] = (u32x4){0u, 0u, 0u, 0u}; if (has_prev) H[i] = *(const u32x4*)(src - (size_t)(3 - i) * LDU); }
        const float* cw = (const float*)(ws + O_PAR) + PAR_CW + l * 4 * 1024 + convch; const float* cbias = (const float*)(ws + O_PAR) + PAR_CB + l * 1024 + convch;
        float wt[4][8], bb[8];
#pragma unroll
        for (int j = 0; j < 4; ++j) { const f32x4 a = *(const f32x4*)(cw + j * 1024), c2 = *(const f32x4*)(cw + j * 1024 + 4);
            wt[j][0] = a[0]; wt[j][1] = a[1]; wt[j][2] = a[2]; wt[j][3] = a[3]; wt[j][4] = c2[0]; wt[j][5] = c2[1]; wt[j][6] = c2[2]; wt[j][7] = c2[3]; }
        { const f32x4 a = *(const f32x4*)cbias, c2 = *(const f32x4*)(cbias + 4); bb[0] = a[0]; bb[1] = a[1]; bb[2] = a[2]; bb[3] = a[3]; bb[4] = c2[0]; bb[5] = c2[1]; bb[6] = c2[2]; bb[7] = c2[3]; }
        float xm3[8], xm2[8], xm1[8];
#define UNPK(dst, v) do { dst[0] = bflo(v.x); dst[1] = bfhi(v.x); dst[2] = bflo(v.y); dst[3] = bfhi(v.y); dst[4] = bflo(v.z); dst[5] = bfhi(v.z); dst[6] = bflo(v.w); dst[7] = bfhi(v.w); } while (0)
        UNPK(xm3, H[0]); UNPK(xm2, H[1]); UNPK(xm1, H[2]);
#pragma unroll
        for (int i = 0; i < 8; ++i) {
            float xc[8], y[8]; UNPK(xc, R[i]);
#pragma unroll
            for (int e = 0; e < 8; ++e) { const float v = bb[e] + wt[0][e] * xm3[e] + wt[1][e] * xm2[e] + wt[2][e] * xm1[e] + wt[3][e] * xc[e]; y[e] = v * sigm(v) * oscale; xm3[e] = xm2[e]; xm2[e] = xm1[e]; xm1[e] = xc[e]; }
            u32x4 o; o.x = pk2(y[0], y[1]); o.y = pk2(y[2], y[3]); o.z = pk2(y[4], y[5]); o.w = pk2(y[6], y[7]);
            R[i] = o;
            *(u32x4*)(dN + (size_t)(tok0 + tg * 8 + i) * 512) = o;
        }
#undef UNPK
    }
    if (dT) {
        bf16_t* dst = dT + s0 + tg * 8;
#pragma unroll
        for (int k = 0; k < 4; ++k) {
            u32x4 lo, hi;
            lo.x = (R[0][k] & 0xffffu) | (R[1][k] << 16); lo.y = (R[2][k] & 0xffffu) | (R[3][k] << 16); lo.z = (R[4][k] & 0xffffu) | (R[5][k] << 16); lo.w = (R[6][k] & 0xffffu) | (R[7][k] << 16);
            hi.x = (R[0][k] >> 16) | (R[1][k] & 0xffff0000u); hi.y = (R[2][k] >> 16) | (R[3][k] & 0xffff0000u); hi.z = (R[4][k] >> 16) | (R[5][k] & 0xffff0000u); hi.w = (R[6][k] >> 16) | (R[7][k] & 0xffff0000u);
            *(u32x4*)(dst + (size_t)(2 * k) * SEQ) = lo; *(u32x4*)(dst + (size_t)(2 * k + 1) * SEQ) = hi;
        }
    }
}
#define MFMA32(a, b, c) __builtin_amdgcn_mfma_f32_32x32x16_bf16((a), (b), (c), 0, 0, 0)
template <bool SWA>
__device__ __forceinline__ void attn_qtile(const bf16_t* __restrict__ Q, const bf16_t* __restrict__ K, int kpitch, const bf16_t* __restrict__ VT,
                                           const float* __restrict__ C, float sink2, bf16_t* __restrict__ Y, int qt, int lane) {
    const int r = lane & 31, hh = lane >> 5;
    const int pr = ((r >> 2) & 1) * 16 + ((r >> 4) & 1) * 8 + ((r >> 3) & 1) * 4 + (r & 3);
    const int q0 = qt * 32;
    bf16x8 qf[4];
#pragma unroll
    for (int st = 0; st < 4; ++st) qf[st] = *(const bf16x8*)(Q + (size_t)(q0 + r) * 512 + 16 * st + 8 * hh);
    float cq = 0.f; if (!SWA) cq = C[q0 + r];
    float m = -1e30f, lsum = 0.f;
    f32x16 o0, o1;
#pragma unroll
    for (int i = 0; i < 16; ++i) { o0[i] = 0.f; o1[i] = 0.f; }
    const int kt_lo = SWA ? (qt > 4 ? qt - 4 : 0) : 0;
#define ATT_LOAD(KF, VF, CK, kt_) do { const int k0_ = (kt_) * 32; \
        _Pragma("unroll") for (int st = 0; st < 4; ++st) KF[st] = *(const bf16x8*)(K + (size_t)(k0_ + pr) * kpitch + 16 * st + 8 * hh); \
        _Pragma("unroll") for (int dh = 0; dh < 2; ++dh) _Pragma("unroll") for (int s2 = 0; s2 < 2; ++s2) VF[dh][s2] = *(const bf16x8*)(VT + (size_t)(dh * 32 + r) * SEQ + k0_ + 16 * hh + 8 * s2); \
        if (!SWA) { _Pragma("unroll") for (int g = 0; g < 4; ++g) CK[g] = *(const f32x4*)(C + k0_ + 16 * hh + 4 * g); } } while (0)
    bf16x8 kfn[4], vfn[2][2]; f32x4 ckn[4];
#pragma unroll
    for (int g = 0; g < 4; ++g) ckn[g] = (f32x4){0.f, 0.f, 0.f, 0.f};
    ATT_LOAD(kfn, vfn, ckn, kt_lo);
    for (int kt = kt_lo; kt <= qt; ++kt) {
        bf16x8 kf[4], vf[2][2]; f32x4 ckc[4];
#pragma unroll
        for (int st = 0; st < 4; ++st) kf[st] = kfn[st];
#pragma unroll
        for (int dh = 0; dh < 2; ++dh) { vf[dh][0] = vfn[dh][0]; vf[dh][1] = vfn[dh][1]; }
#pragma unroll
        for (int g = 0; g < 4; ++g) ckc[g] = ckn[g];
        if (kt < qt) ATT_LOAD(kfn, vfn, ckn, kt + 1);
        f32x16 sc;
#pragma unroll
        for (int i = 0; i < 16; ++i) sc[i] = 0.f;
#pragma unroll
        for (int st = 0; st < 4; ++st) sc = MFMA32(kf[st], qf[st], sc);
        if (!SWA) {
#pragma unroll
            for (int g = 0; g < 4; ++g) { const f32x4 ck = ckc[g];
#pragma unroll
                for (int e = 0; e < 4; ++e) sc[4 * g + e] += cq - ck[e]; }
        }
        if (kt == qt) {
#pragma unroll
            for (int i = 0; i < 16; ++i) if (16 * hh + i > r) sc[i] = -INFINITY;
        }
        if (SWA && kt == qt - 4) {
#pragma unroll
            for (int i = 0; i < 16; ++i) if (16 * hh + i <= r) sc[i] = -INFINITY;
        }
        float tm = sc[0];
#pragma unroll
        for (int i = 1; i < 16; ++i) tm = fmaxf(tm, sc[i]);
        tm = fmaxf(tm, __shfl_xor(tm, 32));
        const float mn = fmaxf(m, tm), alpha = __builtin_amdgcn_exp2f(m - mn);
        m = mn;
        float ps = 0.f;
#pragma unroll
        for (int i = 0; i < 16; ++i) { sc[i] = __builtin_amdgcn_exp2f(sc[i] - mn); ps += sc[i]; }
        lsum = lsum * alpha + ps;
#pragma unroll
        for (int i = 0; i < 16; ++i) { o0[i] *= alpha; o1[i] *= alpha; }
        u32x4 pw0, pw1;
        pw0.x = pk2(sc[0], sc[1]); pw0.y = pk2(sc[2], sc[3]); pw0.z = pk2(sc[4], sc[5]); pw0.w = pk2(sc[6], sc[7]);
        pw1.x = pk2(sc[8], sc[9]); pw1.y = pk2(sc[10], sc[11]); pw1.z = pk2(sc[12], sc[13]); pw1.w = pk2(sc[14], sc[15]);
        const bf16x8 pf0 = __builtin_bit_cast(bf16x8, pw0), pf1 = __builtin_bit_cast(bf16x8, pw1);
        o0 = MFMA32(vf[0][0], pf0, o0); o0 = MFMA32(vf[0][1], pf1, o0);
        o1 = MFMA32(vf[1][0], pf0, o1); o1 = MFMA32(vf[1][1], pf1, o1);
    }
    float lt = lsum + __shfl_xor(lsum, 32);
    if (SWA) lt += __builtin_amdgcn_exp2f(sink2 - m);
    const float inv = 1.f / lt;
    bf16_t* yrow = Y + (size_t)(q0 + r) * 512 + 4 * hh;
#pragma unroll
    for (int g = 0; g < 4; ++g) {
        u32x2 a, c;
        a.x = pk2(o0[4 * g] * inv, o0[4 * g + 1] * inv); a.y = pk2(o0[4 * g + 2] * inv, o0[4 * g + 3] * inv);
        c.x = pk2(o1[4 * g] * inv, o1[4 * g + 1] * inv); c.y = pk2(o1[4 * g + 2] * inv, o1[4 * g + 3] * inv);
        *(u32x2*)(yrow + 8 * g) = a; *(u32x2*)(yrow + 32 + 8 * g) = c;
    }
}
constexpr int AT_SLOT = 10240, AT_K = 0, AT_V = 4608, AT_C = 9728;
__device__ __forceinline__ float xmax32(float v) { auto rr = __builtin_amdgcn_permlane32_swap(__float_as_uint(v), __float_as_uint(v), false, false); return fmaxf(__uint_as_float(rr[0]), __uint_as_float(rr[1])); }
template <bool SWA>
__device__ __forceinline__ void attn_compute(const LAS unsigned char* sl, const bf16x8 (&qf)[4], float cq, float& m, float& lsum, f32x16& o0, f32x16& o1,
                                             bool diag, bool wedge, int pr, int r, int hh) {
    bf16x8 kf[4], vf[2][2]; f32x4 ckv[4];
#pragma unroll
    for (int st = 0; st < 4; ++st) kf[st] = *(const LAS bf16x8*)(sl + AT_K + pr * 144 + 32 * st + 16 * hh);
    if (!SWA) {
#pragma unroll
        for (int g = 0; g < 4; ++g) ckv[g] = *(const LAS f32x4*)(sl + AT_C + 64 * hh + 16 * g);
    }
#pragma unroll
    for (int dh = 0; dh < 2; ++dh)
#pragma unroll
        for (int s = 0; s < 2; ++s) vf[dh][s] = *(const LAS bf16x8*)(sl + AT_V + (dh * 32 + r) * 80 + 32 * hh + 16 * s);
    __builtin_amdgcn_sched_barrier(0);
    f32x16 sc;
#pragma unroll
    for (int i = 0; i < 16; ++i) sc[i] = 0.f;
#pragma unroll
    for (int st = 0; st < 4; ++st) sc = MFMA32(kf[st], qf[st], sc);
    if (!SWA) {
#pragma unroll
        for (int g = 0; g < 4; ++g)
#pragma unroll
            for (int e = 0; e < 4; ++e) sc[4 * g + e] += cq - ckv[g][e];
    }
    if (diag) {
#pragma unroll
        for (int i = 0; i < 16; ++i) if (16 * hh + i > r) sc[i] = -INFINITY;
    }
    if (SWA && wedge) {
#pragma unroll
        for (int i = 0; i < 16; ++i) if (16 * hh + i <= r) sc[i] = -INFINITY;
    }
    float tm = sc[0];
#pragma unroll
    for (int i = 1; i < 16; ++i) tm = fmaxf(tm, sc[i]);
    tm = xmax32(tm);
    if (__any(tm > m)) {
        const float mn = fmaxf(m, tm), alpha = __builtin_amdgcn_exp2f(m - mn);
        m = mn; lsum *= alpha;
#pragma unroll
        for (int i = 0; i < 16; ++i) { o0[i] *= alpha; o1[i] *= alpha; }
    }
    float ps = 0.f;
#pragma unroll
    for (int i = 0; i < 16; ++i) { sc[i] = __builtin_amdgcn_exp2f(sc[i] - m); ps += sc[i]; }
    lsum += ps;
    u32x4 pw0, pw1;
    pw0.x = pk2(sc[0], sc[1]); pw0.y = pk2(sc[2], sc[3]); pw0.z = pk2(sc[4], sc[5]); pw0.w = pk2(sc[6], sc[7]);
    pw1.x = pk2(sc[8], sc[9]); pw1.y = pk2(sc[10], sc[11]); pw1.z = pk2(sc[12], sc[13]); pw1.w = pk2(sc[14], sc[15]);
    const bf16x8 pf0 = __builtin_bit_cast(bf16x8, pw0), pf1 = __builtin_bit_cast(bf16x8, pw1);
    o0 = MFMA32(vf[0][0], pf0, o0); o0 = MFMA32(vf[0][1], pf1, o0);
    o1 = MFMA32(vf[1][0], pf0, o1); o1 = MFMA32(vf[1][1], pf1, o1);
}
template <bool SWA>
__device__ __forceinline__ void attn_block(LAS unsigned char* lds, const bf16_t* __restrict__ Q, const bf16_t* __restrict__ K, int kpitch, const bf16_t* __restrict__ VT,
                                           const float* __restrict__ C, float sink2, bf16_t* __restrict__ Y, int qt, int t_lo, int t_hi, int wave, int lane) {
    const int r = lane & 31, hh = lane >> 5;
    const int pr = ((r >> 2) & 1) * 16 + ((r >> 4) & 1) * 8 + ((r >> 3) & 1) * 4 + (r & 3);
    const int q0 = qt * 32;
    const bool isK = wave < 4; const int chunk = (wave & 3) * 64 + lane;
    const bf16_t* gsrc = isK ? K + (size_t)(chunk >> 3) * kpitch + (chunk & 7) * 8 : VT + (size_t)(chunk >> 2) * SEQ + (chunk & 3) * 8;
    const int gstep = isK ? 32 * kpitch : 32;
    const int ldst = isK ? AT_K + (chunk >> 3) * 144 + (chunk & 7) * 16 : AT_V + (chunk >> 2) * 80 + (chunk & 3) * 16;
    const bool doC = !SWA && wave == 0 && lane < 8;
#define AB_LD(t_) (*(const u32x4*)(gsrc + (size_t)((t_) < t_hi ? (t_) : t_hi) * gstep))
#define AB_LDC(t_) (*(const u32x4*)(C + ((t_) < t_hi ? (t_) : t_hi) * 32 + lane * 4))
#define AB_WR(slot_, v_, c_) do { LAS unsigned char* sl_ = lds + (slot_) * AT_SLOT; *(LAS u32x4*)(sl_ + ldst) = (v_); if (doC) *(LAS u32x4*)(sl_ + AT_C + lane * 16) = (c_); } while (0)
    u32x4 R0 = AB_LD(t_lo), R1 = AB_LD(t_lo + 1), R2 = AB_LD(t_lo + 2);
    u32x4 C0 = {0u, 0u, 0u, 0u}, C1 = C0, C2 = C0;
    if (doC) { C0 = AB_LDC(t_lo); C1 = AB_LDC(t_lo + 1); C2 = AB_LDC(t_lo + 2); }
    bf16x8 qf[4];
#pragma unroll
    for (int st = 0; st < 4; ++st) qf[st] = *(const bf16x8*)(Q + (size_t)(q0 + r) * 512 + 16 * st + 8 * hh);
    float cq = 0.f; if (!SWA) cq = C[q0 + r];
    float m = -1e30f, lsum = 0.f;
    f32x16 o0, o1;
#pragma unroll
    for (int i = 0; i < 16; ++i) { o0[i] = 0.f; o1[i] = 0.f; }
    AB_WR(0, R0, C0);
#define AB_ITER(t_, RL, CL, RW, CW, SLOT_CUR, SLOT_NEXT) do { \
        RL = AB_LD((t_) + 3); if (doC) CL = AB_LDC((t_) + 3); \
        if ((t_) + 1 <= t_hi) AB_WR(SLOT_NEXT, RW, CW); \
        __syncthreads(); \
        const bool active_ = SWA ? ((t_) <= qt && (t_) >= qt - 4) : ((t_) <= qt); \
        if (active_) attn_compute<SWA>(lds + (SLOT_CUR) * AT_SLOT, qf, cq, m, lsum, o0, o1, (t_) == qt, (t_) == qt - 4, pr, r, hh); \
    } while (0)
    for (int t = t_lo; t <= t_hi; t += 3) {
        AB_ITER(t, R0, C0, R1, C1, 0, 1);
        if (t + 1 > t_hi) break;
        AB_ITER(t + 1, R1, C1, R2, C2, 1, 2);
        if (t + 2 > t_hi) break;
        AB_ITER(t + 2, R2, C2, R0, C0, 2, 0);
    }
    __syncthreads();
#undef AB_ITER
#undef AB_LD
#undef AB_LDC
#undef AB_WR
    float lt = lsum + __shfl_xor(lsum, 32);
    if (SWA) lt += __builtin_amdgcn_exp2f(sink2 - m);
    const float inv = 1.f / lt;
    bf16_t* yrow = Y + (size_t)(q0 + r) * 512 + 4 * hh;
#pragma unroll
    for (int g = 0; g < 4; ++g) {
        u32x2 a, c;
        a.x = pk2(o0[4 * g] * inv, o0[4 * g + 1] * inv); a.y = pk2(o0[4 * g + 2] * inv, o0[4 * g + 3] * inv);
        c.x = pk2(o1[4 * g] * inv, o1[4 * g + 1] * inv); c.y = pk2(o1[4 * g + 2] * inv, o1[4 * g + 3] * inv);
        *(u32x2*)(yrow + 8 * g) = a; *(u32x2*)(yrow + 32 + 8 * g) = c;
    }
}
__device__ __forceinline__ void m1_item(unsigned char* ws, int it, int lane) {
    const int r = lane & 31, hh = lane >> 5;
    const int dvt = it & 3, c = (it >> 2) & 15, bh = it >> 6;
    const bf16_t* VTp = (const bf16_t*)(ws + O_MVT) + ((size_t)bh * 128 + dvt * 32 + r) * SEQ + c * 128 + 8 * hh;
    const bf16_t* KTp = (const bf16_t*)(ws + O_KT) + ((size_t)bh * 128 + r) * SEQ + c * 128 + 8 * hh;
    const float* MPp = (const float*)(ws + O_MP) + (size_t)bh * SEQ + c * 128 + 8 * hh;
    const float mx = ((const float*)(ws + O_MCH))[(bh * 16 + c) * 4 + 1];
    f32x16 acc[4];
#pragma unroll
    for (int d = 0; d < 4; ++d)
#pragma unroll
        for (int i = 0; i < 16; ++i) acc[d][i] = 0.f;
    float dn[4] = {0.f, 0.f, 0.f, 0.f};
#pragma unroll 1
    for (int st = 0; st < 8; ++st) {
        const bf16x8 vf = *(const bf16x8*)(VTp + 16 * st);
        const f32x4 pa = *(const f32x4*)(MPp + 16 * st), pb = *(const f32x4*)(MPp + 16 * st + 4);
        float wk[8];
#pragma unroll
        for (int e = 0; e < 4; ++e) { wk[e] = __expf(pa[e] - mx); wk[4 + e] = __expf(pb[e] - mx); }
#pragma unroll
        for (int d = 0; d < 4; ++d) {
            const u32x4 kr = *(const u32x4*)(KTp + (size_t)d * 32 * SEQ + 16 * st);
            const float k0 = bflo(kr.x) * wk[0], k1 = bfhi(kr.x) * wk[1], k2 = bflo(kr.y) * wk[2], k3 = bfhi(kr.y) * wk[3];
            const float k4 = bflo(kr.z) * wk[4], k5 = bfhi(kr.z) * wk[5], k6 = bflo(kr.w) * wk[6], k7 = bfhi(kr.w) * wk[7];
            dn[d] += ((k0 + k1) + (k2 + k3)) + ((k4 + k5) + (k6 + k7));
            u32x4 kw; kw.x = pk2(k0, k1); kw.y = pk2(k2, k3); kw.z = pk2(k4, k5); kw.w = pk2(k6, k7);
            acc[d] = MFMA32(vf, __builtin_bit_cast(bf16x8, kw), acc[d]);
        }
    }
    bf16_t* DCT = (bf16_t*)(ws + O_DCT) + (size_t)(bh * 16 + c) * 16384;
#pragma unroll
    for (int d = 0; d < 4; ++d) {
#pragma unroll
        for (int g4 = 0; g4 < 4; ++g4) { int og = (dvt * 32 + 8 * g4 + 4 * hh) * 128 + d * 32 + r; asm volatile("" : "+v"(og)); bf16_t* pg = DCT + og;
            pg[0] = (bf16_t)pk2(acc[d][4 * g4], 0.f); pg[128] = (bf16_t)pk2(acc[d][4 * g4 + 1], 0.f); pg[256] = (bf16_t)pk2(acc[d][4 * g4 + 2], 0.f); pg[384] = (bf16_t)pk2(acc[d][4 * g4 + 3], 0.f); }
        const float t = dn[d] + __shfl_xor(dn[d], 32);
        if (dvt == 0 && hh == 0) ((float*)(ws + O_DN))[(bh * 16 + c) * 128 + d * 32 + r] = t;
    }
}
__device__ __forceinline__ void phase_m2(unsigned char* ws, int gtid, int NT) {
    const float* MCH = (const float*)(ws + O_MCH);
    for (int e = gtid; e < BG * 4 * 2048; e += NT) {
        const int bh = e >> 11, pp = e & 2047;
        const bf16_t* src = (const bf16_t*)(ws + O_DCT) + (size_t)bh * 16 * 16384 + 8 * pp;
        bf16_t* dst = (bf16_t*)(ws + O_CT) + (size_t)bh * 16 * 16384 + 8 * pp;
        u32x4 d[15]; float dec[15];
#pragma unroll
        for (int c = 0; c < 15; ++c) { d[c] = *(const u32x4*)(src + (size_t)c * 16384); dec[c] = MCH[(bh * 16 + c) * 4 + 2]; }
        float cs[8] = {0.f, 0.f, 0.f, 0.f, 0.f, 0.f, 0.f, 0.f};
        *(u32x4*)dst = (u32x4){0u, 0u, 0u, 0u};
#pragma unroll
        for (int c = 0; c < 15; ++c) {
            cs[0] = dec[c] * cs[0] + bflo(d[c].x); cs[1] = dec[c] * cs[1] + bfhi(d[c].x); cs[2] = dec[c] * cs[2] + bflo(d[c].y); cs[3] = dec[c] * cs[3] + bfhi(d[c].y);
            cs[4] = dec[c] * cs[4] + bflo(d[c].z); cs[5] = dec[c] * cs[5] + bfhi(d[c].z); cs[6] = dec[c] * cs[6] + bflo(d[c].w); cs[7] = dec[c] * cs[7] + bfhi(d[c].w);
            u32x4 o; o.x = pk2(cs[0], cs[1]); o.y = pk2(cs[2], cs[3]); o.z = pk2(cs[4], cs[5]); o.w = pk2(cs[6], cs[7]);
            *(u32x4*)(dst + (size_t)(c + 1) * 16384) = o;
        }
    }
    for (int e = gtid; e < BG * 4 * 128; e += NT) {
        const int bh = e >> 7, dk = e & 127; float n = 0.f;
        for (int c = 0; c < 16; ++c) { const size_t off = (size_t)(bh * 16 + c) * 128 + dk; ((float*)(ws + O_NN))[off] = n; n = MCH[(bh * 16 + c) * 4 + 2] * n + ((const float*)(ws + O_DN))[off]; }
    }
}
__device__ __forceinline__ void m3_item(unsigned char* ws, int l, int it, int lane) {
    const int r = lane & 31, hh = lane >> 5;
    const int pr = ((r >> 2) & 1) * 16 + ((r >> 4) & 1) * 8 + ((r >> 3) & 1) * 4 + (r & 3);
    const int tt = 3 - (it & 3), c = (it >> 2) & 15, bh = it >> 6, b = bh >> 2, h = bh & 3;
    const int ts = c * 128 + tt * 32 + r;
    const size_t trow = (size_t)b * SEQ + ts;
    bf16x8 qf[8];
    const bf16_t* Qp = (const bf16_t*)(ws + O_MQC) + trow * 512 + h * 128 + 8 * hh;
#pragma unroll
    for (int k = 0; k < 8; ++k) qf[k] = *(const bf16x8*)(Qp + 16 * k);
    const float Et = ((const float*)(ws + O_ME))[(size_t)bh * SEQ + ts], bt = ((const float*)(ws + O_MBT))[(size_t)bh * SEQ + ts];
    const float mc = ((const float*)(ws + O_MCH))[(bh * 16 + c) * 4];
    const float winter = __expf(mc - Et);
    f32x16 acc[4];
#pragma unroll
    for (int d = 0; d < 4; ++d)
#pragma unroll
        for (int i = 0; i < 16; ++i) acc[d][i] = 0.f;
    const bf16_t* CTp = (const bf16_t*)(ws + O_CT) + (size_t)(bh * 16 + c) * 16384 + (size_t)r * 128 + 8 * hh;
    const float* NNp = (const float*)(ws + O_NN) + (size_t)(bh * 16 + c) * 128 + 8 * hh;
    float qn = 0.f;
#pragma unroll
    for (int k = 0; k < 8; ++k) {
#pragma unroll
        for (int d = 0; d < 4; ++d) acc[d] = MFMA32(*(const bf16x8*)(CTp + (size_t)d * 32 * 128 + 16 * k), qf[k], acc[d]);
        const f32x4 na = *(const f32x4*)(NNp + 16 * k), nb = *(const f32x4*)(NNp + 16 * k + 4);
        const u32x4 qw = __builtin_bit_cast(u32x4, qf[k]);
        qn += bflo(qw.x) * na[0] + bfhi(qw.x) * na[1] + bflo(qw.y) * na[2] + bfhi(qw.y) * na[3] + bflo(qw.z) * nb[0] + bfhi(qw.z) * nb[1] + bflo(qw.w) * nb[2] + bfhi(qw.w) * nb[3];
        asm volatile("" ::: "memory");
    }
    qn += __shfl_xor(qn, 32);
#pragma unroll
    for (int d = 0; d < 4; ++d)
#pragma unroll
        for (int i = 0; i < 16; ++i) acc[d][i] *= winter;
    float dpart = 0.f;
    const bf16_t* Kb = (const bf16_t*)(ws + O_MKC) + ((size_t)b * SEQ + c * 128 + pr) * 512 + h * 128 + 8 * hh;
    const bf16_t* Vb = (const bf16_t*)(ws + O_MVT) + ((size_t)bh * 128 + r) * SEQ + c * 128 + 16 * hh;
    const float* MPb = (const float*)(ws + O_MP) + (size_t)bh * SEQ + c * 128 + 16 * hh;
    for (int st = 0; st <= tt; ++st) {
        f32x16 sc;
#pragma unroll
        for (int i = 0; i < 16; ++i) sc[i] = 0.f;
#pragma unroll
        for (int k = 0; k < 8; ++k) { sc = MFMA32(*(const bf16x8*)(Kb + (size_t)st * 32 * 512 + 16 * k), qf[k], sc); if (k == 3) asm volatile("" ::: "memory"); }
        asm volatile("" ::: "memory");
#pragma unroll
        for (int g = 0; g < 4; ++g) { const f32x4 pv = *(const f32x4*)(MPb + st * 32 + 4 * g);
#pragma unroll
            for (int e = 0; e < 4; ++e) { const int i = 4 * g + e;
                const bool ok = (st < tt) || (16 * hh + i <= r);
                const float w = ok ? __expf(pv[e] - Et) : 0.f;
                sc[i] = ok ? sc[i] * w : 0.f; dpart += sc[i]; } }
        u32x4 pw0, pw1;
        pw0.x = pk2(sc[0], sc[1]); pw0.y = pk2(sc[2], sc[3]); pw0.z = pk2(sc[4], sc[5]); pw0.w = pk2(sc[6], sc[7]);
        pw1.x = pk2(sc[8], sc[9]); pw1.y = pk2(sc[10], sc[11]); pw1.z = pk2(sc[12], sc[13]); pw1.w = pk2(sc[14], sc[15]);
        const bf16x8 pf0 = __builtin_bit_cast(bf16x8, pw0), pf1 = __builtin_bit_cast(bf16x8, pw1);
#pragma unroll
        for (int d = 0; d < 4; ++d) {
            acc[d] = MFMA32(*(const bf16x8*)(Vb + (size_t)d * 32 * SEQ + st * 32), pf0, acc[d]);
            acc[d] = MFMA32(*(const bf16x8*)(Vb + (size_t)d * 32 * SEQ + st * 32 + 8), pf1, acc[d]);
            if (d == 1) asm volatile("" ::: "memory");
        }
    }
    const float den = winter * qn + (dpart + __shfl_xor(dpart, 32));
    const float dinv = 1.f / fmaxf(fabsf(den), __expf(-(bt + Et)));
    float ss = 0.f;
#pragma unroll
    for (int d = 0; d < 4; ++d)
#pragma unroll
        for (int i = 0; i < 16; ++i) { acc[d][i] *= dinv; ss += acc[d][i] * acc[d][i]; }
    ss += __shfl_xor(ss, 32);
    const float rn = rsqrtf(ss * (1.f / 128.f) + EPS);
    const float* onorm = (const float*)(ws + O_PAR) + PAR_ON + l * 512 + h * 128 + 4 * hh;
    const bf16_t* mo = (const bf16_t*)(ws + O_U) + trow * LDU + UC_MO + h * 128 + 4 * hh;
    bf16_t* y = (bf16_t*)(ws + O_Y) + (size_t)2 * MG * 512 + trow * 512 + h * 128 + 4 * hh;
#pragma unroll
    for (int d = 0; d < 4; ++d)
#pragma unroll
        for (int g = 0; g < 4; ++g) {
            const int dv = d * 32 + 8 * g;
            const f32x4 wn = *(const f32x4*)(onorm + dv); const u32x2 og = *(const u32x2*)(mo + dv);
            const float y0 = acc[d][4 * g] * rn * wn[0] * sigm(bflo(og.x)), y1 = acc[d][4 * g + 1] * rn * wn[1] * sigm(bfhi(og.x));
            const float y2 = acc[d][4 * g + 2] * rn * wn[2] * sigm(bflo(og.y)), y3 = acc[d][4 * g + 3] * rn * wn[3] * sigm(bfhi(og.y));
            u32x2 o; o.x = pk2(y0, y1); o.y = pk2(y2, y3); *(u32x2*)(y + dv) = o;
            if (g & 1) asm volatile("" ::: "memory");
        }
}

#define XB_TMO      128
#define XB_XCNT(j)  (256  + 64 * (j))
#define XB_XSUB(j)  (1280 + 64 * (j))
#define XB_XGEN(j)  (2304 + 64 * (j))
#define XB_TOP      3328
#define XB_TOPGEN   3392
#define XCD_BAR_WORDS 3456
#define XB_SPIN_CAP (1u << 18)

__device__ __forceinline__ unsigned xb_ld(unsigned* p)              { return __hip_atomic_load(p, __ATOMIC_RELAXED, __HIP_MEMORY_SCOPE_AGENT); }
__device__ __forceinline__ unsigned xb_add(unsigned* p, unsigned v) { return __hip_atomic_fetch_add(p, v, __ATOMIC_RELAXED, __HIP_MEMORY_SCOPE_AGENT); }
__device__ __forceinline__ unsigned xb_xcc_id() { return (unsigned)__builtin_amdgcn_s_getreg((3 << 11) | 20) & 0xFu; }
#define XB_SPIN(cond, bar) do { unsigned _sp = 0; while (cond) { __builtin_amdgcn_s_sleep(1); \
    if ((++_sp & 255u) == 0u) { if (xb_ld(&(bar)[XB_TMO])) break; if (_sp > XB_SPIN_CAP) { atomicAdd(&(bar)[XB_TMO], 1u); break; } } } } while (0)

struct XcdBarrier {
    unsigned* bar; unsigned x;
    volatile LAS unsigned* st;
};

__device__ __forceinline__ XcdBarrier xcd_barrier_post(unsigned* bar, volatile LAS unsigned* st) {
    XcdBarrier b; b.bar = bar; b.x = xb_xcc_id(); b.st = st;
    if (threadIdx.x == 0) (void)xb_add(&bar[XB_XCNT(b.x)], 1u);
    return b;
}
__device__ __forceinline__ void xcd_barrier_complete(unsigned* bar, unsigned x, unsigned& nloc, unsigned& nx) {
    const unsigned G = gridDim.x * gridDim.y * gridDim.z;
    unsigned sum, cnt, mine, sp = 0u;
    for (;;) {
        sum = 0u; cnt = 0u; mine = 0u;
#pragma unroll
        for (unsigned j = 0; j < 16; ++j) { const unsigned c = xb_ld(&bar[XB_XCNT(j)]); sum += c; cnt += (c > 0u) ? 1u : 0u; mine = (j == x) ? c : mine; }
        if (sum == G) break;
        __builtin_amdgcn_s_sleep(1);
        if ((++sp & 255u) == 0u) { if (xb_ld(&bar[XB_TMO])) break; if (sp > XB_SPIN_CAP) { atomicAdd(&bar[XB_TMO], 1u); break; } }
    }
    nloc = mine > 0u ? mine : 1u; nx = cnt > 0u ? cnt : 1u;
}

__device__ __forceinline__ void xcd_barrier(const XcdBarrier& b) {
    asm volatile("s_waitcnt vmcnt(0)" ::: "memory");
    __syncthreads();
    if (threadIdx.x == 0) {
        unsigned* bar = b.bar;
        __builtin_amdgcn_s_waitcnt(0);
        unsigned nloc = b.st[0], nx = b.st[1];
        if (nloc == 0u) { xcd_barrier_complete(bar, b.x, nloc, nx); b.st[0] = nloc; b.st[1] = nx; }
        const unsigned old = xb_add(&bar[XB_XSUB(b.x)], 1u);
        const unsigned gen = old / nloc;
        if (old + 1u == (gen + 1u) * nloc) {
            __builtin_amdgcn_fence(__ATOMIC_RELEASE, "agent");
            asm volatile("s_waitcnt vmcnt(0)" ::: "memory");
            const unsigned og = xb_add(&bar[XB_TOP], 1u);
            const unsigned tg = og / nx;
            if (og + 1u == (tg + 1u) * nx) xb_add(&bar[XB_TOPGEN], 1u);
            else XB_SPIN(xb_ld(&bar[XB_TOPGEN]) == tg, bar);
            __builtin_amdgcn_fence(__ATOMIC_ACQUIRE, "agent");
            xb_add(&bar[XB_XGEN(b.x)], 1u);
            asm volatile("s_waitcnt vmcnt(0)" ::: "memory");
        } else {
            XB_SPIN(xb_ld(&bar[XB_XGEN(b.x)]) == gen, bar);
            __builtin_amdgcn_fence(__ATOMIC_ACQUIRE, "agent");
            asm volatile("s_waitcnt vmcnt(0)" ::: "memory");
        }
    }
    __syncthreads();
}


__global__ void __launch_bounds__(NTHR, 2) fwd_kernel(KP p) {
    extern __shared__ __attribute__((aligned(16))) unsigned char lds_raw[];
    LAS unsigned char* lds = (LAS unsigned char*)lds_raw;
    cg::grid_group grid = cg::this_grid();
    const int tid = threadIdx.x, lane0 = tid & 63, wave = __builtin_amdgcn_readfirstlane(tid >> 6);
    const int G = gridDim.x, gw0 = blockIdx.x * NWAVES + wave, NWV = G * NWAVES, NT = G * NTHR;
    unsigned char* ws0 = p.ws;
    volatile LAS unsigned* MISC = (volatile LAS unsigned*)(lds + 131072);
    if (tid < 64) MISC[tid] = 0u;
    __syncthreads();
    XcdBarrier bar = xcd_barrier_post((unsigned*)(ws0 + O_BAR), MISC + 8);
#ifndef PM
#define PM 0xFFFF
#endif
#ifndef PROBE_ID
#define PROBE_ID -1
#define PROBE_REP 1
#endif
#ifndef PM4
#define PM4 7
#endif
#define XB ((bf16_t*)(ws + O_XB))
#define RS ((float*)(ws + O_RS))
#define U ((bf16_t*)(ws + O_U))
    for (int pc = p.ph_lo; pc < p.ph_hi; ++pc) {
        int id = 0, g = 0, l = 0;
        if (pc > 0) { const int q_ = pc - 1, r_ = q_ % (1 + DEPTH * 9); g = q_ / (1 + DEPTH * 9); if (r_ == 0) id = 1; else { l = (r_ - 1) / 9; id = 2 + (r_ - 1) % 9; } }
        const size_t goff = (size_t)g * MG * DM;
        const int nrep = (PROBE_ID == id) ? PROBE_REP : 1;
        for (int rep_ = 0; rep_ < nrep; ++rep_) {
            size_t zo_ = 0; int lane = lane0, gw = gw0; asm volatile("" : "+s"(zo_), "+v"(lane), "+s"(gw));
            unsigned char* ws = p.ws + zo_;
            const int gtid = gw * 64 + lane; (void)gtid;
            if (!((PM >> id) & 1)) continue;
            switch (id) {
    case 0: { phase_p0(p, ws, lds, gw, NWV, wave, lane); } break;

        case 1: { phase_x0(p.in[0] + goff, XB, RS, gw, NWV, lane); } break;
            case 2: { {
                pg8::Gemm gm{XB, (const bf16_t*)(ws + O_WIN) + (size_t)l * NINP * DM, MG, NINP, DM}; pg8::StaticOrder S; S.init(MG, NINP, G, (int)blockIdx.x);
                pg8::EpiA E{0, 0, RS, U, LDU, (float*)(ws + O_SG), nullptr, 0, nullptr};
                pg8::gemm_phase<pg8::EpiA, pg8::StaticOrder, true, true>(lds, gm, S, E);
            } } break;
            case 3: { {
                constexpr int N_SCAN = BG * 12, N_HN3 = 3 * (MG / 8), N_HK = MG / 32, N_ST = 34 * (MG / 64);
                const int sw = (wave == 7 && (int)blockIdx.x < N_SCAN) ? (int)blockIdx.x : -1;
                if (sw >= 0) { for (int it = sw; it < N_SCAN; it += G) gate_scan_item(ws, l, it, lane); }
                else {
                    const int nscanw = (N_SCAN < G ? N_SCAN : G);
                    const int wi = (int)blockIdx.x < nscanw ? (int)blockIdx.x * 7 + wave : nscanw * 7 + ((int)blockIdx.x - nscanw) * 8 + wave;
                    const int nw = NWV - nscanw;
                    for (int it = wi; it < N_HN3 + N_HK + N_ST; it += nw) {
                        if (it < N_HN3) headnorm_item(ws, l, it % 3, it / 3, lane);
                        else if (it < N_HN3 + N_HK) headnorm_item(ws, l, 3, it - N_HN3, lane);
                        else stream_item(ws, l, it - N_HN3 - N_HK, lane);
                    }
                }
            } } break;
            case 4: { {
                if (PM4 & 1) for (int it = gw; it < BG * 4 * 16 * 4; it += NWV) m1_item(ws, it, lane);
                __syncthreads();
                if (PM4 & 2) for (int it = (int)blockIdx.x; it < BG * 8 * 4; it += G) {
                    const int b = it >> 5, h = (it >> 2) & 7, jp = it & 3;
                    const bf16_t* Q = (const bf16_t*)(ws + O_FQN) + (size_t)b * SEQ * 512 + h * 64; const bf16_t* K = (const bf16_t*)(ws + O_FKN) + (size_t)b * SEQ * 512 + h * 64;
                    const bf16_t* VT = (const bf16_t*)(ws + O_FVT) + (size_t)(b * 8 + h) * 64 * SEQ; const float* C = (const float*)(ws + O_FC) + (size_t)(b * 8 + h) * SEQ;
                    bf16_t* Y = (bf16_t*)(ws + O_Y) + (size_t)b * SEQ * 512 + h * 64;
                    attn_block<false>(lds, Q, K, 512, VT, C, 0.f, Y, 8 * (7 - jp) + wave, 0, 8 * (7 - jp) + 7, wave, lane);
                    attn_block<false>(lds, Q, K, 512, VT, C, 0.f, Y, 8 * jp + wave, 0, 8 * jp + 7, wave, lane);
                }
                if (PM4 & 4) for (int it = (int)blockIdx.x; it < BG * 2 * 32; it += G) {
                    const int b = it >> 6, hk = (it >> 5) & 1, u = it & 31, hq = hk * 4 + (wave & 3), qt = 2 * u + (wave >> 2);
                    const bf16_t* Q = (const bf16_t*)(ws + O_SQR) + (size_t)b * SEQ * 512 + hq * 64; const bf16_t* K = (const bf16_t*)(ws + O_SKR) + (size_t)b * SEQ * 128 + hk * 64;
                    const bf16_t* VT = (const bf16_t*)(ws + O_SVT) + (size_t)(b * 2 + hk) * 64 * SEQ;
                    bf16_t* Y = (bf16_t*)(ws + O_Y) + (size_t)MG * 512 + (size_t)b * SEQ * 512 + hq * 64;
                    attn_block<true>(lds, Q, K, 128, VT, nullptr, ((const float*)(ws + O_PAR))[PAR_SINK + l * 8 + hq] * LOG2E, Y, qt, (2 * u > 4 ? 2 * u - 4 : 0), 2 * u + 1, wave, lane);
                }
            } } break;
            case 5: { phase_m2(ws, gtid, NT); } break;
            case 6: { { for (int it = gw; it < BG * 4 * 16 * 4; it += NWV) m3_item(ws, l, it, lane); } } break;
            case 7: { {
                pg8::Gemm gm{(const bf16_t*)(ws + O_Y), (const bf16_t*)(ws + O_WB) + (size_t)l * 3 * DM * 512, 3 * MG, 3 * DM, 512}; pg8::DiagOrder S; S.init(MG, DM, G, (int)blockIdx.x);
                pg8::EpiM E{MG / 256, (bf16_t*)(ws + O_MRG), U + UC_G, LDU, (float*)(ws + O_TMP)};
                pg8::gemm_phase<pg8::EpiM, pg8::DiagOrder, true, true>(lds, gm, S, E);
            } } break;
            case 8: { {
                pg8::Gemm gm{(const bf16_t*)(ws + O_MRG), (const bf16_t*)(ws + O_WOUT) + (size_t)l * DM * DM, MG, DM, DM}; pg8::StaticOrder S; S.init(MG, DM, G, (int)blockIdx.x);
                pg8::EpiB E{(l == 0 ? p.in[0] : (const float*)p.out) + goff, p.out + goff, XB, RS};
                pg8::gemm_phase<pg8::EpiB, pg8::StaticOrder, true, true>(lds, gm, S, E);
            } } break;
            case 9: { {
                pg8::Gemm gm{XB, (const bf16_t*)(ws + O_WUP) + (size_t)l * FF * DM, MG, FF, DM}; pg8::StaticOrder S; S.init(MG, FF, G, (int)blockIdx.x);
                pg8::EpiA E{2, 0, RS, U  , FF, nullptr, nullptr, 0, nullptr};
                pg8::gemm_phase<pg8::EpiA, pg8::StaticOrder, true, true>(lds, gm, S, E);
            } } break;
            case 10: { {
                pg8::Gemm gm{U  , (const bf16_t*)(ws + O_WDN) + (size_t)l * DM * FF, MG, DM, FF}; pg8::StaticOrder S; S.init(MG, DM, G, (int)blockIdx.x);
                pg8::EpiB E{(const float*)p.out + goff, p.out + goff, XB, RS};
                pg8::gemm_phase<pg8::EpiB, pg8::StaticOrder, true, true>(lds, gm, S, E);
            } } break;
            default: break;
            }
        }
        if (pc + 1 < p.ph_hi) { if (pc == 0) grid.sync(); else xcd_barrier(bar); }
    }
}
constexpr int N_PHASES = 1 + NG * (1 + DEPTH * 9);

#ifndef MK_MULTI
#define MK_MULTI 0
#endif
extern "C" void kernel_launch(void* const* d_in, const int* in_sizes, int n_in, void* d_out, int out_size, void* d_ws, size_t ws_size, hipStream_t stream) {
    static int grid = 0;
    if (grid == 0) {
        if (n_in != 19 || out_size != NB * SEQ * DM || ws_size < WS_NEED) { fprintf(stderr, "kernel_launch: unexpected problem (n_in %d out %d ws %zu need %zu)\n", n_in, out_size, ws_size, (size_t)WS_NEED); grid = -1; return; }
        int dev = 0, cus = 0, per_cu = 0;
        hipGetDevice(&dev); hipDeviceGetAttribute(&cus, hipDeviceAttributeMultiprocessorCount, dev);
        if (hipFuncSetAttribute((const void*)fwd_kernel, hipFuncAttributeMaxDynamicSharedMemorySize, LDS_BYTES) != hipSuccess) { fprintf(stderr, "kernel_launch: hipFuncSetAttribute failed\n"); grid = -1; return; }
        hipOccupancyMaxActiveBlocksPerMultiprocessor(&per_cu, (const void*)fwd_kernel, NTHR, LDS_BYTES);
        (void)hipGetLastError();
        if (per_cu < 1) { fprintf(stderr, "kernel_launch: occupancy query says %d blocks per CU\n", per_cu); per_cu = 1; }
        grid = cus;
    }
    if (grid < 0) return;
    if (hipMemsetAsync((char*)d_ws + O_BAR, 0, 16384, stream) != hipSuccess) { fprintf(stderr, "kernel_launch: memset failed\n"); return; }
    KP a{};
    for (int i = 0; i < 19; ++i) a.in[i] = (const float*)d_in[i];
    a.out = (float*)d_out; a.ws = (unsigned char*)d_ws;
#if MK_MULTI
    for (int ph = 0; ph < N_PHASES; ++ph) { a.ph_lo = ph; a.ph_hi = ph + 1; hipLaunchKernelGGL(fwd_kernel, dim3(grid), dim3(NTHR), LDS_BYTES, stream, a); }
#else
    a.ph_lo = 0; a.ph_hi = N_PHASES;
    void* args[] = {&a};
    hipError_t e = hipLaunchCooperativeKernel((const void*)fwd_kernel, dim3(grid), dim3(NTHR), args, LDS_BYTES, stream);
    if (e != hipSuccess) fprintf(stderr, "kernel_launch: cooperative launch failed: %s (grid %d)\n", hipGetErrorString(e), grid);
#endif
}
```

```cpp
#include <hip/hip_runtime.h>
#include <hip/hip_cooperative_groups.h>
#include <cstdio>
#include <cstdint>
#include <cmath>
namespace cg = cooperative_groups;
namespace pg8 {
#define PG8_LAS __attribute__((address_space(3)))
typedef unsigned short bf16_t;
typedef short bf16x8 __attribute__((ext_vector_type(8)));
typedef float f32x4 __attribute__((ext_vector_type(4)));
typedef unsigned u32x4 __attribute__((ext_vector_type(4)));
constexpr int BM = 256, BK = 64, HALF = 128, HTB = HALF * BK * 2  , STAGE_BYTES = 8 * HTB, NXCD = 8, WGM = 8;

__host__ __device__ __forceinline__ int lds_byte(int r, int c) { const int st = (r >> 4) * 2 + (c >> 5), rr = r & 15, cc = c & 31, ob = rr * 64 + cc * 2; return st * 1024 + (ob ^ (((ob >> 9) & 1) << 5)); }
__host__ __device__ __forceinline__ void stage_rc(int b, int& R, int& C) { const int st = b / 1024, sb = b % 1024, swz = sb ^ (((sb >> 9) & 1) << 5); R = (st >> 1) * 16 + swz / 64; C = (st & 1) * 32 + (swz % 64) / 2; }
__host__ __device__ __forceinline__ int perm32(int rho) { const int n = rho >> 4, i = rho & 15; return 8 * (i >> 2) + 4 * n + (i & 3); }

struct Unit { int pm, pn; };
struct Gemm { const bf16_t* A; const bf16_t* Bt; int M, N, K; };

struct StaticOrder {
    int nM, nN, nwg, G, c;
    __host__ __device__ void init(int M, int N, int G_, int c_) { nM = M / BM; nN = N / BM; nwg = nM * nN; G = G_; c = c_; }
    __host__ __device__ bool next(int i, Unit& u) const {
        const long L = (long)i * G + c; if (L >= nwg) return false;
        int wgid = (int)L; { const int q = nwg / NXCD, r = nwg % NXCD, xcd = wgid % NXCD, off = wgid / NXCD; wgid = (xcd < r ? xcd * (q + 1) : r * (q + 1) + (xcd - r) * q) + off; }
        const int nig = WGM * nN, gid = wgid / nig, fm = gid * WGM, gsz = (nM - fm) < WGM ? (nM - fm) : WGM;
        u.pm = fm + ((wgid % nig) % gsz); u.pn = (wgid % nig) / gsz; return true;
    }
    __device__ __forceinline__ void a_ready(const Unit&) const {}
    __device__ __forceinline__ void done(const Unit&) const {}
};


typedef unsigned u32x2 __attribute__((ext_vector_type(2)));
typedef float f32x2_t __attribute__((ext_vector_type(2)));
typedef __bf16 bf16x2_t __attribute__((ext_vector_type(2)));
__device__ __forceinline__ unsigned pk2(float lo, float hi) { f32x2_t v = {lo, hi}; bf16x2_t b = __builtin_convertvector(v, bf16x2_t); return __builtin_bit_cast(unsigned, b); }
__device__ __forceinline__ float bflo(unsigned w) { return __uint_as_float(w << 16); }
__device__ __forceinline__ float bfhi(unsigned w) { return __uint_as_float(w & 0xffff0000u); }
__device__ __forceinline__ float sigm(float x) { return __builtin_amdgcn_rcpf(1.f + __expf(-x)); }
__device__ __forceinline__ float rowscale(const float* rs, int row) {
    const f32x4* p = (const f32x4*)(rs + (size_t)row * 16);
    const f32x4 a = p[0], b = p[1], c = p[2], d = p[3];
    const float s = ((a[0] + a[1]) + (a[2] + a[3])) + ((b[0] + b[1]) + (b[2] + b[3])) + ((c[0] + c[1]) + (c[2] + c[3])) + ((d[0] + d[1]) + (d[2] + d[3]));
    return rsqrtf(s * (1.f / 1024.f) + 1e-6f);
}
struct EpiA {
    static constexpr bool PERM = true, AFTER_DRAIN = false;
    static __device__ __forceinline__ bool keeps(const Unit&) { return false; }
    int mode, sub; const float* rs; bf16_t* out; int ldo; float* sg; const bf16_t* gate; int ldg; float* tmp;
    __device__ __forceinline__ void operator()(const f32x4 (&acc)[2][2][4][2], const Unit& u, int wr, int wc, int fr, int fq) const {
        const int row0 = u.pm * BM + wr * 64 + fr, colb = u.pn * BM + wc * 32 + 8 * fq;
        float rsv8[2][4];
        if (mode != 1) {
            f32x4 part[2][4];
#pragma unroll
            for (int ai = 0; ai < 2; ++ai)
#pragma unroll
                for (int m = 0; m < 4; ++m) part[ai][m] = *(const f32x4*)(rs + (size_t)(row0 + ai * HALF + m * 16) * 16 + 4 * fq);
#pragma unroll
            for (int ai = 0; ai < 2; ++ai)
#pragma unroll
                for (int m = 0; m < 4; ++m) { float sp = (part[ai][m][0] + part[ai][m][1]) + (part[ai][m][2] + part[ai][m][3]); sp += __shfl_xor(sp, 16); sp += __shfl_xor(sp, 32); rsv8[ai][m] = rsqrtf(sp * (1.f / 1024.f) + 1e-6f); }
        } else {
#pragma unroll
            for (int ai = 0; ai < 2; ++ai)
#pragma unroll
                for (int m = 0; m < 4; ++m) rsv8[ai][m] = 1.f;
        }
#pragma unroll
        for (int ai = 0; ai < 2; ++ai)
#pragma unroll
            for (int m = 0; m < 4; ++m) {
                const int row = row0 + ai * HALF + m * 16;
                const float rsv = rsv8[ai][m];
#pragma unroll
                for (int bj = 0; bj < 2; ++bj) {
                    const int col = colb + bj * HALF;
                    f32x4 v0 = acc[ai][bj][m][0] * rsv, v1 = acc[ai][bj][m][1] * rsv;
                    if (mode == 0) {
                        if (u.pn == 29) {
                            if (bj == 0 && wc == 0 && fq < 2) { float* q = sg + (size_t)row * 16 + 8 * fq; *(f32x4*)q = v0; *(f32x4*)(q + 4) = v1; }
                        } else {
                            if (u.pn >= 17) {
#pragma unroll
                                for (int e = 0; e < 4; ++e) { v0[e] = sigm(v0[e]); v1[e] = sigm(v1[e]); }
                            }
                            u32x4 w; w.x = pk2(v0[0], v0[1]); w.y = pk2(v0[2], v0[3]); w.z = pk2(v1[0], v1[1]); w.w = pk2(v1[2], v1[3]);
                            *(u32x4*)(out + (size_t)row * ldo + col) = w;
                        }
                    } else if (mode == 1) {
                        const u32x4 g = *(const u32x4*)(gate + (size_t)row * ldg + col);
                        f32x4 p0 = {v0[0] * bflo(g.x), v0[1] * bfhi(g.x), v0[2] * bflo(g.y), v0[3] * bfhi(g.y)};
                        f32x4 p1 = {v1[0] * bflo(g.z), v1[1] * bfhi(g.z), v1[2] * bflo(g.w), v1[3] * bfhi(g.w)};
                        float* tp = tmp + (size_t)row * 1024 + col;
                        if (sub == 0) { *(f32x4*)tp = p0; *(f32x4*)(tp + 4) = p1; }
                        else if (sub == 1) { *(f32x4*)tp = *(const f32x4*)tp + p0; *(f32x4*)(tp + 4) = *(const f32x4*)(tp + 4) + p1; }
                        else { p0 = p0 + *(const f32x4*)tp; p1 = p1 + *(const f32x4*)(tp + 4);
                            u32x4 w; w.x = pk2(p0[0], p0[1]); w.y = pk2(p0[2], p0[3]); w.z = pk2(p1[0], p1[1]); w.w = pk2(p1[2], p1[3]);
                            *(u32x4*)(out + (size_t)row * ldo + col) = w; }
                    } else {
#pragma unroll
                        for (int e = 0; e < 4; ++e) { const float a = fmaxf(v0[e], 0.f), b = fmaxf(v1[e], 0.f); v0[e] = a * a; v1[e] = b * b; }
                        u32x4 w; w.x = pk2(v0[0], v0[1]); w.y = pk2(v0[2], v0[3]); w.z = pk2(v1[0], v1[1]); w.w = pk2(v1[2], v1[3]);
                        *(u32x4*)(out + (size_t)row * ldo + col) = w;
                    }
                }
            }
    }
};
struct EpiB {
    static constexpr bool PERM = false, AFTER_DRAIN = false;
    static __device__ __forceinline__ bool keeps(const Unit&) { return false; }
    const float* resid; float* out; bf16_t* xb; float* rs;
    __device__ __forceinline__ void operator()(const f32x4 (&acc)[2][2][4][2], const Unit& u, int wr, int wc, int fr, int fq) const {
        const int row0 = u.pm * BM + wr * 64 + fr, colb = u.pn * BM + wc * 32 + 4 * fq;
#pragma unroll
        for (int ai = 0; ai < 2; ++ai)
#pragma unroll
            for (int m = 0; m < 4; ++m) {
                const int row = row0 + ai * HALF + m * 16; float ss = 0.f;
#pragma unroll
                for (int bj = 0; bj < 2; ++bj)
#pragma unroll
                    for (int n = 0; n < 2; ++n) {
                        const size_t off = (size_t)row * 1024 + colb + bj * HALF + n * 16;
                        const f32x4 x = *(const f32x4*)(resid + off) + acc[ai][bj][m][n];
                        *(f32x4*)(out + off) = x;
                        u32x2 w; w.x = pk2(x[0], x[1]); w.y = pk2(x[2], x[3]); *(u32x2*)(xb + off) = w;
                        ss += (x[0] * x[0] + x[1] * x[1]) + (x[2] * x[2] + x[3] * x[3]);
                    }
                ss += __shfl_xor(ss, 16); ss += __shfl_xor(ss, 32);
                if (fq == 0) rs[(size_t)row * 16 + u.pn * 4 + wc] = ss;
            }
    }
};

struct EpiM {
    static constexpr bool PERM = true, AFTER_DRAIN = false;
    static __device__ __forceinline__ bool keeps(const Unit& u) { return (u.pn >> 2) != 2; }
    int nM; bf16_t* out; const bf16_t* gate; int ldg;
    __device__ __forceinline__ void operator()(const f32x4 (&acc_)[2][2][4][2], const Unit& u, int wr, int wc, int fr, int fq) const {
        f32x4 (&acc)[2][2][4][2] = const_cast<f32x4 (&)[2][2][4][2]>(acc_);
        const int sub = u.pn >> 2, pm = u.pm - sub * nM, pn = u.pn & 3;
        const int row0 = pm * BM + wr * 64 + fr, colb = pn * BM + wc * 32 + 8 * fq;
        const bf16_t* gb = gate + sub * 1024;
#pragma unroll
        for (int ai = 0; ai < 2; ++ai)
#pragma unroll
            for (int m = 0; m < 4; ++m)
#pragma unroll
                for (int bj = 0; bj < 2; ++bj) {
                    const size_t goff = (size_t)(row0 + ai * HALF + m * 16) * ldg + colb + bj * HALF;
                    const u32x4 g = *(const u32x4*)(gb + goff);
                    float f[8] = {bflo(g.x), bfhi(g.x), bflo(g.y), bfhi(g.y), bflo(g.z), bfhi(g.z), bflo(g.w), bfhi(g.w)};
#pragma unroll
                    for (int e = 0; e < 8; ++e) f[e] = fmaxf(f[e], 1e-30f);
                    if (sub != 2) {
                        const u32x4 gn = *(const u32x4*)(gb + 1024 + goff);
                        const float d[8] = {bflo(gn.x), bfhi(gn.x), bflo(gn.y), bfhi(gn.y), bflo(gn.z), bfhi(gn.z), bflo(gn.w), bfhi(gn.w)};
#pragma unroll
                        for (int e = 0; e < 8; ++e) f[e] = f[e] * __builtin_amdgcn_rcpf(fmaxf(d[e], 1e-30f));
                    }
                    f32x4& v0 = acc[ai][bj][m][0]; f32x4& v1 = acc[ai][bj][m][1];
                    v0[0] *= f[0]; v0[1] *= f[1]; v0[2] *= f[2]; v0[3] *= f[3]; v1[0] *= f[4]; v1[1] *= f[5]; v1[2] *= f[6]; v1[3] *= f[7];
                    if (sub == 2) {
                        u32x4 w; w.x = pk2(v0[0], v0[1]); w.y = pk2(v0[2], v0[3]); w.z = pk2(v1[0], v1[1]); w.w = pk2(v1[2], v1[3]);
                        *(u32x4*)(out + (size_t)(row0 + ai * HALF + m * 16) * 1024 + colb + bj * HALF) = w;
                    }
                }
    }
};
struct DiagOrder {
    StaticOrder S; int nM;
    __host__ __device__ void init(int M, int N, int G_, int c_) { S.init(M, N, G_, c_); nM = M / BM; }
    __host__ __device__ bool next(int i, Unit& u) const { Unit v; if (!S.next(i / 3, v)) return false; const int b = i % 3; u.pm = b * nM + v.pm; u.pn = b * 4 + v.pn; return true; }
    __device__ __forceinline__ void a_ready(const Unit&) const {}
    __device__ __forceinline__ void done(const Unit&) const {}
};

template <class Epi, class Sched, bool ALIGN_EPI = false, bool SP2 = false>
__device__ __forceinline__ void gemm_phase(PG8_LAS unsigned char* lds, const Gemm g, const Sched& S, const Epi& E) {
    int tid_ = threadIdx.x; asm volatile("" : "+v"(tid_));
    const int tid = tid_, wid = __builtin_amdgcn_readfirstlane(tid >> 6), lane = tid & 63, wr = wid >> 2, wc = wid & 3, fr = lane & 15, fq = lane >> 4;
    const int K = g.K, nt = K / BK;
    unsigned voffA[2], voffB[2];
#pragma unroll
    for (int i = 0; i < 2; ++i) { int R, C; stage_rc(tid * 16 + i * 8192, R, C); const int Rb = Epi::PERM ? ((R & ~31) + perm32(R & 31)) : R;
        voffA[i] = (unsigned)(R * K + C) * 2u; voffB[i] = (unsigned)(Rb * K + C) * 2u; }
    const size_t kstep = (size_t)(BK * 2);
    const size_t hstep = (size_t)HALF * K * 2;
    const size_t tstep = 2 * hstep;
    const unsigned ldsw = (unsigned)wid * 1024u;
    const int aoff = lds_byte(wr * 64 + fr, fq * 8), boff = lds_byte(wc * 32 + fr, fq * 8);
#define PG8_SA(b, h) (((b) * 2 + (h)) * HTB)
#define PG8_SB(b, h) ((4 + (b) * 2 + (h)) * HTB)
#define PG8_STAGE(bufoff, gbase, voff) do { _Pragma("unroll") for (int _i = 0; _i < 2; ++_i) \
        __builtin_amdgcn_global_load_lds((const unsigned*)((const char*)(gbase) + (voff)[_i]), (PG8_LAS unsigned*)(lds + (bufoff) + ldsw + _i * 8192), 16, 0, 0); } while (0)
#define PG8_LDA(dst, b, h) do { _Pragma("unroll") for (int m = 0; m < 4; ++m) _Pragma("unroll") for (int k = 0; k < 2; ++k) dst[m][k] = *(const PG8_LAS bf16x8*)(lds + PG8_SA(b, h) + aoff + m * 2048 + k * 1024); } while (0)
#define PG8_LDB(dst, b, h) do { _Pragma("unroll") for (int n = 0; n < 2; ++n) _Pragma("unroll") for (int k = 0; k < 2; ++k) dst[n][k] = *(const PG8_LAS bf16x8*)(lds + PG8_SB(b, h) + boff + n * 2048 + k * 1024); } while (0)
#define PG8_MMA(ai, bj, At, Bt) do { __builtin_amdgcn_s_setprio(1); _Pragma("unroll") for (int m = 0; m < 4; ++m) _Pragma("unroll") for (int n = 0; n < 2; ++n) _Pragma("unroll") for (int k = 0; k < 2; ++k) \
        acc[ai][bj][m][n] = __builtin_amdgcn_mfma_f32_16x16x32_bf16(Bt[n][k], At[m][k], acc[ai][bj][m][n], 0, 0, 0); __builtin_amdgcn_s_setprio(0); } while (0)
#define PG8_WAIT_V(n) asm volatile("s_waitcnt vmcnt(" #n ")" ::: "memory")
#define PG8_WAIT_L(n) asm volatile("s_waitcnt lgkmcnt(" #n ")" ::: "memory")
#define PG8_BAR __builtin_amdgcn_s_barrier()
#define PG8_SCHED __builtin_amdgcn_sched_barrier(0)
    Unit cur, nxt; int ui = 0;
    if (!S.next(0, cur)) return;
    f32x4 acc[2][2][4][2];
#pragma unroll
    for (int a = 0; a < 2; ++a)
#pragma unroll
        for (int b = 0; b < 2; ++b)
#pragma unroll
            for (int m = 0; m < 4; ++m)
#pragma unroll
                for (int n = 0; n < 2; ++n) acc[a][b][m][n] = (f32x4){0.f, 0.f, 0.f, 0.f};
    bf16x8 At[4][2], B0[2][2], B1[2][2];
    const char* cA = (const char*)g.A + (size_t)cur.pm * tstep; const char* cB = (const char*)g.Bt + (size_t)cur.pn * tstep;
    S.a_ready(cur);
    if constexpr (SP2) {
        PG8_STAGE(PG8_SB(0, 0), cB, voffB); PG8_STAGE(PG8_SB(0, 1), cB + hstep, voffB); PG8_STAGE(PG8_SA(0, 0), cA, voffA); PG8_STAGE(PG8_SA(0, 1), cA + hstep, voffA);
        if (wr == 1) PG8_BAR;
        PG8_WAIT_V(2); PG8_BAR;
        PG8_STAGE(PG8_SB(1, 0), cB + kstep, voffB); PG8_STAGE(PG8_SA(1, 0), cA + kstep, voffA); PG8_STAGE(PG8_SB(1, 1), cB + hstep + kstep, voffB);
        PG8_WAIT_V(6); PG8_BAR;
    } else {
        PG8_STAGE(PG8_SB(0, 0), cB, voffB); PG8_STAGE(PG8_SA(0, 0), cA, voffA); PG8_STAGE(PG8_SB(0, 1), cB + hstep, voffB); PG8_STAGE(PG8_SA(0, 1), cA + hstep, voffA);
        if (wr == 1) PG8_BAR;
        PG8_WAIT_V(4); PG8_BAR;
        PG8_STAGE(PG8_SB(1, 0), cB + kstep, voffB); PG8_STAGE(PG8_SA(1, 0), cA + kstep, voffA); PG8_STAGE(PG8_SB(1, 1), cB + hstep + kstep, voffB);
        PG8_WAIT_V(6); PG8_BAR;
    }
    for (;;) {
        const bool has_next = S.next(ui + 1, nxt);
        const char* nA = has_next ? (const char*)g.A + (size_t)nxt.pm * tstep : cA; const char* nB = has_next ? (const char*)g.Bt + (size_t)nxt.pn * tstep : cB;
        for (int t = 0; t < nt; t += 2) {
            const bool last = (t == nt - 2);
            const char* a1 = cA + (size_t)(t + 1) * kstep;
            const char* a2 = last ? nA : cA + (size_t)(t + 2) * kstep; const char* b2 = last ? nB : cB + (size_t)(t + 2) * kstep;
            const char* a3 = a2 + kstep; const char* b3 = b2 + kstep;
            if (last && has_next) S.a_ready(nxt);
            if constexpr (SP2) {
            PG8_LDB(B0, 0, 0); PG8_LDB(B1, 0, 1); PG8_SCHED; PG8_LDA(At, 0, 0); PG8_STAGE(PG8_SA(1, 1), a1 + hstep, voffA);
            PG8_WAIT_V(8); PG8_WAIT_L(0); PG8_BAR; PG8_MMA(0, 0, At, B0); PG8_MMA(0, 1, At, B1); PG8_BAR; PG8_SCHED;
            PG8_LDA(At, 0, 1); PG8_STAGE(PG8_SB(0, 0), b2, voffB); PG8_STAGE(PG8_SB(0, 1), b2 + hstep, voffB); PG8_STAGE(PG8_SA(0, 0), a2, voffA);
            PG8_WAIT_V(8); PG8_WAIT_L(0); PG8_BAR; PG8_MMA(1, 0, At, B0); PG8_MMA(1, 1, At, B1); PG8_BAR; PG8_SCHED;
            PG8_LDB(B0, 1, 0); PG8_LDB(B1, 1, 1); PG8_SCHED; PG8_LDA(At, 1, 0); PG8_STAGE(PG8_SA(0, 1), a2 + hstep, voffA);
            PG8_WAIT_V(8); PG8_WAIT_L(0); PG8_BAR; PG8_MMA(0, 0, At, B0); PG8_MMA(0, 1, At, B1); PG8_BAR; PG8_SCHED;
            PG8_LDA(At, 1, 1); PG8_STAGE(PG8_SB(1, 0), b3, voffB); PG8_STAGE(PG8_SB(1, 1), b3 + hstep, voffB); PG8_STAGE(PG8_SA(1, 0), a3, voffA);
            PG8_WAIT_V(8); PG8_WAIT_L(0); PG8_BAR; PG8_MMA(1, 0, At, B0); PG8_MMA(1, 1, At, B1); PG8_BAR; PG8_SCHED;
            } else {
            PG8_LDB(B0, 0, 0); PG8_SCHED; PG8_LDA(At, 0, 0); PG8_STAGE(PG8_SA(1, 1), a1 + hstep, voffA);
            PG8_WAIT_L(8); PG8_BAR; PG8_WAIT_L(0); PG8_MMA(0, 0, At, B0); PG8_BAR; PG8_SCHED;
            PG8_LDB(B1, 0, 1); PG8_STAGE(PG8_SB(0, 0), b2, voffB);
            PG8_BAR; PG8_WAIT_L(0); PG8_MMA(0, 1, At, B1); PG8_BAR;
            PG8_LDA(At, 0, 1); PG8_STAGE(PG8_SA(0, 0), a2, voffA);
            PG8_BAR; PG8_WAIT_L(0); PG8_MMA(1, 0, At, B0); PG8_BAR; PG8_SCHED;
            PG8_STAGE(PG8_SB(0, 1), b2 + hstep, voffB);
            PG8_WAIT_V(6); PG8_BAR; PG8_MMA(1, 1, At, B1); PG8_BAR;
            PG8_LDB(B0, 1, 0); PG8_SCHED; PG8_LDA(At, 1, 0); PG8_STAGE(PG8_SA(0, 1), a2 + hstep, voffA);
            PG8_WAIT_L(8); PG8_BAR; PG8_WAIT_L(0); PG8_MMA(0, 0, At, B0); PG8_BAR; PG8_SCHED;
            PG8_LDB(B1, 1, 1); PG8_STAGE(PG8_SB(1, 0), b3, voffB);
            PG8_BAR; PG8_WAIT_L(0); PG8_MMA(0, 1, At, B1); PG8_BAR;
            PG8_LDA(At, 1, 1); PG8_STAGE(PG8_SA(1, 0), a3, voffA);
            PG8_BAR; PG8_WAIT_L(0); PG8_MMA(1, 0, At, B0); PG8_BAR; PG8_SCHED;
            PG8_STAGE(PG8_SB(1, 1), b3 + hstep, voffB);
            PG8_WAIT_V(6); PG8_BAR; PG8_MMA(1, 1, At, B1); PG8_BAR;
            }
        }
        if constexpr (ALIGN_EPI) { if (wr == 0) PG8_BAR; }
        if constexpr (!Epi::AFTER_DRAIN) { E(acc, cur, wr, wc, fr, fq); S.done(cur); }
        if (!has_next) break;
        if (!Epi::keeps(cur)) {
#pragma unroll
        for (int a = 0; a < 2; ++a)
#pragma unroll
            for (int b = 0; b < 2; ++b)
#pragma unroll
                for (int m = 0; m < 4; ++m)
#pragma unroll
                    for (int n = 0; n < 2; ++n) acc[a][b][m][n] = (f32x4){0.f, 0.f, 0.f, 0.f};
        }
        cur = nxt; cA = nA; cB = nB; ++ui;
        if constexpr (ALIGN_EPI) { if (wr == 1) PG8_BAR; }
    }
    PG8_WAIT_V(0);
    if constexpr (!ALIGN_EPI) { if (wr == 0) PG8_BAR; }
    PG8_BAR;
    if constexpr (Epi::AFTER_DRAIN) { E.fused(acc, cur, wr, wc, fr, fq, lds, wid, lane); S.done(cur); }
#undef PG8_SA
#undef PG8_SB
#undef PG8_STAGE
#undef PG8_LDA
#undef PG8_LDB
#undef PG8_MMA
#undef PG8_WAIT_V
#undef PG8_WAIT_L
#undef PG8_BAR
#undef PG8_SCHED
}
}

#define LAS __attribute__((address_space(3)))
typedef unsigned short bf16_t;
typedef short bf16x8 __attribute__((ext_vector_type(8)));
typedef float f32x4 __attribute__((ext_vector_type(4)));
typedef float f32x2 __attribute__((ext_vector_type(2)));
typedef float f32x16 __attribute__((ext_vector_type(16)));
typedef unsigned u32x4 __attribute__((ext_vector_type(4)));
typedef unsigned u32x2 __attribute__((ext_vector_type(2)));
using pg8::pk2; using pg8::bflo; using pg8::bfhi; using pg8::sigm;

constexpr int NB = 32, SEQ = 2048, DM = 1024, DEPTH = 2, INW = 7440, NINP = 7680, LDU = 7424, FF = 4096;
constexpr int NG = 2, BG = NB / NG, MG = BG * SEQ;
constexpr float LOG2E = 1.4426950408889634f, EPS = 1e-6f;
constexpr int NWAVES = 8, NTHR = 512;
constexpr int LDS_BYTES = 131072 + 1024;

constexpr int UC_FQ = 0, UC_FK = 512, UC_FV = 1024, UC_SQ = 1536, UC_SK = 2048, UC_SV = 2176, UC_MQ = 2304, UC_MK = 2816, UC_MV = 3328, UC_MO = 3840, UC_G = 4352;

constexpr size_t al(size_t x) { return (x + 255) & ~(size_t)255; }
constexpr size_t O_WIN = 0;
constexpr size_t O_WB = O_WIN + al((size_t)DEPTH * NINP * DM * 2);
constexpr size_t O_WOUT = O_WB + al((size_t)DEPTH * 3 * DM * 512 * 2);
constexpr size_t O_WUP = O_WOUT + al((size_t)DEPTH * DM * DM * 2);
constexpr size_t O_WDN = O_WUP + al((size_t)DEPTH * FF * DM * 2);
constexpr size_t O_ROPE = O_WDN + al((size_t)DEPTH * DM * FF * 2);
constexpr size_t O_PAR = O_ROPE + al((size_t)SEQ * 32 * 2 * 4);
constexpr int PAR_FFB = 0, PAR_FQN = 16, PAR_FKN = 144, PAR_SQN = 272, PAR_SKN = 400, PAR_SINK = 528, PAR_CW = 544, PAR_CB = 8736, PAR_IB = 10784, PAR_FB = 10792, PAR_ON = 10800, PAR_N = 11824;
constexpr size_t O_XB = O_PAR + al((size_t)PAR_N * 4);
constexpr size_t O_RS = O_XB + al((size_t)MG * DM * 2);
constexpr size_t O_U = O_RS + al((size_t)MG * 16 * 4);
constexpr size_t O_SG = O_U + al((size_t)MG * LDU * 2);
constexpr size_t O_FC = O_SG + al((size_t)MG * 16 * 4);
constexpr size_t O_MP = O_FC + al((size_t)BG * 8 * SEQ * 4);
constexpr size_t O_ME = O_MP + al((size_t)BG * 4 * SEQ * 4);
constexpr size_t O_MBT = O_ME + al((size_t)BG * 4 * SEQ * 4);
constexpr size_t O_MCH = O_MBT + al((size_t)BG * 4 * SEQ * 4);
constexpr size_t O_FQN = O_MCH + al((size_t)BG * 4 * 16 * 4 * 4);
constexpr size_t O_FKN = O_FQN + (size_t)MG * 512 * 2;
constexpr size_t O_FVT = O_FKN + (size_t)MG * 512 * 2;
constexpr size_t O_SQR = O_FVT + (size_t)MG * 512 * 2;
constexpr size_t O_TMP = O_FQN;
constexpr size_t O_SKR = O_SQR + (size_t)MG * 512 * 2;
constexpr size_t O_SVT = O_SKR + (size_t)MG * 128 * 2;
constexpr size_t O_MQC = O_SVT + (size_t)MG * 128 * 2;
constexpr size_t O_MKC = O_MQC + (size_t)MG * 512 * 2;
constexpr size_t O_MRG = O_MQC;
constexpr size_t O_KT = O_MKC + (size_t)MG * 512 * 2;
constexpr size_t O_MVT = O_KT + (size_t)MG * 512 * 2;
constexpr size_t O_DN = O_MVT + (size_t)MG * 512 * 2;
constexpr size_t O_CT = O_KT;
constexpr size_t O_NN = O_DN + al((size_t)BG * 4 * 16 * 128 * 4);
constexpr size_t O_Y = O_NN + al((size_t)BG * 4 * 16 * 128 * 4);
constexpr size_t O_DCT = O_Y + (size_t)2 * MG * 512 * 2;
constexpr size_t O_BAR = O_Y + (size_t)3 * MG * 512 * 2;
constexpr size_t WS_NEED = O_BAR + 16384;
static_assert((size_t)BG * 4 * 16 * 16384 * 2 == (size_t)MG * 512 * 2, "DCT overlays Y2; CT overlays KT");
static_assert((size_t)MG * FF * 2 <= (size_t)MG * LDU * 2, "ACT overlays U");

struct KP { const float* in[19]; float* out; unsigned char* ws; int ph_lo, ph_hi; };

__device__ __forceinline__ float wave_sum(float v) {
#pragma unroll
    for (int o = 1; o < 64; o <<= 1) v += __shfl_xor(v, o);
    return v;
}
__device__ __forceinline__ float logsig(float x) { return fminf(x, 0.f) - log1pf(__expf(-fabsf(x))); }
#define LDSW() asm volatile("s_waitcnt lgkmcnt(0)" ::: "memory")

__device__ __forceinline__ int win_srccol(int n) {
    if (n < 1536) return n; if (n < 3840) return n + 8; if (n < 7424) return n + 16; if (n < 7432) return n - 7424 + 1536; if (n < 7440) return n - 7432 + 3848; return -1;
}
template <bool REMAP>
__device__ __forceinline__ void tr_item(const float* W, int K, int N, const float* kscale, bf16_t* WT, int item, int nblk, LAS float* scr, int lane) {
    const int kb = item / nblk, nb = item % nblk, k0 = 64 * kb, n0 = 32 * nb;
    const int nd = n0 + (lane & 31); const int ns = REMAP ? win_srccol(nd) : nd;
#pragma unroll 8
    for (int i = 0; i < 32; ++i) { const int kk = 2 * i + (lane >> 5); float v = 0.f; if (ns >= 0) v = W[(size_t)(k0 + kk) * N + ns]; if (kscale) v *= kscale[k0 + kk]; scr[kk * 33 + (lane & 31)] = v; }
    LDSW();
    const int c = lane & 7;
#pragma unroll
    for (int j = 0; j < 4; ++j) { const int n = (lane >> 3) + 8 * j; const LAS float* s = scr + (8 * c) * 33 + n;
        u32x4 o; o.x = pk2(s[0 * 33], s[1 * 33]); o.y = pk2(s[2 * 33], s[3 * 33]); o.z = pk2(s[4 * 33], s[5 * 33]); o.w = pk2(s[6 * 33], s[7 * 33]);
        *(u32x4*)(WT + (size_t)(n0 + n) * K + k0 + 8 * c) = o; }
    LDSW();
}
__device__ __forceinline__ void phase_p0(const KP& p, unsigned char* ws, LAS unsigned char* lds, int gw, int NWV, int wave, int lane) {
    LAS float* scr = (LAS float*)(lds + wave * 16384);
    const float *norm_mix = p.in[1], *w_in = p.in[2], *w_branch = p.in[14], *w_out = p.in[15], *norm_mlp = p.in[16], *w_up = p.in[17], *w_down = p.in[18];
    constexpr int PER = 3840 + 768 + 512 + 2048 + 2048;
    for (int it = gw; it < DEPTH * PER; it += NWV) {
        const int l = it / PER; int r = it % PER;
        if (r < 3840) { tr_item<true>(w_in + (size_t)l * DM * INW, DM, INW, norm_mix + l * DM, (bf16_t*)(ws + O_WIN) + (size_t)l * NINP * DM, r, 240, scr, lane); continue; } r -= 3840;
        if (r < 768) { const int b = r / 256; tr_item<false>(w_branch + (size_t)(l * 3 + b) * 512 * DM, 512, DM, nullptr, (bf16_t*)(ws + O_WB) + (size_t)(l * 3 + b) * DM * 512, r % 256, 32, scr, lane); continue; } r -= 768;
        if (r < 512) { tr_item<false>(w_out + (size_t)l * DM * DM, DM, DM, nullptr, (bf16_t*)(ws + O_WOUT) + (size_t)l * DM * DM, r, 32, scr, lane); continue; } r -= 512;
        if (r < 2048) { tr_item<false>(w_up + (size_t)l * DM * FF, DM, FF, norm_mlp + l * DM, (bf16_t*)(ws + O_WUP) + (size_t)l * FF * DM, r, 128, scr, lane); continue; } r -= 2048;
        tr_item<false>(w_down + (size_t)l * FF * DM, FF, DM, nullptr, (bf16_t*)(ws + O_WDN) + (size_t)l * DM * FF, r, 32, scr, lane);
    }
    { float* par = (float*)(ws + O_PAR); const int t0 = gw * 64 + lane, ts = NWV * 64;
      for (int e = t0; e < 16; e += ts) { par[PAR_FFB + e] = p.in[3][e]; par[PAR_SINK + e] = p.in[8][e]; }
      for (int e = t0; e < 128; e += ts) { par[PAR_FQN + e] = p.in[4][e]; par[PAR_FKN + e] = p.in[5][e]; par[PAR_SQN + e] = p.in[6][e]; par[PAR_SKN + e] = p.in[7][e]; }
      for (int e = t0; e < 8192; e += ts) par[PAR_CW + e] = p.in[9][e];
      for (int e = t0; e < 2048; e += ts) par[PAR_CB + e] = p.in[10][e];
      for (int e = t0; e < 8; e += ts) { par[PAR_IB + e] = p.in[11][e]; par[PAR_FB + e] = p.in[12][e]; }
      for (int e = t0; e < 1024; e += ts) par[PAR_ON + e] = p.in[13][e]; }
    float* rope = (float*)(ws + O_ROPE);
    for (int e = gw * 64 + lane; e < SEQ * 32; e += NWV * 64) {
        const int pos = e >> 5, i = e & 31;
        const float inv = powf(10000.f, -(float)(2 * i) / 64.f), ang = (float)pos * inv;
        rope[2 * e] = cosf(ang); rope[2 * e + 1] = sinf(ang);
    }
}
__device__ __forceinline__ void phase_x0(const float* x, bf16_t* XB, float* RS, int gw, int NWV, int lane) {
    for (int row = gw; row < MG; row += NWV) {
        const f32x4* xr = (const f32x4*)(x + (size_t)row * DM) + lane;
        f32x4 v[4]; float s = 0.f;
#pragma unroll
        for (int j = 0; j < 4; ++j) { v[j] = xr[64 * j]; s += (v[j][0] * v[j][0] + v[j][1] * v[j][1]) + (v[j][2] * v[j][2] + v[j][3] * v[j][3]); }
        s = wave_sum(s);
        u32x2* o = (u32x2*)(XB + (size_t)row * DM) + lane;
#pragma unroll
        for (int j = 0; j < 4; ++j) { u32x2 w; w.x = pk2(v[j][0], v[j][1]); w.y = pk2(v[j][2], v[j][3]); o[64 * j] = w; }
        if (lane < 16) RS[(size_t)row * 16 + lane] = (lane == 0) ? s : 0.f;
    }
}
__device__ __forceinline__ void gate_scan_item(unsigned char* ws, int l, int it, int lane) {
    const float* par = (const float*)(ws + O_PAR); const float* SG = (const float*)(ws + O_SG);
    if (it < BG * 8) {
        const int b = it >> 3, h = it & 7; const float bias = par[PAR_FFB + l * 8 + h];
        const float* src = SG + ((size_t)b * SEQ + lane * 32) * 16 + h;
        float tot = 0.f;
#pragma unroll 4
        for (int j = 0; j < 32; ++j) tot += logsig(src[j * 16] + bias);
        float x = tot;
#pragma unroll
        for (int o = 1; o < 64; o <<= 1) { const float y = __shfl_up(x, o); if (lane >= o) x += y; }
        float run = x - tot;
        float* dst = (float*)(ws + O_FC) + (size_t)it * SEQ + lane * 32;
#pragma unroll 4
        for (int j = 0; j < 32; ++j) { run += logsig(src[j * 16] + bias); dst[j] = run * LOG2E; }
    } else {
        const int sq = it - BG * 8, b = sq >> 2, h = sq & 3;
        const float ibias = par[PAR_IB + l * 4 + h], fbias = par[PAR_FB + l * 4 + h];
        float* MP = (float*)(ws + O_MP) + (size_t)sq * SEQ; float* ME = (float*)(ws + O_ME) + (size_t)sq * SEQ; float* MBT = (float*)(ws + O_MBT) + (size_t)sq * SEQ;
        float* MCH = (float*)(ws + O_MCH) + (size_t)sq * 64;
        float mc = 0.f;
#pragma unroll 1
        for (int c = 0; c < 16; ++c) {
            const float* s0 = SG + ((size_t)b * SEQ + c * 128 + 2 * lane) * 16;
            const float f0 = logsig(s0[12 + h] + fbias), f1 = logsig(s0[16 + 12 + h] + fbias);
            const float i0 = s0[8 + h] + ibias, i1 = s0[16 + 8 + h] + ibias;
            float x = f0 + f1;
#pragma unroll
            for (int o = 1; o < 64; o <<= 1) { const float y = __shfl_up(x, o); if (lane >= o) x += y; }
            const float b1 = x, b0 = x - f1;
            const float p0 = i0 - b0, p1 = i1 - b1;
            float mxs = fmaxf(p0, p1);
#pragma unroll
            for (int o = 1; o < 64; o <<= 1) { const float y = __shfl_up(mxs, o); if (lane >= o) mxs = fmaxf(mxs, y); }
            float prev = __shfl_up(mxs, 1); if (lane == 0) prev = -INFINITY;
            const float u0 = fmaxf(prev, p0), u1 = mxs;
            const float e0 = fmaxf(mc, u0), e1 = fmaxf(mc, u1);
            const int t = c * 128 + 2 * lane;
            *(f32x2*)(MP + t) = (f32x2){p0, p1}; *(f32x2*)(ME + t) = (f32x2){e0, e1}; *(f32x2*)(MBT + t) = (f32x2){b0, b1};
            const float ulast = __shfl(mxs, 63), bL = __shfl(x, 63);
            const float mx = fmaxf(mc, ulast), dec = __expf(mc - mx);
            if (lane == 0) *(f32x4*)(MCH + c * 4) = (f32x4){mc, mx, dec, bL};
            mc = bL + mx;
        }
    }
}
__device__ __forceinline__ void headnorm_item(unsigned char* ws, int l, int kind, int item, int lane) {
    const float* par = (const float*)(ws + O_PAR);
    const int c = lane & 7;
    int srccol, dpitch, tstep, tok0, tsub; bf16_t* dbase; const float* w; float scale;
    if (kind == 0) { srccol = UC_FQ + lane * 8; dbase = (bf16_t*)(ws + O_FQN) + lane * 8; dpitch = 512; w = par + PAR_FQN + l * 64; scale = 0.125f * LOG2E; tstep = 1; tok0 = item * 8; tsub = 0; }
    else if (kind == 1) { srccol = UC_FK + lane * 8; dbase = (bf16_t*)(ws + O_FKN) + lane * 8; dpitch = 512; w = par + PAR_FKN + l * 64; scale = 1.f; tstep = 1; tok0 = item * 8; tsub = 0; }
    else if (kind == 2) { srccol = UC_SQ + lane * 8; dbase = (bf16_t*)(ws + O_SQR) + lane * 8; dpitch = 512; w = par + PAR_SQN + l * 64; scale = 0.125f * LOG2E; tstep = 1; tok0 = item * 8; tsub = 0; }
    else { srccol = UC_SK + (lane & 15) * 8; dbase = (bf16_t*)(ws + O_SKR) + (lane & 15) * 8; dpitch = 128; w = par + PAR_SKN + l * 64; scale = 1.f; tstep = 4; tok0 = item * 32; tsub = lane >> 4; }
    const bool rp = kind >= 2;
    const f32x4 w0 = *(const f32x4*)(w + 8 * c), w1 = *(const f32x4*)(w + 8 * c + 4);
    const bf16_t* src = (const bf16_t*)(ws + O_U) + (size_t)(tok0 + tsub) * LDU + srccol;
    u32x4 xv[8];
#pragma unroll
    for (int i = 0; i < 8; ++i) xv[i] = *(const u32x4*)(src + (size_t)(i * tstep) * LDU);
#pragma unroll
    for (int i = 0; i < 8; ++i) {
        const int tok = tok0 + tsub + i * tstep;
        float x[8] = {bflo(xv[i].x), bfhi(xv[i].x), bflo(xv[i].y), bfhi(xv[i].y), bflo(xv[i].z), bfhi(xv[i].z), bflo(xv[i].w), bfhi(xv[i].w)};
        float ss = ((x[0] * x[0] + x[1] * x[1]) + (x[2] * x[2] + x[3] * x[3])) + ((x[4] * x[4] + x[5] * x[5]) + (x[6] * x[6] + x[7] * x[7]));
        ss += __shfl_xor(ss, 1); ss += __shfl_xor(ss, 2); ss += __shfl_xor(ss, 4);
        const float rn = rsqrtf(ss * (1.f / 64.f) + EPS);
        x[0] *= rn * w0[0]; x[1] *= rn * w0[1]; x[2] *= rn * w0[2]; x[3] *= rn * w0[3]; x[4] *= rn * w1[0]; x[5] *= rn * w1[1]; x[6] *= rn * w1[2]; x[7] *= rn * w1[3];
        if (rp) {
            const float* rt = (const float*)(ws + O_ROPE) + ((size_t)(tok % SEQ) * 32 + 8 * (c & 3)) * 2;
            const bool second = (c & 4) != 0;
#pragma unroll
            for (int e = 0; e < 8; e += 2) { const f32x4 cs = *(const f32x4*)(rt + 2 * e);
                const float o0 = __shfl_xor(x[e], 4), o1 = __shfl_xor(x[e + 1], 4);
                x[e] = second ? (o0 * cs[1] + x[e] * cs[0]) : (x[e] * cs[0] - o0 * cs[1]);
                x[e + 1] = second ? (o1 * cs[3] + x[e + 1] * cs[2]) : (x[e + 1] * cs[2] - o1 * cs[3]); }
        }
        u32x4 o; o.x = pk2(x[0] * scale, x[1] * scale); o.y = pk2(x[2] * scale, x[3] * scale); o.z = pk2(x[4] * scale, x[5] * scale); o.w = pk2(x[6] * scale, x[7] * scale);
        *(u32x4*)(dbase + (size_t)tok * dpitch) = o;
    }
}
__device__ __forceinline__ void stream_item(unsigned char* ws, int l, int item, int lane) {
    const int cb = item % 34, tb = item / 34, tok0 = tb * 64, b = tok0 / SEQ, s0 = tok0 % SEQ;
    const int tg = lane >> 3, co = lane & 7;
    const bf16_t* U = (const bf16_t*)(ws + O_U);
    int srccol, chan; bf16_t* dT = nullptr; bf16_t* dN = nullptr; int convch = -1; float oscale = 1.f;
    if (cb < 8) { chan = cb * 64 + co * 8; srccol = UC_FV + chan; dT = (bf16_t*)(ws + O_FVT) + ((size_t)b * 512 + chan) * SEQ; }
    else if (cb < 10) { chan = (cb - 8) * 64 + co * 8; srccol = UC_SV + chan; dT = (bf16_t*)(ws + O_SVT) + ((size_t)b * 128 + chan) * SEQ; }
    else if (cb < 18) { chan = (cb - 10) * 64 + co * 8; srccol = UC_MV + chan; dT = (bf16_t*)(ws + O_MVT) + ((size_t)b * 512 + chan) * SEQ; }
    else if (cb < 26) { chan = (cb - 18) * 64 + co * 8; srccol = UC_MQ + chan; dN = (bf16_t*)(ws + O_MQC) + chan; convch = chan; }
    else { chan = (cb - 26) * 64 + co * 8; srccol = UC_MK + chan; dN = (bf16_t*)(ws + O_MKC) + chan; dT = (bf16_t*)(ws + O_KT) + ((size_t)b * 512 + chan) * SEQ; convch = 512 + chan; oscale = 0.08838834764831845f; }
    const bf16_t* src = U + (size_t)(tok0 + tg * 8) * LDU + srccol;
    u32x4 R[8];
#pragma unroll
    for (int i = 0; i < 8; ++i) R[i] = *(const u32x4*)(src + (size_t)i * LDU);
    if (cb >= 18) {
        u32x4 H[3];
        const bool has_prev = (s0 + tg * 8) > 0;
#pragma unroll
        for (int i = 0; i < 3; ++i) { H[i] = (u32x4){0u, 0u, 0u, 0u}; if (has_prev) H[i] = *(const u32x4*)(src - (size_t)(3 - i) * LDU); }
        const float* cw = (const float*)(ws + O_PAR) + PAR_CW + l * 4 * 1024 + convch; const float* cbias = (const float*)(ws + O_PAR) + PAR_CB + l * 1024 + convch;
        float wt[4][8], bb[8];
#pragma unroll
        for (int j = 0; j < 4; ++j) { const f32x4 a = *(const f32x4*)(cw + j * 1024), c2 = *(const f32x4*)(cw + j * 1024 + 4);
            wt[j][0] = a[0]; wt[j][1] = a[1]; wt[j][2] = a[2]; wt[j][3] = a[3]; wt[j][4] = c2[0]; wt[j][5] = c2[1]; wt[j][6] = c2[2]; wt[j][7] = c2[3]; }
        { const f32x4 a = *(const f32x4*)cbias, c2 = *(const f32x4*)(cbias + 4); bb[0] = a[0]; bb[1] = a[1]; bb[2] = a[2]; bb[3] = a[3]; bb[4] = c2[0]; bb[5] = c2[1]; bb[6] = c2[2]; bb[7] = c2[3]; }
        float xm3[8], xm2[8], xm1[8];
#define UNPK(dst, v) do { dst[0] = bflo(v.x); dst[1] = bfhi(v.x); dst[2] = bflo(v.y); dst[3] = bfhi(v.y); dst[4] = bflo(v.z); dst[5] = bfhi(v.z); dst[6] = bflo(v.w); dst[7] = bfhi(v.w); } while (0)
        UNPK(xm3, H[0]); UNPK(xm2, H[1]); UNPK(xm1, H[2]);
#pragma unroll
        for (int i = 0; i < 8; ++i) {
            float xc[8], y[8]; UNPK(xc, R[i]);
#pragma unroll
            for (int e = 0; e < 8; ++e) { const float v = bb[e] + wt[0][e] * xm3[e] + wt[1][e] * xm2[e] + wt[2][e] * xm1[e] + wt[3][e] * xc[e]; y[e] = v * sigm(v) * oscale; xm3[e] = xm2[e]; xm2[e] = xm1[e]; xm1[e] = xc[e]; }
            u32x4 o; o.x = pk2(y[0], y[1]); o.y = pk2(y[2], y[3]); o.z = pk2(y[4], y[5]); o.w = pk2(y[6], y[7]);
            R[i] = o;
            *(u32x4*)(dN + (size_t)(tok0 + tg * 8 + i) * 512) = o;
        }
#undef UNPK
    }
    if (dT) {
        bf16_t* dst = dT + s0 + tg * 8;
#pragma unroll
        for (int k = 0; k < 4; ++k) {
            u32x4 lo, hi;
            lo.x = (R[0][k] & 0xffffu) | (R[1][k] << 16); lo.y = (R[2][k] & 0xffffu) | (R[3][k] << 16); lo.z = (R[4][k] & 0xffffu) | (R[5][k] << 16); lo.w = (R[6][k] & 0xffffu) | (R[7][k] << 16);
            hi.x = (R[0][k] >> 16) | (R[1][k] & 0xffff0000u); hi.y = (R[2][k] >> 16) | (R[3][k] & 0xffff0000u); hi.z = (R[4][k] >> 16) | (R[5][k] & 0xffff0000u); hi.w = (R[6][k] >> 16) | (R[7][k] & 0xffff0000u);
            *(u32x4*)(dst + (size_t)(2 * k) * SEQ) = lo; *(u32x4*)(dst + (size_t)(2 * k + 1) * SEQ) = hi;
        }
    }
}
#define MFMA32(a, b, c) __builtin_amdgcn_mfma_f32_32x32x16_bf16((a), (b), (c), 0, 0, 0)
template <bool SWA>
__device__ __forceinline__ void attn_qtile(const bf16_t* __restrict__ Q, const bf16_t* __restrict__ K, int kpitch, const bf16_t* __restrict__ VT,
                                           const float* __restrict__ C, float sink2, bf16_t* __restrict__ Y, int qt, int lane) {
    const int r = lane & 31, hh = lane >> 5;
    const int pr = ((r >> 2) & 1) * 16 + ((r >> 4) & 1) * 8 + ((r >> 3) & 1) * 4 + (r & 3);
    const int q0 = qt * 32;
    bf16x8 qf[4];
#pragma unroll
    for (int st = 0; st < 4; ++st) qf[st] = *(const bf16x8*)(Q + (size_t)(q0 + r) * 512 + 16 * st + 8 * hh);
    float cq = 0.f; if (!SWA) cq = C[q0 + r];
    float m = -1e30f, lsum = 0.f;
    f32x16 o0, o1;
#pragma unroll
    for (int i = 0; i < 16; ++i) { o0[i] = 0.f; o1[i] = 0.f; }
    const int kt_lo = SWA ? (qt > 4 ? qt - 4 : 0) : 0;
#define ATT_LOAD(KF, VF, CK, kt_) do { const int k0_ = (kt_) * 32; \
        _Pragma("unroll") for (int st = 0; st < 4; ++st) KF[st] = *(const bf16x8*)(K + (size_t)(k0_ + pr) * kpitch + 16 * st + 8 * hh); \
        _Pragma("unroll") for (int dh = 0; dh < 2; ++dh) _Pragma("unroll") for (int s2 = 0; s2 < 2; ++s2) VF[dh][s2] = *(const bf16x8*)(VT + (size_t)(dh * 32 + r) * SEQ + k0_ + 16 * hh + 8 * s2); \
        if (!SWA) { _Pragma("unroll") for (int g = 0; g < 4; ++g) CK[g] = *(const f32x4*)(C + k0_ + 16 * hh + 4 * g); } } while (0)
    bf16x8 kfn[4], vfn[2][2]; f32x4 ckn[4];
#pragma unroll
    for (int g = 0; g < 4; ++g) ckn[g] = (f32x4){0.f, 0.f, 0.f, 0.f};
    ATT_LOAD(kfn, vfn, ckn, kt_lo);
    for (int kt = kt_lo; kt <= qt; ++kt) {
        bf16x8 kf[4], vf[2][2]; f32x4 ckc[4];
#pragma unroll
        for (int st = 0; st < 4; ++st) kf[st] = kfn[st];
#pragma unroll
        for (int dh = 0; dh < 2; ++dh) { vf[dh][0] = vfn[dh][0]; vf[dh][1] = vfn[dh][1]; }
#pragma unroll
        for (int g = 0; g < 4; ++g) ckc[g] = ckn[g];
        if (kt < qt) ATT_LOAD(kfn, vfn, ckn, kt + 1);
        f32x16 sc;
#pragma unroll
        for (int i = 0; i < 16; ++i) sc[i] = 0.f;
#pragma unroll
        for (int st = 0; st < 4; ++st) sc = MFMA32(kf[st], qf[st], sc);
        if (!SWA) {
#pragma unroll
            for (int g = 0; g < 4; ++g) { const f32x4 ck = ckc[g];
#pragma unroll
                for (int e = 0; e < 4; ++e) sc[4 * g + e] += cq - ck[e]; }
        }
        if (kt == qt) {
#pragma unroll
            for (int i = 0; i < 16; ++i) if (16 * hh + i > r) sc[i] = -INFINITY;
        }
        if (SWA && kt == qt - 4) {
#pragma unroll
            for (int i = 0; i < 16; ++i) if (16 * hh + i <= r) sc[i] = -INFINITY;
        }
        float tm = sc[0];
#pragma unroll
        for (int i = 1; i < 16; ++i) tm = fmaxf(tm, sc[i]);
        tm = fmaxf(tm, __shfl_xor(tm, 32));
        const float mn = fmaxf(m, tm), alpha = __builtin_amdgcn_exp2f(m - mn);
        m = mn;
        float ps = 0.f;
#pragma unroll
        for (int i = 0; i < 16; ++i) { sc[i] = __builtin_amdgcn_exp2f(sc[i] - mn); ps += sc[i]; }
        lsum = lsum * alpha + ps;
#pragma unroll
        for (int i = 0; i < 16; ++i) { o0[i] *= alpha; o1[i] *= alpha; }
        u32x4 pw0, pw1;
        pw0.x = pk2(sc[0], sc[1]); pw0.y = pk2(sc[2], sc[3]); pw0.z = pk2(sc[4], sc[5]); pw0.w = pk2(sc[6], sc[7]);
        pw1.x = pk2(sc[8], sc[9]); pw1.y = pk2(sc[10], sc[11]); pw1.z = pk2(sc[12], sc[13]); pw1.w = pk2(sc[14], sc[15]);
        const bf16x8 pf0 = __builtin_bit_cast(bf16x8, pw0), pf1 = __builtin_bit_cast(bf16x8, pw1);
        o0 = MFMA32(vf[0][0], pf0, o0); o0 = MFMA32(vf[0][1], pf1, o0);
        o1 = MFMA32(vf[1][0], pf0, o1); o1 = MFMA32(vf[1][1], pf1, o1);
    }
    float lt = lsum + __shfl_xor(lsum, 32);
    if (SWA) lt += __builtin_amdgcn_exp2f(sink2 - m);
    const float inv = 1.f / lt;
    bf16_t* yrow = Y + (size_t)(q0 + r) * 512 + 4 * hh;
#pragma unroll
    for (int g = 0; g < 4; ++g) {
        u32x2 a, c;
        a.x = pk2(o0[4 * g] * inv, o0[4 * g + 1] * inv); a.y = pk2(o0[4 * g + 2] * inv, o0[4 * g + 3] * inv);
        c.x = pk2(o1[4 * g] * inv, o1[4 * g + 1] * inv); c.y = pk2(o1[4 * g + 2] * inv, o1[4 * g + 3] * inv);
        *(u32x2*)(yrow + 8 * g) = a; *(u32x2*)(yrow + 32 + 8 * g) = c;
    }
}
constexpr int AT_SLOT = 10240, AT_K = 0, AT_V = 4608, AT_C = 9728;
__device__ __forceinline__ float xmax32(float v) { auto rr = __builtin_amdgcn_permlane32_swap(__float_as_uint(v), __float_as_uint(v), false, false); return fmaxf(__uint_as_float(rr[0]), __uint_as_float(rr[1])); }
template <bool SWA>
__device__ __forceinline__ void attn_compute(const LAS unsigned char* sl, const bf16x8 (&qf)[4], float cq, float& m, float& lsum, f32x16& o0, f32x16& o1,
                                             bool diag, bool wedge, int pr, int r, int hh) {
    bf16x8 kf[4], vf[2][2]; f32x4 ckv[4];
#pragma unroll
    for (int st = 0; st < 4; ++st) kf[st] = *(const LAS bf16x8*)(sl + AT_K + pr * 144 + 32 * st + 16 * hh);
    if (!SWA) {
#pragma unroll
        for (int g = 0; g < 4; ++g) ckv[g] = *(const LAS f32x4*)(sl + AT_C + 64 * hh + 16 * g);
    }
#pragma unroll
    for (int dh = 0; dh < 2; ++dh)
#pragma unroll
        for (int s = 0; s < 2; ++s) vf[dh][s] = *(const LAS bf16x8*)(sl + AT_V + (dh * 32 + r) * 80 + 32 * hh + 16 * s);
    __builtin_amdgcn_sched_barrier(0);
    f32x16 sc;
#pragma unroll
    for (int i = 0; i < 16; ++i) sc[i] = 0.f;
#pragma unroll
    for (int st = 0; st < 4; ++st) sc = MFMA32(kf[st], qf[st], sc);
    if (!SWA) {
#pragma unroll
        for (int g = 0; g < 4; ++g)
#pragma unroll
            for (int e = 0; e < 4; ++e) sc[4 * g + e] += cq - ckv[g][e];
    }
    if (diag) {
#pragma unroll
        for (int i = 0; i < 16; ++i) if (16 * hh + i > r) sc[i] = -INFINITY;
    }
    if (SWA && wedge) {
#pragma unroll
        for (int i = 0; i < 16; ++i) if (16 * hh + i <= r) sc[i] = -INFINITY;
    }
    float tm = sc[0];
#pragma unroll
    for (int i = 1; i < 16; ++i) tm = fmaxf(tm, sc[i]);
    tm = xmax32(tm);
    if (__any(tm > m)) {
        const float mn = fmaxf(m, tm), alpha = __builtin_amdgcn_exp2f(m - mn);
        m = mn; lsum *= alpha;
#pragma unroll
        for (int i = 0; i < 16; ++i) { o0[i] *= alpha; o1[i] *= alpha; }
    }
    float ps = 0.f;
#pragma unroll
    for (int i = 0; i < 16; ++i) { sc[i] = __builtin_amdgcn_exp2f(sc[i] - m); ps += sc[i]; }
    lsum += ps;
    u32x4 pw0, pw1;
    pw0.x = pk2(sc[0], sc[1]); pw0.y = pk2(sc[2], sc[3]); pw0.z = pk2(sc[4], sc[5]); pw0.w = pk2(sc[6], sc[7]);
    pw1.x = pk2(sc[8], sc[9]); pw1.y = pk2(sc[10], sc[11]); pw1.z = pk2(sc[12], sc[13]); pw1.w = pk2(sc[14], sc[15]);
    const bf16x8 pf0 = __builtin_bit_cast(bf16x8, pw0), pf1 = __builtin_bit_cast(bf16x8, pw1);
    o0 = MFMA32(vf[0][0], pf0, o0); o0 = MFMA32(vf[0][1], pf1, o0);
    o1 = MFMA32(vf[1][0], pf0, o1); o1 = MFMA32(vf[1][1], pf1, o1);
}
template <bool SWA>
__device__ __forceinline__ void attn_block(LAS unsigned char* lds, const bf16_t* __restrict__ Q, const bf16_t* __restrict__ K, int kpitch, const bf16_t* __restrict__ VT,
                                           const float* __restrict__ C, float sink2, bf16_t* __restrict__ Y, int qt, int t_lo, int t_hi, int wave, int lane) {
    const int r = lane & 31, hh = lane >> 5;
    const int pr = ((r >> 2) & 1) * 16 + ((r >> 4) & 1) * 8 + ((r >> 3) & 1) * 4 + (r & 3);
    const int q0 = qt * 32;
    const bool isK = wave < 4; const int chunk = (wave & 3) * 64 + lane;
    const bf16_t* gsrc = isK ? K + (size_t)(chunk >> 3) * kpitch + (chunk & 7) * 8 : VT + (size_t)(chunk >> 2) * SEQ + (chunk & 3) * 8;
    const int gstep = isK ? 32 * kpitch : 32;
    const int ldst = isK ? AT_K + (chunk >> 3) * 144 + (chunk & 7) * 16 : AT_V + (chunk >> 2) * 80 + (chunk & 3) * 16;
    const bool doC = !SWA && wave == 0 && lane < 8;
#define AB_LD(t_) (*(const u32x4*)(gsrc + (size_t)((t_) < t_hi ? (t_) : t_hi) * gstep))
#define AB_LDC(t_) (*(const u32x4*)(C + ((t_) < t_hi ? (t_) : t_hi) * 32 + lane * 4))
#define AB_WR(slot_, v_, c_) do { LAS unsigned char* sl_ = lds + (slot_) * AT_SLOT; *(LAS u32x4*)(sl_ + ldst) = (v_); if (doC) *(LAS u32x4*)(sl_ + AT_C + lane * 16) = (c_); } while (0)
    u32x4 R0 = AB_LD(t_lo), R1 = AB_LD(t_lo + 1), R2 = AB_LD(t_lo + 2);
    u32x4 C0 = {0u, 0u, 0u, 0u}, C1 = C0, C2 = C0;
    if (doC) { C0 = AB_LDC(t_lo); C1 = AB_LDC(t_lo + 1); C2 = AB_LDC(t_lo + 2); }
    bf16x8 qf[4];
#pragma unroll
    for (int st = 0; st < 4; ++st) qf[st] = *(const bf16x8*)(Q + (size_t)(q0 + r) * 512 + 16 * st + 8 * hh);
    float cq = 0.f; if (!SWA) cq = C[q0 + r];
    float m = -1e30f, lsum = 0.f;
    f32x16 o0, o1;
#pragma unroll
    for (int i = 0; i < 16; ++i) { o0[i] = 0.f; o1[i] = 0.f; }
    AB_WR(0, R0, C0);
#define AB_ITER(t_, RL, CL, RW, CW, SLOT_CUR, SLOT_NEXT) do { \
        RL = AB_LD((t_) + 3); if (doC) CL = AB_LDC((t_) + 3); \
        if ((t_) + 1 <= t_hi) AB_WR(SLOT_NEXT, RW, CW); \
        __syncthreads(); \
        const bool active_ = SWA ? ((t_) <= qt && (t_) >= qt - 4) : ((t_) <= qt); \
        if (active_) attn_compute<SWA>(lds + (SLOT_CUR) * AT_SLOT, qf, cq, m, lsum, o0, o1, (t_) == qt, (t_) == qt - 4, pr, r, hh); \
    } while (0)
    for (int t = t_lo; t <= t_hi; t += 3) {
        AB_ITER(t, R0, C0, R1, C1, 0, 1);
        if (t + 1 > t_hi) break;
        AB_ITER(t + 1, R1, C1, R2, C2, 1, 2);
        if (t + 2 > t_hi) break;
        AB_ITER(t + 2, R2, C2, R0, C0, 2, 0);
    }
    __syncthreads();
#undef AB_ITER
#undef AB_LD
#undef AB_LDC
#undef AB_WR
    float lt = lsum + __shfl_xor(lsum, 32);
    if (SWA) lt += __builtin_amdgcn_exp2f(sink2 - m);
    const float inv = 1.f / lt;
    bf16_t* yrow = Y + (size_t)(q0 + r) * 512 + 4 * hh;
#pragma unroll
    for (int g = 0; g < 4; ++g) {
        u32x2 a, c;
        a.x = pk2(o0[4 * g] * inv, o0[4 * g + 1] * inv); a.y = pk2(o0[4 * g + 2] * inv, o0[4 * g + 3] * inv);
        c.x = pk2(o1[4 * g] * inv, o1[4 * g + 1] * inv); c.y = pk2(o1[4 * g + 2] * inv, o1[4 * g + 3] * inv);
        *(u32x2*)(yrow + 8 * g) = a; *(u32x2*)(yrow + 32 + 8 * g) = c;
    }
}
__device__ __forceinline__ void m1_item(unsigned char* ws, int it, int lane) {
    const int r = lane & 31, hh = lane >> 5;
    const int dvt = it & 3, c = (it >> 2) & 15, bh = it >> 6;
    const bf16_t* VTp = (const bf16_t*)(ws + O_MVT) + ((size_t)bh * 128 + dvt * 32 + r) * SEQ + c * 128 + 8 * hh;
    const bf16_t* KTp = (const bf16_t*)(ws + O_KT) + ((size_t)bh * 128 + r) * SEQ + c * 128 + 8 * hh;
    const float* MPp = (const float*)(ws + O_MP) + (size_t)bh * SEQ + c * 128 + 8 * hh;
    const float mx = ((const float*)(ws + O_MCH))[(bh * 16 + c) * 4 + 1];
    f32x16 acc[4];
#pragma unroll
    for (int d = 0; d < 4; ++d)
#pragma unroll
        for (int i = 0; i < 16; ++i) acc[d][i] = 0.f;
    float dn[4] = {0.f, 0.f, 0.f, 0.f};
#pragma unroll 1
    for (int st = 0; st < 8; ++st) {
        const bf16x8 vf = *(const bf16x8*)(VTp + 16 * st);
        const f32x4 pa = *(const f32x4*)(MPp + 16 * st), pb = *(const f32x4*)(MPp + 16 * st + 4);
        float wk[8];
#pragma unroll
        for (int e = 0; e < 4; ++e) { wk[e] = __expf(pa[e] - mx); wk[4 + e] = __expf(pb[e] - mx); }
#pragma unroll
        for (int d = 0; d < 4; ++d) {
            const u32x4 kr = *(const u32x4*)(KTp + (size_t)d * 32 * SEQ + 16 * st);
            const float k0 = bflo(kr.x) * wk[0], k1 = bfhi(kr.x) * wk[1], k2 = bflo(kr.y) * wk[2], k3 = bfhi(kr.y) * wk[3];
            const float k4 = bflo(kr.z) * wk[4], k5 = bfhi(kr.z) * wk[5], k6 = bflo(kr.w) * wk[6], k7 = bfhi(kr.w) * wk[7];
            dn[d] += ((k0 + k1) + (k2 + k3)) + ((k4 + k5) + (k6 + k7));
            u32x4 kw; kw.x = pk2(k0, k1); kw.y = pk2(k2, k3); kw.z = pk2(k4, k5); kw.w = pk2(k6, k7);
            acc[d] = MFMA32(vf, __builtin_bit_cast(bf16x8, kw), acc[d]);
        }
    }
    bf16_t* DCT = (bf16_t*)(ws + O_DCT) + (size_t)(bh * 16 + c) * 16384;
#pragma unroll
    for (int d = 0; d < 4; ++d) {
#pragma unroll
        for (int g4 = 0; g4 < 4; ++g4) { int og = (dvt * 32 + 8 * g4 + 4 * hh) * 128 + d * 32 + r; asm volatile("" : "+v"(og)); bf16_t* pg = DCT + og;
            pg[0] = (bf16_t)pk2(acc[d][4 * g4], 0.f); pg[128] = (bf16_t)pk2(acc[d][4 * g4 + 1], 0.f); pg[256] = (bf16_t)pk2(acc[d][4 * g4 + 2], 0.f); pg[384] = (bf16_t)pk2(acc[d][4 * g4 + 3], 0.f); }
        const float t = dn[d] + __shfl_xor(dn[d], 32);
        if (dvt == 0 && hh == 0) ((float*)(ws + O_DN))[(bh * 16 + c) * 128 + d * 32 + r] = t;
    }
}
__device__ __forceinline__ void phase_m2(unsigned char* ws, int gtid, int NT) {
    const float* MCH = (const float*)(ws + O_MCH);
    for (int e = gtid; e < BG * 4 * 2048; e += NT) {
        const int bh = e >> 11, pp = e & 2047;
        const bf16_t* src = (const bf16_t*)(ws + O_DCT) + (size_t)bh * 16 * 16384 + 8 * pp;
        bf16_t* dst = (bf16_t*)(ws + O_CT) + (size_t)bh * 16 * 16384 + 8 * pp;
        u32x4 d[15]; float dec[15];
#pragma unroll
        for (int c = 0; c < 15; ++c) { d[c] = *(const u32x4*)(src + (size_t)c * 16384); dec[c] = MCH[(bh * 16 + c) * 4 + 2]; }
        float cs[8] = {0.f, 0.f, 0.f, 0.f, 0.f, 0.f, 0.f, 0.f};
        *(u32x4*)dst = (u32x4){0u, 0u, 0u, 0u};
#pragma unroll
        for (int c = 0; c < 15; ++c) {
            cs[0] = dec[c] * cs[0] + bflo(d[c].x); cs[1] = dec[c] * cs[1] + bfhi(d[c].x); cs[2] = dec[c] * cs[2] + bflo(d[c].y); cs[3] = dec[c] * cs[3] + bfhi(d[c].y);
            cs[4] = dec[c] * cs[4] + bflo(d[c].z); cs[5] = dec[c] * cs[5] + bfhi(d[c].z); cs[6] = dec[c] * cs[6] + bflo(d[c].w); cs[7] = dec[c] * cs[7] + bfhi(d[c].w);
            u32x4 o; o.x = pk2(cs[0], cs[1]); o.y = pk2(cs[2], cs[3]); o.z = pk2(cs[4], cs[5]); o.w = pk2(cs[6], cs[7]);
            *(u32x4*)(dst + (size_t)(c + 1) * 16384) = o;
        }
    }
    for (int e = gtid; e < BG * 4 * 128; e += NT) {
        const int bh = e >> 7, dk = e & 127; float n = 0.f;
        for (int c = 0; c < 16; ++c) { const size_t off = (size_t)(bh * 16 + c) * 128 + dk; ((float*)(ws + O_NN))[off] = n; n = MCH[(bh * 16 + c) * 4 + 2] * n + ((const float*)(ws + O_DN))[off]; }
    }
}
__device__ __forceinline__ void m3_item(unsigned char* ws, int l, int it, int lane) {
    const int r = lane & 31, hh = lane >> 5;
    const int pr = ((r >> 2) & 1) * 16 + ((r >> 4) & 1) * 8 + ((r >> 3) & 1) * 4 + (r & 3);
    const int tt = 3 - (it & 3), c = (it >> 2) & 15, bh = it >> 6, b = bh >> 2, h = bh & 3;
    const int ts = c * 128 + tt * 32 + r;
    const size_t trow = (size_t)b * SEQ + ts;
    bf16x8 qf[8];
    const bf16_t* Qp = (const bf16_t*)(ws + O_MQC) + trow * 512 + h * 128 + 8 * hh;
#pragma unroll
    for (int k = 0; k < 8; ++k) qf[k] = *(const bf16x8*)(Qp + 16 * k);
    const float Et = ((const float*)(ws + O_ME))[(size_t)bh * SEQ + ts], bt = ((const float*)(ws + O_MBT))[(size_t)bh * SEQ + ts];
    const float mc = ((const float*)(ws + O_MCH))[(bh * 16 + c) * 4];
    const float winter = __expf(mc - Et);
    f32x16 acc[4];
#pragma unroll
    for (int d = 0; d < 4; ++d)
#pragma unroll
        for (int i = 0; i < 16; ++i) acc[d][i] = 0.f;
    const bf16_t* CTp = (const bf16_t*)(ws + O_CT) + (size_t)(bh * 16 + c) * 16384 + (size_t)r * 128 + 8 * hh;
    const float* NNp = (const float*)(ws + O_NN) + (size_t)(bh * 16 + c) * 128 + 8 * hh;
    float qn = 0.f;
#pragma unroll
    for (int k = 0; k < 8; ++k) {
#pragma unroll
        for (int d = 0; d < 4; ++d) acc[d] = MFMA32(*(const bf16x8*)(CTp + (size_t)d * 32 * 128 + 16 * k), qf[k], acc[d]);
        const f32x4 na = *(const f32x4*)(NNp + 16 * k), nb = *(const f32x4*)(NNp + 16 * k + 4);
        const u32x4 qw = __builtin_bit_cast(u32x4, qf[k]);
        qn += bflo(qw.x) * na[0] + bfhi(qw.x) * na[1] + bflo(qw.y) * na[2] + bfhi(qw.y) * na[3] + bflo(qw.z) * nb[0] + bfhi(qw.z) * nb[1] + bflo(qw.w) * nb[2] + bfhi(qw.w) * nb[3];
        asm volatile("" ::: "memory");
    }
    qn += __shfl_xor(qn, 32);
#pragma unroll
    for (int d = 0; d < 4; ++d)
#pragma unroll
        for (int i = 0; i < 16; ++i) acc[d][i] *= winter;
    float dpart = 0.f;
    const bf16_t* Kb = (const bf16_t*)(ws + O_MKC) + ((size_t)b * SEQ + c * 128 + pr) * 512 + h * 128 + 8 * hh;
    const bf16_t* Vb = (const bf16_t*)(ws + O_MVT) + ((size_t)bh * 128 + r) * SEQ + c * 128 + 16 * hh;
    const float* MPb = (const float*)(ws + O_MP) + (size_t)bh * SEQ + c * 128 + 16 * hh;
    for (int st = 0; st <= tt; ++st) {
        f32x16 sc;
#pragma unroll
        for (int i = 0; i < 16; ++i) sc[i] = 0.f;
#pragma unroll
        for (int k = 0; k < 8; ++k) { sc = MFMA32(*(const bf16x8*)(Kb + (size_t)st * 32 * 512 + 16 * k), qf[k], sc); if (k == 3) asm volatile("" ::: "memory"); }
        asm volatile("" ::: "memory");
#pragma unroll
        for (int g = 0; g < 4; ++g) { const f32x4 pv = *(const f32x4*)(MPb + st * 32 + 4 * g);
#pragma unroll
            for (int e = 0; e < 4; ++e) { const int i = 4 * g + e;
                const bool ok = (st < tt) || (16 * hh + i <= r);
                const float w = ok ? __expf(pv[e] - Et) : 0.f;
                sc[i] = ok ? sc[i] * w : 0.f; dpart += sc[i]; } }
        u32x4 pw0, pw1;
        pw0.x = pk2(sc[0], sc[1]); pw0.y = pk2(sc[2], sc[3]); pw0.z = pk2(sc[4], sc[5]); pw0.w = pk2(sc[6], sc[7]);
        pw1.x = pk2(sc[8], sc[9]); pw1.y = pk2(sc[10], sc[11]); pw1.z = pk2(sc[12], sc[13]); pw1.w = pk2(sc[14], sc[15]);
        const bf16x8 pf0 = __builtin_bit_cast(bf16x8, pw0), pf1 = __builtin_bit_cast(bf16x8, pw1);
#pragma unroll
        for (int d = 0; d < 4; ++d) {
            acc[d] = MFMA32(*(const bf16x8*)(Vb + (size_t)d * 32 * SEQ + st * 32), pf0, acc[d]);
            acc[d] = MFMA32(*(const bf16x8*)(Vb + (size_t)d * 32 * SEQ + st * 32 + 8), pf1, acc[d]);
            if (d == 1) asm volatile("" ::: "memory");
        }
    }
    const float den = winter * qn + (dpart + __shfl_xor(dpart, 32));
    const float dinv = 1.f / fmaxf(fabsf(den), __expf(-(bt + Et)));
    float ss = 0.f;
#pragma unroll
    for (int d = 0; d < 4; ++d)
#pragma unroll
        for (int i = 0; i < 16; ++i) { acc[d][i] *= dinv; ss += acc[d][i] * acc[d][i]; }
    ss += __shfl_xor(ss, 32);
    const float rn = rsqrtf(ss * (1.f / 128.f) + EPS);
    const float* onorm = (const float*)(ws + O_PAR) + PAR_ON + l * 512 + h * 128 + 4 * hh;
    const bf16_t* mo = (const bf16_t*)(ws + O_U) + trow * LDU + UC_MO + h * 128 + 4 * hh;
    bf16_t* y = (bf16_t*)(ws + O_Y) + (size_t)2 * MG * 512 + trow * 512 + h * 128 + 4 * hh;
#pragma unroll
    for (int d = 0; d < 4; ++d)
#pragma unroll
        for (int g = 0; g < 4; ++g) {
            const int dv = d * 32 + 8 * g;
            const f32x4 wn = *(const f32x4*)(onorm + dv); const u32x2 og = *(const u32x2*)(mo + dv);
            const float y0 = acc[d][4 * g] * rn * wn[0] * sigm(bflo(og.x)), y1 = acc[d][4 * g + 1] * rn * wn[1] * sigm(bfhi(og.x));
            const float y2 = acc[d][4 * g + 2] * rn * wn[2] * sigm(bflo(og.y)), y3 = acc[d][4 * g + 3] * rn * wn[3] * sigm(bfhi(og.y));
            u32x2 o; o.x = pk2(y0, y1); o.y = pk2(y2, y3); *(u32x2*)(y + dv) = o;
            if (g & 1) asm volatile("" ::: "memory");
        }
}

#define XB_TMO      128
#define XB_XCNT(j)  (256  + 64 * (j))
#define XB_XSUB(j)  (1280 + 64 * (j))
#define XB_XGEN(j)  (2304 + 64 * (j))
#define XB_TOP      3328
#define XB_TOPGEN   3392
#define XCD_BAR_WORDS 3456
#define XB_SPIN_CAP (1u << 18)

__device__ __forceinline__ unsigned xb_ld(unsigned* p)              { return __hip_atomic_load(p, __ATOMIC_RELAXED, __HIP_MEMORY_SCOPE_AGENT); }
__device__ __forceinline__ unsigned xb_add(unsigned* p, unsigned v) { return __hip_atomic_fetch_add(p, v, __ATOMIC_RELAXED, __HIP_MEMORY_SCOPE_AGENT); }
__device__ __forceinline__ unsigned xb_xcc_id() { return (unsigned)__builtin_amdgcn_s_getreg((3 << 11) | 20) & 0xFu; }
#define XB_SPIN(cond, bar) do { unsigned _sp = 0; while (cond) { __builtin_amdgcn_s_sleep(1); \
    if ((++_sp & 255u) == 0u) { if (xb_ld(&(bar)[XB_TMO])) break; if (_sp > XB_SPIN_CAP) { atomicAdd(&(bar)[XB_TMO], 1u); break; } } } } while (0)

struct XcdBarrier {
    unsigned* bar; unsigned x;
    volatile LAS unsigned* st;
};

__device__ __forceinline__ XcdBarrier xcd_barrier_post(unsigned* bar, volatile LAS unsigned* st) {
    XcdBarrier b; b.bar = bar; b.x = xb_xcc_id(); b.st = st;
    if (threadIdx.x == 0) (void)xb_add(&bar[XB_XCNT(b.x)], 1u);
    return b;
}
__device__ __forceinline__ void xcd_barrier_complete(unsigned* bar, unsigned x, unsigned& nloc, unsigned& nx) {
    const unsigned G = gridDim.x * gridDim.y * gridDim.z;
    unsigned sum, cnt, mine, sp = 0u;
    for (;;) {
        sum = 0u; cnt = 0u; mine = 0u;
#pragma unroll
        for (unsigned j = 0; j < 16; ++j) { const unsigned c = xb_ld(&bar[XB_XCNT(j)]); sum += c; cnt += (c > 0u) ? 1u : 0u; mine = (j == x) ? c : mine; }
        if (sum == G) break;
        __builtin_amdgcn_s_sleep(1);
        if ((++sp & 255u) == 0u) { if (xb_ld(&bar[XB_TMO])) break; if (sp > XB_SPIN_CAP) { atomicAdd(&bar[XB_TMO], 1u); break; } }
    }
    nloc = mine > 0u ? mine : 1u; nx = cnt > 0u ? cnt : 1u;
}

__device__ __forceinline__ void xcd_barrier(const XcdBarrier& b) {
    asm volatile("s_waitcnt vmcnt(0)" ::: "memory");
    __syncthreads();
    if (threadIdx.x == 0) {
        unsigned* bar = b.bar;
        __builtin_amdgcn_s_waitcnt(0);
        unsigned nloc = b.st[0], nx = b.st[1];
        if (nloc == 0u) { xcd_barrier_complete(bar, b.x, nloc, nx); b.st[0] = nloc; b.st[1] = nx; }
        const unsigned old = xb_add(&bar[XB_XSUB(b.x)], 1u);
        const unsigned gen = old / nloc;
        if (old + 1u == (gen + 1u) * nloc) {
            __builtin_amdgcn_fence(__ATOMIC_RELEASE, "agent");
            asm volatile("s_waitcnt vmcnt(0)" ::: "memory");
            const unsigned og = xb_add(&bar[XB_TOP], 1u);
            const unsigned tg = og / nx;
            if (og + 1u == (tg + 1u) * nx) xb_add(&bar[XB_TOPGEN], 1u);
            else XB_SPIN(xb_ld(&bar[XB_TOPGEN]) == tg, bar);
            __builtin_amdgcn_fence(__ATOMIC_ACQUIRE, "agent");
            xb_add(&bar[XB_XGEN(b.x)], 1u);
            asm volatile("s_waitcnt vmcnt(0)" ::: "memory");
        } else {
            XB_SPIN(xb_ld(&bar[XB_XGEN(b.x)]) == gen, bar);
            __builtin_amdgcn_fence(__ATOMIC_ACQUIRE, "agent");
            asm volatile("s_waitcnt vmcnt(0)" ::: "memory");
        }
    }
    __syncthreads();
}


__global__ void __launch_bounds__(NTHR, 2) fwd_kernel(KP p) {
    extern __shared__ __attribute__((aligned(16))) unsigned char lds_raw[];
    LAS unsigned char* lds = (LAS unsigned char*)lds_raw;
    cg::grid_group grid = cg::this_grid();
    const int tid = threadIdx.x, lane0 = tid & 63, wave = __builtin_amdgcn_readfirstlane(tid >> 6);
    const int G = gridDim.x, gw0 = blockIdx.x * NWAVES + wave, NWV = G * NWAVES, NT = G * NTHR;
    unsigned char* ws0 = p.ws;
    volatile LAS unsigned* MISC = (volatile LAS unsigned*)(lds + 131072);
    if (tid < 64) MISC[tid] = 0u;
    __syncthreads();
    XcdBarrier bar = xcd_barrier_post((unsigned*)(ws0 + O_BAR), MISC + 8);
#ifndef PM
#define PM 0xFFFF
#endif
#ifndef PROBE_ID
#define PROBE_ID -1
#define PROBE_REP 1
#endif
#ifndef PM4
#define PM4 7
#endif
#define XB ((bf16_t*)(ws + O_XB))
#define RS ((float*)(ws + O_RS))
#define U ((bf16_t*)(ws + O_U))
    for (int pc = p.ph_lo; pc < p.ph_hi; ++pc) {
        int id = 0, g = 0, l = 0;
        if (pc > 0) { const int q_ = pc - 1, r_ = q_ % (1 + DEPTH * 9); g = q_ / (1 + DEPTH * 9); if (r_ == 0) id = 1; else { l = (r_ - 1) / 9; id = 2 + (r_ - 1) % 9; } }
        const size_t goff = (size_t)g * MG * DM;
        const int nrep = (PROBE_ID == id) ? PROBE_REP : 1;
        for (int rep_ = 0; rep_ < nrep; ++rep_) {
            size_t zo_ = 0; int lane = lane0, gw = gw0; asm volatile("" : "+s"(zo_), "+v"(lane), "+s"(gw));
            unsigned char* ws = p.ws + zo_;
            const int gtid = gw * 64 + lane; (void)gtid;
            if (!((PM >> id) & 1)) continue;
            switch (id) {
    case 0: { phase_p0(p, ws, lds, gw, NWV, wave, lane); } break;

        case 1: { phase_x0(p.in[0] + goff, XB, RS, gw, NWV, lane); } break;
            case 2: { {
                pg8::Gemm gm{XB, (const bf16_t*)(ws + O_WIN) + (size_t)l * NINP * DM, MG, NINP, DM}; pg8::StaticOrder S; S.init(MG, NINP, G, (int)blockIdx.x);
                pg8::EpiA E{0, 0, RS, U, LDU, (float*)(ws + O_SG), nullptr, 0, nullptr};
                pg8::gemm_phase<pg8::EpiA, pg8::StaticOrder, true, true>(lds, gm, S, E);
            } } break;
            case 3: { {
                constexpr int N_SCAN = BG * 12, N_HN3 = 3 * (MG / 8), N_HK = MG / 32, N_ST = 34 * (MG / 64);
                const int sw = (wave == 7 && (int)blockIdx.x < N_SCAN) ? (int)blockIdx.x : -1;
                if (sw >= 0) { for (int it = sw; it < N_SCAN; it += G) gate_scan_item(ws, l, it, lane); }
                else {
                    const int nscanw = (N_SCAN < G ? N_SCAN : G);
                    const int wi = (int)blockIdx.x < nscanw ? (int)blockIdx.x * 7 + wave : nscanw * 7 + ((int)blockIdx.x - nscanw) * 8 + wave;
                    const int nw = NWV - nscanw;
                    for (int it = wi; it < N_HN3 + N_HK + N_ST; it += nw) {
                        if (it < N_HN3) headnorm_item(ws, l, it % 3, it / 3, lane);
                        else if (it < N_HN3 + N_HK) headnorm_item(ws, l, 3, it - N_HN3, lane);
                        else stream_item(ws, l, it - N_HN3 - N_HK, lane);
                    }
                }
            } } break;
            case 4: { {
                if (PM4 & 1) for (int it = gw; it < BG * 4 * 16 * 4; it += NWV) m1_item(ws, it, lane);
                __syncthreads();
                if (PM4 & 2) for (int it = (int)blockIdx.x; it < BG * 8 * 4; it += G) {
                    const int b = it >> 5, h = (it >> 2) & 7, jp = it & 3;
                    const bf16_t* Q = (const bf16_t*)(ws + O_FQN) + (size_t)b * SEQ * 512 + h * 64; const bf16_t* K = (const bf16_t*)(ws + O_FKN) + (size_t)b * SEQ * 512 + h * 64;
                    const bf16_t* VT = (const bf16_t*)(ws + O_FVT) + (size_t)(b * 8 + h) * 64 * SEQ; const float* C = (const float*)(ws + O_FC) + (size_t)(b * 8 + h) * SEQ;
                    bf16_t* Y = (bf16_t*)(ws + O_Y) + (size_t)b * SEQ * 512 + h * 64;
                    attn_block<false>(lds, Q, K, 512, VT, C, 0.f, Y, 8 * (7 - jp) + wave, 0, 8 * (7 - jp) + 7, wave, lane);
                    attn_block<false>(lds, Q, K, 512, VT, C, 0.f, Y, 8 * jp + wave, 0, 8 * jp + 7, wave, lane);
                }
                if (PM4 & 4) for (int it = (int)blockIdx.x; it < BG * 2 * 32; it += G) {
                    const int b = it >> 6, hk = (it >> 5) & 1, u = it & 31, hq = hk * 4 + (wave & 3), qt = 2 * u + (wave >> 2);
                    const bf16_t* Q = (const bf16_t*)(ws + O_SQR) + (size_t)b * SEQ * 512 + hq * 64; const bf16_t* K = (const bf16_t*)(ws + O_SKR) + (size_t)b * SEQ * 128 + hk * 64;
                    const bf16_t* VT = (const bf16_t*)(ws + O_SVT) + (size_t)(b * 2 + hk) * 64 * SEQ;
                    bf16_t* Y = (bf16_t*)(ws + O_Y) + (size_t)MG * 512 + (size_t)b * SEQ * 512 + hq * 64;
                    attn_block<true>(lds, Q, K, 128, VT, nullptr, ((const float*)(ws + O_PAR))[PAR_SINK + l * 8 + hq] * LOG2E, Y, qt, (2 * u > 4 ? 2 * u - 4 : 0), 2 * u + 1, wave, lane);
                }
            } } break;
            case 5: { phase_m2(ws, gtid, NT); } break;
            case 6: { { for (int it = gw; it < BG * 4 * 16 * 4; it += NWV) m3_item(ws, l, it, lane); } } break;
            case 7: { {
                pg8::Gemm gm{(const bf16_t*)(ws + O_Y), (const bf16_t*)(ws + O_WB) + (size_t)l * 3 * DM * 512, 3 * MG, 3 * DM, 512}; pg8::DiagOrder S; S.init(MG, DM, G, (int)blockIdx.x);
                pg8::EpiM E{MG / 256, (bf16_t*)(ws + O_MRG), U + UC_G, LDU};
                pg8::gemm_phase<pg8::EpiM, pg8::DiagOrder, true, true>(lds, gm, S, E);
            } } break;
            case 8: { {
                pg8::Gemm gm{(const bf16_t*)(ws + O_MRG), (const bf16_t*)(ws + O_WOUT) + (size_t)l * DM * DM, MG, DM, DM}; pg8::StaticOrder S; S.init(MG, DM, G, (int)blockIdx.x);
                pg8::EpiB E{(l == 0 ? p.in[0] : (const float*)p.out) + goff, p.out + goff, XB, RS};
                pg8::gemm_phase<pg8::EpiB, pg8::StaticOrder, true, true>(lds, gm, S, E);
            } } break;
            case 9: { {
                pg8::Gemm gm{XB, (const bf16_t*)(ws + O_WUP) + (size_t)l * FF * DM, MG, FF, DM}; pg8::StaticOrder S; S.init(MG, FF, G, (int)blockIdx.x);
                pg8::EpiA E{2, 0, RS, U  , FF, nullptr, nullptr, 0, nullptr};
                pg8::gemm_phase<pg8::EpiA, pg8::StaticOrder, true, true>(lds, gm, S, E);
            } } break;
            case 10: { {
                pg8::Gemm gm{U  , (const bf16_t*)(ws + O_WDN) + (size_t)l * DM * FF, MG, DM, FF}; pg8::StaticOrder S; S.init(MG, DM, G, (int)blockIdx.x);
                pg8::EpiB E{(const float*)p.out + goff, p.out + goff, XB, RS};
                pg8::gemm_phase<pg8::EpiB, pg8::StaticOrder, true, true>(lds, gm, S, E);
            } } break;
            default: break;
            }
        }
        if (pc + 1 < p.ph_hi) { if (pc == 0) grid.sync(); else xcd_barrier(bar); }
    }
}
constexpr int N_PHASES = 1 + NG * (1 + DEPTH * 9);

#ifndef MK_MULTI
#define MK_MULTI 0
#endif
extern "C" void kernel_launch(void* const* d_in, const int* in_sizes, int n_in, void* d_out, int out_size, void* d_ws, size_t ws_size, hipStream_t stream) {
    static int grid = 0;
    if (grid == 0) {
        if (n_in != 19 || out_size != NB * SEQ * DM || ws_size < WS_NEED) { fprintf(stderr, "kernel_launch: unexpected problem (n_in %d out %d ws %zu need %zu)\n", n_in, out_size, ws_size, (size_t)WS_NEED); grid = -1; return; }
        int dev = 0, cus = 0, per_cu = 0;
        hipGetDevice(&dev); hipDeviceGetAttribute(&cus, hipDeviceAttributeMultiprocessorCount, dev);
        if (hipFuncSetAttribute((const void*)fwd_kernel, hipFuncAttributeMaxDynamicSharedMemorySize, LDS_BYTES) != hipSuccess) { fprintf(stderr, "kernel_launch: hipFuncSetAttribute failed\n"); grid = -1; return; }
        hipOccupancyMaxActiveBlocksPerMultiprocessor(&per_cu, (const void*)fwd_kernel, NTHR, LDS_BYTES);
        (void)hipGetLastError();
        if (per_cu < 1) { fprintf(stderr, "kernel_launch: occupancy query says %d blocks per CU\n", per_cu); per_cu = 1; }
        grid = cus;
    }
    if (grid < 0) return;
    if (hipMemsetAsync((char*)d_ws + O_BAR, 0, 16384, stream) != hipSuccess) { fprintf(stderr, "kernel_launch: memset failed\n"); return; }
    KP a{};
    for (int i = 0; i < 19; ++i) a.in[i] = (const float*)d_in[i];
    a.out = (float*)d_out; a.ws = (unsigned char*)d_ws;
#if MK_MULTI
    for (int ph = 0; ph < N_PHASES; ++ph) { a.ph_lo = ph; a.ph_hi = ph + 1; hipLaunchKernelGGL(fwd_kernel, dim3(grid), dim3(NTHR), LDS_BYTES, stream, a); }
#else
    a.ph_lo = 0; a.ph_hi = N_PHASES;
    void* args[] = {&a};
    hipError_t e = hipLaunchCooperativeKernel((const void*)fwd_kernel, dim3(grid), dim3(NTHR), args, LDS_BYTES, stream);
    if (e != hipSuccess) fprintf(stderr, "kernel_launch: cooperative launch failed: %s (grid %d)\n", hipGetErrorString(e), grid);
#endif
}
```

```cpp
#include <hip/hip_runtime.h>
#include <hip/hip_cooperative_groups.h>
#include <cstdio>
#include <cstdint>
#include <cmath>
namespace cg = cooperative_groups;
namespace pg8 {
#define PG8_LAS __attribute__((address_space(3)))
typedef unsigned short bf16_t;
typedef short bf16x8 __attribute__((ext_vector_type(8)));
typedef float f32x4 __attribute__((ext_vector_type(4)));
typedef unsigned u32x4 __attribute__((ext_vector_type(4)));
constexpr int BM = 256, BK = 64, HALF = 128, HTB = HALF * BK * 2  , STAGE_BYTES = 8 * HTB, NXCD = 8, WGM = 8;

__host__ __device__ __forceinline__ int lds_byte(int r, int c) { const int st = (r >> 4) * 2 + (c >> 5), rr = r & 15, cc = c & 31, ob = rr * 64 + cc * 2; return st * 1024 + (ob ^ (((ob >> 9) & 1) << 5)); }
__host__ __device__ __forceinline__ void stage_rc(int b, int& R, int& C) { const int st = b / 1024, sb = b % 1024, swz = sb ^ (((sb >> 9) & 1) << 5); R = (st >> 1) * 16 + swz / 64; C = (st & 1) * 32 + (swz % 64) / 2; }
__host__ __device__ __forceinline__ int perm32(int rho) { const int n = rho >> 4, i = rho & 15; return 8 * (i >> 2) + 4 * n + (i & 3); }

struct Unit { int pm, pn; };
struct Gemm { const bf16_t* A; const bf16_t* Bt; int M, N, K; };

struct StaticOrder {
    int nM, nN, nwg, G, c;
    __host__ __device__ void init(int M, int N, int G_, int c_) { nM = M / BM; nN = N / BM; nwg = nM * nN; G = G_; c = c_; }
    __host__ __device__ bool next(int i, Unit& u) const {
        const long L = (long)i * G + c; if (L >= nwg) return false;
        int wgid = (int)L; { const int q = nwg / NXCD, r = nwg % NXCD, xcd = wgid % NXCD, off = wgid / NXCD; wgid = (xcd < r ? xcd * (q + 1) : r * (q + 1) + (xcd - r) * q) + off; }
        const int nig = WGM * nN, gid = wgid / nig, fm = gid * WGM, gsz = (nM - fm) < WGM ? (nM - fm) : WGM;
        u.pm = fm + ((wgid % nig) % gsz); u.pn = (wgid % nig) / gsz; return true;
    }
    __device__ __forceinline__ void a_ready(const Unit&) const {}
    __device__ __forceinline__ void done(const Unit&) const {}
};


typedef unsigned u32x2 __attribute__((ext_vector_type(2)));
typedef float f32x2_t __attribute__((ext_vector_type(2)));
typedef __bf16 bf16x2_t __attribute__((ext_vector_type(2)));
__device__ __forceinline__ unsigned pk2(float lo, float hi) { f32x2_t v = {lo, hi}; bf16x2_t b = __builtin_convertvector(v, bf16x2_t); return __builtin_bit_cast(unsigned, b); }
__device__ __forceinline__ float bflo(unsigned w) { return __uint_as_float(w << 16); }
__device__ __forceinline__ float bfhi(unsigned w) { return __uint_as_float(w & 0xffff0000u); }
__device__ __forceinline__ float sigm(float x) { return __builtin_amdgcn_rcpf(1.f + __expf(-x)); }
__device__ __forceinline__ float rowscale(const float* rs, int row) {
    const f32x4* p = (const f32x4*)(rs + (size_t)row * 16);
    const f32x4 a = p[0], b = p[1], c = p[2], d = p[3];
    const float s = ((a[0] + a[1]) + (a[2] + a[3])) + ((b[0] + b[1]) + (b[2] + b[3])) + ((c[0] + c[1]) + (c[2] + c[3])) + ((d[0] + d[1]) + (d[2] + d[3]));
    return rsqrtf(s * (1.f / 1024.f) + 1e-6f);
}
struct EpiA {
    static constexpr bool PERM = true, AFTER_DRAIN = false;
    static __device__ __forceinline__ bool keeps(const Unit&) { return false; }
    int mode, sub; const float* rs; bf16_t* out; int ldo; float* sg; const bf16_t* gate; int ldg; float* tmp;
    __device__ __forceinline__ void operator()(const f32x4 (&acc)[2][2][4][2], const Unit& u, int wr, int wc, int fr, int fq) const {
        const int row0 = u.pm * BM + wr * 64 + fr, colb = u.pn * BM + wc * 32 + 8 * fq;
        float rsv8[2][4];
        if (mode != 1) {
            f32x4 part[2][4];
#pragma unroll
            for (int ai = 0; ai < 2; ++ai)
#pragma unroll
                for (int m = 0; m < 4; ++m) part[ai][m] = *(const f32x4*)(rs + (size_t)(row0 + ai * HALF + m * 16) * 16 + 4 * fq);
#pragma unroll
            for (int ai = 0; ai < 2; ++ai)
#pragma unroll
                for (int m = 0; m < 4; ++m) { float sp = (part[ai][m][0] + part[ai][m][1]) + (part[ai][m][2] + part[ai][m][3]); sp += __shfl_xor(sp, 16); sp += __shfl_xor(sp, 32); rsv8[ai][m] = rsqrtf(sp * (1.f / 1024.f) + 1e-6f); }
        } else {
#pragma unroll
            for (int ai = 0; ai < 2; ++ai)
#pragma unroll
                for (int m = 0; m < 4; ++m) rsv8[ai][m] = 1.f;
        }
#pragma unroll
        for (int ai = 0; ai < 2; ++ai)
#pragma unroll
            for (int m = 0; m < 4; ++m) {
                const int row = row0 + ai * HALF + m * 16;
                const float rsv = rsv8[ai][m];
#pragma unroll
                for (int bj = 0; bj < 2; ++bj) {
                    const int col = colb + bj * HALF;
                    f32x4 v0 = acc[ai][bj][m][0] * rsv, v1 = acc[ai][bj][m][1] * rsv;
                    if (mode == 0) {
                        if (u.pn == 29) {
                            if (bj == 0 && wc == 0 && fq < 2) { float* q = sg + (size_t)row * 16 + 8 * fq; *(f32x4*)q = v0; *(f32x4*)(q + 4) = v1; }
                        } else {
                            if (u.pn >= 17) {
#pragma unroll
                                for (int e = 0; e < 4; ++e) { v0[e] = sigm(v0[e]); v1[e] = sigm(v1[e]); }
                            }
                            u32x4 w; w.x = pk2(v0[0], v0[1]); w.y = pk2(v0[2], v0[3]); w.z = pk2(v1[0], v1[1]); w.w = pk2(v1[2], v1[3]);
                            *(u32x4*)(out + (size_t)row * ldo + col) = w;
                        }
                    } else if (mode == 1) {
                        const u32x4 g = *(const u32x4*)(gate + (size_t)row * ldg + col);
                        f32x4 p0 = {v0[0] * bflo(g.x), v0[1] * bfhi(g.x), v0[2] * bflo(g.y), v0[3] * bfhi(g.y)};
                        f32x4 p1 = {v1[0] * bflo(g.z), v1[1] * bfhi(g.z), v1[2] * bflo(g.w), v1[3] * bfhi(g.w)};
                        float* tp = tmp + (size_t)row * 1024 + col;
                        if (sub == 0) { *(f32x4*)tp = p0; *(f32x4*)(tp + 4) = p1; }
                        else if (sub == 1) { *(f32x4*)tp = *(const f32x4*)tp + p0; *(f32x4*)(tp + 4) = *(const f32x4*)(tp + 4) + p1; }
                        else { p0 = p0 + *(const f32x4*)tp; p1 = p1 + *(const f32x4*)(tp + 4);
                            u32x4 w; w.x = pk2(p0[0], p0[1]); w.y = pk2(p0[2], p0[3]); w.z = pk2(p1[0], p1[1]); w.w = pk2(p1[2], p1[3]);
                            *(u32x4*)(out + (size_t)row * ldo + col) = w; }
                    } else {
#pragma unroll
                        for (int e = 0; e < 4; ++e) { const float a = fmaxf(v0[e], 0.f), b = fmaxf(v1[e], 0.f); v0[e] = a * a; v1[e] = b * b; }
                        u32x4 w; w.x = pk2(v0[0], v0[1]); w.y = pk2(v0[2], v0[3]); w.z = pk2(v1[0], v1[1]); w.w = pk2(v1[2], v1[3]);
                        *(u32x4*)(out + (size_t)row * ldo + col) = w;
                    }
                }
            }
    }
};
struct EpiB {
    static constexpr bool PERM = false, AFTER_DRAIN = false;
    static __device__ __forceinline__ bool keeps(const Unit&) { return false; }
    const float* resid; float* out; bf16_t* xb; float* rs;
    __device__ __forceinline__ void operator()(const f32x4 (&acc)[2][2][4][2], const Unit& u, int wr, int wc, int fr, int fq) const {
        const int row0 = u.pm * BM + wr * 64 + fr, colb = u.pn * BM + wc * 32 + 4 * fq;
#pragma unroll
        for (int ai = 0; ai < 2; ++ai)
#pragma unroll
            for (int m = 0; m < 4; ++m) {
                const int row = row0 + ai * HALF + m * 16; float ss = 0.f;
#pragma unroll
                for (int bj = 0; bj < 2; ++bj)
#pragma unroll
                    for (int n = 0; n < 2; ++n) {
                        const size_t off = (size_t)row * 1024 + colb + bj * HALF + n * 16;
                        f32x4 x;
                        if (resid) x = *(const f32x4*)(resid + off);
                        else { const u32x2 rb = *(const u32x2*)(xb + off); x = (f32x4){bflo(rb.x), bfhi(rb.x), bflo(rb.y), bfhi(rb.y)}; }
                        x = x + acc[ai][bj][m][n];
                        if (out) *(f32x4*)(out + off) = x;
                        else { u32x2 w; w.x = pk2(x[0], x[1]); w.y = pk2(x[2], x[3]); *(u32x2*)(xb + off) = w; }
                        ss += (x[0] * x[0] + x[1] * x[1]) + (x[2] * x[2] + x[3] * x[3]);
                    }
                if (!out) { ss += __shfl_xor(ss, 16); ss += __shfl_xor(ss, 32);
                    if (fq == 0) rs[(size_t)row * 16 + u.pn * 4 + wc] = ss; }
            }
    }
};
struct EpiM {
    static constexpr bool PERM = true, AFTER_DRAIN = false;
    static __device__ __forceinline__ bool keeps(const Unit& u) { return (u.pn >> 2) != 2; }
    int nM; bf16_t* out; const bf16_t* gate; int ldg;
    __device__ __forceinline__ void operator()(const f32x4 (&acc_)[2][2][4][2], const Unit& u, int wr, int wc, int fr, int fq) const {
        f32x4 (&acc)[2][2][4][2] = const_cast<f32x4 (&)[2][2][4][2]>(acc_);
        const int sub = u.pn >> 2, pm = u.pm - sub * nM, pn = u.pn & 3;
        const int row0 = pm * BM + wr * 64 + fr, colb = pn * BM + wc * 32 + 8 * fq;
        const bf16_t* gb = gate + sub * 1024;
#pragma unroll
        for (int ai = 0; ai < 2; ++ai)
#pragma unroll
            for (int m = 0; m < 4; ++m)
#pragma unroll
                for (int bj = 0; bj < 2; ++bj) {
                    const size_t goff = (size_t)(row0 + ai * HALF + m * 16) * ldg + colb + bj * HALF;
                    const u32x4 g = *(const u32x4*)(gb + goff);
                    float f[8] = {bflo(g.x), bfhi(g.x), bflo(g.y), bfhi(g.y), bflo(g.z), bfhi(g.z), bflo(g.w), bfhi(g.w)};
#pragma unroll
                    for (int e = 0; e < 8; ++e) f[e] = fmaxf(f[e], 1e-30f);
                    if (sub != 2) {
                        const u32x4 gn = *(const u32x4*)(gb + 1024 + goff);
                        const float d[8] = {bflo(gn.x), bfhi(gn.x), bflo(gn.y), bfhi(gn.y), bflo(gn.z), bfhi(gn.z), bflo(gn.w), bfhi(gn.w)};
#pragma unroll
                        for (int e = 0; e < 8; ++e) f[e] = f[e] * __builtin_amdgcn_rcpf(fmaxf(d[e], 1e-30f));
                    }
                    f32x4& v0 = acc[ai][bj][m][0]; f32x4& v1 = acc[ai][bj][m][1];
                    v0[0] *= f[0]; v0[1] *= f[1]; v0[2] *= f[2]; v0[3] *= f[3]; v1[0] *= f[4]; v1[1] *= f[5]; v1[2] *= f[6]; v1[3] *= f[7];
                    if (sub == 2) {
                        u32x4 w; w.x = pk2(v0[0], v0[1]); w.y = pk2(v0[2], v0[3]); w.z = pk2(v1[0], v1[1]); w.w = pk2(v1[2], v1[3]);
                        *(u32x4*)(out + (size_t)(row0 + ai * HALF + m * 16) * 1024 + colb + bj * HALF) = w;
                    }
                }
    }
};
struct DiagOrder {
    StaticOrder S; int nM;
    __host__ __device__ void init(int M, int N, int G_, int c_) { S.init(M, N, G_, c_); nM = M / BM; }
    __host__ __device__ bool next(int i, Unit& u) const { Unit v; if (!S.next(i / 3, v)) return false; const int b = i % 3; u.pm = b * nM + v.pm; u.pn = b * 4 + v.pn; return true; }
    __device__ __forceinline__ void a_ready(const Unit&) const {}
    __device__ __forceinline__ void done(const Unit&) const {}
};

template <class Epi, class Sched, bool ALIGN_EPI = false, bool SP2 = false>
__device__ __forceinline__ void gemm_phase(PG8_LAS unsigned char* lds, const Gemm g, const Sched& S, const Epi& E) {
    int tid_ = threadIdx.x; asm volatile("" : "+v"(tid_));
    const int tid = tid_, wid = __builtin_amdgcn_readfirstlane(tid >> 6), lane = tid & 63, wr = wid >> 2, wc = wid & 3, fr = lane & 15, fq = lane >> 4;
    const int K = g.K, nt = K / BK;
    unsigned voffA[2], voffB[2];
#pragma unroll
    for (int i = 0; i < 2; ++i) { int R, C; stage_rc(tid * 16 + i * 8192, R, C); const int Rb = Epi::PERM ? ((R & ~31) + perm32(R & 31)) : R;
        voffA[i] = (unsigned)(R * K + C) * 2u; voffB[i] = (unsigned)(Rb * K + C) * 2u; }
    const size_t kstep = (size_t)(BK * 2);
    const size_t hstep = (size_t)HALF * K * 2;
    const size_t tstep = 2 * hstep;
    const unsigned ldsw = (unsigned)wid * 1024u;
    const int aoff = lds_byte(wr * 64 + fr, fq * 8), boff = lds_byte(wc * 32 + fr, fq * 8);
#define PG8_SA(b, h) (((b) * 2 + (h)) * HTB)
#define PG8_SB(b, h) ((4 + (b) * 2 + (h)) * HTB)
#define PG8_STAGE(bufoff, gbase, voff) do { _Pragma("unroll") for (int _i = 0; _i < 2; ++_i) \
        __builtin_amdgcn_global_load_lds((const unsigned*)((const char*)(gbase) + (voff)[_i]), (PG8_LAS unsigned*)(lds + (bufoff) + ldsw + _i * 8192), 16, 0, 0); } while (0)
#define PG8_LDA(dst, b, h) do { _Pragma("unroll") for (int m = 0; m < 4; ++m) _Pragma("unroll") for (int k = 0; k < 2; ++k) dst[m][k] = *(const PG8_LAS bf16x8*)(lds + PG8_SA(b, h) + aoff + m * 2048 + k * 1024); } while (0)
#define PG8_LDB(dst, b, h) do { _Pragma("unroll") for (int n = 0; n < 2; ++n) _Pragma("unroll") for (int k = 0; k < 2; ++k) dst[n][k] = *(const PG8_LAS bf16x8*)(lds + PG8_SB(b, h) + boff + n * 2048 + k * 1024); } while (0)
#define PG8_MMA(ai, bj, At, Bt) do { __builtin_amdgcn_s_setprio(1); _Pragma("unroll") for (int m = 0; m < 4; ++m) _Pragma("unroll") for (int n = 0; n < 2; ++n) _Pragma("unroll") for (int k = 0; k < 2; ++k) \
        acc[ai][bj][m][n] = __builtin_amdgcn_mfma_f32_16x16x32_bf16(Bt[n][k], At[m][k], acc[ai][bj][m][n], 0, 0, 0); __builtin_amdgcn_s_setprio(0); } while (0)
#define PG8_WAIT_V(n) asm volatile("s_waitcnt vmcnt(" #n ")" ::: "memory")
#define PG8_WAIT_L(n) asm volatile("s_waitcnt lgkmcnt(" #n ")" ::: "memory")
#define PG8_BAR __builtin_amdgcn_s_barrier()
#define PG8_SCHED __builtin_amdgcn_sched_barrier(0)
    Unit cur, nxt; int ui = 0;
    if (!S.next(0, cur)) return;
    f32x4 acc[2][2][4][2];
#pragma unroll
    for (int a = 0; a < 2; ++a)
#pragma unroll
        for (int b = 0; b < 2; ++b)
#pragma unroll
            for (int m = 0; m < 4; ++m)
#pragma unroll
                for (int n = 0; n < 2; ++n) acc[a][b][m][n] = (f32x4){0.f, 0.f, 0.f, 0.f};
    bf16x8 At[4][2], B0[2][2], B1[2][2];
    const char* cA = (const char*)g.A + (size_t)cur.pm * tstep; const char* cB = (const char*)g.Bt + (size_t)cur.pn * tstep;
    S.a_ready(cur);
    if constexpr (SP2) {
        PG8_STAGE(PG8_SB(0, 0), cB, voffB); PG8_STAGE(PG8_SB(0, 1), cB + hstep, voffB); PG8_STAGE(PG8_SA(0, 0), cA, voffA); PG8_STAGE(PG8_SA(0, 1), cA + hstep, voffA);
        if (wr == 1) PG8_BAR;
        PG8_WAIT_V(2); PG8_BAR;
        PG8_STAGE(PG8_SB(1, 0), cB + kstep, voffB); PG8_STAGE(PG8_SA(1, 0), cA + kstep, voffA); PG8_STAGE(PG8_SB(1, 1), cB + hstep + kstep, voffB);
        PG8_WAIT_V(6); PG8_BAR;
    } else {
        PG8_STAGE(PG8_SB(0, 0), cB, voffB); PG8_STAGE(PG8_SA(0, 0), cA, voffA); PG8_STAGE(PG8_SB(0, 1), cB + hstep, voffB); PG8_STAGE(PG8_SA(0, 1), cA + hstep, voffA);
        if (wr == 1) PG8_BAR;
        PG8_WAIT_V(4); PG8_BAR;
        PG8_STAGE(PG8_SB(1, 0), cB + kstep, voffB); PG8_STAGE(PG8_SA(1, 0), cA + kstep, voffA); PG8_STAGE(PG8_SB(1, 1), cB + hstep + kstep, voffB);
        PG8_WAIT_V(6); PG8_BAR;
    }
    for (;;) {
        const bool has_next = S.next(ui + 1, nxt);
        const char* nA = has_next ? (const char*)g.A + (size_t)nxt.pm * tstep : cA; const char* nB = has_next ? (const char*)g.Bt + (size_t)nxt.pn * tstep : cB;
        for (int t = 0; t < nt; t += 2) {
            const bool last = (t == nt - 2);
            const char* a1 = cA + (size_t)(t + 1) * kstep;
            const char* a2 = last ? nA : cA + (size_t)(t + 2) * kstep; const char* b2 = last ? nB : cB + (size_t)(t + 2) * kstep;
            const char* a3 = a2 + kstep; const char* b3 = b2 + kstep;
            if (last && has_next) S.a_ready(nxt);
            if constexpr (SP2) {
            PG8_LDB(B0, 0, 0); PG8_LDB(B1, 0, 1); PG8_SCHED; PG8_LDA(At, 0, 0); PG8_STAGE(PG8_SA(1, 1), a1 + hstep, voffA);
            PG8_WAIT_V(8); PG8_WAIT_L(0); PG8_BAR; PG8_MMA(0, 0, At, B0); PG8_MMA(0, 1, At, B1); PG8_BAR; PG8_SCHED;
            PG8_LDA(At, 0, 1); PG8_STAGE(PG8_SB(0, 0), b2, voffB); PG8_STAGE(PG8_SB(0, 1), b2 + hstep, voffB); PG8_STAGE(PG8_SA(0, 0), a2, voffA);
            PG8_WAIT_V(8); PG8_WAIT_L(0); PG8_BAR; PG8_MMA(1, 0, At, B0); PG8_MMA(1, 1, At, B1); PG8_BAR; PG8_SCHED;
            PG8_LDB(B0, 1, 0); PG8_LDB(B1, 1, 1); PG8_SCHED; PG8_LDA(At, 1, 0); PG8_STAGE(PG8_SA(0, 1), a2 + hstep, voffA);
            PG8_WAIT_V(8); PG8_WAIT_L(0); PG8_BAR; PG8_MMA(0, 0, At, B0); PG8_MMA(0, 1, At, B1); PG8_BAR; PG8_SCHED;
            PG8_LDA(At, 1, 1); PG8_STAGE(PG8_SB(1, 0), b3, voffB); PG8_STAGE(PG8_SB(1, 1), b3 + hstep, voffB); PG8_STAGE(PG8_SA(1, 0), a3, voffA);
            PG8_WAIT_V(8); PG8_WAIT_L(0); PG8_BAR; PG8_MMA(1, 0, At, B0); PG8_MMA(1, 1, At, B1); PG8_BAR; PG8_SCHED;
            } else {
            PG8_LDB(B0, 0, 0); PG8_SCHED; PG8_LDA(At, 0, 0); PG8_STAGE(PG8_SA(1, 1), a1 + hstep, voffA);
            PG8_WAIT_L(8); PG8_BAR; PG8_WAIT_L(0); PG8_MMA(0, 0, At, B0); PG8_BAR; PG8_SCHED;
            PG8_LDB(B1, 0, 1); PG8_STAGE(PG8_SB(0, 0), b2, voffB);
            PG8_BAR; PG8_WAIT_L(0); PG8_MMA(0, 1, At, B1); PG8_BAR;
            PG8_LDA(At, 0, 1); PG8_STAGE(PG8_SA(0, 0), a2, voffA);
            PG8_BAR; PG8_WAIT_L(0); PG8_MMA(1, 0, At, B0); PG8_BAR; PG8_SCHED;
            PG8_STAGE(PG8_SB(0, 1), b2 + hstep, voffB);
            PG8_WAIT_V(6); PG8_BAR; PG8_MMA(1, 1, At, B1); PG8_BAR;
            PG8_LDB(B0, 1, 0); PG8_SCHED; PG8_LDA(At, 1, 0); PG8_STAGE(PG8_SA(0, 1), a2 + hstep, voffA);
            PG8_WAIT_L(8); PG8_BAR; PG8_WAIT_L(0); PG8_MMA(0, 0, At, B0); PG8_BAR; PG8_SCHED;
            PG8_LDB(B1, 1, 1); PG8_STAGE(PG8_SB(1, 0), b3, voffB);
            PG8_BAR; PG8_WAIT_L(0); PG8_MMA(0, 1, At, B1); PG8_BAR;
            PG8_LDA(At, 1, 1); PG8_STAGE(PG8_SA(1, 0), a3, voffA);
            PG8_BAR; PG8_WAIT_L(0); PG8_MMA(1, 0, At, B0); PG8_BAR; PG8_SCHED;
            PG8_STAGE(PG8_SB(1, 1), b3 + hstep, voffB);
            PG8_WAIT_V(6); PG8_BAR; PG8_MMA(1, 1, At, B1); PG8_BAR;
            }
        }
        if constexpr (ALIGN_EPI) { if (wr == 0) PG8_BAR; }
        if constexpr (!Epi::AFTER_DRAIN) { E(acc, cur, wr, wc, fr, fq); S.done(cur); }
        if (!has_next) break;
        if (!Epi::keeps(cur)) {
#pragma unroll
        for (int a = 0; a < 2; ++a)
#pragma unroll
            for (int b = 0; b < 2; ++b)
#pragma unroll
                for (int m = 0; m < 4; ++m)
#pragma unroll
                    for (int n = 0; n < 2; ++n) acc[a][b][m][n] = (f32x4){0.f, 0.f, 0.f, 0.f};
        }
        cur = nxt; cA = nA; cB = nB; ++ui;
        if constexpr (ALIGN_EPI) { if (wr == 1) PG8_BAR; }
    }
    PG8_WAIT_V(0);
    if constexpr (!ALIGN_EPI) { if (wr == 0) PG8_BAR; }
    PG8_BAR;
    if constexpr (Epi::AFTER_DRAIN) { E.fused(acc, cur, wr, wc, fr, fq, lds, wid, lane); S.done(cur); }
#undef PG8_SA
#undef PG8_SB
#undef PG8_STAGE
#undef PG8_LDA
#undef PG8_LDB
#undef PG8_MMA
#undef PG8_WAIT_V
#undef PG8_WAIT_L
#undef PG8_BAR
#undef PG8_SCHED
}
}

#define LAS __attribute__((address_space(3)))
typedef unsigned short bf16_t;
typedef short bf16x8 __attribute__((ext_vector_type(8)));
typedef float f32x4 __attribute__((ext_vector_type(4)));
typedef float f32x2 __attribute__((ext_vector_type(2)));
typedef float f32x16 __attribute__((ext_vector_type(16)));
typedef unsigned u32x4 __attribute__((ext_vector_type(4)));
typedef unsigned u32x2 __attribute__((ext_vector_type(2)));
using pg8::pk2; using pg8::bflo; using pg8::bfhi; using pg8::sigm;

constexpr int NB = 32, SEQ = 2048, DM = 1024, DEPTH = 2, INW = 7440, NINP = 7680, LDU = 7424, FF = 4096;
constexpr int NG = 2, BG = NB / NG, MG = BG * SEQ;
constexpr float LOG2E = 1.4426950408889634f, EPS = 1e-6f;
constexpr int NWAVES = 8, NTHR = 512;
constexpr int LDS_BYTES = 131072 + 1024;

constexpr int UC_FQ = 0, UC_FK = 512, UC_FV = 1024, UC_SQ = 1536, UC_SK = 2048, UC_SV = 2176, UC_MQ = 2304, UC_MK = 2816, UC_MV = 3328, UC_MO = 3840, UC_G = 4352;

constexpr size_t al(size_t x) { return (x + 255) & ~(size_t)255; }
constexpr size_t O_WIN = 0;
constexpr size_t O_WB = O_WIN + al((size_t)DEPTH * NINP * DM * 2);
constexpr size_t O_WOUT = O_WB + al((size_t)DEPTH * 3 * DM * 512 * 2);
constexpr size_t O_WUP = O_WOUT + al((size_t)DEPTH * DM * DM * 2);
constexpr size_t O_WDN = O_WUP + al((size_t)DEPTH * FF * DM * 2);
constexpr size_t O_ROPE = O_WDN + al((size_t)DEPTH * DM * FF * 2);
constexpr size_t O_PAR = O_ROPE + al((size_t)SEQ * 32 * 2 * 4);
constexpr int PAR_FFB = 0, PAR_FQN = 16, PAR_FKN = 144, PAR_SQN = 272, PAR_SKN = 400, PAR_SINK = 528, PAR_CW = 544, PAR_CB = 8736, PAR_IB = 10784, PAR_FB = 10792, PAR_ON = 10800, PAR_N = 11824;
constexpr size_t O_XB = O_PAR + al((size_t)PAR_N * 4);
constexpr size_t O_RS = O_XB + al((size_t)MG * DM * 2);
constexpr size_t O_U = O_RS + al((size_t)MG * 16 * 4);
constexpr size_t O_SG = O_U + al((size_t)MG * LDU * 2);
constexpr size_t O_FC = O_SG + al((size_t)MG * 16 * 4);
constexpr size_t O_MP = O_FC + al((size_t)BG * 8 * SEQ * 4);
constexpr size_t O_ME = O_MP + al((size_t)BG * 4 * SEQ * 4);
constexpr size_t O_MBT = O_ME + al((size_t)BG * 4 * SEQ * 4);
constexpr size_t O_MCH = O_MBT + al((size_t)BG * 4 * SEQ * 4);
constexpr size_t O_FQN = O_MCH + al((size_t)BG * 4 * 16 * 4 * 4);
constexpr size_t O_FKN = O_FQN + (size_t)MG * 512 * 2;
constexpr size_t O_FVT = O_FKN + (size_t)MG * 512 * 2;
constexpr size_t O_SQR = O_FVT + (size_t)MG * 512 * 2;
constexpr size_t O_TMP = O_FQN;
constexpr size_t O_SKR = O_SQR + (size_t)MG * 512 * 2;
constexpr size_t O_SVT = O_SKR + (size_t)MG * 128 * 2;
constexpr size_t O_MQC = O_SVT + (size_t)MG * 128 * 2;
constexpr size_t O_MKC = O_MQC + (size_t)MG * 512 * 2;
constexpr size_t O_MRG = O_MQC;
constexpr size_t O_KT = O_MKC + (size_t)MG * 512 * 2;
constexpr size_t O_MVT = O_KT + (size_t)MG * 512 * 2;
constexpr size_t O_DN = O_MVT + (size_t)MG * 512 * 2;
constexpr size_t O_CT = O_KT;
constexpr size_t O_NN = O_DN + al((size_t)BG * 4 * 16 * 128 * 4);
constexpr size_t O_Y = O_NN + al((size_t)BG * 4 * 16 * 128 * 4);
constexpr size_t O_DCT = O_Y + (size_t)2 * MG * 512 * 2;
constexpr size_t O_BAR = O_Y + (size_t)3 * MG * 512 * 2;
constexpr size_t WS_NEED = O_BAR + 16384;
static_assert((size_t)BG * 4 * 16 * 16384 * 2 == (size_t)MG * 512 * 2, "DCT overlays Y2; CT overlays KT");
static_assert((size_t)MG * FF * 2 <= (size_t)MG * LDU * 2, "ACT overlays U");

struct KP { const float* in[19]; float* out; unsigned char* ws; int ph_lo, ph_hi; };

__device__ __forceinline__ float wave_sum(float v) {
#pragma unroll
    for (int o = 1; o < 64; o <<= 1) v += __shfl_xor(v, o);
    return v;
}
__device__ __forceinline__ float logsig(float x) { return fminf(x, 0.f) - log1pf(__expf(-fabsf(x))); }
#define LDSW() asm volatile("s_waitcnt lgkmcnt(0)" ::: "memory")

__device__ __forceinline__ int win_srccol(int n) {
    if (n < 1536) return n; if (n < 3840) return n + 8; if (n < 7424) return n + 16; if (n < 7432) return n - 7424 + 1536; if (n < 7440) return n - 7432 + 3848; return -1;
}
template <bool REMAP>
__device__ __forceinline__ void tr_item(const float* W, int K, int N, const float* kscale, bf16_t* WT, int item, int nblk, LAS float* scr, int lane) {
    const int kb = item / nblk, nb = item % nblk, k0 = 64 * kb, n0 = 32 * nb;
    const int nd = n0 + (lane & 31); const int ns = REMAP ? win_srccol(nd) : nd;
#pragma unroll 8
    for (int i = 0; i < 32; ++i) { const int kk = 2 * i + (lane >> 5); float v = 0.f; if (ns >= 0) v = W[(size_t)(k0 + kk) * N + ns]; if (kscale) v *= kscale[k0 + kk]; scr[kk * 33 + (lane & 31)] = v; }
    LDSW();
    const int c = lane & 7;
#pragma unroll
    for (int j = 0; j < 4; ++j) { const int n = (lane >> 3) + 8 * j; const LAS float* s = scr + (8 * c) * 33 + n;
        u32x4 o; o.x = pk2(s[0 * 33], s[1 * 33]); o.y = pk2(s[2 * 33], s[3 * 33]); o.z = pk2(s[4 * 33], s[5 * 33]); o.w = pk2(s[6 * 33], s[7 * 33]);
        *(u32x4*)(WT + (size_t)(n0 + n) * K + k0 + 8 * c) = o; }
    LDSW();
}
__device__ __forceinline__ void phase_p0(const KP& p, unsigned char* ws, LAS unsigned char* lds, int gw, int NWV, int wave, int lane) {
    LAS float* scr = (LAS float*)(lds + wave * 16384);
    const float *norm_mix = p.in[1], *w_in = p.in[2], *w_branch = p.in[14], *w_out = p.in[15], *norm_mlp = p.in[16], *w_up = p.in[17], *w_down = p.in[18];
    constexpr int PER = 3840 + 768 + 512 + 2048 + 2048;
    for (int it = gw; it < DEPTH * PER; it += NWV) {
        const int l = it / PER; int r = it % PER;
        if (r < 3840) { tr_item<true>(w_in + (size_t)l * DM * INW, DM, INW, norm_mix + l * DM, (bf16_t*)(ws + O_WIN) + (size_t)l * NINP * DM, r, 240, scr, lane); continue; } r -= 3840;
        if (r < 768) { const int b = r / 256; tr_item<false>(w_branch + (size_t)(l * 3 + b) * 512 * DM, 512, DM, nullptr, (bf16_t*)(ws + O_WB) + (size_t)(l * 3 + b) * DM * 512, r % 256, 32, scr, lane); continue; } r -= 768;
        if (r < 512) { tr_item<false>(w_out + (size_t)l * DM * DM, DM, DM, nullptr, (bf16_t*)(ws + O_WOUT) + (size_t)l * DM * DM, r, 32, scr, lane); continue; } r -= 512;
        if (r < 2048) { tr_item<false>(w_up + (size_t)l * DM * FF, DM, FF, norm_mlp + l * DM, (bf16_t*)(ws + O_WUP) + (size_t)l * FF * DM, r, 128, scr, lane); continue; } r -= 2048;
        tr_item<false>(w_down + (size_t)l * FF * DM, FF, DM, nullptr, (bf16_t*)(ws + O_WDN) + (size_t)l * DM * FF, r, 32, scr, lane);
    }
    { float* par = (float*)(ws + O_PAR); const int t0 = gw * 64 + lane, ts = NWV * 64;
      for (int e = t0; e < 16; e += ts) { par[PAR_FFB + e] = p.in[3][e]; par[PAR_SINK + e] = p.in[8][e]; }
      for (int e = t0; e < 128; e += ts) { par[PAR_FQN + e] = p.in[4][e]; par[PAR_FKN + e] = p.in[5][e]; par[PAR_SQN + e] = p.in[6][e]; par[PAR_SKN + e] = p.in[7][e]; }
      for (int e = t0; e < 8192; e += ts) par[PAR_CW + e] = p.in[9][e];
      for (int e = t0; e < 2048; e += ts) par[PAR_CB + e] = p.in[10][e];
      for (int e = t0; e < 8; e += ts) { par[PAR_IB + e] = p.in[11][e]; par[PAR_FB + e] = p.in[12][e]; }
      for (int e = t0; e < 1024; e += ts) par[PAR_ON + e] = p.in[13][e]; }
    float* rope = (float*)(ws + O_ROPE);
    for (int e = gw * 64 + lane; e < SEQ * 32; e += NWV * 64) {
        const int pos = e >> 5, i = e & 31;
        const float inv = powf(10000.f, -(float)(2 * i) / 64.f), ang = (float)pos * inv;
        rope[2 * e] = cosf(ang); rope[2 * e + 1] = sinf(ang);
    }
}
__device__ __forceinline__ void phase_x0(const float* x, bf16_t* XB, float* RS, int gw, int NWV, int lane) {
    for (int row = gw; row < MG; row += NWV) {
        const f32x4* xr = (const f32x4*)(x + (size_t)row * DM) + lane;
        f32x4 v[4]; float s = 0.f;
#pragma unroll
        for (int j = 0; j < 4; ++j) { v[j] = xr[64 * j]; s += (v[j][0] * v[j][0] + v[j][1] * v[j][1]) + (v[j][2] * v[j][2] + v[j][3] * v[j][3]); }
        s = wave_sum(s);
        u32x2* o = (u32x2*)(XB + (size_t)row * DM) + lane;
#pragma unroll
        for (int j = 0; j < 4; ++j) { u32x2 w; w.x = pk2(v[j][0], v[j][1]); w.y = pk2(v[j][2], v[j][3]); o[64 * j] = w; }
        if (lane < 16) RS[(size_t)row * 16 + lane] = (lane == 0) ? s : 0.f;
    }
}
__device__ __forceinline__ void gate_scan_item(unsigned char* ws, int l, int it, int lane) {
    const float* par = (const float*)(ws + O_PAR); const float* SG = (const float*)(ws + O_SG);
    if (it < BG * 8) {
        const int b = it >> 3, h = it & 7; const float bias = par[PAR_FFB + l * 8 + h];
        const float* src = SG + ((size_t)b * SEQ + lane * 32) * 16 + h;
        float tot = 0.f;
#pragma unroll 4
        for (int j = 0; j < 32; ++j) tot += logsig(src[j * 16] + bias);
        float x = tot;
#pragma unroll
        for (int o = 1; o < 64; o <<= 1) { const float y = __shfl_up(x, o); if (lane >= o) x += y; }
        float run = x - tot;
        float* dst = (float*)(ws + O_FC) + (size_t)it * SEQ + lane * 32;
#pragma unroll 4
        for (int j = 0; j < 32; ++j) { run += logsig(src[j * 16] + bias); dst[j] = run * LOG2E; }
    } else {
        const int sq = it - BG * 8, b = sq >> 2, h = sq & 3;
        const float ibias = par[PAR_IB + l * 4 + h], fbias = par[PAR_FB + l * 4 + h];
        float* MP = (float*)(ws + O_MP) + (size_t)sq * SEQ; float* ME = (float*)(ws + O_ME) + (size_t)sq * SEQ; float* MBT = (float*)(ws + O_MBT) + (size_t)sq * SEQ;
        float* MCH = (float*)(ws + O_MCH) + (size_t)sq * 64;
        float mc = 0.f;
#pragma unroll 1
        for (int c = 0; c < 16; ++c) {
            const float* s0 = SG + ((size_t)b * SEQ + c * 128 + 2 * lane) * 16;
            const float f0 = logsig(s0[12 + h] + fbias), f1 = logsig(s0[16 + 12 + h] + fbias);
            const float i0 = s0[8 + h] + ibias, i1 = s0[16 + 8 + h] + ibias;
            float x = f0 + f1;
#pragma unroll
            for (int o = 1; o < 64; o <<= 1) { const float y = __shfl_up(x, o); if (lane >= o) x += y; }
            const float b1 = x, b0 = x - f1;
            const float p0 = i0 - b0, p1 = i1 - b1;
            float mxs = fmaxf(p0, p1);
#pragma unroll
            for (int o = 1; o < 64; o <<= 1) { const float y = __shfl_up(mxs, o); if (lane >= o) mxs = fmaxf(mxs, y); }
            float prev = __shfl_up(mxs, 1); if (lane == 0) prev = -INFINITY;
            const float u0 = fmaxf(prev, p0), u1 = mxs;
            const float e0 = fmaxf(mc, u0), e1 = fmaxf(mc, u1);
            const int t = c * 128 + 2 * lane;
            *(f32x2*)(MP + t) = (f32x2){p0, p1}; *(f32x2*)(ME + t) = (f32x2){e0, e1}; *(f32x2*)(MBT + t) = (f32x2){b0, b1};
            const float ulast = __shfl(mxs, 63), bL = __shfl(x, 63);
            const float mx = fmaxf(mc, ulast), dec = __expf(mc - mx);
            if (lane == 0) *(f32x4*)(MCH + c * 4) = (f32x4){mc, mx, dec, bL};
            mc = bL + mx;
        }
    }
}
__device__ __forceinline__ void headnorm_item(unsigned char* ws, int l, int kind, int item, int lane) {
    const float* par = (const float*)(ws + O_PAR);
    const int c = lane & 7;
    int srccol, dpitch, tstep, tok0, tsub; bf16_t* dbase; const float* w; float scale;
    if (kind == 0) { srccol = UC_FQ + lane * 8; dbase = (bf16_t*)(ws + O_FQN) + lane * 8; dpitch = 512; w = par + PAR_FQN + l * 64; scale = 0.125f * LOG2E; tstep = 1; tok0 = item * 8; tsub = 0; }
    else if (kind == 1) { srccol = UC_FK + lane * 8; dbase = (bf16_t*)(ws + O_FKN) + lane * 8; dpitch = 512; w = par + PAR_FKN + l * 64; scale = 1.f; tstep = 1; tok0 = item * 8; tsub = 0; }
    else if (kind == 2) { srccol = UC_SQ + lane * 8; dbase = (bf16_t*)(ws + O_SQR) + lane * 8; dpitch = 512; w = par + PAR_SQN + l * 64; scale = 0.125f * LOG2E; tstep = 1; tok0 = item * 8; tsub = 0; }
    else { srccol = UC_SK + (lane & 15) * 8; dbase = (bf16_t*)(ws + O_SKR) + (lane & 15) * 8; dpitch = 128; w = par + PAR_SKN + l * 64; scale = 1.f; tstep = 4; tok0 = item * 32; tsub = lane >> 4; }
    const bool rp = kind >= 2;
    const f32x4 w0 = *(const f32x4*)(w + 8 * c), w1 = *(const f32x4*)(w + 8 * c + 4);
    const bf16_t* src = (const bf16_t*)(ws + O_U) + (size_t)(tok0 + tsub) * LDU + srccol;
    u32x4 xv[8];
#pragma unroll
    for (int i = 0; i < 8; ++i) xv[i] = *(const u32x4*)(src + (size_t)(i * tstep) * LDU);
#pragma unroll
    for (int i = 0; i < 8; ++i) {
        const int tok = tok0 + tsub + i * tstep;
        float x[8] = {bflo(xv[i].x), bfhi(xv[i].x), bflo(xv[i].y), bfhi(xv[i].y), bflo(xv[i].z), bfhi(xv[i].z), bflo(xv[i].w), bfhi(xv[i].w)};
        float ss = ((x[0] * x[0] + x[1] * x[1]) + (x[2] * x[2] + x[3] * x[3])) + ((x[4] * x[4] + x[5] * x[5]) + (x[6] * x[6] + x[7] * x[7]));
        ss += __shfl_xor(ss, 1); ss += __shfl_xor(ss, 2); ss += __shfl_xor(ss, 4);
        const float rn = rsqrtf(ss * (1.f / 64.f) + EPS);
        x[0] *= rn * w0[0]; x[1] *= rn * w0[1]; x[2] *= rn * w0[2]; x[3] *= rn * w0[3]; x[4] *= rn * w1[0]; x[5] *= rn * w1[1]; x[6] *= rn * w1[2]; x[7] *= rn * w1[3];
        if (rp) {
            const float* rt = (const float*)(ws + O_ROPE) + ((size_t)(tok % SEQ) * 32 + 8 * (c & 3)) * 2;
            const bool second = (c & 4) != 0;
#pragma unroll
            for (int e = 0; e < 8; e += 2) { const f32x4 cs = *(const f32x4*)(rt + 2 * e);
                const float o0 = __shfl_xor(x[e], 4), o1 = __shfl_xor(x[e + 1], 4);
                x[e] = second ? (o0 * cs[1] + x[e] * cs[0]) : (x[e] * cs[0] - o0 * cs[1]);
                x[e + 1] = second ? (o1 * cs[3] + x[e + 1] * cs[2]) : (x[e + 1] * cs[2] - o1 * cs[3]); }
        }
        u32x4 o; o.x = pk2(x[0] * scale, x[1] * scale); o.y = pk2(x[2] * scale, x[3] * scale); o.z = pk2(x[4] * scale, x[5] * scale); o.w = pk2(x[6] * scale, x[7] * scale);
        *(u32x4*)(dbase + (size_t)tok * dpitch) = o;
    }
}
__device__ __forceinline__ void stream_item(unsigned char* ws, int l, int item, int lane) {
    const int cb = item % 34, tb = item / 34, tok0 = tb * 64, b = tok0 / SEQ, s0 = tok0 % SEQ;
    const int tg = lane >> 3, co = lane & 7;
    const bf16_t* U = (const bf16_t*)(ws + O_U);
    int srccol, chan; bf16_t* dT = nullptr; bf16_t* dN = nullptr; int convch = -1; float oscale = 1.f;
    if (cb < 8) { chan = cb * 64 + co * 8; srccol = UC_FV + chan; dT = (bf16_t*)(ws + O_FVT) + ((size_t)b * 512 + chan) * SEQ; }
    else if (cb < 10) { chan = (cb - 8) * 64 + co * 8; srccol = UC_SV + chan; dT = (bf16_t*)(ws + O_SVT) + ((size_t)b * 128 + chan) * SEQ; }
    else if (cb < 18) { chan = (cb - 10) * 64 + co * 8; srccol = UC_MV + chan; dT = (bf16_t*)(ws + O_MVT) + ((size_t)b * 512 + chan) * SEQ; }
    else if (cb < 26) { chan = (cb - 18) * 64 + co * 8; srccol = UC_MQ + chan; dN = (bf16_t*)(ws + O_MQC) + chan; convch = chan; }
    else { chan = (cb - 26) * 64 + co * 8; srccol = UC_MK + chan; dN = (bf16_t*)(ws + O_MKC) + chan; dT = (bf16_t*)(ws + O_KT) + ((size_t)b * 512 + chan) * SEQ; convch = 512 + chan; oscale = 0.08838834764831845f; }
    const bf16_t* src = U + (size_t)(tok0 + tg * 8) * LDU + srccol;
    u32x4 R[8];
#pragma unroll
    for (int i = 0; i < 8; ++i) R[i] = *(const u32x4*)(src + (size_t)i * LDU);
    if (cb >= 18) {
        u32x4 H[3];
        const bool has_prev = (s0 + tg * 8) > 0;
#pragma unroll
        for (int i = 0; i < 3; ++i) { H[i] = (u32x4){0u, 0u, 0u, 0u}; if (has_prev) H[i] = *(const u32x4*)(src - (size_t)(3 - i) * LDU); }
        const float* cw = (const float*)(ws + O_PAR) + PAR_CW + l * 4 * 1024 + convch; const float* cbias = (const float*)(ws + O_PAR) + PAR_CB + l * 1024 + convch;
        float wt[4][8], bb[8];
#pragma unroll
        for (int j = 0; j < 4; ++j) { const f32x4 a = *(const f32x4*)(cw + j * 1024), c2 = *(const f32x4*)(cw + j * 1024 + 4);
            wt[j][0] = a[0]; wt[j][1] = a[1]; wt[j][2] = a[2]; wt[j][3] = a[3]; wt[j][4] = c2[0]; wt[j][5] = c2[1]; wt[j][6] = c2[2]; wt[j][7] = c2[3]; }
        { const f32x4 a = *(const f32x4*)cbias, c2 = *(const f32x4*)(cbias + 4); bb[0] = a[0]; bb[1] = a[1]; bb[2] = a[2]; bb[3] = a[3]; bb[4] = c2[0]; bb[5] = c2[1]; bb[6] = c2[2]; bb[7] = c2[3]; }
        float xm3[8], xm2[8], xm1[8];
#define UNPK(dst, v) do { dst[0] = bflo(v.x); dst[1] = bfhi(v.x); dst[2] = bflo(v.y); dst[3] = bfhi(v.y); dst[4] = bflo(v.z); dst[5] = bfhi(v.z); dst[6] = bflo(v.w); dst[7] = bfhi(v.w); } while (0)
        UNPK(xm3, H[0]); UNPK(xm2, H[1]); UNPK(xm1, H[2]);
#pragma unroll
        for (int i = 0; i < 8; ++i) {
            float xc[8], y[8]; UNPK(xc, R[i]);
#pragma unroll
            for (int e = 0; e < 8; ++e) { const float v = bb[e] + wt[0][e] * xm3[e] + wt[1][e] * xm2[e] + wt[2][e] * xm1[e] + wt[3][e] * xc[e]; y[e] = v * sigm(v) * oscale; xm3[e] = xm2[e]; xm2[e] = xm1[e]; xm1[e] = xc[e]; }
            u32x4 o; o.x = pk2(y[0], y[1]); o.y = pk2(y[2], y[3]); o.z = pk2(y[4], y[5]); o.w = pk2(y[6], y[7]);
            R[i] = o;
            *(u32x4*)(dN + (size_t)(tok0 + tg * 8 + i) * 512) = o;
        }
#undef UNPK
    }
    if (dT) {
        bf16_t* dst = dT + s0 + tg * 8;
#pragma unroll
        for (int k = 0; k < 4; ++k) {
            u32x4 lo, hi;
            lo.x = (R[0][k] & 0xffffu) | (R[1][k] << 16); lo.y = (R[2][k] & 0xffffu) | (R[3][k] << 16); lo.z = (R[4][k] & 0xffffu) | (R[5][k] << 16); lo.w = (R[6][k] & 0xffffu) | (R[7][k] << 16);
            hi.x = (R[0][k] >> 16) | (R[1][k] & 0xffff0000u); hi.y = (R[2][k] >> 16) | (R[3][k] & 0xffff0000u); hi.z = (R[4][k] >> 16) | (R[5][k] & 0xffff0000u); hi.w = (R[6][k] >> 16) | (R[7][k] & 0xffff0000u);
            *(u32x4*)(dst + (size_t)(2 * k) * SEQ) = lo; *(u32x4*)(dst + (size_t)(2 * k + 1) * SEQ) = hi;
        }
    }
}
#define MFMA32(a, b, c) __builtin_amdgcn_mfma_f32_32x32x16_bf16((a), (b), (c), 0, 0, 0)
template <bool SWA>
__device__ __forceinline__ void attn_qtile(const bf16_t* __restrict__ Q, const bf16_t* __restrict__ K, int kpitch, const bf16_t* __restrict__ VT,
                                           const float* __restrict__ C, float sink2, bf16_t* __restrict__ Y, int qt, int lane) {
    const int r = lane & 31, hh = lane >> 5;
    const int pr = ((r >> 2) & 1) * 16 + ((r >> 4) & 1) * 8 + ((r >> 3) & 1) * 4 + (r & 3);
    const int q0 = qt * 32;
    bf16x8 qf[4];
#pragma unroll
    for (int st = 0; st < 4; ++st) qf[st] = *(const bf16x8*)(Q + (size_t)(q0 + r) * 512 + 16 * st + 8 * hh);
    float cq = 0.f; if (!SWA) cq = C[q0 + r];
    float m = -1e30f, lsum = 0.f;
    f32x16 o0, o1;
#pragma unroll
    for (int i = 0; i < 16; ++i) { o0[i] = 0.f; o1[i] = 0.f; }
    const int kt_lo = SWA ? (qt > 4 ? qt - 4 : 0) : 0;
#define ATT_LOAD(KF, VF, CK, kt_) do { const int k0_ = (kt_) * 32; \
        _Pragma("unroll") for (int st = 0; st < 4; ++st) KF[st] = *(const bf16x8*)(K + (size_t)(k0_ + pr) * kpitch + 16 * st + 8 * hh); \
        _Pragma("unroll") for (int dh = 0; dh < 2; ++dh) _Pragma("unroll") for (int s2 = 0; s2 < 2; ++s2) VF[dh][s2] = *(const bf16x8*)(VT + (size_t)(dh * 32 + r) * SEQ + k0_ + 16 * hh + 8 * s2); \
        if (!SWA) { _Pragma("unroll") for (int g = 0; g < 4; ++g) CK[g] = *(const f32x4*)(C + k0_ + 16 * hh + 4 * g); } } while (0)
    bf16x8 kfn[4], vfn[2][2]; f32x4 ckn[4];
#pragma unroll
    for (int g = 0; g < 4; ++g) ckn[g] = (f32x4){0.f, 0.f, 0.f, 0.f};
    ATT_LOAD(kfn, vfn, ckn, kt_lo);
    for (int kt = kt_lo; kt <= qt; ++kt) {
        bf16x8 kf[4], vf[2][2]; f32x4 ckc[4];
#pragma unroll
        for (int st = 0; st < 4; ++st) kf[st] = kfn[st];
#pragma unroll
        for (int dh = 0; dh < 2; ++dh) { vf[dh][0] = vfn[dh][0]; vf[dh][1] = vfn[dh][1]; }
#pragma unroll
        for (int g = 0; g < 4; ++g) ckc[g] = ckn[g];
        if (kt < qt) ATT_LOAD(kfn, vfn, ckn, kt + 1);
        f32x16 sc;
#pragma unroll
        for (int i = 0; i < 16; ++i) sc[i] = 0.f;
#pragma unroll
        for (int st = 0; st < 4; ++st) sc = MFMA32(kf[st], qf[st], sc);
        if (!SWA) {
#pragma unroll
            for (int g = 0; g < 4; ++g) { const f32x4 ck = ckc[g];
#pragma unroll
                for (int e = 0; e < 4; ++e) sc[4 * g + e] += cq - ck[e]; }
        }
        if (kt == qt) {
#pragma unroll
            for (int i = 0; i < 16; ++i) if (16 * hh + i > r) sc[i] = -INFINITY;
        }
        if (SWA && kt == qt - 4) {
#pragma unroll
            for (int i = 0; i < 16; ++i) if (16 * hh + i <= r) sc[i] = -INFINITY;
        }
        float tm = sc[0];
#pragma unroll
        for (int i = 1; i < 16; ++i) tm = fmaxf(tm, sc[i]);
        tm = fmaxf(tm, __shfl_xor(tm, 32));
        const float mn = fmaxf(m, tm), alpha = __builtin_amdgcn_exp2f(m - mn);
        m = mn;
        float ps = 0.f;
#pragma unroll
        for (int i = 0; i < 16; ++i) { sc[i] = __builtin_amdgcn_exp2f(sc[i] - mn); ps += sc[i]; }
        lsum = lsum * alpha + ps;
#pragma unroll
        for (int i = 0; i < 16; ++i) { o0[i] *= alpha; o1[i] *= alpha; }
        u32x4 pw0, pw1;
        pw0.x = pk2(sc[0], sc[1]); pw0.y = pk2(sc[2], sc[3]); pw0.z = pk2(sc[4], sc[5]); pw0.w = pk2(sc[6], sc[7]);
        pw1.x = pk2(sc[8], sc[9]); pw1.y = pk2(sc[10], sc[11]); pw1.z = pk2(sc[12], sc[13]); pw1.w = pk2(sc[14], sc[15]);
        const bf16x8 pf0 = __builtin_bit_cast(bf16x8, pw0), pf1 = __builtin_bit_cast(bf16x8, pw1);
        o0 = MFMA32(vf[0][0], pf0, o0); o0 = MFMA32(vf[0][1], pf1, o0);
        o1 = MFMA32(vf[1][0], pf0, o1); o1 = MFMA32(vf[1][1], pf1, o1);
    }
    float lt = lsum + __shfl_xor(lsum, 32);
    if (SWA) lt += __builtin_amdgcn_exp2f(sink2 - m);
    const float inv = 1.f / lt;
    bf16_t* yrow = Y + (size_t)(q0 + r) * 512 + 4 * hh;
#pragma unroll
    for (int g = 0; g < 4; ++g) {
        u32x2 a, c;
        a.x = pk2(o0[4 * g] * inv, o0[4 * g + 1] * inv); a.y = pk2(o0[4 * g + 2] * inv, o0[4 * g + 3] * inv);
        c.x = pk2(o1[4 * g] * inv, o1[4 * g + 1] * inv); c.y = pk2(o1[4 * g + 2] * inv, o1[4 * g + 3] * inv);
        *(u32x2*)(yrow + 8 * g) = a; *(u32x2*)(yrow + 32 + 8 * g) = c;
    }
}
constexpr int AT_SLOT = 10240, AT_K = 0, AT_V = 4608, AT_C = 9728;
__device__ __forceinline__ float xmax32(float v) { auto rr = __builtin_amdgcn_permlane32_swap(__float_as_uint(v), __float_as_uint(v), false, false); return fmaxf(__uint_as_float(rr[0]), __uint_as_float(rr[1])); }
template <bool SWA>
__device__ __forceinline__ void attn_compute(const LAS unsigned char* sl, const bf16x8 (&qf)[4], float cq, float& m, float& lsum, f32x16& o0, f32x16& o1,
                                             bool diag, bool wedge, int pr, int r, int hh) {
    bf16x8 kf[4], vf[2][2]; f32x4 ckv[4];
#pragma unroll
    for (int st = 0; st < 4; ++st) kf[st] = *(const LAS bf16x8*)(sl + AT_K + pr * 144 + 32 * st + 16 * hh);
    if (!SWA) {
#pragma unroll
        for (int g = 0; g < 4; ++g) ckv[g] = *(const LAS f32x4*)(sl + AT_C + 64 * hh + 16 * g);
    }
#pragma unroll
    for (int dh = 0; dh < 2; ++dh)
#pragma unroll
        for (int s = 0; s < 2; ++s) vf[dh][s] = *(const LAS bf16x8*)(sl + AT_V + (dh * 32 + r) * 80 + 32 * hh + 16 * s);
    __builtin_amdgcn_sched_barrier(0);
    f32x16 sc;
#pragma unroll
    for (int i = 0; i < 16; ++i) sc[i] = 0.f;
#pragma unroll
    for (int st = 0; st < 4; ++st) sc = MFMA32(kf[st], qf[st], sc);
    if (!SWA) {
#pragma unroll
        for (int g = 0; g < 4; ++g)
#pragma unroll
            for (int e = 0; e < 4; ++e) sc[4 * g + e] += cq - ckv[g][e];
    }
    if (diag) {
#pragma unroll
        for (int i = 0; i < 16; ++i) if (16 * hh + i > r) sc[i] = -INFINITY;
    }
    if (SWA && wedge) {
#pragma unroll
        for (int i = 0; i < 16; ++i) if (16 * hh + i <= r) sc[i] = -INFINITY;
    }
    float tm = sc[0];
#pragma unroll
    for (int i = 1; i < 16; ++i) tm = fmaxf(tm, sc[i]);
    tm = xmax32(tm);
    if (__any(tm > m)) {
        const float mn = fmaxf(m, tm), alpha = __builtin_amdgcn_exp2f(m - mn);
        m = mn; lsum *= alpha;
#pragma unroll
        for (int i = 0; i < 16; ++i) { o0[i] *= alpha; o1[i] *= alpha; }
    }
    float ps = 0.f;
#pragma unroll
    for (int i = 0; i < 16; ++i) { sc[i] = __builtin_amdgcn_exp2f(sc[i] - m); ps += sc[i]; }
    lsum += ps;
    u32x4 pw0, pw1;
    pw0.x = pk2(sc[0], sc[1]); pw0.y = pk2(sc[2], sc[3]); pw0.z = pk2(sc[4], sc[5]); pw0.w = pk2(sc[6], sc[7]);
    pw1.x = pk2(sc[8], sc[9]); pw1.y = pk2(sc[10], sc[11]); pw1.z = pk2(sc[12], sc[13]); pw1.w = pk2(sc[14], sc[15]);
    const bf16x8 pf0 = __builtin_bit_cast(bf16x8, pw0), pf1 = __builtin_bit_cast(bf16x8, pw1);
    o0 = MFMA32(vf[0][0], pf0, o0); o0 = MFMA32(vf[0][1], pf1, o0);
    o1 = MFMA32(vf[1][0], pf0, o1); o1 = MFMA32(vf[1][1], pf1, o1);
}
template <bool SWA>
__device__ __forceinline__ void attn_block(LAS unsigned char* lds, const bf16_t* __restrict__ Q, const bf16_t* __restrict__ K, int kpitch, const bf16_t* __restrict__ VT,
                                           const float* __restrict__ C, float sink2, bf16_t* __restrict__ Y, int qt, int t_lo, int t_hi, int wave, int lane) {
    const int r = lane & 31, hh = lane >> 5;
    const int pr = ((r >> 2) & 1) * 16 + ((r >> 4) & 1) * 8 + ((r >> 3) & 1) * 4 + (r & 3);
    const int q0 = qt * 32;
    const bool isK = wave < 4; const int chunk = (wave & 3) * 64 + lane;
    const bf16_t* gsrc = isK ? K + (size_t)(chunk >> 3) * kpitch + (chunk & 7) * 8 : VT + (size_t)(chunk >> 2) * SEQ + (chunk & 3) * 8;
    const int gstep = isK ? 32 * kpitch : 32;
    const int ldst = isK ? AT_K + (chunk >> 3) * 144 + (chunk & 7) * 16 : AT_V + (chunk >> 2) * 80 + (chunk & 3) * 16;
    const bool doC = !SWA && wave == 0 && lane < 8;
#define AB_LD(t_) (*(const u32x4*)(gsrc + (size_t)((t_) < t_hi ? (t_) : t_hi) * gstep))
#define AB_LDC(t_) (*(const u32x4*)(C + ((t_) < t_hi ? (t_) : t_hi) * 32 + lane * 4))
#define AB_WR(slot_, v_, c_) do { LAS unsigned char* sl_ = lds + (slot_) * AT_SLOT; *(LAS u32x4*)(sl_ + ldst) = (v_); if (doC) *(LAS u32x4*)(sl_ + AT_C + lane * 16) = (c_); } while (0)
    u32x4 R0 = AB_LD(t_lo), R1 = AB_LD(t_lo + 1), R2 = AB_LD(t_lo + 2);
    u32x4 C0 = {0u, 0u, 0u, 0u}, C1 = C0, C2 = C0;
    if (doC) { C0 = AB_LDC(t_lo); C1 = AB_LDC(t_lo + 1); C2 = AB_LDC(t_lo + 2); }
    bf16x8 qf[4];
#pragma unroll
    for (int st = 0; st < 4; ++st) qf[st] = *(const bf16x8*)(Q + (size_t)(q0 + r) * 512 + 16 * st + 8 * hh);
    float cq = 0.f; if (!SWA) cq = C[q0 + r];
    float m = -1e30f, lsum = 0.f;
    f32x16 o0, o1;
#pragma unroll
    for (int i = 0; i < 16; ++i) { o0[i] = 0.f; o1[i] = 0.f; }
    AB_WR(0, R0, C0);
#define AB_ITER(t_, RL, CL, RW, CW, SLOT_CUR, SLOT_NEXT) do { \
        RL = AB_LD((t_) + 3); if (doC) CL = AB_LDC((t_) + 3); \
        if ((t_) + 1 <= t_hi) AB_WR(SLOT_NEXT, RW, CW); \
        __syncthreads(); \
        const bool active_ = SWA ? ((t_) <= qt && (t_) >= qt - 4) : ((t_) <= qt); \
        if (active_) attn_compute<SWA>(lds + (SLOT_CUR) * AT_SLOT, qf, cq, m, lsum, o0, o1, (t_) == qt, (t_) == qt - 4, pr, r, hh); \
    } while (0)
    for (int t = t_lo; t <= t_hi; t += 3) {
        AB_ITER(t, R0, C0, R1, C1, 0, 1);
        if (t + 1 > t_hi) break;
        AB_ITER(t + 1, R1, C1, R2, C2, 1, 2);
        if (t + 2 > t_hi) break;
        AB_ITER(t + 2, R2, C2, R0, C0, 2, 0);
    }
    __syncthreads();
#undef AB_ITER
#undef AB_LD
#undef AB_LDC
#undef AB_WR
    float lt = lsum + __shfl_xor(lsum, 32);
    if (SWA) lt += __builtin_amdgcn_exp2f(sink2 - m);
    const float inv = 1.f / lt;
    bf16_t* yrow = Y + (size_t)(q0 + r) * 512 + 4 * hh;
#pragma unroll
    for (int g = 0; g < 4; ++g) {
        u32x2 a, c;
        a.x = pk2(o0[4 * g] * inv, o0[4 * g + 1] * inv); a.y = pk2(o0[4 * g + 2] * inv, o0[4 * g + 3] * inv);
        c.x = pk2(o1[4 * g] * inv, o1[4 * g + 1] * inv); c.y = pk2(o1[4 * g + 2] * inv, o1[4 * g + 3] * inv);
        *(u32x2*)(yrow + 8 * g) = a; *(u32x2*)(yrow + 32 + 8 * g) = c;
    }
}
__device__ __forceinline__ void m1_item(unsigned char* ws, int it, int lane) {
    const int r = lane & 31, hh = lane >> 5;
    const int dvt = it & 3, c = (it >> 2) & 15, bh = it >> 6;
    const bf16_t* VTp = (const bf16_t*)(ws + O_MVT) + ((size_t)bh * 128 + dvt * 32 + r) * SEQ + c * 128 + 8 * hh;
    const bf16_t* KTp = (const bf16_t*)(ws + O_KT) + ((size_t)bh * 128 + r) * SEQ + c * 128 + 8 * hh;
    const float* MPp = (const float*)(ws + O_MP) + (size_t)bh * SEQ + c * 128 + 8 * hh;
    const float mx = ((const float*)(ws + O_MCH))[(bh * 16 + c) * 4 + 1];
    f32x16 acc[4];
#pragma unroll
    for (int d = 0; d < 4; ++d)
#pragma unroll
        for (int i = 0; i < 16; ++i) acc[d][i] = 0.f;
    float dn[4] = {0.f, 0.f, 0.f, 0.f};
#pragma unroll 1
    for (int st = 0; st < 8; ++st) {
        const bf16x8 vf = *(const bf16x8*)(VTp + 16 * st);
        const f32x4 pa = *(const f32x4*)(MPp + 16 * st), pb = *(const f32x4*)(MPp + 16 * st + 4);
        float wk[8];
#pragma unroll
        for (int e = 0; e < 4; ++e) { wk[e] = __expf(pa[e] - mx); wk[4 + e] = __expf(pb[e] - mx); }
#pragma unroll
        for (int d = 0; d < 4; ++d) {
            const u32x4 kr = *(const u32x4*)(KTp + (size_t)d * 32 * SEQ + 16 * st);
            const float k0 = bflo(kr.x) * wk[0], k1 = bfhi(kr.x) * wk[1], k2 = bflo(kr.y) * wk[2], k3 = bfhi(kr.y) * wk[3];
            const float k4 = bflo(kr.z) * wk[4], k5 = bfhi(kr.z) * wk[5], k6 = bflo(kr.w) * wk[6], k7 = bfhi(kr.w) * wk[7];
            dn[d] += ((k0 + k1) + (k2 + k3)) + ((k4 + k5) + (k6 + k7));
            u32x4 kw; kw.x = pk2(k0, k1); kw.y = pk2(k2, k3); kw.z = pk2(k4, k5); kw.w = pk2(k6, k7);
            acc[d] = MFMA32(vf, __builtin_bit_cast(bf16x8, kw), acc[d]);
        }
    }
    bf16_t* DCT = (bf16_t*)(ws + O_DCT) + (size_t)(bh * 16 + c) * 16384;
#pragma unroll
    for (int d = 0; d < 4; ++d) {
#pragma unroll
        for (int g4 = 0; g4 < 4; ++g4) { int og = (dvt * 32 + 8 * g4 + 4 * hh) * 128 + d * 32 + r; asm volatile("" : "+v"(og)); bf16_t* pg = DCT + og;
            pg[0] = (bf16_t)pk2(acc[d][4 * g4], 0.f); pg[128] = (bf16_t)pk2(acc[d][4 * g4 + 1], 0.f); pg[256] = (bf16_t)pk2(acc[d][4 * g4 + 2], 0.f); pg[384] = (bf16_t)pk2(acc[d][4 * g4 + 3], 0.f); }
        const float t = dn[d] + __shfl_xor(dn[d], 32);
        if (dvt == 0 && hh == 0) ((float*)(ws + O_DN))[(bh * 16 + c) * 128 + d * 32 + r] = t;
    }
}
__device__ __forceinline__ void phase_m2(unsigned char* ws, int gtid, int NT) {
    const float* MCH = (const float*)(ws + O_MCH);
    for (int e = gtid; e < BG * 4 * 2048; e += NT) {
        const int bh = e >> 11, pp = e & 2047;
        const bf16_t* src = (const bf16_t*)(ws + O_DCT) + (size_t)bh * 16 * 16384 + 8 * pp;
        bf16_t* dst = (bf16_t*)(ws + O_CT) + (size_t)bh * 16 * 16384 + 8 * pp;
        u32x4 d[15]; float dec[15];
#pragma unroll
        for (int c = 0; c < 15; ++c) { d[c] = *(const u32x4*)(src + (size_t)c * 16384); dec[c] = MCH[(bh * 16 + c) * 4 + 2]; }
        float cs[8] = {0.f, 0.f, 0.f, 0.f, 0.f, 0.f, 0.f, 0.f};
        *(u32x4*)dst = (u32x4){0u, 0u, 0u, 0u};
#pragma unroll
        for (int c = 0; c < 15; ++c) {
            cs[0] = dec[c] * cs[0] + bflo(d[c].x); cs[1] = dec[c] * cs[1] + bfhi(d[c].x); cs[2] = dec[c] * cs[2] + bflo(d[c].y); cs[3] = dec[c] * cs[3] + bfhi(d[c].y);
            cs[4] = dec[c] * cs[4] + bflo(d[c].z); cs[5] = dec[c] * cs[5] + bfhi(d[c].z); cs[6] = dec[c] * cs[6] + bflo(d[c].w); cs[7] = dec[c] * cs[7] + bfhi(d[c].w);
            u32x4 o; o.x = pk2(cs[0], cs[1]); o.y = pk2(cs[2], cs[3]); o.z = pk2(cs[4], cs[5]); o.w = pk2(cs[6], cs[7]);
            *(u32x4*)(dst + (size_t)(c + 1) * 16384) = o;
        }
    }
    for (int e = gtid; e < BG * 4 * 128; e += NT) {
        const int bh = e >> 7, dk = e & 127; float n = 0.f;
        for (int c = 0; c < 16; ++c) { const size_t off = (size_t)(bh * 16 + c) * 128 + dk; ((float*)(ws + O_NN))[off] = n; n = MCH[(bh * 16 + c) * 4 + 2] * n + ((const float*)(ws + O_DN))[off]; }
    }
}
__device__ __forceinline__ void m3_item(unsigned char* ws, int l, int it, int lane) {
    const int r = lane & 31, hh = lane >> 5;
    const int pr = ((r >> 2) & 1) * 16 + ((r >> 4) & 1) * 8 + ((r >> 3) & 1) * 4 + (r & 3);
    const int tt = 3 - (it & 3), c = (it >> 2) & 15, bh = it >> 6, b = bh >> 2, h = bh & 3;
    const int ts = c * 128 + tt * 32 + r;
    const size_t trow = (size_t)b * SEQ + ts;
    bf16x8 qf[8];
    const bf16_t* Qp = (const bf16_t*)(ws + O_MQC) + trow * 512 + h * 128 + 8 * hh;
#pragma unroll
    for (int k = 0; k < 8; ++k) qf[k] = *(const bf16x8*)(Qp + 16 * k);
    const float Et = ((const float*)(ws + O_ME))[(size_t)bh * SEQ + ts], bt = ((const float*)(ws + O_MBT))[(size_t)bh * SEQ + ts];
    const float mc = ((const float*)(ws + O_MCH))[(bh * 16 + c) * 4];
    const float winter = __expf(mc - Et);
    f32x16 acc[4];
#pragma unroll
    for (int d = 0; d < 4; ++d)
#pragma unroll
        for (int i = 0; i < 16; ++i) acc[d][i] = 0.f;
    const bf16_t* CTp = (const bf16_t*)(ws + O_CT) + (size_t)(bh * 16 + c) * 16384 + (size_t)r * 128 + 8 * hh;
    const float* NNp = (const float*)(ws + O_NN) + (size_t)(bh * 16 + c) * 128 + 8 * hh;
    float qn = 0.f;
#pragma unroll
    for (int k = 0; k < 8; ++k) {
#pragma unroll
        for (int d = 0; d < 4; ++d) acc[d] = MFMA32(*(const bf16x8*)(CTp + (size_t)d * 32 * 128 + 16 * k), qf[k], acc[d]);
        const f32x4 na = *(const f32x4*)(NNp + 16 * k), nb = *(const f32x4*)(NNp + 16 * k + 4);
        const u32x4 qw = __builtin_bit_cast(u32x4, qf[k]);
        qn += bflo(qw.x) * na[0] + bfhi(qw.x) * na[1] + bflo(qw.y) * na[2] + bfhi(qw.y) * na[3] + bflo(qw.z) * nb[0] + bfhi(qw.z) * nb[1] + bflo(qw.w) * nb[2] + bfhi(qw.w) * nb[3];
        asm volatile("" ::: "memory");
    }
    qn += __shfl_xor(qn, 32);
#pragma unroll
    for (int d = 0; d < 4; ++d)
#pragma unroll
        for (int i = 0; i < 16; ++i) acc[d][i] *= winter;
    float dpart = 0.f;
    const bf16_t* Kb = (const bf16_t*)(ws + O_MKC) + ((size_t)b * SEQ + c * 128 + pr) * 512 + h * 128 + 8 * hh;
    const bf16_t* Vb = (const bf16_t*)(ws + O_MVT) + ((size_t)bh * 128 + r) * SEQ + c * 128 + 16 * hh;
    const float* MPb = (const float*)(ws + O_MP) + (size_t)bh * SEQ + c * 128 + 16 * hh;
    for (int st = 0; st <= tt; ++st) {
        f32x16 sc;
#pragma unroll
        for (int i = 0; i < 16; ++i) sc[i] = 0.f;
#pragma unroll
        for (int k = 0; k < 8; ++k) { sc = MFMA32(*(const bf16x8*)(Kb + (size_t)st * 32 * 512 + 16 * k), qf[k], sc); if (k == 3) asm volatile("" ::: "memory"); }
        asm volatile("" ::: "memory");
#pragma unroll
        for (int g = 0; g < 4; ++g) { const f32x4 pv = *(const f32x4*)(MPb + st * 32 + 4 * g);
#pragma unroll
            for (int e = 0; e < 4; ++e) { const int i = 4 * g + e;
                const bool ok = (st < tt) || (16 * hh + i <= r);
                const float w = ok ? __expf(pv[e] - Et) : 0.f;
                sc[i] = ok ? sc[i] * w : 0.f; dpart += sc[i]; } }
        u32x4 pw0, pw1;
        pw0.x = pk2(sc[0], sc[1]); pw0.y = pk2(sc[2], sc[3]); pw0.z = pk2(sc[4], sc[5]); pw0.w = pk2(sc[6], sc[7]);
        pw1.x = pk2(sc[8], sc[9]); pw1.y = pk2(sc[10], sc[11]); pw1.z = pk2(sc[12], sc[13]); pw1.w = pk2(sc[14], sc[15]);
        const bf16x8 pf0 = __builtin_bit_cast(bf16x8, pw0), pf1 = __builtin_bit_cast(bf16x8, pw1);
#pragma unroll
        for (int d = 0; d < 4; ++d) {
            acc[d] = MFMA32(*(const bf16x8*)(Vb + (size_t)d * 32 * SEQ + st * 32), pf0, acc[d]);
            acc[d] = MFMA32(*(const bf16x8*)(Vb + (size_t)d * 32 * SEQ + st * 32 + 8), pf1, acc[d]);
            if (d == 1) asm volatile("" ::: "memory");
        }
    }
    const float den = winter * qn + (dpart + __shfl_xor(dpart, 32));
    const float dinv = 1.f / fmaxf(fabsf(den), __expf(-(bt + Et)));
    float ss = 0.f;
#pragma unroll
    for (int d = 0; d < 4; ++d)
#pragma unroll
        for (int i = 0; i < 16; ++i) { acc[d][i] *= dinv; ss += acc[d][i] * acc[d][i]; }
    ss += __shfl_xor(ss, 32);
    const float rn = rsqrtf(ss * (1.f / 128.f) + EPS);
    const float* onorm = (const float*)(ws + O_PAR) + PAR_ON + l * 512 + h * 128 + 4 * hh;
    const bf16_t* mo = (const bf16_t*)(ws + O_U) + trow * LDU + UC_MO + h * 128 + 4 * hh;
    bf16_t* y = (bf16_t*)(ws + O_Y) + (size_t)2 * MG * 512 + trow * 512 + h * 128 + 4 * hh;
#pragma unroll
    for (int d = 0; d < 4; ++d)
#pragma unroll
        for (int g = 0; g < 4; ++g) {
            const int dv = d * 32 + 8 * g;
            const f32x4 wn = *(const f32x4*)(onorm + dv); const u32x2 og = *(const u32x2*)(mo + dv);
            const float y0 = acc[d][4 * g] * rn * wn[0] * sigm(bflo(og.x)), y1 = acc[d][4 * g + 1] * rn * wn[1] * sigm(bfhi(og.x));
            const float y2 = acc[d][4 * g + 2] * rn * wn[2] * sigm(bflo(og.y)), y3 = acc[d][4 * g + 3] * rn * wn[3] * sigm(bfhi(og.y));
            u32x2 o; o.x = pk2(y0, y1); o.y = pk2(y2, y3); *(u32x2*)(y + dv) = o;
            if (g & 1) asm volatile("" ::: "memory");
        }
}

#define XB_TMO      128
#define XB_XCNT(j)  (256  + 64 * (j))
#define XB_XSUB(j)  (1280 + 64 * (j))
#define XB_XGEN(j)  (2304 + 64 * (j))
#define XB_TOP      3328
#define XB_TOPGEN   3392
#define XCD_BAR_WORDS 3456
#define XB_SPIN_CAP (1u << 18)

__device__ __forceinline__ unsigned xb_ld(unsigned* p)              { return __hip_atomic_load(p, __ATOMIC_RELAXED, __HIP_MEMORY_SCOPE_AGENT); }
__device__ __forceinline__ unsigned xb_add(unsigned* p, unsigned v) { return __hip_atomic_fetch_add(p, v, __ATOMIC_RELAXED, __HIP_MEMORY_SCOPE_AGENT); }
__device__ __forceinline__ unsigned xb_xcc_id() { return (unsigned)__builtin_amdgcn_s_getreg((3 << 11) | 20) & 0xFu; }
#define XB_SPIN(cond, bar) do { unsigned _sp = 0; while (cond) { __builtin_amdgcn_s_sleep(1); \
    if ((++_sp & 255u) == 0u) { if (xb_ld(&(bar)[XB_TMO])) break; if (_sp > XB_SPIN_CAP) { atomicAdd(&(bar)[XB_TMO], 1u); break; } } } } while (0)

struct XcdBarrier {
    unsigned* bar; unsigned x;
    volatile LAS unsigned* st;
};

__device__ __forceinline__ XcdBarrier xcd_barrier_post(unsigned* bar, volatile LAS unsigned* st) {
    XcdBarrier b; b.bar = bar; b.x = xb_xcc_id(); b.st = st;
    if (threadIdx.x == 0) (void)xb_add(&bar[XB_XCNT(b.x)], 1u);
    return b;
}
__device__ __forceinline__ void xcd_barrier_complete(unsigned* bar, unsigned x, unsigned& nloc, unsigned& nx) {
    const unsigned G = gridDim.x * gridDim.y * gridDim.z;
    unsigned sum, cnt, mine, sp = 0u;
    for (;;) {
        sum = 0u; cnt = 0u; mine = 0u;
#pragma unroll
        for (unsigned j = 0; j < 16; ++j) { const unsigned c = xb_ld(&bar[XB_XCNT(j)]); sum += c; cnt += (c > 0u) ? 1u : 0u; mine = (j == x) ? c : mine; }
        if (sum == G) break;
        __builtin_amdgcn_s_sleep(1);
        if ((++sp & 255u) == 0u) { if (xb_ld(&bar[XB_TMO])) break; if (sp > XB_SPIN_CAP) { atomicAdd(&bar[XB_TMO], 1u); break; } }
    }
    nloc = mine > 0u ? mine : 1u; nx = cnt > 0u ? cnt : 1u;
}

__device__ __forceinline__ void xcd_barrier(const XcdBarrier& b) {
    asm volatile("s_waitcnt vmcnt(0)" ::: "memory");
    __syncthreads();
    if (threadIdx.x == 0) {
        unsigned* bar = b.bar;
        __builtin_amdgcn_s_waitcnt(0);
        unsigned nloc = b.st[0], nx = b.st[1];
        if (nloc == 0u) { xcd_barrier_complete(bar, b.x, nloc, nx); b.st[0] = nloc; b.st[1] = nx; }
        const unsigned old = xb_add(&bar[XB_XSUB(b.x)], 1u);
        const unsigned gen = old / nloc;
        if (old + 1u == (gen + 1u) * nloc) {
            __builtin_amdgcn_fence(__ATOMIC_RELEASE, "agent");
            asm volatile("s_waitcnt vmcnt(0)" ::: "memory");
            const unsigned og = xb_add(&bar[XB_TOP], 1u);
            const unsigned tg = og / nx;
            if (og + 1u == (tg + 1u) * nx) xb_add(&bar[XB_TOPGEN], 1u);
            else XB_SPIN(xb_ld(&bar[XB_TOPGEN]) == tg, bar);
            __builtin_amdgcn_fence(__ATOMIC_ACQUIRE, "agent");
            xb_add(&bar[XB_XGEN(b.x)], 1u);
            asm volatile("s_waitcnt vmcnt(0)" ::: "memory");
        } else {
            XB_SPIN(xb_ld(&bar[XB_XGEN(b.x)]) == gen, bar);
            __builtin_amdgcn_fence(__ATOMIC_ACQUIRE, "agent");
            asm volatile("s_waitcnt vmcnt(0)" ::: "memory");
        }
    }
    __syncthreads();
}


__global__ void __launch_bounds__(NTHR, 2) fwd_kernel(KP p) {
    extern __shared__ __attribute__((aligned(16))) unsigned char lds_raw[];
    LAS unsigned char* lds = (LAS unsigned char*)lds_raw;
    cg::grid_group grid = cg::this_grid();
    const int tid = threadIdx.x, lane0 = tid & 63, wave = __builtin_amdgcn_readfirstlane(tid >> 6);
    const int G = gridDim.x, gw0 = blockIdx.x * NWAVES + wave, NWV = G * NWAVES, NT = G * NTHR;
    unsigned char* ws0 = p.ws;
    volatile LAS unsigned* MISC = (volatile LAS unsigned*)(lds + 131072);
    if (tid < 64) MISC[tid] = 0u;
    __syncthreads();
    XcdBarrier bar = xcd_barrier_post((unsigned*)(ws0 + O_BAR), MISC + 8);
#ifndef PM
#define PM 0xFFFF
#endif
#ifndef PROBE_ID
#define PROBE_ID -1
#define PROBE_REP 1
#endif
#ifndef PM4
#define PM4 7
#endif
#define XB ((bf16_t*)(ws + O_XB))
#define RS ((float*)(ws + O_RS))
#define U ((bf16_t*)(ws + O_U))
    for (int pc = p.ph_lo; pc < p.ph_hi; ++pc) {
        int id = 0, g = 0, l = 0;
        if (pc > 0) { const int q_ = pc - 1, r_ = q_ % (1 + DEPTH * 9); g = q_ / (1 + DEPTH * 9); if (r_ == 0) id = 1; else { l = (r_ - 1) / 9; id = 2 + (r_ - 1) % 9; } }
        const size_t goff = (size_t)g * MG * DM;
        const int nrep = (PROBE_ID == id) ? PROBE_REP : 1;
        for (int rep_ = 0; rep_ < nrep; ++rep_) {
            size_t zo_ = 0; int lane = lane0, gw = gw0; asm volatile("" : "+s"(zo_), "+v"(lane), "+s"(gw));
            unsigned char* ws = p.ws + zo_;
            const int gtid = gw * 64 + lane; (void)gtid;
            if (!((PM >> id) & 1)) continue;
            switch (id) {
    case 0: { phase_p0(p, ws, lds, gw, NWV, wave, lane); } break;

        case 1: { phase_x0(p.in[0] + goff, XB, RS, gw, NWV, lane); } break;
            case 2: { {
                pg8::Gemm gm{XB, (const bf16_t*)(ws + O_WIN) + (size_t)l * NINP * DM, MG, NINP, DM}; pg8::StaticOrder S; S.init(MG, NINP, G, (int)blockIdx.x);
                pg8::EpiA E{0, 0, RS, U, LDU, (float*)(ws + O_SG), nullptr, 0, nullptr};
                pg8::gemm_phase<pg8::EpiA, pg8::StaticOrder, true, true>(lds, gm, S, E);
            } } break;
            case 3: { {
                constexpr int N_SCAN = BG * 12, N_HN3 = 3 * (MG / 8), N_HK = MG / 32, N_ST = 34 * (MG / 64);
                const int sw = (wave == 7 && (int)blockIdx.x < N_SCAN) ? (int)blockIdx.x : -1;
                if (sw >= 0) { for (int it = sw; it < N_SCAN; it += G) gate_scan_item(ws, l, it, lane); }
                else {
                    const int nscanw = (N_SCAN < G ? N_SCAN : G);
                    const int wi = (int)blockIdx.x < nscanw ? (int)blockIdx.x * 7 + wave : nscanw * 7 + ((int)blockIdx.x - nscanw) * 8 + wave;
                    const int nw = NWV - nscanw;
                    for (int it = wi; it < N_HN3 + N_HK + N_ST; it += nw) {
                        if (it < N_HN3) headnorm_item(ws, l, it % 3, it / 3, lane);
                        else if (it < N_HN3 + N_HK) headnorm_item(ws, l, 3, it - N_HN3, lane);
                        else stream_item(ws, l, it - N_HN3 - N_HK, lane);
                    }
                }
            } } break;
            case 4: { {
                if (PM4 & 1) for (int it = gw; it < BG * 4 * 16 * 4; it += NWV) m1_item(ws, it, lane);
                __syncthreads();
                if (PM4 & 2) for (int it = (int)blockIdx.x; it < BG * 8 * 4; it += G) {
                    const int b = it >> 5, h = (it >> 2) & 7, jp = it & 3;
                    const bf16_t* Q = (const bf16_t*)(ws + O_FQN) + (size_t)b * SEQ * 512 + h * 64; const bf16_t* K = (const bf16_t*)(ws + O_FKN) + (size_t)b * SEQ * 512 + h * 64;
                    const bf16_t* VT = (const bf16_t*)(ws + O_FVT) + (size_t)(b * 8 + h) * 64 * SEQ; const float* C = (const float*)(ws + O_FC) + (size_t)(b * 8 + h) * SEQ;
                    bf16_t* Y = (bf16_t*)(ws + O_Y) + (size_t)b * SEQ * 512 + h * 64;
                    attn_block<false>(lds, Q, K, 512, VT, C, 0.f, Y, 8 * (7 - jp) + wave, 0, 8 * (7 - jp) + 7, wave, lane);
                    attn_block<false>(lds, Q, K, 512, VT, C, 0.f, Y, 8 * jp + wave, 0, 8 * jp + 7, wave, lane);
                }
                if (PM4 & 4) for (int it = (int)blockIdx.x; it < BG * 2 * 32; it += G) {
                    const int b = it >> 6, hk = (it >> 5) & 1, u = it & 31, hq = hk * 4 + (wave & 3), qt = 2 * u + (wave >> 2);
                    const bf16_t* Q = (const bf16_t*)(ws + O_SQR) + (size_t)b * SEQ * 512 + hq * 64; const bf16_t* K = (const bf16_t*)(ws + O_SKR) + (size_t)b * SEQ * 128 + hk * 64;
                    const bf16_t* VT = (const bf16_t*)(ws + O_SVT) + (size_t)(b * 2 + hk) * 64 * SEQ;
                    bf16_t* Y = (bf16_t*)(ws + O_Y) + (size_t)MG * 512 + (size_t)b * SEQ * 512 + hq * 64;
                    attn_block<true>(lds, Q, K, 128, VT, nullptr, ((const float*)(ws + O_PAR))[PAR_SINK + l * 8 + hq] * LOG2E, Y, qt, (2 * u > 4 ? 2 * u - 4 : 0), 2 * u + 1, wave, lane);
                }
            } } break;
            case 5: { phase_m2(ws, gtid, NT); } break;
            case 6: { { for (int it = gw; it < BG * 4 * 16 * 4; it += NWV) m3_item(ws, l, it, lane); } } break;
            case 7: { {
                pg8::Gemm gm{(const bf16_t*)(ws + O_Y), (const bf16_t*)(ws + O_WB) + (size_t)l * 3 * DM * 512, 3 * MG, 3 * DM, 512}; pg8::DiagOrder S; S.init(MG, DM, G, (int)blockIdx.x);
                pg8::EpiM E{MG / 256, (bf16_t*)(ws + O_MRG), U + UC_G, LDU};
                pg8::gemm_phase<pg8::EpiM, pg8::DiagOrder, true, true>(lds, gm, S, E);
            } } break;
            case 8: { {
                pg8::Gemm gm{(const bf16_t*)(ws + O_MRG), (const bf16_t*)(ws + O_WOUT) + (size_t)l * DM * DM, MG, DM, DM}; pg8::StaticOrder S; S.init(MG, DM, G, (int)blockIdx.x);
                pg8::EpiB E{l == 0 ? p.in[0] + goff : (const float*)nullptr, nullptr, XB, RS};
                pg8::gemm_phase<pg8::EpiB, pg8::StaticOrder, true, true>(lds, gm, S, E);
            } } break;
            case 9: { {
                pg8::Gemm gm{XB, (const bf16_t*)(ws + O_WUP) + (size_t)l * FF * DM, MG, FF, DM}; pg8::StaticOrder S; S.init(MG, FF, G, (int)blockIdx.x);
                pg8::EpiA E{2, 0, RS, U  , FF, nullptr, nullptr, 0, nullptr};
                pg8::gemm_phase<pg8::EpiA, pg8::StaticOrder, true, true>(lds, gm, S, E);
            } } break;
            case 10: { {
                pg8::Gemm gm{U  , (const bf16_t*)(ws + O_WDN) + (size_t)l * DM * FF, MG, DM, FF}; pg8::StaticOrder S; S.init(MG, DM, G, (int)blockIdx.x);
                pg8::EpiB E{nullptr, l == DEPTH - 1 ? p.out + goff : (float*)nullptr, XB, RS};
                pg8::gemm_phase<pg8::EpiB, pg8::StaticOrder, true, true>(lds, gm, S, E);
            } } break;
            default: break;
            }
        }
        if (pc + 1 < p.ph_hi) { if (pc == 0) grid.sync(); else xcd_barrier(bar); }
    }
}
constexpr int N_PHASES = 1 + NG * (1 + DEPTH * 9);

#ifndef MK_MULTI
#define MK_MULTI 0
#endif
extern "C" void kernel_launch(void* const* d_in, const int* in_sizes, int n_in, void* d_out, int out_size, void* d_ws, size_t ws_size, hipStream_t stream) {
    static int grid = 0;
    if (grid == 0) {
        if (n_in != 19 || out_size != NB * SEQ * DM || ws_size < WS_NEED) { fprintf(stderr, "kernel_launch: unexpected problem (n_in %d out %d ws %zu need %zu)\n", n_in, out_size, ws_size, (size_t)WS_NEED); grid = -1; return; }
        int dev = 0, cus = 0, per_cu = 0;
        hipGetDevice(&dev); hipDeviceGetAttribute(&cus, hipDeviceAttributeMultiprocessorCount, dev);
        if (hipFuncSetAttribute((const void*)fwd_kernel, hipFuncAttributeMaxDynamicSharedMemorySize, LDS_BYTES) != hipSuccess) { fprintf(stderr, "kernel_launch: hipFuncSetAttribute failed\n"); grid = -1; return; }
        hipOccupancyMaxActiveBlocksPerMultiprocessor(&per_cu, (const void*)fwd_kernel, NTHR, LDS_BYTES);
        (void)hipGetLastError();
        if (per_cu < 1) { fprintf(stderr, "kernel_launch: occupancy query says %d blocks per CU\n", per_cu); per_cu = 1; }
        grid = cus;
    }
    if (grid < 0) return;
    if (hipMemsetAsync((char*)d_ws + O_BAR, 0, 16384, stream) != hipSuccess) { fprintf(stderr, "kernel_launch: memset failed\n"); return; }
    KP a{};
    for (int i = 0; i < 19; ++i) a.in[i] = (const float*)d_in[i];
    a.out = (float*)d_out; a.ws = (unsigned char*)d_ws;
#if MK_MULTI
    for (int ph = 0; ph < N_PHASES; ++ph) { a.ph_lo = ph; a.ph_hi = ph + 1; hipLaunchKernelGGL(fwd_kernel, dim3(grid), dim3(NTHR), LDS_BYTES, stream, a); }
#else
    a.ph_lo = 0; a.ph_hi = N_PHASES;
    void* args[] = {&a};
    hipError_t e = hipLaunchCooperativeKernel((const void*)fwd_kernel, dim3(grid), dim3(NTHR), args, LDS_BYTES, stream);
    if (e != hipSuccess) fprintf(stderr, "kernel_launch: cooperative launch failed: %s (grid %d)\n", hipGetErrorString(e), grid);
#endif
}
```

```cpp
#include <hip/hip_runtime.h>
#include <hip/hip_cooperative_groups.h>
#include <cstdio>
#include <cstdint>
#include <cmath>
namespace cg = cooperative_groups;
namespace pg8 {
#define PG8_LAS __attribute__((address_space(3)))
typedef unsigned short bf16_t;
typedef short bf16x8 __attribute__((ext_vector_type(8)));
typedef float f32x4 __attribute__((ext_vector_type(4)));
typedef unsigned u32x4 __attribute__((ext_vector_type(4)));
constexpr int BM = 256, BK = 64, HALF = 128, HTB = HALF * BK * 2  , STAGE_BYTES = 8 * HTB, NXCD = 8, WGM = 8;

__host__ __device__ __forceinline__ int lds_byte(int r, int c) { const int st = (r >> 4) * 2 + (c >> 5), rr = r & 15, cc = c & 31, ob = rr * 64 + cc * 2; return st * 1024 + (ob ^ (((ob >> 9) & 1) << 5)); }
__host__ __device__ __forceinline__ void stage_rc(int b, int& R, int& C) { const int st = b / 1024, sb = b % 1024, swz = sb ^ (((sb >> 9) & 1) << 5); R = (st >> 1) * 16 + swz / 64; C = (st & 1) * 32 + (swz % 64) / 2; }
__host__ __device__ __forceinline__ int perm32(int rho) { const int n = rho >> 4, i = rho & 15; return 8 * (i >> 2) + 4 * n + (i & 3); }

struct Unit { int pm, pn; };
struct Gemm { const bf16_t* A; const bf16_t* Bt; int M, N, K; };

struct StaticOrder {
    int nM, nN, nwg, G, c;
    __host__ __device__ void init(int M, int N, int G_, int c_) { nM = M / BM; nN = N / BM; nwg = nM * nN; G = G_; c = c_; }
    __host__ __device__ bool next(int i, Unit& u) const {
        const long L = (long)i * G + c; if (L >= nwg) return false;
        int wgid = (int)L; { const int q = nwg / NXCD, r = nwg % NXCD, xcd = wgid % NXCD, off = wgid / NXCD; wgid = (xcd < r ? xcd * (q + 1) : r * (q + 1) + (xcd - r) * q) + off; }
        const int nig = WGM * nN, gid = wgid / nig, fm = gid * WGM, gsz = (nM - fm) < WGM ? (nM - fm) : WGM;
        u.pm = fm + ((wgid % nig) % gsz); u.pn = (wgid % nig) / gsz; return true;
    }
    __device__ __forceinline__ void a_ready(const Unit&) const {}
    __device__ __forceinline__ void done(const Unit&) const {}
};


typedef unsigned u32x2 __attribute__((ext_vector_type(2)));
typedef float f32x2_t __attribute__((ext_vector_type(2)));
typedef __bf16 bf16x2_t __attribute__((ext_vector_type(2)));
__device__ __forceinline__ unsigned pk2(float lo, float hi) { f32x2_t v = {lo, hi}; bf16x2_t b = __builtin_convertvector(v, bf16x2_t); return __builtin_bit_cast(unsigned, b); }
__device__ __forceinline__ float bflo(unsigned w) { return __uint_as_float(w << 16); }
__device__ __forceinline__ float bfhi(unsigned w) { return __uint_as_float(w & 0xffff0000u); }
__device__ __forceinline__ float sigm(float x) { return __builtin_amdgcn_rcpf(1.f + __expf(-x)); }
__device__ __forceinline__ float rowscale(const float* rs, int row) {
    const f32x4* p = (const f32x4*)(rs + (size_t)row * 16);
    const f32x4 a = p[0], b = p[1], c = p[2], d = p[3];
    const float s = ((a[0] + a[1]) + (a[2] + a[3])) + ((b[0] + b[1]) + (b[2] + b[3])) + ((c[0] + c[1]) + (c[2] + c[3])) + ((d[0] + d[1]) + (d[2] + d[3]));
    return rsqrtf(s * (1.f / 1024.f) + 1e-6f);
}
struct EpiA {
    static constexpr bool PERM = true, AFTER_DRAIN = false;
    static __device__ __forceinline__ bool keeps(const Unit&) { return false; }
    int mode, sub; const float* rs; bf16_t* out; int ldo; float* sg; const bf16_t* gate; int ldg; float* tmp;
    __device__ __forceinline__ void operator()(const f32x4 (&acc)[2][2][4][2], const Unit& u, int wr, int wc, int fr, int fq) const {
        const int row0 = u.pm * BM + wr * 64 + fr, colb = u.pn * BM + wc * 32 + 8 * fq;
        float rsv8[2][4];
        if (mode != 1) {
            f32x4 part[2][4];
#pragma unroll
            for (int ai = 0; ai < 2; ++ai)
#pragma unroll
                for (int m = 0; m < 4; ++m) part[ai][m] = *(const f32x4*)(rs + (size_t)(row0 + ai * HALF + m * 16) * 16 + 4 * fq);
#pragma unroll
            for (int ai = 0; ai < 2; ++ai)
#pragma unroll
                for (int m = 0; m < 4; ++m) { float sp = (part[ai][m][0] + part[ai][m][1]) + (part[ai][m][2] + part[ai][m][3]); sp += __shfl_xor(sp, 16); sp += __shfl_xor(sp, 32); rsv8[ai][m] = rsqrtf(sp * (1.f / 1024.f) + 1e-6f); }
        } else {
#pragma unroll
            for (int ai = 0; ai < 2; ++ai)
#pragma unroll
                for (int m = 0; m < 4; ++m) rsv8[ai][m] = 1.f;
        }
#pragma unroll
        for (int ai = 0; ai < 2; ++ai)
#pragma unroll
            for (int m = 0; m < 4; ++m) {
                const int row = row0 + ai * HALF + m * 16;
                const float rsv = rsv8[ai][m];
#pragma unroll
                for (int bj = 0; bj < 2; ++bj) {
                    const int col = colb + bj * HALF;
                    f32x4 v0 = acc[ai][bj][m][0] * rsv, v1 = acc[ai][bj][m][1] * rsv;
                    if (mode == 0) {
                        if (u.pn == 29) {
                            if (bj == 0 && wc == 0 && fq < 2) { float* q = sg + (size_t)row * 16 + 8 * fq; *(f32x4*)q = v0; *(f32x4*)(q + 4) = v1; }
                        } else {
                            if (u.pn >= 17) {
#pragma unroll
                                for (int e = 0; e < 4; ++e) { v0[e] = sigm(v0[e]); v1[e] = sigm(v1[e]); }
                            }
                            u32x4 w; w.x = pk2(v0[0], v0[1]); w.y = pk2(v0[2], v0[3]); w.z = pk2(v1[0], v1[1]); w.w = pk2(v1[2], v1[3]);
                            *(u32x4*)(out + (size_t)row * ldo + col) = w;
                        }
                    } else if (mode == 1) {
                        const u32x4 g = *(const u32x4*)(gate + (size_t)row * ldg + col);
                        f32x4 p0 = {v0[0] * bflo(g.x), v0[1] * bfhi(g.x), v0[2] * bflo(g.y), v0[3] * bfhi(g.y)};
                        f32x4 p1 = {v1[0] * bflo(g.z), v1[1] * bfhi(g.z), v1[2] * bflo(g.w), v1[3] * bfhi(g.w)};
                        float* tp = tmp + (size_t)row * 1024 + col;
                        if (sub == 0) { *(f32x4*)tp = p0; *(f32x4*)(tp + 4) = p1; }
                        else if (sub == 1) { *(f32x4*)tp = *(const f32x4*)tp + p0; *(f32x4*)(tp + 4) = *(const f32x4*)(tp + 4) + p1; }
                        else { p0 = p0 + *(const f32x4*)tp; p1 = p1 + *(const f32x4*)(tp + 4);
                            u32x4 w; w.x = pk2(p0[0], p0[1]); w.y = pk2(p0[2], p0[3]); w.z = pk2(p1[0], p1[1]); w.w = pk2(p1[2], p1[3]);
                            *(u32x4*)(out + (size_t)row * ldo + col) = w; }
                    } else {
#pragma unroll
                        for (int e = 0; e < 4; ++e) { const float a = fmaxf(v0[e], 0.f), b = fmaxf(v1[e], 0.f); v0[e] = a * a; v1[e] = b * b; }
                        u32x4 w; w.x = pk2(v0[0], v0[1]); w.y = pk2(v0[2], v0[3]); w.z = pk2(v1[0], v1[1]); w.w = pk2(v1[2], v1[3]);
                        *(u32x4*)(out + (size_t)row * ldo + col) = w;
                    }
                }
            }
    }
};
struct EpiB {
    static constexpr bool PERM = false, AFTER_DRAIN = false;
    static __device__ __forceinline__ bool keeps(const Unit&) { return false; }
    const float* resid; float* out; bf16_t* xb; float* rs;
    __device__ __forceinline__ void operator()(const f32x4 (&acc)[2][2][4][2], const Unit& u, int wr, int wc, int fr, int fq) const {
        const int row0 = u.pm * BM + wr * 64 + fr, colb = u.pn * BM + wc * 32 + 4 * fq;
#pragma unroll
        for (int ai = 0; ai < 2; ++ai)
#pragma unroll
            for (int m = 0; m < 4; ++m) {
                const int row = row0 + ai * HALF + m * 16; float ss = 0.f;
#pragma unroll
                for (int bj = 0; bj < 2; ++bj)
#pragma unroll
                    for (int n = 0; n < 2; ++n) {
                        const size_t off = (size_t)row * 1024 + colb + bj * HALF + n * 16;
                        f32x4 x;
                        if (resid) x = *(const f32x4*)(resid + off);
                        else { const u32x2 rb = *(const u32x2*)(xb + off); x = (f32x4){bflo(rb.x), bfhi(rb.x), bflo(rb.y), bfhi(rb.y)}; }
                        x = x + acc[ai][bj][m][n];
                        if (out) *(f32x4*)(out + off) = x;
                        else { u32x2 w; w.x = pk2(x[0], x[1]); w.y = pk2(x[2], x[3]); *(u32x2*)(xb + off) = w; }
                        ss += (x[0] * x[0] + x[1] * x[1]) + (x[2] * x[2] + x[3] * x[3]);
                    }
                if (!out) { ss += __shfl_xor(ss, 16); ss += __shfl_xor(ss, 32);
                    if (fq == 0) rs[(size_t)row * 16 + u.pn * 4 + wc] = ss; }
            }
    }
};
struct EpiM {
    static constexpr bool PERM = true, AFTER_DRAIN = false;
    static __device__ __forceinline__ bool keeps(const Unit& u) { return (u.pn >> 2) != 2; }
    int nM; bf16_t* out; const bf16_t* gate; int ldg;
    __device__ __forceinline__ void operator()(const f32x4 (&acc_)[2][2][4][2], const Unit& u, int wr, int wc, int fr, int fq) const {
        f32x4 (&acc)[2][2][4][2] = const_cast<f32x4 (&)[2][2][4][2]>(acc_);
        const int sub = u.pn >> 2, pm = u.pm - sub * nM, pn = u.pn & 3;
        const int row0 = pm * BM + wr * 64 + fr, colb = pn * BM + wc * 32 + 8 * fq;
        const bf16_t* gb = gate + sub * 1024;
#pragma unroll
        for (int ai = 0; ai < 2; ++ai)
#pragma unroll
            for (int m = 0; m < 4; ++m)
#pragma unroll
                for (int bj = 0; bj < 2; ++bj) {
                    const size_t goff = (size_t)(row0 + ai * HALF + m * 16) * ldg + colb + bj * HALF;
                    const u32x4 g = *(const u32x4*)(gb + goff);
                    float f[8] = {bflo(g.x), bfhi(g.x), bflo(g.y), bfhi(g.y), bflo(g.z), bfhi(g.z), bflo(g.w), bfhi(g.w)};
#pragma unroll
                    for (int e = 0; e < 8; ++e) f[e] = fmaxf(f[e], 1e-30f);
                    if (sub != 2) {
                        const u32x4 gn = *(const u32x4*)(gb + 1024 + goff);
                        const float d[8] = {bflo(gn.x), bfhi(gn.x), bflo(gn.y), bfhi(gn.y), bflo(gn.z), bfhi(gn.z), bflo(gn.w), bfhi(gn.w)};
#pragma unroll
                        for (int e = 0; e < 8; ++e) f[e] = f[e] * __builtin_amdgcn_rcpf(fmaxf(d[e], 1e-30f));
                    }
                    f32x4& v0 = acc[ai][bj][m][0]; f32x4& v1 = acc[ai][bj][m][1];
                    v0[0] *= f[0]; v0[1] *= f[1]; v0[2] *= f[2]; v0[3] *= f[3]; v1[0] *= f[4]; v1[1] *= f[5]; v1[2] *= f[6]; v1[3] *= f[7];
                    if (sub == 2) {
                        u32x4 w; w.x = pk2(v0[0], v0[1]); w.y = pk2(v0[2], v0[3]); w.z = pk2(v1[0], v1[1]); w.w = pk2(v1[2], v1[3]);
                        *(u32x4*)(out + (size_t)(row0 + ai * HALF + m * 16) * 1024 + colb + bj * HALF) = w;
                    }
                }
    }
};
struct DiagOrder {
    StaticOrder S; int nM;
    __host__ __device__ void init(int M, int N, int G_, int c_) { S.init(M, N, G_, c_); nM = M / BM; }
    __host__ __device__ bool next(int i, Unit& u) const { Unit v; if (!S.next(i / 3, v)) return false; const int b = i % 3; u.pm = b * nM + v.pm; u.pn = b * 4 + v.pn; return true; }
    __device__ __forceinline__ void a_ready(const Unit&) const {}
    __device__ __forceinline__ void done(const Unit&) const {}
};

template <class Epi, class Sched, bool ALIGN_EPI = false, bool SP2 = false>
__device__ __forceinline__ void gemm_phase(PG8_LAS unsigned char* lds, const Gemm g, const Sched& S, const Epi& E) {
    int tid_ = threadIdx.x; asm volatile("" : "+v"(tid_));
    const int tid = tid_, wid = __builtin_amdgcn_readfirstlane(tid >> 6), lane = tid & 63, wr = wid >> 2, wc = wid & 3, fr = lane & 15, fq = lane >> 4;
    const int K = g.K, nt = K / BK;
    unsigned voffA[2], voffB[2];
#pragma unroll
    for (int i = 0; i < 2; ++i) { int R, C; stage_rc(tid * 16 + i * 8192, R, C); const int Rb = Epi::PERM ? ((R & ~31) + perm32(R & 31)) : R;
        voffA[i] = (unsigned)(R * K + C) * 2u; voffB[i] = (unsigned)(Rb * K + C) * 2u; }
    const size_t kstep = (size_t)(BK * 2);
    const size_t hstep = (size_t)HALF * K * 2;
    const size_t tstep = 2 * hstep;
    const unsigned ldsw = (unsigned)wid * 1024u;
    const int aoff = lds_byte(wr * 64 + fr, fq * 8), boff = lds_byte(wc * 32 + fr, fq * 8);
#define PG8_SA(b, h) (((b) * 2 + (h)) * HTB)
#define PG8_SB(b, h) ((4 + (b) * 2 + (h)) * HTB)
#define PG8_STAGE(bufoff, gbase, voff) do { _Pragma("unroll") for (int _i = 0; _i < 2; ++_i) \
        __builtin_amdgcn_global_load_lds((const unsigned*)((const char*)(gbase) + (voff)[_i]), (PG8_LAS unsigned*)(lds + (bufoff) + ldsw + _i * 8192), 16, 0, 0); } while (0)
#define PG8_LDA(dst, b, h) do { _Pragma("unroll") for (int m = 0; m < 4; ++m) _Pragma("unroll") for (int k = 0; k < 2; ++k) dst[m][k] = *(const PG8_LAS bf16x8*)(lds + PG8_SA(b, h) + aoff + m * 2048 + k * 1024); } while (0)
#define PG8_LDB(dst, b, h) do { _Pragma("unroll") for (int n = 0; n < 2; ++n) _Pragma("unroll") for (int k = 0; k < 2; ++k) dst[n][k] = *(const PG8_LAS bf16x8*)(lds + PG8_SB(b, h) + boff + n * 2048 + k * 1024); } while (0)
#define PG8_MMA(ai, bj, At, Bt) do { __builtin_amdgcn_s_setprio(1); _Pragma("unroll") for (int m = 0; m < 4; ++m) _Pragma("unroll") for (int n = 0; n < 2; ++n) _Pragma("unroll") for (int k = 0; k < 2; ++k) \
        acc[ai][bj][m][n] = __builtin_amdgcn_mfma_f32_16x16x32_bf16(Bt[n][k], At[m][k], acc[ai][bj][m][n], 0, 0, 0); __builtin_amdgcn_s_setprio(0); } while (0)
#define PG8_WAIT_V(n) asm volatile("s_waitcnt vmcnt(" #n ")" ::: "memory")
#define PG8_WAIT_L(n) asm volatile("s_waitcnt lgkmcnt(" #n ")" ::: "memory")
#define PG8_BAR __builtin_amdgcn_s_barrier()
#define PG8_SCHED __builtin_amdgcn_sched_barrier(0)
    Unit cur, nxt; int ui = 0;
    if (!S.next(0, cur)) return;
    f32x4 acc[2][2][4][2];
#pragma unroll
    for (int a = 0; a < 2; ++a)
#pragma unroll
        for (int b = 0; b < 2; ++b)
#pragma unroll
            for (int m = 0; m < 4; ++m)
#pragma unroll
                for (int n = 0; n < 2; ++n) acc[a][b][m][n] = (f32x4){0.f, 0.f, 0.f, 0.f};
    bf16x8 At[4][2], B0[2][2], B1[2][2];
    const char* cA = (const char*)g.A + (size_t)cur.pm * tstep; const char* cB = (const char*)g.Bt + (size_t)cur.pn * tstep;
    S.a_ready(cur);
    if constexpr (SP2) {
        PG8_STAGE(PG8_SB(0, 0), cB, voffB); PG8_STAGE(PG8_SB(0, 1), cB + hstep, voffB); PG8_STAGE(PG8_SA(0, 0), cA, voffA); PG8_STAGE(PG8_SA(0, 1), cA + hstep, voffA);
        if (wr == 1) PG8_BAR;
        PG8_WAIT_V(2); PG8_BAR;
        PG8_STAGE(PG8_SB(1, 0), cB + kstep, voffB); PG8_STAGE(PG8_SA(1, 0), cA + kstep, voffA); PG8_STAGE(PG8_SB(1, 1), cB + hstep + kstep, voffB);
        PG8_WAIT_V(6); PG8_BAR;
    } else {
        PG8_STAGE(PG8_SB(0, 0), cB, voffB); PG8_STAGE(PG8_SA(0, 0), cA, voffA); PG8_STAGE(PG8_SB(0, 1), cB + hstep, voffB); PG8_STAGE(PG8_SA(0, 1), cA + hstep, voffA);
        if (wr == 1) PG8_BAR;
        PG8_WAIT_V(4); PG8_BAR;
        PG8_STAGE(PG8_SB(1, 0), cB + kstep, voffB); PG8_STAGE(PG8_SA(1, 0), cA + kstep, voffA); PG8_STAGE(PG8_SB(1, 1), cB + hstep + kstep, voffB);
        PG8_WAIT_V(6); PG8_BAR;
    }
    for (;;) {
        const bool has_next = S.next(ui + 1, nxt);
        const char* nA = has_next ? (const char*)g.A + (size_t)nxt.pm * tstep : cA; const char* nB = has_next ? (const char*)g.Bt + (size_t)nxt.pn * tstep : cB;
        for (int t = 0; t < nt; t += 2) {
            const bool last = (t == nt - 2);
            const char* a1 = cA + (size_t)(t + 1) * kstep;
            const char* a2 = last ? nA : cA + (size_t)(t + 2) * kstep; const char* b2 = last ? nB : cB + (size_t)(t + 2) * kstep;
            const char* a3 = a2 + kstep; const char* b3 = b2 + kstep;
            if (last && has_next) S.a_ready(nxt);
            if constexpr (SP2) {
            PG8_LDB(B0, 0, 0); PG8_LDB(B1, 0, 1); PG8_SCHED; PG8_LDA(At, 0, 0); PG8_STAGE(PG8_SA(1, 1), a1 + hstep, voffA);
            PG8_WAIT_V(8); PG8_WAIT_L(0); PG8_BAR; PG8_MMA(0, 0, At, B0); PG8_MMA(0, 1, At, B1); PG8_BAR; PG8_SCHED;
            PG8_LDA(At, 0, 1); PG8_STAGE(PG8_SB(0, 0), b2, voffB); PG8_STAGE(PG8_SB(0, 1), b2 + hstep, voffB); PG8_STAGE(PG8_SA(0, 0), a2, voffA);
            PG8_WAIT_V(8); PG8_WAIT_L(0); PG8_BAR; PG8_MMA(1, 0, At, B0); PG8_MMA(1, 1, At, B1); PG8_BAR; PG8_SCHED;
            PG8_LDB(B0, 1, 0); PG8_LDB(B1, 1, 1); PG8_SCHED; PG8_LDA(At, 1, 0); PG8_STAGE(PG8_SA(0, 1), a2 + hstep, voffA);
            PG8_WAIT_V(8); PG8_WAIT_L(0); PG8_BAR; PG8_MMA(0, 0, At, B0); PG8_MMA(0, 1, At, B1); PG8_BAR; PG8_SCHED;
            PG8_LDA(At, 1, 1); PG8_STAGE(PG8_SB(1, 0), b3, voffB); PG8_STAGE(PG8_SB(1, 1), b3 + hstep, voffB); PG8_STAGE(PG8_SA(1, 0), a3, voffA);
            PG8_WAIT_V(8); PG8_WAIT_L(0); PG8_BAR; PG8_MMA(1, 0, At, B0); PG8_MMA(1, 1, At, B1); PG8_BAR; PG8_SCHED;
            } else {
            PG8_LDB(B0, 0, 0); PG8_SCHED; PG8_LDA(At, 0, 0); PG8_STAGE(PG8_SA(1, 1), a1 + hstep, voffA);
            PG8_WAIT_L(8); PG8_BAR; PG8_WAIT_L(0); PG8_MMA(0, 0, At, B0); PG8_BAR; PG8_SCHED;
            PG8_LDB(B1, 0, 1); PG8_STAGE(PG8_SB(0, 0), b2, voffB);
            PG8_BAR; PG8_WAIT_L(0); PG8_MMA(0, 1, At, B1); PG8_BAR;
            PG8_LDA(At, 0, 1); PG8_STAGE(PG8_SA(0, 0), a2, voffA);
            PG8_BAR; PG8_WAIT_L(0); PG8_MMA(1, 0, At, B0); PG8_BAR; PG8_SCHED;
            PG8_STAGE(PG8_SB(0, 1), b2 + hstep, voffB);
            PG8_WAIT_V(6); PG8_BAR; PG8_MMA(1, 1, At, B1); PG8_BAR;
            PG8_LDB(B0, 1, 0); PG8_SCHED; PG8_LDA(At, 1, 0); PG8_STAGE(PG8_SA(0, 1), a2 + hstep, voffA);
            PG8_WAIT_L(8); PG8_BAR; PG8_WAIT_L(0); PG8_MMA(0, 0, At, B0); PG8_BAR; PG8_SCHED;
            PG8_LDB(B1, 1, 1); PG8_STAGE(PG8_SB(1, 0), b3, voffB);
            PG8_BAR; PG8_WAIT_L(0); PG8_MMA(0, 1, At, B1); PG8_BAR;
            PG8_LDA(At, 1, 1); PG8_STAGE(PG8_SA(1, 0), a3, voffA);
            PG8_BAR; PG8_WAIT_L(0); PG8_MMA(1, 0, At, B0); PG8_BAR; PG8_SCHED;
            PG8_STAGE(PG8_SB(1, 1), b3 + hstep, voffB);
            PG8_WAIT_V(6); PG8_BAR; PG8_MMA(1, 1, At, B1); PG8_BAR;
            }
        }
        if constexpr (ALIGN_EPI) { if (wr == 0) PG8_BAR; }
        if constexpr (!Epi::AFTER_DRAIN) { E(acc, cur, wr, wc, fr, fq); S.done(cur); }
        if (!has_next) break;
        if (!Epi::keeps(cur)) {
#pragma unroll
        for (int a = 0; a < 2; ++a)
#pragma unroll
            for (int b = 0; b < 2; ++b)
#pragma unroll
                for (int m = 0; m < 4; ++m)
#pragma unroll
                    for (int n = 0; n < 2; ++n) acc[a][b][m][n] = (f32x4){0.f, 0.f, 0.f, 0.f};
        }
        cur = nxt; cA = nA; cB = nB; ++ui;
        if constexpr (ALIGN_EPI) { if (wr == 1) PG8_BAR; }
    }
    PG8_WAIT_V(0);
    if constexpr (!ALIGN_EPI) { if (wr == 0) PG8_BAR; }
    PG8_BAR;
    if constexpr (Epi::AFTER_DRAIN) { E.fused(acc, cur, wr, wc, fr, fq, lds, wid, lane); S.done(cur); }
#undef PG8_SA
#undef PG8_SB
#undef PG8_STAGE
#undef PG8_LDA
#undef PG8_LDB
#undef PG8_MMA
#undef PG8_WAIT_V
#undef PG8_WAIT_L
#undef PG8_BAR
#undef PG8_SCHED
}
}

#define LAS __attribute__((address_space(3)))
typedef unsigned short bf16_t;
typedef short bf16x8 __attribute__((ext_vector_type(8)));
typedef float f32x4 __attribute__((ext_vector_type(4)));
typedef float f32x2 __attribute__((ext_vector_type(2)));
typedef float f32x16 __attribute__((ext_vector_type(16)));
typedef unsigned u32x4 __attribute__((ext_vector_type(4)));
typedef unsigned u32x2 __attribute__((ext_vector_type(2)));
using pg8::pk2; using pg8::bflo; using pg8::bfhi; using pg8::sigm;

constexpr int NB = 32, SEQ = 2048, DM = 1024, DEPTH = 2, INW = 7440, NINP = 7680, LDU = 7424, FF = 4096;
constexpr int NG = 2, BG = NB / NG, MG = BG * SEQ;
constexpr float LOG2E = 1.4426950408889634f, EPS = 1e-6f;
constexpr int NWAVES = 8, NTHR = 512;
constexpr int LDS_BYTES = 131072 + 1024;

constexpr int UC_FQ = 0, UC_FK = 512, UC_FV = 1024, UC_SQ = 1536, UC_SK = 2048, UC_SV = 2176, UC_MQ = 2304, UC_MK = 2816, UC_MV = 3328, UC_MO = 3840, UC_G = 4352;

constexpr size_t al(size_t x) { return (x + 255) & ~(size_t)255; }
constexpr size_t O_WIN = 0;
constexpr size_t O_WB = O_WIN + al((size_t)DEPTH * NINP * DM * 2);
constexpr size_t O_WOUT = O_WB + al((size_t)DEPTH * 3 * DM * 512 * 2);
constexpr size_t O_WUP = O_WOUT + al((size_t)DEPTH * DM * DM * 2);
constexpr size_t O_WDN = O_WUP + al((size_t)DEPTH * FF * DM * 2);
constexpr size_t O_ROPE = O_WDN + al((size_t)DEPTH * DM * FF * 2);
constexpr size_t O_PAR = O_ROPE + al((size_t)SEQ * 32 * 2 * 4);
constexpr int PAR_FFB = 0, PAR_FQN = 16, PAR_FKN = 144, PAR_SQN = 272, PAR_SKN = 400, PAR_SINK = 528, PAR_CW = 544, PAR_CB = 8736, PAR_IB = 10784, PAR_FB = 10792, PAR_ON = 10800, PAR_N = 11824;
constexpr size_t O_XB = O_PAR + al((size_t)PAR_N * 4);
constexpr size_t O_RS = O_XB + al((size_t)MG * DM * 2);
constexpr size_t O_U = O_RS + al((size_t)MG * 16 * 4);
constexpr size_t O_SG = O_U + al((size_t)MG * LDU * 2);
constexpr size_t O_FC = O_SG + al((size_t)MG * 16 * 4);
constexpr size_t O_MP = O_FC + al((size_t)BG * 8 * SEQ * 4);
constexpr size_t O_ME = O_MP + al((size_t)BG * 4 * SEQ * 4);
constexpr size_t O_MBT = O_ME + al((size_t)BG * 4 * SEQ * 4);
constexpr size_t O_MCH = O_MBT + al((size_t)BG * 4 * SEQ * 4);
constexpr size_t O_FQN = O_MCH + al((size_t)BG * 4 * 16 * 4 * 4);
constexpr size_t O_FKN = O_FQN + (size_t)MG * 512 * 2;
constexpr size_t O_FVT = O_FKN + (size_t)MG * 512 * 2;
constexpr size_t O_SQR = O_FVT + (size_t)MG * 512 * 2;
constexpr size_t O_TMP = O_FQN;
constexpr size_t O_SKR = O_SQR + (size_t)MG * 512 * 2;
constexpr size_t O_SVT = O_SKR + (size_t)MG * 128 * 2;
constexpr size_t O_MQC = O_SVT + (size_t)MG * 128 * 2;
constexpr size_t O_MKC = O_MQC + (size_t)MG * 512 * 2;
constexpr size_t O_MRG = O_MQC;
constexpr size_t O_KT = O_MKC + (size_t)MG * 512 * 2;
constexpr size_t O_MVT = O_KT + (size_t)MG * 512 * 2;
constexpr size_t O_DN = O_MVT + (size_t)MG * 512 * 2;
constexpr size_t O_CT = O_KT;
constexpr size_t O_NN = O_DN + al((size_t)BG * 4 * 16 * 128 * 4);
constexpr size_t O_Y = O_NN + al((size_t)BG * 4 * 16 * 128 * 4);
constexpr size_t O_DCT = O_Y + (size_t)2 * MG * 512 * 2;
constexpr size_t O_BAR = O_Y + (size_t)3 * MG * 512 * 2;
constexpr size_t WS_NEED = O_BAR + 16384;
static_assert((size_t)BG * 4 * 16 * 16384 * 2 == (size_t)MG * 512 * 2, "DCT overlays Y2; CT overlays KT");
static_assert((size_t)MG * FF * 2 <= (size_t)MG * LDU * 2, "ACT overlays U");

struct KP { const float* in[19]; float* out; unsigned char* ws; int ph_lo, ph_hi; };

__device__ __forceinline__ float wave_sum(float v) {
#pragma unroll
    for (int o = 1; o < 64; o <<= 1) v += __shfl_xor(v, o);
    return v;
}
__device__ __forceinline__ float logsig(float x) { return fminf(x, 0.f) - log1pf(__expf(-fabsf(x))); }
#define LDSW() asm volatile("s_waitcnt lgkmcnt(0)" ::: "memory")

__device__ __forceinline__ int win_srccol(int n) {
    if (n < 1536) return n; if (n < 3840) return n + 8; if (n < 7424) return n + 16; if (n < 7432) return n - 7424 + 1536; if (n < 7440) return n - 7432 + 3848; return -1;
}
template <bool REMAP>
__device__ __forceinline__ void tr_item(const float* W, int K, int N, const float* kscale, bf16_t* WT, int item, int nblk, LAS float* scr, int lane) {
    const int kb = item / nblk, nb = item % nblk, k0 = 64 * kb, n0 = 32 * nb;
    const int kr = lane >> 3, n4 = (lane & 7) * 4;
    const int nd = n0 + n4; const int ns = REMAP ? win_srccol(nd) : nd;
    f32x4 v[8];
#pragma unroll
    for (int i = 0; i < 8; ++i) { v[i] = (f32x4){0.f, 0.f, 0.f, 0.f}; if (ns >= 0) v[i] = *(const f32x4*)(W + (size_t)(k0 + 8 * i + kr) * N + ns); }
#pragma unroll
    for (int i = 0; i < 8; ++i) { const int kk = 8 * i + kr; float sc = 1.f; if (kscale) sc = kscale[k0 + kk];
        scr[kk * 33 + n4] = v[i][0] * sc; scr[kk * 33 + n4 + 1] = v[i][1] * sc; scr[kk * 33 + n4 + 2] = v[i][2] * sc; scr[kk * 33 + n4 + 3] = v[i][3] * sc; }
    LDSW();
    const int c = lane & 7;
#pragma unroll
    for (int j = 0; j < 4; ++j) { const int n = (lane >> 3) + 8 * j; const LAS float* sp = scr + (8 * c) * 33 + n;
        u32x4 o; o.x = pk2(sp[0 * 33], sp[1 * 33]); o.y = pk2(sp[2 * 33], sp[3 * 33]); o.z = pk2(sp[4 * 33], sp[5 * 33]); o.w = pk2(sp[6 * 33], sp[7 * 33]);
        *(u32x4*)(WT + (size_t)(n0 + n) * K + k0 + 8 * c) = o; }
    LDSW();
}
__device__ __forceinline__ void phase_p0(const KP& p, unsigned char* ws, LAS unsigned char* lds, int gw, int NWV, int wave, int lane) {
    LAS float* scr = (LAS float*)(lds + wave * 16384);
    const float *norm_mix = p.in[1], *w_in = p.in[2], *w_branch = p.in[14], *w_out = p.in[15], *norm_mlp = p.in[16], *w_up = p.in[17], *w_down = p.in[18];
    constexpr int PER = 3840 + 768 + 512 + 2048 + 2048;
    for (int it = gw; it < DEPTH * PER; it += NWV) {
        const int l = it / PER; int r = it % PER;
        if (r < 3840) { tr_item<true>(w_in + (size_t)l * DM * INW, DM, INW, norm_mix + l * DM, (bf16_t*)(ws + O_WIN) + (size_t)l * NINP * DM, r, 240, scr, lane); continue; } r -= 3840;
        if (r < 768) { const int b = r / 256; tr_item<false>(w_branch + (size_t)(l * 3 + b) * 512 * DM, 512, DM, nullptr, (bf16_t*)(ws + O_WB) + (size_t)(l * 3 + b) * DM * 512, r % 256, 32, scr, lane); continue; } r -= 768;
        if (r < 512) { tr_item<false>(w_out + (size_t)l * DM * DM, DM, DM, nullptr, (bf16_t*)(ws + O_WOUT) + (size_t)l * DM * DM, r, 32, scr, lane); continue; } r -= 512;
        if (r < 2048) { tr_item<false>(w_up + (size_t)l * DM * FF, DM, FF, norm_mlp + l * DM, (bf16_t*)(ws + O_WUP) + (size_t)l * FF * DM, r, 128, scr, lane); continue; } r -= 2048;
        tr_item<false>(w_down + (size_t)l * FF * DM, FF, DM, nullptr, (bf16_t*)(ws + O_WDN) + (size_t)l * DM * FF, r, 32, scr, lane);
    }
    { float* par = (float*)(ws + O_PAR); const int t0 = gw * 64 + lane, ts = NWV * 64;
      for (int e = t0; e < 16; e += ts) { par[PAR_FFB + e] = p.in[3][e]; par[PAR_SINK + e] = p.in[8][e]; }
      for (int e = t0; e < 128; e += ts) { par[PAR_FQN + e] = p.in[4][e]; par[PAR_FKN + e] = p.in[5][e]; par[PAR_SQN + e] = p.in[6][e]; par[PAR_SKN + e] = p.in[7][e]; }
      for (int e = t0; e < 8192; e += ts) par[PAR_CW + e] = p.in[9][e];
      for (int e = t0; e < 2048; e += ts) par[PAR_CB + e] = p.in[10][e];
      for (int e = t0; e < 8; e += ts) { par[PAR_IB + e] = p.in[11][e]; par[PAR_FB + e] = p.in[12][e]; }
      for (int e = t0; e < 1024; e += ts) par[PAR_ON + e] = p.in[13][e]; }
    float* rope = (float*)(ws + O_ROPE);
    for (int e = gw * 64 + lane; e < SEQ * 32; e += NWV * 64) {
        const int pos = e >> 5, i = e & 31;
        const float inv = powf(10000.f, -(float)(2 * i) / 64.f), ang = (float)pos * inv;
        rope[2 * e] = cosf(ang); rope[2 * e + 1] = sinf(ang);
    }
}
__device__ __forceinline__ void phase_x0(const float* x, bf16_t* XB, float* RS, int gw, int NWV, int lane) {
    for (int row = gw; row < MG; row += NWV) {
        const f32x4* xr = (const f32x4*)(x + (size_t)row * DM) + lane;
        f32x4 v[4]; float s = 0.f;
#pragma unroll
        for (int j = 0; j < 4; ++j) { v[j] = xr[64 * j]; s += (v[j][0] * v[j][0] + v[j][1] * v[j][1]) + (v[j][2] * v[j][2] + v[j][3] * v[j][3]); }
        s = wave_sum(s);
        u32x2* o = (u32x2*)(XB + (size_t)row * DM) + lane;
#pragma unroll
        for (int j = 0; j < 4; ++j) { u32x2 w; w.x = pk2(v[j][0], v[j][1]); w.y = pk2(v[j][2], v[j][3]); o[64 * j] = w; }
        if (lane < 16) RS[(size_t)row * 16 + lane] = (lane == 0) ? s : 0.f;
    }
}
__device__ __forceinline__ void gate_scan_item(unsigned char* ws, int l, int it, int lane) {
    const float* par = (const float*)(ws + O_PAR); const float* SG = (const float*)(ws + O_SG);
    if (it < BG * 8) {
        const int b = it >> 3, h = it & 7; const float bias = par[PAR_FFB + l * 8 + h];
        const float* src = SG + ((size_t)b * SEQ + lane * 32) * 16 + h;
        float tot = 0.f;
#pragma unroll 4
        for (int j = 0; j < 32; ++j) tot += logsig(src[j * 16] + bias);
        float x = tot;
#pragma unroll
        for (int o = 1; o < 64; o <<= 1) { const float y = __shfl_up(x, o); if (lane >= o) x += y; }
        float run = x - tot;
        float* dst = (float*)(ws + O_FC) + (size_t)it * SEQ + lane * 32;
#pragma unroll 4
        for (int j = 0; j < 32; ++j) { run += logsig(src[j * 16] + bias); dst[j] = run * LOG2E; }
    } else {
        const int sq = it - BG * 8, b = sq >> 2, h = sq & 3;
        const float ibias = par[PAR_IB + l * 4 + h], fbias = par[PAR_FB + l * 4 + h];
        float* MP = (float*)(ws + O_MP) + (size_t)sq * SEQ; float* ME = (float*)(ws + O_ME) + (size_t)sq * SEQ; float* MBT = (float*)(ws + O_MBT) + (size_t)sq * SEQ;
        float* MCH = (float*)(ws + O_MCH) + (size_t)sq * 64;
        float mc = 0.f;
#pragma unroll 1
        for (int c = 0; c < 16; ++c) {
            const float* s0 = SG + ((size_t)b * SEQ + c * 128 + 2 * lane) * 16;
            const float f0 = logsig(s0[12 + h] + fbias), f1 = logsig(s0[16 + 12 + h] + fbias);
            const float i0 = s0[8 + h] + ibias, i1 = s0[16 + 8 + h] + ibias;
            float x = f0 + f1;
#pragma unroll
            for (int o = 1; o < 64; o <<= 1) { const float y = __shfl_up(x, o); if (lane >= o) x += y; }
            const float b1 = x, b0 = x - f1;
            const float p0 = i0 - b0, p1 = i1 - b1;
            float mxs = fmaxf(p0, p1);
#pragma unroll
            for (int o = 1; o < 64; o <<= 1) { const float y = __shfl_up(mxs, o); if (lane >= o) mxs = fmaxf(mxs, y); }
            float prev = __shfl_up(mxs, 1); if (lane == 0) prev = -INFINITY;
            const float u0 = fmaxf(prev, p0), u1 = mxs;
            const float e0 = fmaxf(mc, u0), e1 = fmaxf(mc, u1);
            const int t = c * 128 + 2 * lane;
            *(f32x2*)(MP + t) = (f32x2){p0, p1}; *(f32x2*)(ME + t) = (f32x2){e0, e1}; *(f32x2*)(MBT + t) = (f32x2){b0, b1};
            const float ulast = __shfl(mxs, 63), bL = __shfl(x, 63);
            const float mx = fmaxf(mc, ulast), dec = __expf(mc - mx);
            if (lane == 0) *(f32x4*)(MCH + c * 4) = (f32x4){mc, mx, dec, bL};
            mc = bL + mx;
        }
    }
}
__device__ __forceinline__ void headnorm_item(unsigned char* ws, int l, int kind, int item, int lane) {
    const float* par = (const float*)(ws + O_PAR);
    const int c = lane & 7;
    int srccol, dpitch, tstep, tok0, tsub; bf16_t* dbase; const float* w; float scale;
    if (kind == 0) { srccol = UC_FQ + lane * 8; dbase = (bf16_t*)(ws + O_FQN) + lane * 8; dpitch = 512; w = par + PAR_FQN + l * 64; scale = 0.125f * LOG2E; tstep = 1; tok0 = item * 8; tsub = 0; }
    else if (kind == 1) { srccol = UC_FK + lane * 8; dbase = (bf16_t*)(ws + O_FKN) + lane * 8; dpitch = 512; w = par + PAR_FKN + l * 64; scale = 1.f; tstep = 1; tok0 = item * 8; tsub = 0; }
    else if (kind == 2) { srccol = UC_SQ + lane * 8; dbase = (bf16_t*)(ws + O_SQR) + lane * 8; dpitch = 512; w = par + PAR_SQN + l * 64; scale = 0.125f * LOG2E; tstep = 1; tok0 = item * 8; tsub = 0; }
    else { srccol = UC_SK + (lane & 15) * 8; dbase = (bf16_t*)(ws + O_SKR) + (lane & 15) * 8; dpitch = 128; w = par + PAR_SKN + l * 64; scale = 1.f; tstep = 4; tok0 = item * 32; tsub = lane >> 4; }
    const bool rp = kind >= 2;
    const f32x4 w0 = *(const f32x4*)(w + 8 * c), w1 = *(const f32x4*)(w + 8 * c + 4);
    const bf16_t* src = (const bf16_t*)(ws + O_U) + (size_t)(tok0 + tsub) * LDU + srccol;
    u32x4 xv[8];
#pragma unroll
    for (int i = 0; i < 8; ++i) xv[i] = *(const u32x4*)(src + (size_t)(i * tstep) * LDU);
#pragma unroll
    for (int i = 0; i < 8; ++i) {
        const int tok = tok0 + tsub + i * tstep;
        float x[8] = {bflo(xv[i].x), bfhi(xv[i].x), bflo(xv[i].y), bfhi(xv[i].y), bflo(xv[i].z), bfhi(xv[i].z), bflo(xv[i].w), bfhi(xv[i].w)};
        float ss = ((x[0] * x[0] + x[1] * x[1]) + (x[2] * x[2] + x[3] * x[3])) + ((x[4] * x[4] + x[5] * x[5]) + (x[6] * x[6] + x[7] * x[7]));
        ss += __shfl_xor(ss, 1); ss += __shfl_xor(ss, 2); ss += __shfl_xor(ss, 4);
        const float rn = rsqrtf(ss * (1.f / 64.f) + EPS);
        x[0] *= rn * w0[0]; x[1] *= rn * w0[1]; x[2] *= rn * w0[2]; x[3] *= rn * w0[3]; x[4] *= rn * w1[0]; x[5] *= rn * w1[1]; x[6] *= rn * w1[2]; x[7] *= rn * w1[3];
        if (rp) {
            const float* rt = (const float*)(ws + O_ROPE) + ((size_t)(tok % SEQ) * 32 + 8 * (c & 3)) * 2;
            const bool second = (c & 4) != 0;
#pragma unroll
            for (int e = 0; e < 8; e += 2) { const f32x4 cs = *(const f32x4*)(rt + 2 * e);
                const float o0 = __shfl_xor(x[e], 4), o1 = __shfl_xor(x[e + 1], 4);
                x[e] = second ? (o0 * cs[1] + x[e] * cs[0]) : (x[e] * cs[0] - o0 * cs[1]);
                x[e + 1] = second ? (o1 * cs[3] + x[e + 1] * cs[2]) : (x[e + 1] * cs[2] - o1 * cs[3]); }
        }
        u32x4 o; o.x = pk2(x[0] * scale, x[1] * scale); o.y = pk2(x[2] * scale, x[3] * scale); o.z = pk2(x[4] * scale, x[5] * scale); o.w = pk2(x[6] * scale, x[7] * scale);
        *(u32x4*)(dbase + (size_t)tok * dpitch) = o;
    }
}
__device__ __forceinline__ void stream_item(unsigned char* ws, int l, int item, int lane) {
    const int cb = item % 34, tb = item / 34, tok0 = tb * 64, b = tok0 / SEQ, s0 = tok0 % SEQ;
    const int tg = lane >> 3, co = lane & 7;
    const bf16_t* U = (const bf16_t*)(ws + O_U);
    int srccol, chan; bf16_t* dT = nullptr; bf16_t* dN = nullptr; int convch = -1; float oscale = 1.f;
    if (cb < 8) { chan = cb * 64 + co * 8; srccol = UC_FV + chan; dT = (bf16_t*)(ws + O_FVT) + ((size_t)b * 512 + chan) * SEQ; }
    else if (cb < 10) { chan = (cb - 8) * 64 + co * 8; srccol = UC_SV + chan; dT = (bf16_t*)(ws + O_SVT) + ((size_t)b * 128 + chan) * SEQ; }
    else if (cb < 18) { chan = (cb - 10) * 64 + co * 8; srccol = UC_MV + chan; dT = (bf16_t*)(ws + O_MVT) + ((size_t)b * 512 + chan) * SEQ; }
    else if (cb < 26) { chan = (cb - 18) * 64 + co * 8; srccol = UC_MQ + chan; dN = (bf16_t*)(ws + O_MQC) + chan; convch = chan; }
    else { chan = (cb - 26) * 64 + co * 8; srccol = UC_MK + chan; dN = (bf16_t*)(ws + O_MKC) + chan; dT = (bf16_t*)(ws + O_KT) + ((size_t)b * 512 + chan) * SEQ; convch = 512 + chan; oscale = 0.08838834764831845f; }
    const bf16_t* src = U + (size_t)(tok0 + tg * 8) * LDU + srccol;
    u32x4 R[8];
#pragma unroll
    for (int i = 0; i < 8; ++i) R[i] = *(const u32x4*)(src + (size_t)i * LDU);
    if (cb >= 18) {
        u32x4 H[3];
        const bool has_prev = (s0 + tg * 8) > 0;
#pragma unroll
        for (int i = 0; i < 3; ++i) { H[i] = (u32x4){0u, 0u, 0u, 0u}; if (has_prev) H[i] = *(const u32x4*)(src - (size_t)(3 - i) * LDU); }
        const float* cw = (const float*)(ws + O_PAR) + PAR_CW + l * 4 * 1024 + convch; const float* cbias = (const float*)(ws + O_PAR) + PAR_CB + l * 1024 + convch;
        float wt[4][8], bb[8];
#pragma unroll
        for (int j = 0; j < 4; ++j) { const f32x4 a = *(const f32x4*)(cw + j * 1024), c2 = *(const f32x4*)(cw + j * 1024 + 4);
            wt[j][0] = a[0]; wt[j][1] = a[1]; wt[j][2] = a[2]; wt[j][3] = a[3]; wt[j][4] = c2[0]; wt[j][5] = c2[1]; wt[j][6] = c2[2]; wt[j][7] = c2[3]; }
        { const f32x4 a = *(const f32x4*)cbias, c2 = *(const f32x4*)(cbias + 4); bb[0] = a[0]; bb[1] = a[1]; bb[2] = a[2]; bb[3] = a[3]; bb[4] = c2[0]; bb[5] = c2[1]; bb[6] = c2[2]; bb[7] = c2[3]; }
        float xm3[8], xm2[8], xm1[8];
#define UNPK(dst, v) do { dst[0] = bflo(v.x); dst[1] = bfhi(v.x); dst[2] = bflo(v.y); dst[3] = bfhi(v.y); dst[4] = bflo(v.z); dst[5] = bfhi(v.z); dst[6] = bflo(v.w); dst[7] = bfhi(v.w); } while (0)
        UNPK(xm3, H[0]); UNPK(xm2, H[1]); UNPK(xm1, H[2]);
#pragma unroll
        for (int i = 0; i < 8; ++i) {
            float xc[8], y[8]; UNPK(xc, R[i]);
#pragma unroll
            for (int e = 0; e < 8; ++e) { const float v = bb[e] + wt[0][e] * xm3[e] + wt[1][e] * xm2[e] + wt[2][e] * xm1[e] + wt[3][e] * xc[e]; y[e] = v * sigm(v) * oscale; xm3[e] = xm2[e]; xm2[e] = xm1[e]; xm1[e] = xc[e]; }
            u32x4 o; o.x = pk2(y[0], y[1]); o.y = pk2(y[2], y[3]); o.z = pk2(y[4], y[5]); o.w = pk2(y[6], y[7]);
            R[i] = o;
            *(u32x4*)(dN + (size_t)(tok0 + tg * 8 + i) * 512) = o;
        }
#undef UNPK
    }
    if (dT) {
        bf16_t* dst = dT + s0 + tg * 8;
#pragma unroll
        for (int k = 0; k < 4; ++k) {
            u32x4 lo, hi;
            lo.x = (R[0][k] & 0xffffu) | (R[1][k] << 16); lo.y = (R[2][k] & 0xffffu) | (R[3][k] << 16); lo.z = (R[4][k] & 0xffffu) | (R[5][k] << 16); lo.w = (R[6][k] & 0xffffu) | (R[7][k] << 16);
            hi.x = (R[0][k] >> 16) | (R[1][k] & 0xffff0000u); hi.y = (R[2][k] >> 16) | (R[3][k] & 0xffff0000u); hi.z = (R[4][k] >> 16) | (R[5][k] & 0xffff0000u); hi.w = (R[6][k] >> 16) | (R[7][k] & 0xffff0000u);
            *(u32x4*)(dst + (size_t)(2 * k) * SEQ) = lo; *(u32x4*)(dst + (size_t)(2 * k + 1) * SEQ) = hi;
        }
    }
}
#define MFMA32(a, b, c) __builtin_amdgcn_mfma_f32_32x32x16_bf16((a), (b), (c), 0, 0, 0)
template <bool SWA>
__device__ __forceinline__ void attn_qtile(const bf16_t* __restrict__ Q, const bf16_t* __restrict__ K, int kpitch, const bf16_t* __restrict__ VT,
                                           const float* __restrict__ C, float sink2, bf16_t* __restrict__ Y, int qt, int lane) {
    const int r = lane & 31, hh = lane >> 5;
    const int pr = ((r >> 2) & 1) * 16 + ((r >> 4) & 1) * 8 + ((r >> 3) & 1) * 4 + (r & 3);
    const int q0 = qt * 32;
    bf16x8 qf[4];
#pragma unroll
    for (int st = 0; st < 4; ++st) qf[st] = *(const bf16x8*)(Q + (size_t)(q0 + r) * 512 + 16 * st + 8 * hh);
    float cq = 0.f; if (!SWA) cq = C[q0 + r];
    float m = -1e30f, lsum = 0.f;
    f32x16 o0, o1;
#pragma unroll
    for (int i = 0; i < 16; ++i) { o0[i] = 0.f; o1[i] = 0.f; }
    const int kt_lo = SWA ? (qt > 4 ? qt - 4 : 0) : 0;
#define ATT_LOAD(KF, VF, CK, kt_) do { const int k0_ = (kt_) * 32; \
        _Pragma("unroll") for (int st = 0; st < 4; ++st) KF[st] = *(const bf16x8*)(K + (size_t)(k0_ + pr) * kpitch + 16 * st + 8 * hh); \
        _Pragma("unroll") for (int dh = 0; dh < 2; ++dh) _Pragma("unroll") for (int s2 = 0; s2 < 2; ++s2) VF[dh][s2] = *(const bf16x8*)(VT + (size_t)(dh * 32 + r) * SEQ + k0_ + 16 * hh + 8 * s2); \
        if (!SWA) { _Pragma("unroll") for (int g = 0; g < 4; ++g) CK[g] = *(const f32x4*)(C + k0_ + 16 * hh + 4 * g); } } while (0)
    bf16x8 kfn[4], vfn[2][2]; f32x4 ckn[4];
#pragma unroll
    for (int g = 0; g < 4; ++g) ckn[g] = (f32x4){0.f, 0.f, 0.f, 0.f};
    ATT_LOAD(kfn, vfn, ckn, kt_lo);
    for (int kt = kt_lo; kt <= qt; ++kt) {
        bf16x8 kf[4], vf[2][2]; f32x4 ckc[4];
#pragma unroll
        for (int st = 0; st < 4; ++st) kf[st] = kfn[st];
#pragma unroll
        for (int dh = 0; dh < 2; ++dh) { vf[dh][0] = vfn[dh][0]; vf[dh][1] = vfn[dh][1]; }
#pragma unroll
        for (int g = 0; g < 4; ++g) ckc[g] = ckn[g];
        if (kt < qt) ATT_LOAD(kfn, vfn, ckn, kt + 1);
        f32x16 sc;
#pragma unroll
        for (int i = 0; i < 16; ++i) sc[i] = 0.f;
#pragma unroll
        for (int st = 0; st < 4; ++st) sc = MFMA32(kf[st], qf[st], sc);
        if (!SWA) {
#pragma unroll
            for (int g = 0; g < 4; ++g) { const f32x4 ck = ckc[g];
#pragma unroll
                for (int e = 0; e < 4; ++e) sc[4 * g + e] += cq - ck[e]; }
        }
        if (kt == qt) {
#pragma unroll
            for (int i = 0; i < 16; ++i) if (16 * hh + i > r) sc[i] = -INFINITY;
        }
        if (SWA && kt == qt - 4) {
#pragma unroll
            for (int i = 0; i < 16; ++i) if (16 * hh + i <= r) sc[i] = -INFINITY;
        }
        float tm = sc[0];
#pragma unroll
        for (int i = 1; i < 16; ++i) tm = fmaxf(tm, sc[i]);
        tm = fmaxf(tm, __shfl_xor(tm, 32));
        const float mn = fmaxf(m, tm), alpha = __builtin_amdgcn_exp2f(m - mn);
        m = mn;
        float ps = 0.f;
#pragma unroll
        for (int i = 0; i < 16; ++i) { sc[i] = __builtin_amdgcn_exp2f(sc[i] - mn); ps += sc[i]; }
        lsum = lsum * alpha + ps;
#pragma unroll
        for (int i = 0; i < 16; ++i) { o0[i] *= alpha; o1[i] *= alpha; }
        u32x4 pw0, pw1;
        pw0.x = pk2(sc[0], sc[1]); pw0.y = pk2(sc[2], sc[3]); pw0.z = pk2(sc[4], sc[5]); pw0.w = pk2(sc[6], sc[7]);
        pw1.x = pk2(sc[8], sc[9]); pw1.y = pk2(sc[10], sc[11]); pw1.z = pk2(sc[12], sc[13]); pw1.w = pk2(sc[14], sc[15]);
        const bf16x8 pf0 = __builtin_bit_cast(bf16x8, pw0), pf1 = __builtin_bit_cast(bf16x8, pw1);
        o0 = MFMA32(vf[0][0], pf0, o0); o0 = MFMA32(vf[0][1], pf1, o0);
        o1 = MFMA32(vf[1][0], pf0, o1); o1 = MFMA32(vf[1][1], pf1, o1);
    }
    float lt = lsum + __shfl_xor(lsum, 32);
    if (SWA) lt += __builtin_amdgcn_exp2f(sink2 - m);
    const float inv = 1.f / lt;
    bf16_t* yrow = Y + (size_t)(q0 + r) * 512 + 4 * hh;
#pragma unroll
    for (int g = 0; g < 4; ++g) {
        u32x2 a, c;
        a.x = pk2(o0[4 * g] * inv, o0[4 * g + 1] * inv); a.y = pk2(o0[4 * g + 2] * inv, o0[4 * g + 3] * inv);
        c.x = pk2(o1[4 * g] * inv, o1[4 * g + 1] * inv); c.y = pk2(o1[4 * g + 2] * inv, o1[4 * g + 3] * inv);
        *(u32x2*)(yrow + 8 * g) = a; *(u32x2*)(yrow + 32 + 8 * g) = c;
    }
}
constexpr int AT_SLOT = 10240, AT_K = 0, AT_V = 4608, AT_C = 9728;
__device__ __forceinline__ float xmax32(float v) { auto rr = __builtin_amdgcn_permlane32_swap(__float_as_uint(v), __float_as_uint(v), false, false); return fmaxf(__uint_as_float(rr[0]), __uint_as_float(rr[1])); }
template <bool SWA>
__device__ __forceinline__ void attn_compute(const LAS unsigned char* sl, const bf16x8 (&qf)[4], float cq, float& m, float& lsum, f32x16& o0, f32x16& o1,
                                             bool diag, bool wedge, int pr, int r, int hh) {
    bf16x8 kf[4], vf[2][2]; f32x4 ckv[4];
#pragma unroll
    for (int st = 0; st < 4; ++st) kf[st] = *(const LAS bf16x8*)(sl + AT_K + pr * 144 + 32 * st + 16 * hh);
    if (!SWA) {
#pragma unroll
        for (int g = 0; g < 4; ++g) ckv[g] = *(const LAS f32x4*)(sl + AT_C + 64 * hh + 16 * g);
    }
#pragma unroll
    for (int dh = 0; dh < 2; ++dh)
#pragma unroll
        for (int s = 0; s < 2; ++s) vf[dh][s] = *(const LAS bf16x8*)(sl + AT_V + (dh * 32 + r) * 80 + 32 * hh + 16 * s);
    __builtin_amdgcn_sched_barrier(0);
    f32x16 sc;
#pragma unroll
    for (int i = 0; i < 16; ++i) sc[i] = 0.f;
#pragma unroll
    for (int st = 0; st < 4; ++st) sc = MFMA32(kf[st], qf[st], sc);
    if (!SWA) {
#pragma unroll
        for (int g = 0; g < 4; ++g)
#pragma unroll
            for (int e = 0; e < 4; ++e) sc[4 * g + e] += cq - ckv[g][e];
    }
    if (diag) {
#pragma unroll
        for (int i = 0; i < 16; ++i) if (16 * hh + i > r) sc[i] = -INFINITY;
    }
    if (SWA && wedge) {
#pragma unroll
        for (int i = 0; i < 16; ++i) if (16 * hh + i <= r) sc[i] = -INFINITY;
    }
    float tm = sc[0];
#pragma unroll
    for (int i = 1; i < 16; ++i) tm = fmaxf(tm, sc[i]);
    tm = xmax32(tm);
    if (__any(tm > m)) {
        const float mn = fmaxf(m, tm), alpha = __builtin_amdgcn_exp2f(m - mn);
        m = mn; lsum *= alpha;
#pragma unroll
        for (int i = 0; i < 16; ++i) { o0[i] *= alpha; o1[i] *= alpha; }
    }
    float ps = 0.f;
#pragma unroll
    for (int i = 0; i < 16; ++i) { sc[i] = __builtin_amdgcn_exp2f(sc[i] - m); ps += sc[i]; }
    lsum += ps;
    u32x4 pw0, pw1;
    pw0.x = pk2(sc[0], sc[1]); pw0.y = pk2(sc[2], sc[3]); pw0.z = pk2(sc[4], sc[5]); pw0.w = pk2(sc[6], sc[7]);
    pw1.x = pk2(sc[8], sc[9]); pw1.y = pk2(sc[10], sc[11]); pw1.z = pk2(sc[12], sc[13]); pw1.w = pk2(sc[14], sc[15]);
    const bf16x8 pf0 = __builtin_bit_cast(bf16x8, pw0), pf1 = __builtin_bit_cast(bf16x8, pw1);
    o0 = MFMA32(vf[0][0], pf0, o0); o0 = MFMA32(vf[0][1], pf1, o0);
    o1 = MFMA32(vf[1][0], pf0, o1); o1 = MFMA32(vf[1][1], pf1, o1);
}
template <bool SWA>
__device__ __forceinline__ void attn_block(LAS unsigned char* lds, const bf16_t* __restrict__ Q, const bf16_t* __restrict__ K, int kpitch, const bf16_t* __restrict__ VT,
                                           const float* __restrict__ C, float sink2, bf16_t* __restrict__ Y, int qt, int t_lo, int t_hi, int wave, int lane) {
    const int r = lane & 31, hh = lane >> 5;
    const int pr = ((r >> 2) & 1) * 16 + ((r >> 4) & 1) * 8 + ((r >> 3) & 1) * 4 + (r & 3);
    const int q0 = qt * 32;
    const bool isK = wave < 4; const int chunk = (wave & 3) * 64 + lane;
    const bf16_t* gsrc = isK ? K + (size_t)(chunk >> 3) * kpitch + (chunk & 7) * 8 : VT + (size_t)(chunk >> 2) * SEQ + (chunk & 3) * 8;
    const int gstep = isK ? 32 * kpitch : 32;
    const int ldst = isK ? AT_K + (chunk >> 3) * 144 + (chunk & 7) * 16 : AT_V + (chunk >> 2) * 80 + (chunk & 3) * 16;
    const bool doC = !SWA && wave == 0 && lane < 8;
#define AB_LD(t_) (*(const u32x4*)(gsrc + (size_t)((t_) < t_hi ? (t_) : t_hi) * gstep))
#define AB_LDC(t_) (*(const u32x4*)(C + ((t_) < t_hi ? (t_) : t_hi) * 32 + lane * 4))
#define AB_WR(slot_, v_, c_) do { LAS unsigned char* sl_ = lds + (slot_) * AT_SLOT; *(LAS u32x4*)(sl_ + ldst) = (v_); if (doC) *(LAS u32x4*)(sl_ + AT_C + lane * 16) = (c_); } while (0)
    u32x4 R0 = AB_LD(t_lo), R1 = AB_LD(t_lo + 1), R2 = AB_LD(t_lo + 2);
    u32x4 C0 = {0u, 0u, 0u, 0u}, C1 = C0, C2 = C0;
    if (doC) { C0 = AB_LDC(t_lo); C1 = AB_LDC(t_lo + 1); C2 = AB_LDC(t_lo + 2); }
    bf16x8 qf[4];
#pragma unroll
    for (int st = 0; st < 4; ++st) qf[st] = *(const bf16x8*)(Q + (size_t)(q0 + r) * 512 + 16 * st + 8 * hh);
    float cq = 0.f; if (!SWA) cq = C[q0 + r];
    float m = -1e30f, lsum = 0.f;
    f32x16 o0, o1;
#pragma unroll
    for (int i = 0; i < 16; ++i) { o0[i] = 0.f; o1[i] = 0.f; }
    AB_WR(0, R0, C0);
#define AB_ITER(t_, RL, CL, RW, CW, SLOT_CUR, SLOT_NEXT) do { \
        RL = AB_LD((t_) + 3); if (doC) CL = AB_LDC((t_) + 3); \
        if ((t_) + 1 <= t_hi) AB_WR(SLOT_NEXT, RW, CW); \
        __syncthreads(); \
        const bool active_ = SWA ? ((t_) <= qt && (t_) >= qt - 4) : ((t_) <= qt); \
        if (active_) attn_compute<SWA>(lds + (SLOT_CUR) * AT_SLOT, qf, cq, m, lsum, o0, o1, (t_) == qt, (t_) == qt - 4, pr, r, hh); \
    } while (0)
    for (int t = t_lo; t <= t_hi; t += 3) {
        AB_ITER(t, R0, C0, R1, C1, 0, 1);
        if (t + 1 > t_hi) break;
        AB_ITER(t + 1, R1, C1, R2, C2, 1, 2);
        if (t + 2 > t_hi) break;
        AB_ITER(t + 2, R2, C2, R0, C0, 2, 0);
    }
    __syncthreads();
#undef AB_ITER
#undef AB_LD
#undef AB_LDC
#undef AB_WR
    float lt = lsum + __shfl_xor(lsum, 32);
    if (SWA) lt += __builtin_amdgcn_exp2f(sink2 - m);
    const float inv = 1.f / lt;
    bf16_t* yrow = Y + (size_t)(q0 + r) * 512 + 4 * hh;
#pragma unroll
    for (int g = 0; g < 4; ++g) {
        u32x2 a, c;
        a.x = pk2(o0[4 * g] * inv, o0[4 * g + 1] * inv); a.y = pk2(o0[4 * g + 2] * inv, o0[4 * g + 3] * inv);
        c.x = pk2(o1[4 * g] * inv, o1[4 * g + 1] * inv); c.y = pk2(o1[4 * g + 2] * inv, o1[4 * g + 3] * inv);
        *(u32x2*)(yrow + 8 * g) = a; *(u32x2*)(yrow + 32 + 8 * g) = c;
    }
}
__device__ __forceinline__ void m1_item(unsigned char* ws, int it, int lane) {
    const int r = lane & 31, hh = lane >> 5;
    const int dvt = it & 3, c = (it >> 2) & 15, bh = it >> 6;
    const bf16_t* VTp = (const bf16_t*)(ws + O_MVT) + ((size_t)bh * 128 + dvt * 32 + r) * SEQ + c * 128 + 8 * hh;
    const bf16_t* KTp = (const bf16_t*)(ws + O_KT) + ((size_t)bh * 128 + r) * SEQ + c * 128 + 8 * hh;
    const float* MPp = (const float*)(ws + O_MP) + (size_t)bh * SEQ + c * 128 + 8 * hh;
    const float mx = ((const float*)(ws + O_MCH))[(bh * 16 + c) * 4 + 1];
    f32x16 acc[4];
#pragma unroll
    for (int d = 0; d < 4; ++d)
#pragma unroll
        for (int i = 0; i < 16; ++i) acc[d][i] = 0.f;
    float dn[4] = {0.f, 0.f, 0.f, 0.f};
#pragma unroll 1
    for (int st = 0; st < 8; ++st) {
        const bf16x8 vf = *(const bf16x8*)(VTp + 16 * st);
        const f32x4 pa = *(const f32x4*)(MPp + 16 * st), pb = *(const f32x4*)(MPp + 16 * st + 4);
        float wk[8];
#pragma unroll
        for (int e = 0; e < 4; ++e) { wk[e] = __expf(pa[e] - mx); wk[4 + e] = __expf(pb[e] - mx); }
#pragma unroll
        for (int d = 0; d < 4; ++d) {
            const u32x4 kr = *(const u32x4*)(KTp + (size_t)d * 32 * SEQ + 16 * st);
            const float k0 = bflo(kr.x) * wk[0], k1 = bfhi(kr.x) * wk[1], k2 = bflo(kr.y) * wk[2], k3 = bfhi(kr.y) * wk[3];
            const float k4 = bflo(kr.z) * wk[4], k5 = bfhi(kr.z) * wk[5], k6 = bflo(kr.w) * wk[6], k7 = bfhi(kr.w) * wk[7];
            dn[d] += ((k0 + k1) + (k2 + k3)) + ((k4 + k5) + (k6 + k7));
            u32x4 kw; kw.x = pk2(k0, k1); kw.y = pk2(k2, k3); kw.z = pk2(k4, k5); kw.w = pk2(k6, k7);
            acc[d] = MFMA32(vf, __builtin_bit_cast(bf16x8, kw), acc[d]);
        }
    }
    bf16_t* DCT = (bf16_t*)(ws + O_DCT) + (size_t)(bh * 16 + c) * 16384;
#pragma unroll
    for (int d = 0; d < 4; ++d) {
#pragma unroll
        for (int g4 = 0; g4 < 4; ++g4) { int og = (dvt * 32 + 8 * g4 + 4 * hh) * 128 + d * 32 + r; asm volatile("" : "+v"(og)); bf16_t* pg = DCT + og;
            pg[0] = (bf16_t)pk2(acc[d][4 * g4], 0.f); pg[128] = (bf16_t)pk2(acc[d][4 * g4 + 1], 0.f); pg[256] = (bf16_t)pk2(acc[d][4 * g4 + 2], 0.f); pg[384] = (bf16_t)pk2(acc[d][4 * g4 + 3], 0.f); }
        const float t = dn[d] + __shfl_xor(dn[d], 32);
        if (dvt == 0 && hh == 0) ((float*)(ws + O_DN))[(bh * 16 + c) * 128 + d * 32 + r] = t;
    }
}
__device__ __forceinline__ void phase_m2(unsigned char* ws, int gtid, int NT) {
    const float* MCH = (const float*)(ws + O_MCH);
    for (int e = gtid; e < BG * 4 * 2048; e += NT) {
        const int bh = e >> 11, pp = e & 2047;
        const bf16_t* src = (const bf16_t*)(ws + O_DCT) + (size_t)bh * 16 * 16384 + 8 * pp;
        bf16_t* dst = (bf16_t*)(ws + O_CT) + (size_t)bh * 16 * 16384 + 8 * pp;
        u32x4 d[15]; float dec[15];
#pragma unroll
        for (int c = 0; c < 15; ++c) { d[c] = *(const u32x4*)(src + (size_t)c * 16384); dec[c] = MCH[(bh * 16 + c) * 4 + 2]; }
        float cs[8] = {0.f, 0.f, 0.f, 0.f, 0.f, 0.f, 0.f, 0.f};
        *(u32x4*)dst = (u32x4){0u, 0u, 0u, 0u};
#pragma unroll
        for (int c = 0; c < 15; ++c) {
            cs[0] = dec[c] * cs[0] + bflo(d[c].x); cs[1] = dec[c] * cs[1] + bfhi(d[c].x); cs[2] = dec[c] * cs[2] + bflo(d[c].y); cs[3] = dec[c] * cs[3] + bfhi(d[c].y);
            cs[4] = dec[c] * cs[4] + bflo(d[c].z); cs[5] = dec[c] * cs[5] + bfhi(d[c].z); cs[6] = dec[c] * cs[6] + bflo(d[c].w); cs[7] = dec[c] * cs[7] + bfhi(d[c].w);
            u32x4 o; o.x = pk2(cs[0], cs[1]); o.y = pk2(cs[2], cs[3]); o.z = pk2(cs[4], cs[5]); o.w = pk2(cs[6], cs[7]);
            *(u32x4*)(dst + (size_t)(c + 1) * 16384) = o;
        }
    }
    for (int e = gtid; e < BG * 4 * 128; e += NT) {
        const int bh = e >> 7, dk = e & 127; float n = 0.f;
        for (int c = 0; c < 16; ++c) { const size_t off = (size_t)(bh * 16 + c) * 128 + dk; ((float*)(ws + O_NN))[off] = n; n = MCH[(bh * 16 + c) * 4 + 2] * n + ((const float*)(ws + O_DN))[off]; }
    }
}
__device__ __forceinline__ void m3_item(unsigned char* ws, int l, int it, int lane) {
    const int r = lane & 31, hh = lane >> 5;
    const int pr = ((r >> 2) & 1) * 16 + ((r >> 4) & 1) * 8 + ((r >> 3) & 1) * 4 + (r & 3);
    const int tt = ((it >> 11) & 1) ? (it & 3) : 3 - (it & 3), c = (it >> 2) & 15, bh = it >> 6, b = bh >> 2, h = bh & 3;
    const int ts = c * 128 + tt * 32 + r;
    const size_t trow = (size_t)b * SEQ + ts;
    bf16x8 qf[8];
    const bf16_t* Qp = (const bf16_t*)(ws + O_MQC) + trow * 512 + h * 128 + 8 * hh;
#pragma unroll
    for (int k = 0; k < 8; ++k) qf[k] = *(const bf16x8*)(Qp + 16 * k);
    const float Et = ((const float*)(ws + O_ME))[(size_t)bh * SEQ + ts], bt = ((const float*)(ws + O_MBT))[(size_t)bh * SEQ + ts];
    const float mc = ((const float*)(ws + O_MCH))[(bh * 16 + c) * 4];
    const float winter = __expf(mc - Et);
    f32x16 acc[4];
#pragma unroll
    for (int d = 0; d < 4; ++d)
#pragma unroll
        for (int i = 0; i < 16; ++i) acc[d][i] = 0.f;
    const bf16_t* CTp = (const bf16_t*)(ws + O_CT) + (size_t)(bh * 16 + c) * 16384 + (size_t)r * 128 + 8 * hh;
    const float* NNp = (const float*)(ws + O_NN) + (size_t)(bh * 16 + c) * 128 + 8 * hh;
    float qn = 0.f;
#pragma unroll
    for (int k = 0; k < 8; ++k) {
#pragma unroll
        for (int d = 0; d < 4; ++d) acc[d] = MFMA32(*(const bf16x8*)(CTp + (size_t)d * 32 * 128 + 16 * k), qf[k], acc[d]);
        const f32x4 na = *(const f32x4*)(NNp + 16 * k), nb = *(const f32x4*)(NNp + 16 * k + 4);
        const u32x4 qw = __builtin_bit_cast(u32x4, qf[k]);
        qn += bflo(qw.x) * na[0] + bfhi(qw.x) * na[1] + bflo(qw.y) * na[2] + bfhi(qw.y) * na[3] + bflo(qw.z) * nb[0] + bfhi(qw.z) * nb[1] + bflo(qw.w) * nb[2] + bfhi(qw.w) * nb[3];
        asm volatile("" ::: "memory");
    }
    qn += __shfl_xor(qn, 32);
#pragma unroll
    for (int d = 0; d < 4; ++d)
#pragma unroll
        for (int i = 0; i < 16; ++i) acc[d][i] *= winter;
    float dpart = 0.f;
    const bf16_t* Kb = (const bf16_t*)(ws + O_MKC) + ((size_t)b * SEQ + c * 128 + pr) * 512 + h * 128 + 8 * hh;
    const bf16_t* Vb = (const bf16_t*)(ws + O_MVT) + ((size_t)bh * 128 + r) * SEQ + c * 128 + 16 * hh;
    const float* MPb = (const float*)(ws + O_MP) + (size_t)bh * SEQ + c * 128 + 16 * hh;
    for (int st = 0; st <= tt; ++st) {
        f32x16 sc;
#pragma unroll
        for (int i = 0; i < 16; ++i) sc[i] = 0.f;
#pragma unroll
        for (int k = 0; k < 8; ++k) { sc = MFMA32(*(const bf16x8*)(Kb + (size_t)st * 32 * 512 + 16 * k), qf[k], sc); if (k == 3) asm volatile("" ::: "memory"); }
        asm volatile("" ::: "memory");
#pragma unroll
        for (int g = 0; g < 4; ++g) { const f32x4 pv = *(const f32x4*)(MPb + st * 32 + 4 * g);
#pragma unroll
            for (int e = 0; e < 4; ++e) { const int i = 4 * g + e;
                const bool ok = (st < tt) || (16 * hh + i <= r);
                const float w = ok ? __expf(pv[e] - Et) : 0.f;
                sc[i] = ok ? sc[i] * w : 0.f; dpart += sc[i]; } }
        u32x4 pw0, pw1;
        pw0.x = pk2(sc[0], sc[1]); pw0.y = pk2(sc[2], sc[3]); pw0.z = pk2(sc[4], sc[5]); pw0.w = pk2(sc[6], sc[7]);
        pw1.x = pk2(sc[8], sc[9]); pw1.y = pk2(sc[10], sc[11]); pw1.z = pk2(sc[12], sc[13]); pw1.w = pk2(sc[14], sc[15]);
        const bf16x8 pf0 = __builtin_bit_cast(bf16x8, pw0), pf1 = __builtin_bit_cast(bf16x8, pw1);
#pragma unroll
        for (int d = 0; d < 4; ++d) {
            acc[d] = MFMA32(*(const bf16x8*)(Vb + (size_t)d * 32 * SEQ + st * 32), pf0, acc[d]);
            acc[d] = MFMA32(*(const bf16x8*)(Vb + (size_t)d * 32 * SEQ + st * 32 + 8), pf1, acc[d]);
            if (d == 1) asm volatile("" ::: "memory");
        }
    }
    const float den = winter * qn + (dpart + __shfl_xor(dpart, 32));
    const float dinv = 1.f / fmaxf(fabsf(den), __expf(-(bt + Et)));
    float ss = 0.f;
#pragma unroll
    for (int d = 0; d < 4; ++d)
#pragma unroll
        for (int i = 0; i < 16; ++i) { acc[d][i] *= dinv; ss += acc[d][i] * acc[d][i]; }
    ss += __shfl_xor(ss, 32);
    const float rn = rsqrtf(ss * (1.f / 128.f) + EPS);
    const float* onorm = (const float*)(ws + O_PAR) + PAR_ON + l * 512 + h * 128 + 4 * hh;
    const bf16_t* mo = (const bf16_t*)(ws + O_U) + trow * LDU + UC_MO + h * 128 + 4 * hh;
    bf16_t* y = (bf16_t*)(ws + O_Y) + (size_t)2 * MG * 512 + trow * 512 + h * 128 + 4 * hh;
#pragma unroll
    for (int d = 0; d < 4; ++d)
#pragma unroll
        for (int g = 0; g < 4; ++g) {
            const int dv = d * 32 + 8 * g;
            const f32x4 wn = *(const f32x4*)(onorm + dv); const u32x2 og = *(const u32x2*)(mo + dv);
            const float y0 = acc[d][4 * g] * rn * wn[0] * sigm(bflo(og.x)), y1 = acc[d][4 * g + 1] * rn * wn[1] * sigm(bfhi(og.x));
            const float y2 = acc[d][4 * g + 2] * rn * wn[2] * sigm(bflo(og.y)), y3 = acc[d][4 * g + 3] * rn * wn[3] * sigm(bfhi(og.y));
            u32x2 o; o.x = pk2(y0, y1); o.y = pk2(y2, y3); *(u32x2*)(y + dv) = o;
            if (g & 1) asm volatile("" ::: "memory");
        }
}

#define XB_TMO      128
#define XB_XCNT(j)  (256  + 64 * (j))
#define XB_XSUB(j)  (1280 + 64 * (j))
#define XB_XGEN(j)  (2304 + 64 * (j))
#define XB_TOP      3328
#define XB_TOPGEN   3392
#define XCD_BAR_WORDS 3456
#define XB_SPIN_CAP (1u << 18)

__device__ __forceinline__ unsigned xb_ld(unsigned* p)              { return __hip_atomic_load(p, __ATOMIC_RELAXED, __HIP_MEMORY_SCOPE_AGENT); }
__device__ __forceinline__ unsigned xb_add(unsigned* p, unsigned v) { return __hip_atomic_fetch_add(p, v, __ATOMIC_RELAXED, __HIP_MEMORY_SCOPE_AGENT); }
__device__ __forceinline__ unsigned xb_xcc_id() { return (unsigned)__builtin_amdgcn_s_getreg((3 << 11) | 20) & 0xFu; }
#define XB_SPIN(cond, bar) do { unsigned _sp = 0; while (cond) { __builtin_amdgcn_s_sleep(1); \
    if ((++_sp & 255u) == 0u) { if (xb_ld(&(bar)[XB_TMO])) break; if (_sp > XB_SPIN_CAP) { atomicAdd(&(bar)[XB_TMO], 1u); break; } } } } while (0)

struct XcdBarrier {
    unsigned* bar; unsigned x;
    volatile LAS unsigned* st;
};

__device__ __forceinline__ XcdBarrier xcd_barrier_post(unsigned* bar, volatile LAS unsigned* st) {
    XcdBarrier b; b.bar = bar; b.x = xb_xcc_id(); b.st = st;
    if (threadIdx.x == 0) (void)xb_add(&bar[XB_XCNT(b.x)], 1u);
    return b;
}
__device__ __forceinline__ void xcd_barrier_complete(unsigned* bar, unsigned x, unsigned& nloc, unsigned& nx) {
    const unsigned G = gridDim.x * gridDim.y * gridDim.z;
    unsigned sum, cnt, mine, sp = 0u;
    for (;;) {
        sum = 0u; cnt = 0u; mine = 0u;
#pragma unroll
        for (unsigned j = 0; j < 16; ++j) { const unsigned c = xb_ld(&bar[XB_XCNT(j)]); sum += c; cnt += (c > 0u) ? 1u : 0u; mine = (j == x) ? c : mine; }
        if (sum == G) break;
        __builtin_amdgcn_s_sleep(1);
        if ((++sp & 255u) == 0u) { if (xb_ld(&bar[XB_TMO])) break; if (sp > XB_SPIN_CAP) { atomicAdd(&bar[XB_TMO], 1u); break; } }
    }
    nloc = mine > 0u ? mine : 1u; nx = cnt > 0u ? cnt : 1u;
}

__device__ __forceinline__ void xcd_barrier(const XcdBarrier& b) {
    asm volatile("s_waitcnt vmcnt(0)" ::: "memory");
    __syncthreads();
    if (threadIdx.x == 0) {
        unsigned* bar = b.bar;
        __builtin_amdgcn_s_waitcnt(0);
        unsigned nloc = b.st[0], nx = b.st[1];
        if (nloc == 0u) { xcd_barrier_complete(bar, b.x, nloc, nx); b.st[0] = nloc; b.st[1] = nx; }
        const unsigned old = xb_add(&bar[XB_XSUB(b.x)], 1u);
        const unsigned gen = old / nloc;
        if (old + 1u == (gen + 1u) * nloc) {
            __builtin_amdgcn_fence(__ATOMIC_RELEASE, "agent");
            asm volatile("s_waitcnt vmcnt(0)" ::: "memory");
            const unsigned og = xb_add(&bar[XB_TOP], 1u);
            const unsigned tg = og / nx;
            if (og + 1u == (tg + 1u) * nx) xb_add(&bar[XB_TOPGEN], 1u);
            else XB_SPIN(xb_ld(&bar[XB_TOPGEN]) == tg, bar);
            __builtin_amdgcn_fence(__ATOMIC_ACQUIRE, "agent");
            xb_add(&bar[XB_XGEN(b.x)], 1u);
            asm volatile("s_waitcnt vmcnt(0)" ::: "memory");
        } else {
            XB_SPIN(xb_ld(&bar[XB_XGEN(b.x)]) == gen, bar);
            __builtin_amdgcn_fence(__ATOMIC_ACQUIRE, "agent");
            asm volatile("s_waitcnt vmcnt(0)" ::: "memory");
        }
    }
    __syncthreads();
}


__global__ void __launch_bounds__(NTHR, 2) fwd_kernel(KP p) {
    extern __shared__ __attribute__((aligned(16))) unsigned char lds_raw[];
    LAS unsigned char* lds = (LAS unsigned char*)lds_raw;
    cg::grid_group grid = cg::this_grid();
    const int tid = threadIdx.x, lane0 = tid & 63, wave = __builtin_amdgcn_readfirstlane(tid >> 6);
    const int G = gridDim.x, gw0 = blockIdx.x * NWAVES + wave, NWV = G * NWAVES, NT = G * NTHR;
    unsigned char* ws0 = p.ws;
    volatile LAS unsigned* MISC = (volatile LAS unsigned*)(lds + 131072);
    if (tid < 64) MISC[tid] = 0u;
    __syncthreads();
    XcdBarrier bar = xcd_barrier_post((unsigned*)(ws0 + O_BAR), MISC + 8);
#ifndef PM
#define PM 0xFFFF
#endif
#ifndef PROBE_ID
#define PROBE_ID -1
#define PROBE_REP 1
#endif
#ifndef PM4
#define PM4 7
#endif
#define XB ((bf16_t*)(ws + O_XB))
#define RS ((float*)(ws + O_RS))
#define U ((bf16_t*)(ws + O_U))
    for (int pc = p.ph_lo; pc < p.ph_hi; ++pc) {
        int id = 0, g = 0, l = 0;
        if (pc > 0) { const int q_ = pc - 1, r_ = q_ % (1 + DEPTH * 9); g = q_ / (1 + DEPTH * 9); if (r_ == 0) id = 1; else { l = (r_ - 1) / 9; id = 2 + (r_ - 1) % 9; } }
        const size_t goff = (size_t)g * MG * DM;
        const int nrep = (PROBE_ID == id) ? PROBE_REP : 1;
        for (int rep_ = 0; rep_ < nrep; ++rep_) {
            size_t zo_ = 0; int lane = lane0, gw = gw0; asm volatile("" : "+s"(zo_), "+v"(lane), "+s"(gw));
            unsigned char* ws = p.ws + zo_;
            const int gtid = gw * 64 + lane; (void)gtid;
            if (!((PM >> id) & 1)) continue;
            switch (id) {
    case 0: { phase_p0(p, ws, lds, gw, NWV, wave, lane); } break;

        case 1: { phase_x0(p.in[0] + goff, XB, RS, gw, NWV, lane); } break;
            case 2: { {
                pg8::Gemm gm{XB, (const bf16_t*)(ws + O_WIN) + (size_t)l * NINP * DM, MG, NINP, DM}; pg8::StaticOrder S; S.init(MG, NINP, G, (int)blockIdx.x);
                pg8::EpiA E{0, 0, RS, U, LDU, (float*)(ws + O_SG), nullptr, 0, nullptr};
                pg8::gemm_phase<pg8::EpiA, pg8::StaticOrder, true, true>(lds, gm, S, E);
            } } break;
            case 3: { {
                constexpr int N_SCAN = BG * 12, N_HN3 = 3 * (MG / 8), N_HK = MG / 32, N_ST = 34 * (MG / 64);
                const int sw = (wave == 7 && (int)blockIdx.x < N_SCAN) ? (int)blockIdx.x : -1;
                if (sw >= 0) { for (int it = sw; it < N_SCAN; it += G) gate_scan_item(ws, l, it, lane); }
                else {
                    const int nscanw = (N_SCAN < G ? N_SCAN : G);
                    const int wi = (int)blockIdx.x < nscanw ? (int)blockIdx.x * 7 + wave : nscanw * 7 + ((int)blockIdx.x - nscanw) * 8 + wave;
                    const int nw = NWV - nscanw;
                    for (int it = wi; it < N_HN3 + N_HK + N_ST; it += nw) {
                        if (it < N_HN3) headnorm_item(ws, l, it % 3, it / 3, lane);
                        else if (it < N_HN3 + N_HK) headnorm_item(ws, l, 3, it - N_HN3, lane);
                        else stream_item(ws, l, it - N_HN3 - N_HK, lane);
                    }
                }
            } } break;
            case 4: { {
                if (PM4 & 1) for (int it = gw; it < BG * 4 * 16 * 4; it += NWV) m1_item(ws, it, lane);
                __syncthreads();
                if (PM4 & 2) for (int it = (int)blockIdx.x; it < BG * 8 * 4; it += G) {
                    const int b = it >> 5, h = (it >> 2) & 7, jp = it & 3;
                    const bf16_t* Q = (const bf16_t*)(ws + O_FQN) + (size_t)b * SEQ * 512 + h * 64; const bf16_t* K = (const bf16_t*)(ws + O_FKN) + (size_t)b * SEQ * 512 + h * 64;
                    const bf16_t* VT = (const bf16_t*)(ws + O_FVT) + (size_t)(b * 8 + h) * 64 * SEQ; const float* C = (const float*)(ws + O_FC) + (size_t)(b * 8 + h) * SEQ;
                    bf16_t* Y = (bf16_t*)(ws + O_Y) + (size_t)b * SEQ * 512 + h * 64;
                    attn_block<false>(lds, Q, K, 512, VT, C, 0.f, Y, 8 * (7 - jp) + wave, 0, 8 * (7 - jp) + 7, wave, lane);
                    attn_block<false>(lds, Q, K, 512, VT, C, 0.f, Y, 8 * jp + wave, 0, 8 * jp + 7, wave, lane);
                }
                if (PM4 & 4) for (int it = (int)blockIdx.x; it < BG * 2 * 32; it += G) {
                    const int b = it >> 6, hk = (it >> 5) & 1, u = it & 31, hq = hk * 4 + (wave & 3), qt = 2 * u + (wave >> 2);
                    const bf16_t* Q = (const bf16_t*)(ws + O_SQR) + (size_t)b * SEQ * 512 + hq * 64; const bf16_t* K = (const bf16_t*)(ws + O_SKR) + (size_t)b * SEQ * 128 + hk * 64;
                    const bf16_t* VT = (const bf16_t*)(ws + O_SVT) + (size_t)(b * 2 + hk) * 64 * SEQ;
                    bf16_t* Y = (bf16_t*)(ws + O_Y) + (size_t)MG * 512 + (size_t)b * SEQ * 512 + hq * 64;
                    attn_block<true>(lds, Q, K, 128, VT, nullptr, ((const float*)(ws + O_PAR))[PAR_SINK + l * 8 + hq] * LOG2E, Y, qt, (2 * u > 4 ? 2 * u - 4 : 0), 2 * u + 1, wave, lane);
                }
            } } break;
            case 5: { phase_m2(ws, gtid, NT); } break;
            case 6: { { for (int it = gw; it < BG * 4 * 16 * 4; it += NWV) m3_item(ws, l, it, lane); } } break;
            case 7: { {
                pg8::Gemm gm{(const bf16_t*)(ws + O_Y), (const bf16_t*)(ws + O_WB) + (size_t)l * 3 * DM * 512, 3 * MG, 3 * DM, 512}; pg8::DiagOrder S; S.init(MG, DM, G, (int)blockIdx.x);
                pg8::EpiM E{MG / 256, (bf16_t*)(ws + O_MRG), U + UC_G, LDU};
                pg8::gemm_phase<pg8::EpiM, pg8::DiagOrder, true, true>(lds, gm, S, E);
            } } break;
            case 8: { {
                pg8::Gemm gm{(const bf16_t*)(ws + O_MRG), (const bf16_t*)(ws + O_WOUT) + (size_t)l * DM * DM, MG, DM, DM}; pg8::StaticOrder S; S.init(MG, DM, G, (int)blockIdx.x);
                pg8::EpiB E{l == 0 ? p.in[0] + goff : (const float*)nullptr, nullptr, XB, RS};
                pg8::gemm_phase<pg8::EpiB, pg8::StaticOrder, true, true>(lds, gm, S, E);
            } } break;
            case 9: { {
                pg8::Gemm gm{XB, (const bf16_t*)(ws + O_WUP) + (size_t)l * FF * DM, MG, FF, DM}; pg8::StaticOrder S; S.init(MG, FF, G, (int)blockIdx.x);
                pg8::EpiA E{2, 0, RS, U  , FF, nullptr, nullptr, 0, nullptr};
                pg8::gemm_phase<pg8::EpiA, pg8::StaticOrder, true, true>(lds, gm, S, E);
            } } break;
            case 10: { {
                pg8::Gemm gm{U  , (const bf16_t*)(ws + O_WDN) + (size_t)l * DM * FF, MG, DM, FF}; pg8::StaticOrder S; S.init(MG, DM, G, (int)blockIdx.x);
                pg8::EpiB E{nullptr, l == DEPTH - 1 ? p.out + goff : (float*)nullptr, XB, RS};
                pg8::gemm_phase<pg8::EpiB, pg8::StaticOrder, true, true>(lds, gm, S, E);
            } } break;
            default: break;
            }
        }
        if (pc + 1 < p.ph_hi) { if (p.ph_hi < 0) grid.sync(); else xcd_barrier(bar); }
    }
}
constexpr int N_PHASES = 1 + NG * (1 + DEPTH * 9);

#ifndef MK_MULTI
#define MK_MULTI 0
#endif
extern "C" void kernel_launch(void* const* d_in, const int* in_sizes, int n_in, void* d_out, int out_size, void* d_ws, size_t ws_size, hipStream_t stream) {
    static int grid = 0;
    if (grid == 0) {
        if (n_in != 19 || out_size != NB * SEQ * DM || ws_size < WS_NEED) { fprintf(stderr, "kernel_launch: unexpected problem (n_in %d out %d ws %zu need %zu)\n", n_in, out_size, ws_size, (size_t)WS_NEED); grid = -1; return; }
        int dev = 0, cus = 0, per_cu = 0;
        hipGetDevice(&dev); hipDeviceGetAttribute(&cus, hipDeviceAttributeMultiprocessorCount, dev);
        if (hipFuncSetAttribute((const void*)fwd_kernel, hipFuncAttributeMaxDynamicSharedMemorySize, LDS_BYTES) != hipSuccess) { fprintf(stderr, "kernel_launch: hipFuncSetAttribute failed\n"); grid = -1; return; }
        hipOccupancyMaxActiveBlocksPerMultiprocessor(&per_cu, (const void*)fwd_kernel, NTHR, LDS_BYTES);
        (void)hipGetLastError();
        if (per_cu < 1) { fprintf(stderr, "kernel_launch: occupancy query says %d blocks per CU\n", per_cu); per_cu = 1; }
        grid = cus;
    }
    if (grid < 0) return;
    if (hipMemsetAsync((char*)d_ws + O_BAR, 0, 16384, stream) != hipSuccess) { fprintf(stderr, "kernel_launch: memset failed\n"); return; }
    KP a{};
    for (int i = 0; i < 19; ++i) a.in[i] = (const float*)d_in[i];
    a.out = (float*)d_out; a.ws = (unsigned char*)d_ws;
#if MK_MULTI
    for (int ph = 0; ph < N_PHASES; ++ph) { a.ph_lo = ph; a.ph_hi = ph + 1; hipLaunchKernelGGL(fwd_kernel, dim3(grid), dim3(NTHR), LDS_BYTES, stream, a); }
#else
    a.ph_lo = 0; a.ph_hi = N_PHASES;
    void* args[] = {&a};
    hipError_t e = hipLaunchCooperativeKernel((const void*)fwd_kernel, dim3(grid), dim3(NTHR), args, LDS_BYTES, stream);
    if (e != hipSuccess) fprintf(stderr, "kernel_launch: cooperative launch failed: %s (grid %d)\n", hipGetErrorString(e), grid);
#endif
}
```
